# Optimizing an MI355X kernel written in HIP

```python
import math
import jax, jax.numpy as jnp
from jax import lax
import numpy as np

D_MODEL = 1024
BATCH = 8
SEQ = 8192
DEPTH = 1

CHUNK = 64
EPS = 1e-6
ATT_HEADS = 8
ATT_KV_HEADS = 2
ATT_HEAD_DIM = 64
IDX_HEADS = 8
IDX_HEAD_DIM = 64
TOPK_MAX = 256
Q_BLOCK = 128
MLSTM_HEADS = 4
MLSTM_QK_DIM = 64
MLSTM_V_DIM = 128
CONV_WIDTH = 4
MIX_A = ATT_HEADS * ATT_HEAD_DIM
MIX_B = MLSTM_HEADS * MLSTM_V_DIM
D_FF = 2816
SPLIT_WIDTHS = (
    ATT_HEADS * ATT_HEAD_DIM,
    ATT_KV_HEADS * ATT_HEAD_DIM,
    ATT_KV_HEADS * ATT_HEAD_DIM,
    IDX_HEADS * IDX_HEAD_DIM,
    IDX_HEAD_DIM,
    IDX_HEADS,
    MIX_B,
    MIX_B,
    MLSTM_HEADS,
    MLSTM_HEADS,
    MIX_B,
    D_MODEL,
    D_MODEL,
)
D_IN = sum(SPLIT_WIDTHS)

kernel_name = "hybrid_dsa_mlstm_macaron_block"


def rms_norm(x, g):
    xf = x.astype(jnp.float32)
    y = xf * lax.rsqrt(jnp.mean(xf * xf, axis=-1, keepdims=True) + EPS)
    return (y * g.astype(jnp.float32)).astype(x.dtype)


def swiglu_ffn(x, g, w_gate, w_up, w_down):
    h = rms_norm(x, g)
    return (jax.nn.silu(h @ w_gate) * (h @ w_up)) @ w_down


def split_columns(p):
    parts, off = [], 0
    for w in SPLIT_WIDTHS:
        parts.append(p[..., off:off + w])
        off += w
    return parts


def dsa_attention(q, k, v, iq, ik, iw):
    B, S = q.shape[0], q.shape[1]
    k_sel = min(TOPK_MAX, S // 4)
    nb = S // Q_BLOCK
    reps = ATT_HEADS // ATT_KV_HEADS
    idx_scale = (IDX_HEAD_DIM ** -0.5) * (IDX_HEADS ** -0.5)
    att_scale = ATT_HEAD_DIM ** -0.5
    key_pos = jnp.arange(S)

    qb = q.reshape(B, nb, Q_BLOCK, ATT_KV_HEADS, reps, ATT_HEAD_DIM).transpose(1, 0, 2, 3, 4, 5)
    iqb = iq.reshape(B, nb, Q_BLOCK, IDX_HEADS, IDX_HEAD_DIM).transpose(1, 0, 2, 3, 4)
    iwb = iw.reshape(B, nb, Q_BLOCK, IDX_HEADS).transpose(1, 0, 2, 3)
    ids = jnp.arange(nb, dtype=jnp.int32)

    def block(args):
        q_blk, iq_blk, iw_blk, bi = args
        t = bi * Q_BLOCK + jnp.arange(Q_BLOCK)
        logits = jnp.einsum('bqhd,bsd->bqhs', iq_blk, ik)
        score = jnp.einsum('bqhs,bqh->bqs', jax.nn.relu(logits), iw_blk).astype(jnp.float32) * idx_scale
        limit = (t // CHUNK + 1) * CHUNK
        allowed = key_pos[None, :] < limit[:, None]
        score = jnp.where(allowed[None], score, -jnp.inf)
        top_s, top_i = lax.top_k(score, k_sel)
        valid = jnp.isfinite(top_s)
        kg = jax.vmap(lambda kb, ib: kb[ib])(k, top_i)
        vg = jax.vmap(lambda vb, ib: vb[ib])(v, top_i)
        s = jnp.einsum('bqgrd,bqkgd->bqgrk', q_blk, kg).astype(jnp.float32) * att_scale
        s = jnp.where(valid[:, :, None, None, :], s, -jnp.inf)
        p = jax.nn.softmax(s, axis=-1).astype(vg.dtype)
        return jnp.einsum('bqgrk,bqkgd->bqgrd', p, vg)

    o = lax.map(block, (qb, iqb, iwb, ids))
    return o.transpose(1, 0, 2, 3, 4, 5).reshape(B, S, MIX_A)


def mlstm_branch(xm, vm, ig, fg, o_pre, conv_w, conv_b, w_mq, w_mk, b_i, b_f, head_g):
    B, S, _ = xm.shape
    H, L = MLSTM_HEADS, CHUNK
    nc = S // L
    xpad = jnp.pad(xm, ((0, 0), (CONV_WIDTH - 1, 0), (0, 0)))
    xc = conv_b + xpad[:, 0:S] * conv_w[0]
    for j in range(1, CONV_WIDTH):
        xc = xc + xpad[:, j:j + S] * conv_w[j]
    xc = jax.nn.silu(xc).reshape(B, S, H, MLSTM_V_DIM)
    q = jnp.einsum('bshc,hcd->bshd', xc, w_mq).astype(jnp.float32) * (MLSTM_QK_DIM ** -0.5)
    k = jnp.einsum('bshc,hcd->bshd', xc, w_mk).astype(jnp.float32)
    v = vm.reshape(B, S, H, MLSTM_V_DIM).astype(jnp.float32)
    log_i = (ig + b_i).astype(jnp.float32)
    log_f = jax.nn.log_sigmoid((fg + b_f).astype(jnp.float32))

    def to_chunks(a):
        a = a.reshape((B, nc, L) + a.shape[2:])
        perm = (1, 0, 3, 2) + tuple(range(4, a.ndim))
        return a.transpose(perm)

    tril = jnp.tril(jnp.ones((L, L), dtype=bool))

    def step(carry, inp):
        C, n, m = carry
        qc, kc, vc, ic, fc = inp
        b = jnp.cumsum(fc, axis=-1)
        D = b[..., :, None] - b[..., None, :] + ic[..., None, :]
        D = jnp.where(tril, D, -jnp.inf)
        inter = b + m[..., None]
        m_t = jnp.maximum(jnp.max(D, axis=-1), inter)
        W = jnp.einsum('bhtd,bhsd->bhts', qc, kc) * jnp.exp(D - m_t[..., None])
        w_int = jnp.exp(inter - m_t)
        num = jnp.einsum('bhts,bhsv->bhtv', W, vc) + w_int[..., None] * jnp.einsum('bhtd,bhdv->bhtv', qc, C)
        den = jnp.sum(W, axis=-1) + w_int * jnp.einsum('bhtd,bhd->bht', qc, n)
        h = num / jnp.maximum(jnp.abs(den), jnp.exp(-m_t))[..., None]
        bL = b[..., -1]
        wk = bL[..., None] - b + ic
        m_new = jnp.maximum(bL + m, jnp.max(wk, axis=-1))
        ws = jnp.exp(wk - m_new[..., None])
        wc = jnp.exp(bL + m - m_new)
        C_new = wc[..., None, None] * C + jnp.einsum('bhs,bhsd,bhsv->bhdv', ws, kc, vc)
        n_new = wc[..., None] * n + jnp.einsum('bhs,bhsd->bhd', ws, kc)
        return (C_new, n_new, m_new), h

    init = (jnp.zeros((B, H, MLSTM_QK_DIM, MLSTM_V_DIM), jnp.float32),
            jnp.zeros((B, H, MLSTM_QK_DIM), jnp.float32),
            jnp.zeros((B, H), jnp.float32))
    _, hs = lax.scan(step, init, (to_chunks(q), to_chunks(k), to_chunks(v), to_chunks(log_i), to_chunks(log_f)))
    h = hs.transpose(1, 0, 3, 2, 4).reshape(B, S, H, MLSTM_V_DIM)
    h = rms_norm(h, head_g.reshape(H, MLSTM_V_DIM)).reshape(B, S, MIX_B).astype(xm.dtype)
    return h * jax.nn.sigmoid(o_pre)


def setup_inputs(seed: int = 0) -> dict:
    key = jax.random.key(seed)
    ks = jax.random.split(key, 32)
    f32 = jnp.float32

    def nrm(k, shape, fan_in):
        return jax.random.normal(k, shape, f32) * (fan_in ** -0.5)

    def gain(k, shape):
        return 1.0 + 0.02 * jax.random.normal(k, shape, f32)

    Ld = DEPTH
    return {
        "x": jax.random.normal(ks[0], (BATCH, SEQ, D_MODEL), f32),
        "ffn1_norm": gain(ks[1], (Ld, D_MODEL)),
        "ffn1_w_gate": nrm(ks[2], (Ld, D_MODEL, D_FF), D_MODEL),
        "ffn1_w_up": nrm(ks[3], (Ld, D_MODEL, D_FF), D_MODEL),
        "ffn1_w_down": nrm(ks[4], (Ld, D_FF, D_MODEL), D_FF),
        "mix_norm": gain(ks[5], (Ld, D_MODEL)),
        "w_in": nrm(ks[6], (Ld, D_MODEL, D_IN), D_MODEL),
        "q_norm": gain(ks[7], (Ld, ATT_HEAD_DIM)),
        "k_norm": gain(ks[8], (Ld, ATT_HEAD_DIM)),
        "idx_k_norm": gain(ks[9], (Ld, IDX_HEAD_DIM)),
        "conv_w": nrm(ks[10], (Ld, CONV_WIDTH, MIX_B), CONV_WIDTH),
        "conv_b": 0.02 * jax.random.normal(ks[11], (Ld, MIX_B), f32),
        "w_mq": nrm(ks[12], (Ld, MLSTM_HEADS, MLSTM_V_DIM, MLSTM_QK_DIM), MLSTM_V_DIM),
        "w_mk": nrm(ks[13], (Ld, MLSTM_HEADS, MLSTM_V_DIM, MLSTM_QK_DIM), MLSTM_V_DIM),
        "b_i": 0.1 * jax.random.normal(ks[14], (Ld, MLSTM_HEADS), f32),
        "b_f": 3.0 + 0.1 * jax.random.normal(ks[15], (Ld, MLSTM_HEADS), f32),
        "m_head_norm": gain(ks[16], (Ld, MIX_B)),
        "w_proj_a": nrm(ks[17], (Ld, MIX_A, D_MODEL), MIX_A),
        "w_proj_b": nrm(ks[18], (Ld, MIX_B, D_MODEL), MIX_B),
        "w_out": nrm(ks[19], (Ld, D_MODEL, D_MODEL), D_MODEL),
        "ffn2_norm": gain(ks[20], (Ld, D_MODEL)),
        "ffn2_w_gate": nrm(ks[21], (Ld, D_MODEL, D_FF), D_MODEL),
        "ffn2_w_up": nrm(ks[22], (Ld, D_MODEL, D_FF), D_MODEL),
        "ffn2_w_down": nrm(ks[23], (Ld, D_FF, D_MODEL), D_FF),
    }


def reference(x, ffn1_norm, ffn1_w_gate, ffn1_w_up, ffn1_w_down, mix_norm, w_in,
              q_norm, k_norm, idx_k_norm, conv_w, conv_b, w_mq, w_mk, b_i, b_f,
              m_head_norm, w_proj_a, w_proj_b, w_out, ffn2_norm, ffn2_w_gate,
              ffn2_w_up, ffn2_w_down):
    B, S, _ = x.shape
    for l in range(DEPTH):
        x = x + 0.5 * swiglu_ffn(x, ffn1_norm[l], ffn1_w_gate[l], ffn1_w_up[l], ffn1_w_down[l])
        h = rms_norm(x, mix_norm[l])
        (aq, ak, av, iq, ik, iw, mx, mv, mi, mf, mo, ga, gb) = split_columns(h @ w_in[l])
        q = rms_norm(aq.reshape(B, S, ATT_HEADS, ATT_HEAD_DIM), q_norm[l])
        k = rms_norm(ak.reshape(B, S, ATT_KV_HEADS, ATT_HEAD_DIM), k_norm[l])
        v = av.reshape(B, S, ATT_KV_HEADS, ATT_HEAD_DIM)
        iq = iq.reshape(B, S, IDX_HEADS, IDX_HEAD_DIM)
        ik = rms_norm(ik, idx_k_norm[l])
        ya = dsa_attention(q, k, v, iq, ik, iw)
        yb = mlstm_branch(mx, mv, mi, mf, mo, conv_w[l], conv_b[l], w_mq[l], w_mk[l],
                          b_i[l], b_f[l], m_head_norm[l])
        merged = jax.nn.sigmoid(ga) * (ya @ w_proj_a[l]) + jax.nn.sigmoid(gb) * (yb @ w_proj_b[l])
        x = x + merged @ w_out[l]
        x = x + 0.5 * swiglu_ffn(x, ffn2_norm[l], ffn2_w_gate[l], ffn2_w_up[l], ffn2_w_down[l])
    return x
```

```cpp
#include <hip/hip_runtime.h>
#include <hip/hip_cooperative_groups.h>
#include <cstdio>
#include <cstdint>
namespace cg = cooperative_groups;
#define DBG_ZERO_YA 0
#define DBG_TWICE 0
#define DBG_NOSEL 0

#define LAS __attribute__((address_space(3)))
typedef unsigned short bf16_t;
typedef short bf16x8 __attribute__((ext_vector_type(8)));
typedef float f32x4 __attribute__((ext_vector_type(4)));
typedef unsigned u32x4 __attribute__((ext_vector_type(4)));
typedef unsigned u32x2 __attribute__((ext_vector_type(2)));
typedef __bf16 bf2_t __attribute__((ext_vector_type(2)));

constexpr int MROWS = 65536, DM = 1024, FF = 2816, SEQ = 8192, NB = 8;
constexpr int LDP = 5120;
constexpr int C_AQ = 0, C_AK = 512, C_AV = 640, C_IQ = 768, C_IK = 1280, C_MX = 1344, C_MV = 1856, C_MO = 2368, C_GA = 2880, C_GB = 3904, C_SM = 4928;
constexpr float EPS = 1e-6f;
constexpr size_t MiB = 1u << 20;
constexpr size_t WS_SS0 = 0, WS_SS1 = 256 * 1024, WS_SS2 = 512 * 1024;
constexpr size_t WS_DN = 1 * MiB;
constexpr size_t WS_ML = 2 * MiB, WS_BL = 2 * MiB + 16384, WS_MS = 2 * MiB + 32768;
constexpr size_t WS_BAR = 2 * MiB + 65536;
constexpr size_t WS_SM = 3 * MiB;
constexpr size_t WS_W1 = 8 * MiB, WS_W2 = 19 * MiB, WS_W3 = 25 * MiB, WS_W4 = 36 * MiB, WS_WIN = 42 * MiB, WS_WA = 52 * MiB, WS_WB = 53 * MiB, WS_WO = 54 * MiB, WS_WQK = 56 * MiB;
constexpr size_t WS_XB = 64 * MiB;
constexpr size_t WS_P = 192 * MiB;
constexpr size_t WS_MG = 832 * MiB;
constexpr size_t WS_IKC = 832 * MiB;
constexpr size_t WS_KVC = 840 * MiB;
constexpr size_t WS_QK = 960 * MiB;
constexpr size_t WS_END = 1024 * MiB;
constexpr int LDS_BYTES = 156 * 1024;

__device__ __forceinline__ unsigned cvt_pk_bf16(float lo, float hi) { unsigned r; asm volatile("v_cvt_pk_bf16_f32 %0, %1, %2" : "=v"(r) : "v"(lo), "v"(hi)); return r; }
__device__ __forceinline__ float bflo(unsigned u) { return __uint_as_float(u << 16); }
__device__ __forceinline__ float bfhi(unsigned u) { return __uint_as_float(u & 0xffff0000u); }
__device__ __forceinline__ float bf1(bf16_t u) { return __uint_as_float(((unsigned)u) << 16); }
__device__ __forceinline__ bf16_t f2bf(float f) { return (bf16_t)(cvt_pk_bf16(f, 0.f) & 0xffffu); }
__device__ __forceinline__ float wave_sum(float v) {
#pragma unroll
    for (int o = 1; o < 64; o <<= 1) v += __shfl_xor(v, o);
    return v;
}
__device__ __forceinline__ float wave_max(float v) {
#pragma unroll
    for (int o = 1; o < 64; o <<= 1) v = fmaxf(v, __shfl_xor(v, o));
    return v;
}
__device__ __forceinline__ float sigmoidf_(float x) { return __builtin_amdgcn_rcpf(1.f + __expf(-x)); }
__device__ __forceinline__ float dot2bf(unsigned a, unsigned b, float c) { const unsigned aa = a, bb = b; return __builtin_amdgcn_fdot2_f32_bf16(__builtin_bit_cast(bf2_t, aa), __builtin_bit_cast(bf2_t, bb), c, false); }
__device__ __forceinline__ float relu_(float x) { const int i = __float_as_int(x); return __int_as_float(i > 0 ? i : 0); }
__device__ __forceinline__ void lds_fence() { asm volatile("s_waitcnt lgkmcnt(0)" ::: "memory"); }
__device__ __forceinline__ void unpack8(u32x4 v, float* f) {
    f[0] = bflo(v.x); f[1] = bfhi(v.x); f[2] = bflo(v.y); f[3] = bfhi(v.y); f[4] = bflo(v.z); f[5] = bfhi(v.z); f[6] = bflo(v.w); f[7] = bfhi(v.w);
}
__device__ __forceinline__ u32x4 pack8(const float* f) {
    u32x4 o; o.x = cvt_pk_bf16(f[0], f[1]); o.y = cvt_pk_bf16(f[2], f[3]); o.z = cvt_pk_bf16(f[4], f[5]); o.w = cvt_pk_bf16(f[6], f[7]); return o;
}

namespace pg8 {
constexpr int BM = 256, BK = 64, HALF = 128, HTB = HALF * BK * 2, NXCD = 8, WGM = 8;
__host__ __device__ __forceinline__ int lds_byte(int r, int c) { const int st = (r >> 4) * 2 + (c >> 5), rr = r & 15, cc = c & 31, ob = rr * 64 + cc * 2; return st * 1024 + (ob ^ (((ob >> 9) & 1) << 5)); }
__host__ __device__ __forceinline__ void stage_rc(int b, int& R, int& C) { const int st = b / 1024, sb = b % 1024, swz = sb ^ (((sb >> 9) & 1) << 5); R = (st >> 1) * 16 + swz / 64; C = (st & 1) * 32 + (swz % 64) / 2; }
__host__ __device__ __forceinline__ int perm32(int rho) { const int n = rho >> 4, i = rho & 15; return 8 * (i >> 2) + 4 * n + (i & 3); }
struct Unit { int pm, pn; };
struct Gemm { const bf16_t* A; const bf16_t* Bt; int lda, ldb, M, N, K; };
struct StaticOrder {
    int nM, nN, nwg, G, c;
    __device__ void init(int M, int N, int G_, int c_) { nM = M / BM; nN = N / BM; nwg = nM * nN; G = G_; c = c_; }
    __device__ bool next(int i, Unit& u) const {
        const long L = (long)i * G + c; if (L >= nwg) return false;
        int wgid = (int)L; { const int q = nwg / NXCD, r = nwg % NXCD, xcd = wgid % NXCD, off = wgid / NXCD; wgid = (xcd < r ? xcd * (q + 1) : r * (q + 1) + (xcd - r) * q) + off; }
        const int nig = WGM * nN, gid = wgid / nig, fm = gid * WGM, gsz = (nM - fm) < WGM ? (nM - fm) : WGM;
        u.pm = fm + ((wgid % nig) % gsz); u.pn = (wgid % nig) / gsz; return true;
    }
};

template <class Epi>
__device__ __forceinline__ void gemm_phase(LAS unsigned char* lds, const Gemm g, const StaticOrder& S, const Epi& E) {
    int tid_ = threadIdx.x; asm volatile("" : "+v"(tid_));
    const int tid = tid_, wid = __builtin_amdgcn_readfirstlane(tid >> 6), lane = tid & 63, wr = wid >> 2, wc = wid & 3, fr = lane & 15, fq = lane >> 4;
    const int K = g.K, nt = K / BK;
    unsigned voffA[2], voffB[2];
#pragma unroll
    for (int i = 0; i < 2; ++i) { int R, C; stage_rc(tid * 16 + i * 8192, R, C); const int Rb = (R & ~31) + perm32(R & 31);
        voffA[i] = (unsigned)(R * g.lda + C) * 2u; voffB[i] = (unsigned)(Rb * g.ldb + C) * 2u; }
    const size_t kstep = (size_t)(BK * 2);
    const size_t hsA = (size_t)HALF * g.lda * 2, hsB = (size_t)HALF * g.ldb * 2;
    const size_t tsA = 2 * hsA, tsB = 2 * hsB;
    const unsigned ldsw = (unsigned)wid * 1024u;
    const int aoff = lds_byte(wr * 64 + fr, fq * 8), boff = lds_byte(wc * 32 + fr, fq * 8);
#define PG8_SA(b, h) (((b) * 2 + (h)) * HTB)
#define PG8_SB(b, h) ((4 + (b) * 2 + (h)) * HTB)
#define PG8_STAGE(bufoff, gbase, voff) do { _Pragma("unroll") for (int _i = 0; _i < 2; ++_i) \
        __builtin_amdgcn_global_load_lds((const unsigned*)((const char*)(gbase) + (voff)[_i]), (LAS unsigned*)(lds + (bufoff) + ldsw + _i * 8192), 16, 0, 0); } while (0)
#define PG8_LDA(dst, b, h) do { _Pragma("unroll") for (int m = 0; m < 4; ++m) _Pragma("unroll") for (int k = 0; k < 2; ++k) dst[m][k] = *(const LAS bf16x8*)(lds + PG8_SA(b, h) + aoff + m * 2048 + k * 1024); } while (0)
#define PG8_LDB(dst, b, h) do { _Pragma("unroll") for (int n = 0; n < 2; ++n) _Pragma("unroll") for (int k = 0; k < 2; ++k) dst[n][k] = *(const LAS bf16x8*)(lds + PG8_SB(b, h) + boff + n * 2048 + k * 1024); } while (0)
#define PG8_MMA(ai, bj, At, Bt) do { __builtin_amdgcn_s_setprio(1); _Pragma("unroll") for (int m = 0; m < 4; ++m) _Pragma("unroll") for (int n = 0; n < 2; ++n) _Pragma("unroll") for (int k = 0; k < 2; ++k) \
        acc[ai][bj][m][n] = __builtin_amdgcn_mfma_f32_16x16x32_bf16(Bt[n][k], At[m][k], acc[ai][bj][m][n], 0, 0, 0); __builtin_amdgcn_s_setprio(0); } while (0)
#define PG8_WAIT_V(n) asm volatile("s_waitcnt vmcnt(" #n ")" ::: "memory")
#define PG8_WAIT_L(n) asm volatile("s_waitcnt lgkmcnt(" #n ")" ::: "memory")
#define PG8_BAR __builtin_amdgcn_s_barrier()
#define PG8_SCHED __builtin_amdgcn_sched_barrier(0)
    Unit cur, nxt; int ui = 0;
    if (!S.next(0, cur)) return;
    f32x4 acc[2][2][4][2];
#pragma unroll
    for (int a = 0; a < 2; ++a)
#pragma unroll
        for (int b = 0; b < 2; ++b)
#pragma unroll
            for (int m = 0; m < 4; ++m)
#pragma unroll
                for (int n = 0; n < 2; ++n) acc[a][b][m][n] = (f32x4){0.f, 0.f, 0.f, 0.f};
    bf16x8 At[4][2], B0[2][2], B1[2][2];
    const char* cA = (const char*)g.A + (size_t)cur.pm * tsA; const char* cB = (const char*)g.Bt + (size_t)cur.pn * tsB;
    PG8_STAGE(PG8_SB(0, 0), cB, voffB); PG8_STAGE(PG8_SB(0, 1), cB + hsB, voffB); PG8_STAGE(PG8_SA(0, 0), cA, voffA); PG8_STAGE(PG8_SA(0, 1), cA + hsA, voffA);
    if (wr == 1) PG8_BAR;
    PG8_WAIT_V(2); PG8_BAR;
    PG8_STAGE(PG8_SB(1, 0), cB + kstep, voffB); PG8_STAGE(PG8_SA(1, 0), cA + kstep, voffA); PG8_STAGE(PG8_SB(1, 1), cB + hsB + kstep, voffB);
    PG8_WAIT_V(6); PG8_BAR;
    for (;;) {
        const bool has_next = S.next(ui + 1, nxt);
        const char* nA = has_next ? (const char*)g.A + (size_t)nxt.pm * tsA : cA; const char* nB = has_next ? (const char*)g.Bt + (size_t)nxt.pn * tsB : cB;
        for (int t = 0; t < nt; t += 2) {
            const bool last = (t == nt - 2);
            const char* a1 = cA + (size_t)(t + 1) * kstep;
            const char* a2 = last ? nA : cA + (size_t)(t + 2) * kstep; const char* b2 = last ? nB : cB + (size_t)(t + 2) * kstep;
            const char* a3 = a2 + kstep; const char* b3 = b2 + kstep;
            PG8_LDB(B0, 0, 0); PG8_LDB(B1, 0, 1); PG8_SCHED; PG8_LDA(At, 0, 0); PG8_STAGE(PG8_SA(1, 1), a1 + hsA, voffA);
            PG8_WAIT_V(8); PG8_WAIT_L(0); PG8_BAR; PG8_MMA(0, 0, At, B0); PG8_MMA(0, 1, At, B1); PG8_BAR; PG8_SCHED;
            PG8_LDA(At, 0, 1); PG8_STAGE(PG8_SB(0, 0), b2, voffB); PG8_STAGE(PG8_SB(0, 1), b2 + hsB, voffB); PG8_STAGE(PG8_SA(0, 0), a2, voffA);
            PG8_WAIT_V(8); PG8_WAIT_L(0); PG8_BAR; PG8_MMA(1, 0, At, B0); PG8_MMA(1, 1, At, B1); PG8_BAR; PG8_SCHED;
            PG8_LDB(B0, 1, 0); PG8_LDB(B1, 1, 1); PG8_SCHED; PG8_LDA(At, 1, 0); PG8_STAGE(PG8_SA(0, 1), a2 + hsA, voffA);
            PG8_WAIT_V(8); PG8_WAIT_L(0); PG8_BAR; PG8_MMA(0, 0, At, B0); PG8_MMA(0, 1, At, B1); PG8_BAR; PG8_SCHED;
            PG8_LDA(At, 1, 1); PG8_STAGE(PG8_SB(1, 0), b3, voffB); PG8_STAGE(PG8_SB(1, 1), b3 + hsB, voffB); PG8_STAGE(PG8_SA(1, 0), a3, voffA);
            PG8_WAIT_V(8); PG8_WAIT_L(0); PG8_BAR; PG8_MMA(1, 0, At, B0); PG8_MMA(1, 1, At, B1); PG8_BAR; PG8_SCHED;
        }
        if (wr == 0) PG8_BAR;
        E(acc, cur, wr, wc, fr, fq);
        if (!has_next) break;
#pragma unroll
        for (int a = 0; a < 2; ++a)
#pragma unroll
            for (int b = 0; b < 2; ++b)
#pragma unroll
                for (int m = 0; m < 4; ++m)
#pragma unroll
                    for (int n = 0; n < 2; ++n) acc[a][b][m][n] = (f32x4){0.f, 0.f, 0.f, 0.f};
        cur = nxt; cA = nA; cB = nB; ++ui;
        if (wr == 1) PG8_BAR;
    }
    PG8_WAIT_V(0);
    PG8_BAR;
#undef PG8_SA
#undef PG8_SB
#undef PG8_STAGE
#undef PG8_LDA
#undef PG8_LDB
#undef PG8_MMA
#undef PG8_WAIT_V
#undef PG8_WAIT_L
#undef PG8_BAR
#undef PG8_SCHED
}

typedef f32x4 AccT[2][2][4][2];
struct EpiSwiGLU {
    bf16_t* O; const float* ss;
    __device__ __forceinline__ void operator()(const AccT& acc, const Unit& u, int wr, int wc, int fr, int fq) const {
        const int row0 = u.pm * BM + wr * 64 + fr, col = u.pn * 128 + wc * 32 + 8 * fq;
#pragma unroll
        for (int ai = 0; ai < 2; ++ai)
#pragma unroll
            for (int m = 0; m < 4; ++m) {
                const int row = row0 + ai * HALF + m * 16;
                const float rs = rsqrtf(ss[row] * (1.f / 1024.f) + EPS);
                float o[8];
#pragma unroll
                for (int n = 0; n < 2; ++n)
#pragma unroll
                    for (int j = 0; j < 4; ++j) { const float gt = acc[ai][0][m][n][j] * rs, up = acc[ai][1][m][n][j] * rs; o[n * 4 + j] = gt * up * sigmoidf_(gt); }
                *(u32x4*)(O + (size_t)row * FF + col) = pack8(o);
            }
    }
};
template <bool WRITE_XB> struct EpiRes {
    const float* res; float* out; bf16_t* xb; float* ss; float alpha;
    __device__ __forceinline__ void operator()(const AccT& acc, const Unit& u, int wr, int wc, int fr, int fq) const {
        const int row0 = u.pm * BM + wr * 64 + fr, col0 = u.pn * BM + wc * 32 + 8 * fq;
#pragma unroll
        for (int ai = 0; ai < 2; ++ai)
#pragma unroll
            for (int m = 0; m < 4; ++m) {
                const int row = row0 + ai * HALF + m * 16; float sq = 0.f;
#pragma unroll
                for (int bj = 0; bj < 2; ++bj) {
                    const size_t off = (size_t)row * DM + col0 + bj * HALF;
                    const f32x4 r0 = *(const f32x4*)(res + off), r1 = *(const f32x4*)(res + off + 4);
                    const f32x4 v0 = r0 + acc[ai][bj][m][0] * alpha, v1 = r1 + acc[ai][bj][m][1] * alpha;
                    *(f32x4*)(out + off) = v0; *(f32x4*)(out + off + 4) = v1;
                    if (WRITE_XB) {
                        u32x4 w; w.x = cvt_pk_bf16(v0[0], v0[1]); w.y = cvt_pk_bf16(v0[2], v0[3]); w.z = cvt_pk_bf16(v1[0], v1[1]); w.w = cvt_pk_bf16(v1[2], v1[3]);
                        *(u32x4*)(xb + off) = w;
                        sq += v0[0] * v0[0] + v0[1] * v0[1] + v0[2] * v0[2] + v0[3] * v0[3] + v1[0] * v1[0] + v1[1] * v1[1] + v1[2] * v1[2] + v1[3] * v1[3];
                    }
                }
                if (WRITE_XB) { sq += __shfl_xor(sq, 16); sq += __shfl_xor(sq, 32); if (fq == 0) atomicAdd(ss + row, sq); }
            }
    }
};
struct EpiP {
    bf16_t* P; float* SM; const float* ss;
    __device__ __forceinline__ void operator()(const AccT& acc, const Unit& u, int wr, int wc, int fr, int fq) const {
        const int row0 = u.pm * BM + wr * 64 + fr, col0 = u.pn * BM + wc * 32 + 8 * fq;
#pragma unroll
        for (int ai = 0; ai < 2; ++ai)
#pragma unroll
            for (int m = 0; m < 4; ++m) {
                const int row = row0 + ai * HALF + m * 16;
                const float rs = rsqrtf(ss[row] * (1.f / 1024.f) + EPS);
#pragma unroll
                for (int bj = 0; bj < 2; ++bj) {
                    const int col = col0 + bj * HALF;
                    const f32x4 v0 = acc[ai][bj][m][0] * rs, v1 = acc[ai][bj][m][1] * rs;
                    u32x4 w; w.x = cvt_pk_bf16(v0[0], v0[1]); w.y = cvt_pk_bf16(v0[2], v0[3]); w.z = cvt_pk_bf16(v1[0], v1[1]); w.w = cvt_pk_bf16(v1[2], v1[3]);
                    *(u32x4*)(P + (size_t)row * LDP + col) = w;
                    if (col >= C_SM && col < C_SM + 16) { float* s = SM + (size_t)row * 16 + (col - C_SM); *(f32x4*)s = v0; *(f32x4*)(s + 4) = v1; }
                }
            }
    }
};
struct EpiBf16 {
    bf16_t* O; int ldc;
    __device__ __forceinline__ void operator()(const AccT& acc, const Unit& u, int wr, int wc, int fr, int fq) const {
        const int row0 = u.pm * BM + wr * 64 + fr, col0 = u.pn * BM + wc * 32 + 8 * fq;
#pragma unroll
        for (int ai = 0; ai < 2; ++ai)
#pragma unroll
            for (int m = 0; m < 4; ++m) {
                const int row = row0 + ai * HALF + m * 16;
#pragma unroll
                for (int bj = 0; bj < 2; ++bj) {
                    const f32x4 v0 = acc[ai][bj][m][0], v1 = acc[ai][bj][m][1];
                    u32x4 w; w.x = cvt_pk_bf16(v0[0], v0[1]); w.y = cvt_pk_bf16(v0[2], v0[3]); w.z = cvt_pk_bf16(v1[0], v1[1]); w.w = cvt_pk_bf16(v1[2], v1[3]);
                    *(u32x4*)(O + (size_t)row * ldc + col0 + bj * HALF) = w;
                }
            }
    }
};
template <int PASS> struct EpiMerge {
    const bf16_t* P; bf16_t* MG; int goff;
    __device__ __forceinline__ void operator()(const AccT& acc, const Unit& u, int wr, int wc, int fr, int fq) const {
        const int row0 = u.pm * BM + wr * 64 + fr, col0 = u.pn * BM + wc * 32 + 8 * fq;
#pragma unroll
        for (int ai = 0; ai < 2; ++ai)
#pragma unroll
            for (int m = 0; m < 4; ++m) {
                const int row = row0 + ai * HALF + m * 16;
#pragma unroll
                for (int bj = 0; bj < 2; ++bj) {
                    const int col = col0 + bj * HALF;
                    float gt[8], o[8]; unpack8(*(const u32x4*)(P + (size_t)row * LDP + goff + col), gt);
                    if (PASS == 1) unpack8(*(const u32x4*)(MG + (size_t)row * DM + col), o);
#pragma unroll
                    for (int j = 0; j < 8; ++j) { const float a = acc[ai][bj][m][j >> 2][j & 3] * sigmoidf_(gt[j]); o[j] = (PASS == 1) ? o[j] + a : a; }
                    *(u32x4*)(MG + (size_t)row * DM + col) = pack8(o);
                }
            }
    }
};
}

struct Args {
    const float* in[24];
    float* out;
    unsigned char* ws;
};
enum { I_X = 0, I_F1N, I_F1G, I_F1U, I_F1D, I_MIXN, I_WIN, I_QN, I_KN, I_IKN, I_CW, I_CB, I_WMQ, I_WMK, I_BI, I_BF, I_MHN, I_WPA, I_WPB, I_WOUT, I_F2N, I_F2G, I_F2U, I_F2D };

template <class F> __device__ __forceinline__ void prep_tile(bf16_t* Bt, int K, int n0, int k0, const F src, float* tile) {
    const int tid = threadIdx.x;
    { const int nn = tid & 63, kk = tid >> 6;
#pragma unroll
        for (int i = 0; i < 8; ++i) { const int k = i * 8 + kk; tile[k * 65 + nn] = src(k0 + k, n0 + nn); } }
    __syncthreads();
    { const int nn = tid >> 3, kc = tid & 7; const float* s = tile + (kc * 8) * 65 + nn;
        u32x4 o; o.x = cvt_pk_bf16(s[0], s[65]); o.y = cvt_pk_bf16(s[130], s[195]); o.z = cvt_pk_bf16(s[260], s[325]); o.w = cvt_pk_bf16(s[390], s[455]);
        *(u32x4*)(Bt + (size_t)(n0 + nn) * K + k0 + kc * 8) = o; }
    __syncthreads();
}
struct SrcUp { const float* wg; const float* wu; const float* g;
    __device__ __forceinline__ float operator()(int k, int n) const { const int col = (n >> 8) * 128 + (n & 127); const size_t bj = (size_t)((n >> 7) & 1); const float* w = (const float*)((uintptr_t)wg + ((uintptr_t)wu - (uintptr_t)wg) * bj); return w[(size_t)k * FF + col] * g[k]; } };
struct SrcPlain { const float* w; int ldw;
    __device__ __forceinline__ float operator()(int k, int n) const { return w[(size_t)k * ldw + n]; } };
struct SrcIn { const float* w; const float* g;
    __device__ __forceinline__ float operator()(int k, int n) const {
        int col;
        if (n < 1344) col = n; else if (n < 2368) col = n + 8; else if (n < 4928) col = n + 16;
        else if (n < 4936) col = n - 4928 + 1344; else if (n < 4940) col = n - 4936 + 2376; else if (n < 4944) col = n - 4940 + 2380; else col = -1;
        return col >= 0 ? w[(size_t)k * 4944 + col] * g[k] : 0.f; } };
struct SrcQK { const float* wq; const float* wk;
    __device__ __forceinline__ float operator()(int k, int n) const {
        const int isk = n >> 8, h = (n >> 6) & 3, j = n & 63, hk = k >> 7, c = k & 127;
        if (hk != h) return 0.f;
        const float* w = (const float*)((uintptr_t)wq + ((uintptr_t)wk - (uintptr_t)wq) * (size_t)isk); return w[(size_t)(h * 128 + c) * 64 + j] * (isk ? 1.f : 0.125f); } };

__device__ __forceinline__ void phase0(const Args& a, unsigned char* lds) {
    float* tile = (float*)lds;
    unsigned char* ws = a.ws;
    constexpr int T_UP = 88 * 16, T_DN = 16 * 44, T_IN = 80 * 16, T_PR = 16 * 8, T_WO = 16 * 16, T_QK = 8 * 8;
    constexpr int NITEMS = 2 * T_UP + 2 * T_DN + T_IN + 2 * T_PR + T_WO + T_QK;
    for (int it = blockIdx.x; it < NITEMS; it += gridDim.x) {
        int r = it;
        if (r < T_UP) { SrcUp s{a.in[I_F1G], a.in[I_F1U], a.in[I_F1N]}; prep_tile((bf16_t*)(ws + WS_W1), 1024, (r / 16) * 64, (r % 16) * 64, s, tile); continue; } r -= T_UP;
        if (r < T_UP) { SrcUp s{a.in[I_F2G], a.in[I_F2U], a.in[I_F2N]}; prep_tile((bf16_t*)(ws + WS_W3), 1024, (r / 16) * 64, (r % 16) * 64, s, tile); continue; } r -= T_UP;
        if (r < T_DN) { SrcPlain s{a.in[I_F1D], 1024}; prep_tile((bf16_t*)(ws + WS_W2), FF, (r / 44) * 64, (r % 44) * 64, s, tile); continue; } r -= T_DN;
        if (r < T_DN) { SrcPlain s{a.in[I_F2D], 1024}; prep_tile((bf16_t*)(ws + WS_W4), FF, (r / 44) * 64, (r % 44) * 64, s, tile); continue; } r -= T_DN;
        if (r < T_IN) { SrcIn s{a.in[I_WIN], a.in[I_MIXN]}; prep_tile((bf16_t*)(ws + WS_WIN), 1024, (r / 16) * 64, (r % 16) * 64, s, tile); continue; } r -= T_IN;
        if (r < T_PR) { SrcPlain s{a.in[I_WPA], 1024}; prep_tile((bf16_t*)(ws + WS_WA), 512, (r / 8) * 64, (r % 8) * 64, s, tile); continue; } r -= T_PR;
        if (r < T_PR) { SrcPlain s{a.in[I_WPB], 1024}; prep_tile((bf16_t*)(ws + WS_WB), 512, (r / 8) * 64, (r % 8) * 64, s, tile); continue; } r -= T_PR;
        if (r < T_WO) { SrcPlain s{a.in[I_WOUT], 1024}; prep_tile((bf16_t*)(ws + WS_WO), 1024, (r / 16) * 64, (r % 16) * 64, s, tile); continue; } r -= T_WO;
        { SrcQK s{a.in[I_WMQ], a.in[I_WMK]}; prep_tile((bf16_t*)(ws + WS_WQK), 512, (r / 8) * 64, (r % 8) * 64, s, tile); }
    }
    const int lane = threadIdx.x & 63, gw = blockIdx.x * 8 + (threadIdx.x >> 6), NGW = gridDim.x * 8;
    const float* x = a.in[I_X]; bf16_t* XB = (bf16_t*)(ws + WS_XB);
    float* ss0 = (float*)(ws + WS_SS0); float* ss1 = (float*)(ws + WS_SS1); float* ss2 = (float*)(ws + WS_SS2);
    for (int row = gw; row < MROWS; row += NGW) {
        const f32x4* xr = (const f32x4*)(x + (size_t)row * DM) + lane;
        f32x4 v[4]; float s = 0.f;
#pragma unroll
        for (int j = 0; j < 4; ++j) { v[j] = xr[64 * j]; s += v[j][0] * v[j][0] + v[j][1] * v[j][1] + v[j][2] * v[j][2] + v[j][3] * v[j][3]; }
        s = wave_sum(s);
        if (lane == 0) { ss0[row] = s; ss1[row] = 0.f; ss2[row] = 0.f; }
        unsigned long long* o8 = (unsigned long long*)(XB + (size_t)row * DM) + lane;
#pragma unroll
        for (int j = 0; j < 4; ++j) o8[64 * j] = (unsigned long long)cvt_pk_bf16(v[j][0], v[j][1]) | ((unsigned long long)cvt_pk_bf16(v[j][2], v[j][3]) << 32);
    }
}

__device__ __forceinline__ void phase_postp(const Args& a) {
    unsigned char* ws = a.ws;
    bf16_t* P = (bf16_t*)(ws + WS_P); bf16_t* XC = (bf16_t*)(ws + WS_XB); bf16_t* IKC = (bf16_t*)(ws + WS_IKC); bf16_t* KVC = (bf16_t*)(ws + WS_KVC);
    const int lane = threadIdx.x & 63, gw = blockIdx.x * 8 + (threadIdx.x >> 6), NGW = gridDim.x * 8;
    const int c0 = lane * 8;
    float cw[4][8], cb[8], gq[8], gk[8];
#pragma unroll
    for (int e = 0; e < 8; ++e) {
        cb[e] = a.in[I_CB][c0 + e];
#pragma unroll
        for (int j = 0; j < 4; ++j) cw[j][e] = a.in[I_CW][j * 512 + c0 + e];
        gq[e] = a.in[I_QN][(lane & 7) * 8 + e];
        gk[e] = (lane < 16) ? a.in[I_KN][(lane & 7) * 8 + e] : a.in[I_IKN][(lane & 7) * 8 + e];
    }
    const int koff = (lane < 16) ? (C_AK + lane * 8) : (C_IK + (lane & 7) * 8);
    for (int row = gw; row < MROWS; row += NGW) {
        bf16_t* pr = P + (size_t)row * LDP;
        const int t = row & (SEQ - 1);
        float accv[8];
#pragma unroll
        for (int e = 0; e < 8; ++e) accv[e] = cb[e];
#pragma unroll
        for (int j = 0; j < 4; ++j) {
            const int tt = t - 3 + j;
            if (tt >= 0) { float xf[8]; unpack8(*(const u32x4*)(P + (size_t)(row - 3 + j) * LDP + C_MX + c0), xf);
#pragma unroll
                for (int e = 0; e < 8; ++e) accv[e] += xf[e] * cw[j][e]; }
        }
#pragma unroll
        for (int e = 0; e < 8; ++e) accv[e] = accv[e] * sigmoidf_(accv[e]);
        *(u32x4*)(XC + (size_t)row * 512 + c0) = pack8(accv);
        { float f[8]; unpack8(*(const u32x4*)(pr + C_AQ + c0), f); float s = 0.f;
#pragma unroll
            for (int e = 0; e < 8; ++e) s += f[e] * f[e];
            s += __shfl_xor(s, 1); s += __shfl_xor(s, 2); s += __shfl_xor(s, 4);
            const float rs = rsqrtf(s * (1.f / 64.f) + EPS);
#pragma unroll
            for (int e = 0; e < 8; ++e) f[e] = f[e] * rs * gq[e];
            *(u32x4*)(pr + C_AQ + c0) = pack8(f); }
        { float f[8]; unpack8(*(const u32x4*)(pr + koff), f); float s = 0.f;
#pragma unroll
            for (int e = 0; e < 8; ++e) s += f[e] * f[e];
            s += __shfl_xor(s, 1); s += __shfl_xor(s, 2); s += __shfl_xor(s, 4);
            const float rs = rsqrtf(s * (1.f / 64.f) + EPS);
#pragma unroll
            for (int e = 0; e < 8; ++e) f[e] = f[e] * rs * gk[e];
            if (lane < 16) *(u32x4*)(KVC + (size_t)row * 256 + lane * 8) = pack8(f);
            else if (lane < 24) *(u32x4*)(IKC + ((((size_t)(row >> 4)) * 8 + (lane - 16)) * 16 + (row & 15)) * 8) = pack8(f);
            else if (lane >= 32 && lane < 48) *(u32x4*)(KVC + (size_t)row * 256 + 128 + (lane - 32) * 8) = *(const u32x4*)(pr + C_AV + (lane - 32) * 8); }
    }
}

__device__ __forceinline__ unsigned fkey(float s) { const unsigned u = __float_as_uint(s); return (u & 0x80000000u) ? ~u : (u | 0x80000000u); }


__device__ __forceinline__ unsigned wave_incl_scan_dpp(unsigned x) {
    x += (unsigned)__builtin_amdgcn_update_dpp(0, (int)x, 0x111, 0xf, 0xf, false);
    x += (unsigned)__builtin_amdgcn_update_dpp(0, (int)x, 0x112, 0xf, 0xf, false);
    x += (unsigned)__builtin_amdgcn_update_dpp(0, (int)x, 0x114, 0xf, 0xf, false);
    x += (unsigned)__builtin_amdgcn_update_dpp(0, (int)x, 0x118, 0xf, 0xf, false);
    x += (unsigned)__builtin_amdgcn_update_dpp(0, (int)x, 0x142, 0xa, 0xf, false);
    x += (unsigned)__builtin_amdgcn_update_dpp(0, (int)x, 0x143, 0xc, 0xf, false);
    return x;
}
__device__ __forceinline__ int find_bin(const unsigned* hist, int& need, int lane, int& binc) {
    const int base = 1023 - 16 * lane; unsigned s = 0;
#pragma unroll
    for (int i = 0; i < 16; ++i) { const unsigned w = hist[base - ((i + lane) & 15)]; s += (w & 0xffffu) + (w >> 16); }
    const unsigned p = wave_incl_scan_dpp(s);
    const unsigned long long bal = __ballot(p >= (unsigned)need);
    const int L = bal ? (__ffsll((long long)bal) - 1) : 63;
    const unsigned excl = __shfl(p - s, L);
    int cum = (int)excl, bin = -1, fneed = 1, bc = 1; const int b0 = 1023 - 16 * L;
#pragma unroll
    for (int i = 0; i < 16; ++i) {
        const unsigned w = hist[b0 - i]; const int hi = (int)(w >> 16), lo = (int)(w & 0xffffu);
        if (bin < 0) { if (cum + hi >= need) { bin = 2 * (b0 - i) + 1; fneed = need - cum; bc = hi; } else cum += hi; }
        if (bin < 0) { if (cum + lo >= need) { bin = 2 * (b0 - i); fneed = need - cum; bc = lo; } else cum += lo; }
    }
    if (bin < 0) bin = 0;
    need = fneed; binc = bc; return bin;
}


__device__ __forceinline__ int find_bin128(const unsigned* sh, int& need, int lane, int& binc) {
    const unsigned hi = sh[127 - 2 * lane], lo = sh[126 - 2 * lane]; const unsigned s = hi + lo;
    const unsigned p = wave_incl_scan_dpp(s);
    const unsigned long long bal = __ballot(p >= (unsigned)need);
    const int L = bal ? (__ffsll((long long)bal) - 1) : 63;
    const int excl = (int)__shfl(p - s, L); const int hiL = (int)__shfl(hi, L), loL = (int)__shfl(lo, L);
    int bin, fneed, bc;
    if (excl + hiL >= need) { bin = 127 - 2 * L; fneed = need - excl; bc = hiL; } else { bin = 126 - 2 * L; fneed = need - excl - hiL; bc = loL; }
    if (fneed < 1) fneed = 1;
    need = fneed; binc = bc; return bin;
}

template <bool DUMMY> __device__ __forceinline__ void phase_dsa(const Args& a, unsigned char* lds) {
    unsigned char* ws = a.ws;
    bf16_t* P = (bf16_t*)(ws + WS_P); const float* SM = (const float*)(ws + WS_SM);
    const bf16_t* IKC = (const bf16_t*)(ws + WS_IKC); const bf16_t* KVC = (const bf16_t*)(ws + WS_KVC);
    constexpr int SCS = 8200;
    float* SC = (float*)lds;
    unsigned* HIST = (unsigned*)(lds + 131200);
    int* LIST = (int*)(lds + 131200 + 16384);
    unsigned* QS = (unsigned*)(lds + 131200 + 16384 + 4096);
    int* CNT = (int*)(lds + 131200 + 16384 + 4096 + 4096);
    const float idx_scale = 0.125f * 0.35355339059327373f;
    f32x4 wqv[2]; unsigned qsv[2];
#define DSA_LOAD_ITEM(ITEM) do { const int b_ = (ITEM) & 7, t0_ = ((ITEM) >> 3) * 4; const size_t r_ = (size_t)b_ * SEQ + t0_; \
        int tl_ = threadIdx.x; asm volatile("" : "+v"(tl_)); const int ln_ = tl_ & 63, q4_ = ln_ >> 4; \
        wqv[0] = *(const f32x4*)(SM + (r_ + q4_) * 16); wqv[1] = *(const f32x4*)(SM + (r_ + q4_) * 16 + 4); \
        _Pragma("unroll") for (int i_ = 0; i_ < 2; ++i_) { const int e_ = tl_ + 512 * i_; qsv[i_] = *(const unsigned*)(P + (r_ + (e_ >> 8)) * LDP + C_AQ + (e_ & 255) * 2); } } while (0)
    if ((int)blockIdx.x < 16384) DSA_LOAD_ITEM(blockIdx.x);
    for (int item = blockIdx.x; item < 16384; item += gridDim.x) {
        int tid_ = threadIdx.x; asm volatile("" : "+v"(tid_));
        const int tid = tid_, wave = __builtin_amdgcn_readfirstlane(tid >> 6), lane = tid & 63, quad = lane >> 4, l15 = lane & 15;
        const int b = item & 7, tq = item >> 3, t0 = tq * 4, L = ((t0 >> 6) + 1) * 64;
        const size_t r0 = (size_t)b * SEQ + t0;
        const bool do_sel = (L > 256) && !DBG_NOSEL;
        { u32x4* hz = (u32x4*)HIST; hz[tid] = (u32x4){0u, 0u, 0u, 0u}; hz[tid + 512] = (u32x4){0u, 0u, 0u, 0u}; }
        if (tid < 8) CNT[4 + tid] = 0;
        QS[tid] = qsv[0]; QS[tid + 512] = qsv[1];
        float wq[8];
#pragma unroll
        for (int h = 0; h < 4; ++h) { wq[h] = wqv[0][h] * idx_scale; wq[4 + h] = wqv[1][h] * idx_scale; }
        bf16x8 af[2][2];
#pragma unroll
        for (int T = 0; T < 2; ++T)
#pragma unroll
            for (int ks = 0; ks < 2; ++ks) af[T][ks] = *(const bf16x8*)(P + (r0 + (l15 >> 2)) * LDP + C_IQ + (4 * T + (l15 & 3)) * 64 + ks * 32 + quad * 8);
        const int ngroups = L >> 6;
        const bf16_t* ikb = IKC + (size_t)b * SEQ * 64 + (quad * 16 + l15) * 8;
        bf16x8 B0[4][2], B1[4][2], B2[4][2];
#define IDX_LOAD(BUF, G) do { _Pragma("unroll") for (int tt = 0; tt < 4; ++tt) _Pragma("unroll") for (int ks = 0; ks < 2; ++ks) \
                BUF[tt][ks] = *(const bf16x8*)(ikb + (size_t)(((G) * 4 + tt) * 8 + ks * 4) * 128); } while (0)
        if (wave < ngroups) IDX_LOAD(B0, wave);
        if (wave + 8 < ngroups) IDX_LOAD(B1, wave + 8);
        if (wave + 16 < ngroups) IDX_LOAD(B2, wave + 16);
        lds_fence(); __builtin_amdgcn_s_barrier();
        for (int rep = 0; rep < ((DBG_TWICE & 2) ? 2 : 1); ++rep) {
            const bool hist_on = do_sel && (rep == (((DBG_TWICE & 2) ? 2 : 1) - 1));
#define IDX_COMPUTE(BUF, G) do { _Pragma("unroll") for (int tt = 0; tt < 4; ++tt) { \
                const int key = (G) * 64 + tt * 16 + l15; \
                f32x4 c0 = (f32x4){0.f, 0.f, 0.f, 0.f}, c1 = (f32x4){0.f, 0.f, 0.f, 0.f}; \
                c0 = __builtin_amdgcn_mfma_f32_16x16x32_bf16(af[0][0], BUF[tt][0], c0, 0, 0, 0); \
                c1 = __builtin_amdgcn_mfma_f32_16x16x32_bf16(af[1][0], BUF[tt][0], c1, 0, 0, 0); \
                c0 = __builtin_amdgcn_mfma_f32_16x16x32_bf16(af[0][1], BUF[tt][1], c0, 0, 0, 0); \
                c1 = __builtin_amdgcn_mfma_f32_16x16x32_bf16(af[1][1], BUF[tt][1], c1, 0, 0, 0); \
                float sc = 0.f; \
                _Pragma("unroll") for (int j = 0; j < 4; ++j) { sc += wq[j] * relu_(c0[j]); sc += wq[4 + j] * relu_(c1[j]); } \
                sc += 0.f; \
                SC[quad * SCS + key] = sc; \
                if (hist_on) { const unsigned bin = fkey(sc) >> 21; atomicAdd(&HIST[quad * 1024 + (bin >> 1)], (bin & 1u) ? 0x10000u : 1u); } } } while (0)
            int g = wave;
            for (; g < ngroups; g += 24) {
                IDX_COMPUTE(B0, g);
                if (g + 24 < ngroups) IDX_LOAD(B0, g + 24);
                if (g + 8 < ngroups) { IDX_COMPUTE(B1, g + 8); if (g + 32 < ngroups) IDX_LOAD(B1, g + 32); }
                if (g + 16 < ngroups) { IDX_COMPUTE(B2, g + 16); if (g + 40 < ngroups) IDX_LOAD(B2, g + 40); }
            }
#undef IDX_LOAD
#undef IDX_COMPUTE
        }
        lds_fence(); __builtin_amdgcn_s_barrier();
        if (item + (int)gridDim.x < 16384) DSA_LOAD_ITEM(item + (int)gridDim.x);
        {
            constexpr int CAP = 448;
            const unsigned long long ltmask = (1ull << lane) - 1ull;
            if (!do_sel) {
                const int q = wave >> 1, hf = wave & 1; int* list = LIST + q * 256;
                if (hf == 0) { for (int i = lane; i < 256; i += 64) list[i] = (i < L) ? i : 0; if (lane == 0) CNT[q] = L; }
            } else {
                {
                    const int q = wave >> 1, hf = wave & 1; int* list = LIST + q * 256; const float* sc = SC + q * SCS; unsigned* hist = HIST + q * 1024;
                    const int halfL = L >> 1, beg = hf * halfL, end = beg + halfL;
                    int need = 256, binc = 0;
                    const unsigned b1 = (unsigned)find_bin(hist, need, lane, binc);
                    const int c1 = binc, nsure = 256 - need; const bool store_c = c1 <= CAP;
                    if (hf == 0 && lane == 0) { CNT[12 + q] = (int)b1; CNT[16 + q] = need; CNT[8 + q] = c1; }
                    lds_fence(); __builtin_amdgcn_s_barrier();
                    int cs = 0, cc = 0;
                    for (int i0 = beg + lane * 4; i0 < end; i0 += 256) { const f32x4 v = *(const f32x4*)(sc + i0);
#pragma unroll
                        for (int e = 0; e < 4; ++e) { const unsigned k = fkey(v[e]); const unsigned kb = k >> 21;
                            const bool sure = kb > b1, cand = (kb == b1) && store_c;
                            const unsigned long long ms = __ballot(sure), mc = __ballot(cand);
                            if (ms) { const int p = cs + __popcll(ms & ltmask); const int pp = hf ? nsure - 1 - p : p; if (sure && pp >= 0 && pp < 256) list[pp] = i0 + e; cs += __popcll(ms); }
                            if (mc) { const int p = cc + __popcll(mc & ltmask); const int pp = hf ? c1 - 1 - p : p; if (cand && pp >= 0 && pp < CAP) { hist[2 * pp] = k; hist[2 * pp + 1] = (unsigned)(i0 + e); } cc += __popcll(mc); } } }
                    lds_fence(); __builtin_amdgcn_s_barrier();
                }
                if (wave < 4) {
                    const int q = wave; int* list = LIST + q * 256; unsigned* hist = HIST + q * 1024; unsigned* sh = hist + 896; const float* sc = SC + q * SCS;
                    const unsigned b1 = (unsigned)CNT[12 + q]; int need = CNT[16 + q]; const int c = CNT[8 + q]; const int nsure = 256 - need;
                    if (c <= CAP) {
                        unsigned ck[7]; int ci[7];
#pragma unroll
                        for (int t = 0; t < 7; ++t) { const int i = lane + 64 * t; const bool valid = i < c; ck[t] = valid ? hist[2 * i] : 0u; ci[t] = valid ? (int)hist[2 * i + 1] : -1; }
                        int binc = 0;
                        sh[2 * lane] = 0u; sh[2 * lane + 1] = 0u; lds_fence();
#pragma unroll
                        for (int t = 0; t < 7; ++t) if (ci[t] >= 0) atomicAdd(&sh[(ck[t] >> 14) & 127u], 1u);
                        lds_fence();
                        const unsigned bA = (unsigned)find_bin128(sh, need, lane, binc);
                        lds_fence();
                        sh[2 * lane] = 0u; sh[2 * lane + 1] = 0u; lds_fence();
#pragma unroll
                        for (int t = 0; t < 7; ++t) if (ci[t] >= 0 && ((ck[t] >> 14) & 127u) == bA) atomicAdd(&sh[(ck[t] >> 7) & 127u], 1u);
                        lds_fence();
                        const unsigned bB = (unsigned)find_bin128(sh, need, lane, binc);
                        const unsigned preB = (bA << 7) | bB;
                        lds_fence();
                        sh[2 * lane] = 0u; sh[2 * lane + 1] = 0u; lds_fence();
#pragma unroll
                        for (int t = 0; t < 7; ++t) if (ci[t] >= 0 && ((ck[t] >> 7) & 0x3fffu) == preB) atomicAdd(&sh[ck[t] & 127u], 1u);
                        lds_fence();
                        const unsigned bC = (unsigned)find_bin128(sh, need, lane, binc);
                        const unsigned T = (b1 << 21) | (preB << 7) | bC;
                        const int tie_total = binc, need_t = need;
                        int cnt = 0;
#pragma unroll
                        for (int t = 0; t < 7; ++t) {
                            const bool valid = ci[t] >= 0;
                            bool sel = valid && (ck[t] > T);
                            if (valid && ck[t] == T) {
                                if (tie_total == need_t) sel = true;
                                else { int rank = 0; for (int j = 0; j < c; ++j) rank += (hist[2 * j] == T && (int)hist[2 * j + 1] < ci[t]) ? 1 : 0; sel = rank < need_t; }
                            }
                            const unsigned long long m = __ballot(sel);
                            const int pos = nsure + cnt + __popcll(m & ltmask);
                            if (sel && pos < 256) list[pos] = ci[t];
                            cnt += __popcll(m);
                        }
                    } else {
                        int binc = 0;
                        lds_fence();
#pragma unroll
                        for (int i = 0; i < 16; ++i) hist[lane * 16 + i] = 0u;
                        lds_fence();
                        for (int i0 = 0; i0 < L; i0 += 64) { const unsigned k = fkey(sc[i0 + lane]); if ((k >> 21) == b1) { const unsigned bin = (k >> 10) & 2047u; atomicAdd(&hist[bin >> 1], (bin & 1u) ? 0x10000u : 1u); } }
                        lds_fence();
                        const unsigned b2 = (unsigned)find_bin(hist, need, lane, binc);
                        const unsigned pre2 = (b1 << 11) | b2;
                        lds_fence();
#pragma unroll
                        for (int i = 0; i < 16; ++i) hist[lane * 16 + i] = 0u;
                        lds_fence();
                        for (int i0 = 0; i0 < L; i0 += 64) { const unsigned k = fkey(sc[i0 + lane]); if ((k >> 10) == pre2) { const unsigned bin = k & 1023u; atomicAdd(&hist[bin >> 1], (bin & 1u) ? 0x10000u : 1u); } }
                        lds_fence();
                        const unsigned b3 = (unsigned)find_bin(hist, need, lane, binc);
                        const unsigned T = (pre2 << 10) | b3;
                        int count = 0, ties = 0;
                        for (int i0 = 0; i0 < L; i0 += 64) {
                            const unsigned k = fkey(sc[i0 + lane]);
                            const bool eq = (k == T);
                            const unsigned long long em = __ballot(eq);
                            const int erank = ties + __popcll(em & ltmask);
                            const bool sel = (k > T) || (eq && erank < need);
                            const unsigned long long smk = __ballot(sel);
                            const int pos = count + __popcll(smk & ltmask);
                            if (sel && pos < 256) list[pos] = i0 + lane;
                            count += __popcll(smk); ties += __popcll(em);
                        }
                        if (count > 256) count = 256;
                        for (int i = count + lane; i < 256; i += 64) list[i] = 0;
                    }
                    if (lane == 0) CNT[q] = 256;
                }
            }
        }
        lds_fence(); __builtin_amdgcn_s_barrier();
        for (int repc = 0; repc < ((DBG_TWICE & 4) ? 2 : 1); ++repc) {
            const bool dummy_c = (repc + 1) < ((DBG_TWICE & 4) ? 2 : 1);
            int lane_c = lane; asm volatile("" : "+v"(lane_c));
            const int qi = wave >> 1, g = wave & 1; const int count = CNT[qi];
            const int* list = LIST + qi * 256;
            float* PB = SC + wave * 1024;
            const unsigned* qd = QS + (qi * 8 + g * 4) * 32;
            const bf16_t* kvb = KVC + (size_t)b * SEQ * 256 + g * 64;
            const int ks = lane_c >> 3, dg = lane_c & 7, l15c = lane_c & 15, quadc = lane_c >> 4;
            const int nblk = count >> 6;
            bf16_t* KL = (bf16_t*)(lds + 32768 + wave * 9216);
            bf16x8 bq[2];
#pragma unroll
            for (int s2 = 0; s2 < 2; ++s2) {
                bf16x8 t = *(const bf16x8*)((const bf16_t*)QS + (qi * 8 + g * 4 + (l15c & 3)) * 64 + s2 * 32 + quadc * 8);
                if (l15c >= 4) t = (bf16x8){0, 0, 0, 0, 0, 0, 0, 0};
                bq[s2] = t;
            }
            const bf16_t* kb = kvb + dg * 8;
            float sreg[4][4][4];
            u32x4 kcur[8];
#pragma unroll
            for (int u = 0; u < 8; ++u) kcur[u] = *(const u32x4*)(kb + (size_t)list[u * 8 + ks] * 256);
#pragma unroll
            for (int blk = 0; blk < 4; ++blk) {
                if (blk < nblk) {
#pragma unroll
                    for (int u = 0; u < 8; ++u) *(u32x4*)(KL + (u * 8 + ks) * 72 + dg * 8) = kcur[u];
                    if (blk + 1 < nblk) {
#pragma unroll
                        for (int u = 0; u < 8; ++u) kcur[u] = *(const u32x4*)(kb + (size_t)list[(blk + 1) * 64 + u * 8 + ks] * 256);
                    }
                    lds_fence();
#pragma unroll
                    for (int kt = 0; kt < 4; ++kt) {
                        f32x4 acc = (f32x4){0.f, 0.f, 0.f, 0.f};
#pragma unroll
                        for (int s2 = 0; s2 < 2; ++s2) acc = __builtin_amdgcn_mfma_f32_16x16x32_bf16(*(const bf16x8*)(KL + (kt * 16 + l15c) * 72 + s2 * 32 + quadc * 8), bq[s2], acc, 0, 0, 0);
#pragma unroll
                        for (int j = 0; j < 4; ++j) sreg[blk][kt][j] = acc[j] * 0.125f;
                    }
                    lds_fence();
                } else {
#pragma unroll
                    for (int kt = 0; kt < 4; ++kt)
#pragma unroll
                        for (int j = 0; j < 4; ++j) sreg[blk][kt][j] = -INFINITY;
                }
            }
            const bf16_t* vb = kvb + 128 + dg * 8;
            u32x4 vreg[8];
#pragma unroll
            for (int u = 0; u < 8; ++u) vreg[u] = *(const u32x4*)(vb + (size_t)list[u * 8 + ks] * 256);
            float mx = -INFINITY;
#pragma unroll
            for (int blk = 0; blk < 4; ++blk)
#pragma unroll
                for (int kt = 0; kt < 4; ++kt)
#pragma unroll
                    for (int j = 0; j < 4; ++j) mx = fmaxf(mx, sreg[blk][kt][j]);
            mx = fmaxf(mx, __shfl_xor(mx, 16)); mx = fmaxf(mx, __shfl_xor(mx, 32));
            float sum = 0.f;
#pragma unroll
            for (int blk = 0; blk < 4; ++blk)
#pragma unroll
                for (int kt = 0; kt < 4; ++kt)
#pragma unroll
                    for (int j = 0; j < 4; ++j) { const float e = __expf(sreg[blk][kt][j] - mx); sreg[blk][kt][j] = e; sum += e; }
            sum += __shfl_xor(sum, 16); sum += __shfl_xor(sum, 32);
            const float invs = 1.f / sum;
            f32x4 oacc[4];
#pragma unroll
            for (int dt = 0; dt < 4; ++dt) oacc[dt] = (f32x4){0.f, 0.f, 0.f, 0.f};
            bf16_t* VT = KL;
            const int Mx = (((ks >> 2) << 3) | (ks & 3)) ^ (((dg & 3) << 3) ^ ((dg >> 2) << 5));
#pragma unroll
            for (int blk = 0; blk < 4; ++blk) {
                if (blk < nblk) {
#pragma unroll
                    for (int u = 0; u < 8; ++u) {
                        constexpr int dummy0 = 0; (void)dummy0;
                        const int Cu = ((u >> 2) << 5) | (((2 * u) & 3) << 3) | (((u >> 1) & 1) << 2);
                        bf16_t* wp = VT + (dg * 8) * 72 + (Cu ^ Mx);
#pragma unroll
                        for (int e2 = 0; e2 < 4; ++e2) { const unsigned w = vreg[u][e2]; wp[(2 * e2) * 72] = (bf16_t)(w & 0xffffu); wp[(2 * e2 + 1) * 72] = (bf16_t)(w >> 16); }
                    }
                    if (blk + 1 < nblk) {
#pragma unroll
                        for (int u = 0; u < 8; ++u) vreg[u] = *(const u32x4*)(vb + (size_t)list[(blk + 1) * 64 + u * 8 + ks] * 256);
                    }
                    lds_fence();
#pragma unroll
                    for (int s2 = 0; s2 < 2; ++s2) {
                        u32x4 pw;
                        pw[0] = cvt_pk_bf16(sreg[blk][2 * s2][0], sreg[blk][2 * s2][1]); pw[1] = cvt_pk_bf16(sreg[blk][2 * s2][2], sreg[blk][2 * s2][3]);
                        pw[2] = cvt_pk_bf16(sreg[blk][2 * s2 + 1][0], sreg[blk][2 * s2 + 1][1]); pw[3] = cvt_pk_bf16(sreg[blk][2 * s2 + 1][2], sreg[blk][2 * s2 + 1][3]);
                        const bf16x8 pf = __builtin_bit_cast(bf16x8, pw);
#pragma unroll
                        for (int dt = 0; dt < 4; ++dt) {
                            const int dgr = dt * 2 + (l15c >> 3);
                            const int sp = s2 ^ (dgr >> 2), qp = quadc ^ (dgr & 3);
                            oacc[dt] = __builtin_amdgcn_mfma_f32_16x16x32_bf16(*(const bf16x8*)(VT + (dt * 16 + l15c) * 72 + sp * 32 + qp * 8), pf, oacc[dt], 0, 0, 0);
                        }
                    }
                    lds_fence();
                }
            }
            if (l15c < 4) {
                bf16_t* yo = (DUMMY || dummy_c) ? ((bf16_t*)(ws + WS_MG + 48 * MiB) + (r0 + qi) * 512 + (g * 4 + l15c) * 64 + quadc * 4) : (P + (r0 + qi) * LDP + C_AQ + (g * 4 + l15c) * 64 + quadc * 4);
#pragma unroll
                for (int dt = 0; dt < 4; ++dt) {
                    const f32x4 v = oacc[dt] * invs;
                    u32x2 w; w[0] = cvt_pk_bf16(v[0], v[1]); w[1] = cvt_pk_bf16(v[2], v[3]);
                    *(u32x2*)(yo + dt * 16) = w;
                }
            }
        }
        lds_fence(); __builtin_amdgcn_s_barrier();
    }
#undef DSA_LOAD_ITEM
}

__device__ __forceinline__ float logsigmoidf_(float x) { return fminf(x, 0.f) - log1pf(__expf(-fabsf(x))); }
__device__ __forceinline__ float wave_incl_sum(float v, int lane) {
#pragma unroll
    for (int o = 1; o < 64; o <<= 1) { const float t = __shfl_up(v, o); if (lane >= o) v += t; }
    return v;
}
__device__ __forceinline__ float wave_incl_max(float v, int lane) {
#pragma unroll
    for (int o = 1; o < 64; o <<= 1) { const float t = __shfl_up(v, o); if (lane >= o) v = fmaxf(v, t); }
    return v;
}
__device__ __forceinline__ f32x4 mma_lds(const bf16_t* A, int lda, const bf16_t* Bt, int ldb, int K, int lane) {
    f32x4 acc = (f32x4){0.f, 0.f, 0.f, 0.f};
    const bf16_t* ap = A + (lane & 15) * lda + (lane >> 4) * 8; const bf16_t* bp = Bt + (lane & 15) * ldb + (lane >> 4) * 8;
    for (int k = 0; k < K; k += 32) acc = __builtin_amdgcn_mfma_f32_16x16x32_bf16(*(const bf16x8*)(ap + k), *(const bf16x8*)(bp + k), acc, 0, 0, 0);
    return acc;
}

__device__ __forceinline__ void phase_mlstm_a(const Args& a, unsigned char* lds) {
    unsigned char* ws = a.ws;
    const bf16_t* P = (const bf16_t*)(ws + WS_P); const bf16_t* QK = (const bf16_t*)(ws + WS_QK); const float* SM = (const float*)(ws + WS_SM);
    float* ST = (float*)(ws + WS_XB); float* DN = (float*)(ws + WS_DN); float* ML = (float*)(ws + WS_ML); float* BL = (float*)(ws + WS_BL);
    bf16_t* VT = (bf16_t*)lds;
    bf16_t* KT = (bf16_t*)(lds + 18432);
    float* WS_ = (float*)(lds + 18432 + 9216);
    const int tid = threadIdx.x, wave = tid >> 6, lane = tid & 63;
    for (int item = blockIdx.x; item < 4096; item += gridDim.x) {
        const int c = item & 127, h = (item >> 7) & 3, b = item >> 9;
        const size_t r0 = (size_t)b * SEQ + c * 64;
        if (wave == 0) {
            const float ig = SM[(r0 + lane) * 16 + 8 + h] + a.in[I_BI][h];
            const float lf = logsigmoidf_(SM[(r0 + lane) * 16 + 12 + h] + a.in[I_BF][h]);
            const float bs = wave_incl_sum(lf, lane);
            const float bl = __shfl(bs, 63);
            const float wk = bl - bs + ig;
            const float ml = wave_max(wk);
            WS_[lane] = __expf(wk - ml);
            if (lane == 0) { ML[item] = ml; BL[item] = bl; }
        }
        for (int i = tid; i < 1024; i += 512) { const int s = i >> 4, d0 = (i & 15) * 8; float f[8]; unpack8(*(const u32x4*)(P + (r0 + s) * LDP + C_MV + h * 128 + d0), f);
#pragma unroll
            for (int e = 0; e < 8; ++e) VT[(d0 + e) * 72 + s] = f2bf(f[e]); }
        __syncthreads();
        { const int s = tid >> 3, d0 = (tid & 7) * 8; float f[8]; unpack8(*(const u32x4*)(QK + (r0 + s) * 512 + 256 + h * 64 + d0), f); const float w = WS_[s];
#pragma unroll
            for (int e = 0; e < 8; ++e) KT[(d0 + e) * 72 + s] = f2bf(f[e] * w); }
        __syncthreads();
        float* st = ST + (size_t)item * 8192;
#pragma unroll
        for (int nt = 0; nt < 4; ++nt) {
            const f32x4 acc = mma_lds(VT + wave * 16 * 72, 72, KT + nt * 16 * 72, 72, 64, lane);
#pragma unroll
            for (int j = 0; j < 4; ++j) st[(wave * 16 + (lane >> 4) * 4 + j) * 64 + nt * 16 + (lane & 15)] = acc[j];
        }
        if (tid < 64) { float s = 0.f; for (int k = 0; k < 64; ++k) s += bf1(KT[tid * 72 + k]); DN[item * 64 + tid] = s; }
        __syncthreads();
    }
}
__device__ __forceinline__ void phase_mlstm_b(const Args& a) {
    unsigned char* ws = a.ws;
    float* ST = (float*)(ws + WS_XB); float* DN = (float*)(ws + WS_DN); const float* ML = (const float*)(ws + WS_ML); const float* BL = (const float*)(ws + WS_BL); float* MS = (float*)(ws + WS_MS);
    const int total = 32 * 8256;
    for (int w = blockIdx.x * 512 + threadIdx.x; w < total; w += gridDim.x * 512) {
        const int bh = w / 8256, e = w % 8256;
        float* p; int stride;
        if (e < 8192) { p = ST + (size_t)bh * 128 * 8192 + e; stride = 8192; } else { p = DN + (size_t)bh * 128 * 64 + (e - 8192); stride = 64; }
        float C = 0.f, m = 0.f;
        for (int c0 = 0; c0 < 128; c0 += 8) {
            float d[8], bl[8], ml[8];
#pragma unroll
            for (int u = 0; u < 8; ++u) { d[u] = p[(size_t)(c0 + u) * stride]; bl[u] = BL[bh * 128 + c0 + u]; ml[u] = ML[bh * 128 + c0 + u]; }
#pragma unroll
            for (int u = 0; u < 8; ++u) {
                p[(size_t)(c0 + u) * stride] = C;
                if (e == 0) MS[bh * 128 + c0 + u] = m;
                const float mn = fmaxf(bl[u] + m, ml[u]);
                C = __expf(bl[u] + m - mn) * C + __expf(ml[u] - mn) * d[u];
                m = mn;
            }
        }
    }
}
__device__ __forceinline__ void phase_mlstm_c(const Args& a, unsigned char* lds) {
    unsigned char* ws = a.ws;
    bf16_t* P = (bf16_t*)(ws + WS_P); const bf16_t* QK = (const bf16_t*)(ws + WS_QK); const float* SM = (const float*)(ws + WS_SM);
    const float* ST = (const float*)(ws + WS_XB); const float* DN = (const float*)(ws + WS_DN); const float* MS = (const float*)(ws + WS_MS);
    bf16_t* QS_ = (bf16_t*)lds;
    bf16_t* KS = (bf16_t*)(lds + 9216);
    bf16_t* AP = (bf16_t*)(lds + 18432);
    bf16_t* BT = (bf16_t*)(lds + 18432 + 17408);
    float* OUT = (float*)(lds + 18432 + 17408 + 34816);
    float* GS = (float*)(lds + 18432 + 17408 + 34816 + 33792);
    float* bS = GS; float* aS = GS + 64; float* mtS = GS + 128; float* wiS = GS + 192; float* nS = GS + 256; float* denS = GS + 320;
    const int tid = threadIdx.x, wave = tid >> 6, lane = tid & 63;
    for (int item = blockIdx.x; item < 4096; item += gridDim.x) {
        const int c = item & 127, h = (item >> 7) & 3, b = item >> 9;
        const size_t r0 = (size_t)b * SEQ + c * 64;
        if (wave == 0) {
            const float ig = SM[(r0 + lane) * 16 + 8 + h] + a.in[I_BI][h];
            const float lf = logsigmoidf_(SM[(r0 + lane) * 16 + 12 + h] + a.in[I_BF][h]);
            const float bs = wave_incl_sum(lf, lane);
            const float av = ig - bs;
            const float pm = wave_incl_max(av, lane);
            const float m0 = MS[item];
            const float mt = bs + fmaxf(pm, m0);
            bS[lane] = bs; aS[lane] = av; mtS[lane] = mt; wiS[lane] = __expf(bs + m0 - mt);
            nS[lane] = DN[item * 64 + lane];
        }
        { const int s = tid >> 3, d0 = (tid & 7) * 8;
            *(u32x4*)(QS_ + s * 72 + d0) = *(const u32x4*)(QK + (r0 + s) * 512 + h * 64 + d0);
            *(u32x4*)(KS + s * 72 + d0) = *(const u32x4*)(QK + (r0 + s) * 512 + 256 + h * 64 + d0); }
        for (int i = tid; i < 1024; i += 512) { const int s = i >> 4, d0 = (i & 15) * 8; float f[8]; unpack8(*(const u32x4*)(P + (r0 + s) * LDP + C_MV + h * 128 + d0), f);
#pragma unroll
            for (int e = 0; e < 8; ++e) BT[(d0 + e) * 136 + s] = f2bf(f[e]); }
        { const float* st = ST + (size_t)item * 8192;
            for (int i = tid; i < 2048; i += 512) { const int dv = i >> 4, k0 = (i & 15) * 4; const f32x4 v = *(const f32x4*)(st + dv * 64 + k0);
                *(unsigned*)(BT + dv * 136 + 64 + k0) = cvt_pk_bf16(v[0], v[1]); *(unsigned*)(BT + dv * 136 + 64 + k0 + 2) = cvt_pk_bf16(v[2], v[3]); } }
        __syncthreads();
#pragma unroll
        for (int u = 0; u < 2; ++u) {
            const int id = wave * 2 + u, tr = id >> 2, tc = id & 3;
            f32x4 acc = (f32x4){0.f, 0.f, 0.f, 0.f};
            if (tc <= tr) acc = mma_lds(QS_ + tr * 16 * 72, 72, KS + tc * 16 * 72, 72, 64, lane);
            const int s = tc * 16 + (lane & 15);
#pragma unroll
            for (int j = 0; j < 4; ++j) { const int t = tr * 16 + (lane >> 4) * 4 + j;
                const float w = (s <= t) ? acc[j] * __expf(bS[t] + aS[s] - mtS[t]) : 0.f;
                AP[t * 136 + s] = f2bf(w); }
        }
        { const int t = tid >> 3, d0 = (tid & 7) * 8; float f[8]; unpack8(*(const u32x4*)(QS_ + t * 72 + d0), f); const float w = wiS[t];
#pragma unroll
            for (int e = 0; e < 8; ++e) f[e] *= w;
            *(u32x4*)(AP + t * 136 + 64 + d0) = pack8(f); }
        __syncthreads();
#pragma unroll
        for (int tr = 0; tr < 4; ++tr) {
            const f32x4 acc = mma_lds(AP + tr * 16 * 136, 136, BT + wave * 16 * 136, 136, 128, lane);
#pragma unroll
            for (int j = 0; j < 4; ++j) OUT[(tr * 16 + (lane >> 4) * 4 + j) * 132 + wave * 16 + (lane & 15)] = acc[j];
        }
        { const int t = tid >> 3, part = tid & 7; float s = 0.f;
#pragma unroll
            for (int e = 0; e < 16; ++e) { const int k = part * 16 + e; const float v = bf1(AP[t * 136 + k]); s += (k < 64) ? v : v * nS[k - 64]; }
            s += __shfl_xor(s, 1); s += __shfl_xor(s, 2); s += __shfl_xor(s, 4);
            if (part == 0) denS[t] = s; }
        __syncthreads();
        { const int t = tid >> 3, part = tid & 7, dv0 = part * 16;
            const float den = fmaxf(fabsf(denS[t]), __expf(-mtS[t])); const float inv = 1.f / den;
            float hv[16]; float sq = 0.f;
#pragma unroll
            for (int e = 0; e < 16; ++e) { hv[e] = OUT[t * 132 + dv0 + e] * inv; sq += hv[e] * hv[e]; }
            sq += __shfl_xor(sq, 1); sq += __shfl_xor(sq, 2); sq += __shfl_xor(sq, 4);
            const float rs = rsqrtf(sq * (1.f / 128.f) + EPS);
            bf16_t* po = P + (r0 + t) * LDP + C_MO + h * 128 + dv0;
            float og[16]; unpack8(*(const u32x4*)po, og); unpack8(*(const u32x4*)(po + 8), og + 8);
#pragma unroll
            for (int e = 0; e < 16; ++e) hv[e] = hv[e] * rs * a.in[I_MHN][h * 128 + dv0 + e] * sigmoidf_(og[e]);
            *(u32x4*)po = pack8(hv); *(u32x4*)(po + 8) = pack8(hv + 8); }
        __syncthreads();
    }
}


#define XB_TMO      128
#define XB_XCNT(j)  (256  + 64 * (j))
#define XB_XSUB(j)  (1280 + 64 * (j))
#define XB_XGEN(j)  (2304 + 64 * (j))
#define XB_TOP      3328
#define XB_TOPGEN   3392
#define XCD_BAR_WORDS 3456
#define XB_SPIN_CAP (1u << 22)
__device__ __forceinline__ unsigned xb_ld(unsigned* p)              { return __hip_atomic_load(p, __ATOMIC_RELAXED, __HIP_MEMORY_SCOPE_AGENT); }
__device__ __forceinline__ unsigned xb_add(unsigned* p, unsigned v) { return __hip_atomic_fetch_add(p, v, __ATOMIC_RELAXED, __HIP_MEMORY_SCOPE_AGENT); }
__device__ __forceinline__ unsigned xb_xcc_id() { return (unsigned)__builtin_amdgcn_s_getreg((3 << 11) | 20) & 0xFu; }
#define XB_SPIN(cond, bar) do { unsigned _sp = 0; while (cond) { __builtin_amdgcn_s_sleep(1); \
    if ((++_sp & 255u) == 0u) { if (xb_ld(&(bar)[XB_TMO])) break; if (_sp > XB_SPIN_CAP) { atomicAdd(&(bar)[XB_TMO], 1u); break; } } } } while (0)
struct XcdBarrier { unsigned* bar; unsigned x; volatile LAS unsigned* st; };
__device__ __forceinline__ XcdBarrier xcd_barrier_post(unsigned* bar, volatile LAS unsigned* st) {
    XcdBarrier b; b.bar = bar; b.x = xb_xcc_id(); b.st = st;
    if (threadIdx.x == 0) (void)xb_add(&bar[XB_XCNT(b.x)], 1u);
    return b;
}
__device__ __forceinline__ void xcd_barrier_complete(unsigned* bar, unsigned x, unsigned& nloc, unsigned& nx) {
    const unsigned G = gridDim.x * gridDim.y * gridDim.z;
    unsigned sum, cnt, mine, sp = 0u;
    for (;;) {
        sum = 0u; cnt = 0u; mine = 0u;
#pragma unroll
        for (unsigned j = 0; j < 16; ++j) { const unsigned c = xb_ld(&bar[XB_XCNT(j)]); sum += c; cnt += (c > 0u) ? 1u : 0u; mine = (j == x) ? c : mine; }
        if (sum == G) break;
        __builtin_amdgcn_s_sleep(1);
        if ((++sp & 255u) == 0u) { if (xb_ld(&bar[XB_TMO])) break; if (sp > XB_SPIN_CAP) { atomicAdd(&bar[XB_TMO], 1u); break; } }
    }
    nloc = mine > 0u ? mine : 1u; nx = cnt > 0u ? cnt : 1u;
}
__device__ __forceinline__ void xcd_barrier(const XcdBarrier& b) {
    asm volatile("s_waitcnt vmcnt(0)" ::: "memory");
    __syncthreads();
    if (threadIdx.x == 0) {
        unsigned* bar = b.bar;
        __builtin_amdgcn_s_waitcnt(0);
        unsigned nloc = b.st[0], nx = b.st[1];
        if (nloc == 0u) { xcd_barrier_complete(bar, b.x, nloc, nx); b.st[0] = nloc; b.st[1] = nx; }
        const unsigned old = xb_add(&bar[XB_XSUB(b.x)], 1u);
        const unsigned gen = old / nloc;
        if (old + 1u == (gen + 1u) * nloc) {
            __builtin_amdgcn_fence(__ATOMIC_RELEASE, "agent");
            asm volatile("s_waitcnt vmcnt(0)" ::: "memory");
            const unsigned og = xb_add(&bar[XB_TOP], 1u);
            const unsigned tg = og / nx;
            if (og + 1u == (tg + 1u) * nx) xb_add(&bar[XB_TOPGEN], 1u);
            else XB_SPIN(xb_ld(&bar[XB_TOPGEN]) == tg, bar);
            __builtin_amdgcn_fence(__ATOMIC_ACQUIRE, "agent");
            xb_add(&bar[XB_XGEN(b.x)], 1u);
            asm volatile("s_waitcnt vmcnt(0)" ::: "memory");
        } else {
            XB_SPIN(xb_ld(&bar[XB_XGEN(b.x)]) == gen, bar);
            __builtin_amdgcn_fence(__ATOMIC_ACQUIRE, "agent");
            asm volatile("s_waitcnt vmcnt(0)" ::: "memory");
        }
    }
    __syncthreads();
}

#ifndef DBG_ZERO_YA
#define DBG_ZERO_YA 1
#endif
#ifndef PH
#define PH 0xFFFF
#endif
__global__ void __launch_bounds__(512, 2) mega_fwd(Args a) {
    extern __shared__ __attribute__((aligned(16))) unsigned char lds[];
    cg::grid_group grid = cg::this_grid();
    LAS unsigned char* ldsl = (LAS unsigned char*)lds;
    unsigned char* ws = a.ws;
    const int G = gridDim.x, bid = blockIdx.x;
    bf16_t* XB = (bf16_t*)(ws + WS_XB); bf16_t* Pb = (bf16_t*)(ws + WS_P); bf16_t* MG = (bf16_t*)(ws + WS_MG); bf16_t* QKb = (bf16_t*)(ws + WS_QK);
    float* ss0 = (float*)(ws + WS_SS0); float* ss1 = (float*)(ws + WS_SS1); float* ss2 = (float*)(ws + WS_SS2);

    unsigned* barw = (unsigned*)(ws + WS_BAR);
    if (bid == 0) { for (int i = threadIdx.x; i < XCD_BAR_WORDS; i += 512) barw[i] = 0u; }
    volatile LAS unsigned* bst = (volatile LAS unsigned*)(ldsl + LDS_BYTES - 16);
    if (threadIdx.x == 0) { bst[0] = 0u; bst[1] = 0u; }
    if (PH & 1) phase0(a, lds);
    __threadfence();
    grid.sync();
    const XcdBarrier xbar = xcd_barrier_post(barw, bst);
    if (PH & 2) {
        pg8::Gemm g{XB, (const bf16_t*)(ws + WS_W1), DM, DM, MROWS, 2 * FF, DM}; pg8::StaticOrder S; S.init(MROWS, 2 * FF, G, bid);
        pg8::EpiSwiGLU E{Pb, ss0}; pg8::gemm_phase(ldsl, g, S, E);
    }
    xcd_barrier(xbar);
    if (PH & 4) {
        pg8::Gemm g{Pb, (const bf16_t*)(ws + WS_W2), FF, FF, MROWS, DM, FF}; pg8::StaticOrder S; S.init(MROWS, DM, G, bid);
        pg8::EpiRes<true> E{a.in[I_X], a.out, XB, ss1, 0.5f}; pg8::gemm_phase(ldsl, g, S, E);
    }
    xcd_barrier(xbar);
    if (PH & 8) {
        pg8::Gemm g{XB, (const bf16_t*)(ws + WS_WIN), DM, DM, MROWS, LDP, DM}; pg8::StaticOrder S; S.init(MROWS, LDP, G, bid);
        pg8::EpiP E{Pb, (float*)(ws + WS_SM), ss1}; pg8::gemm_phase(ldsl, g, S, E);
    }
    xcd_barrier(xbar);
    if (PH & 16) phase_postp(a);
    xcd_barrier(xbar);
    if (PH & 32) {
        pg8::Gemm g{XB, (const bf16_t*)(ws + WS_WQK), 512, 512, MROWS, 512, 512}; pg8::StaticOrder S; S.init(MROWS, 512, G, bid);
        pg8::EpiBf16 E{QKb, 512}; pg8::gemm_phase(ldsl, g, S, E);
    }
    xcd_barrier(xbar);
    if (PH & 64) phase_mlstm_a(a, lds);
    xcd_barrier(xbar);
    if (PH & 128) phase_mlstm_b(a);
    xcd_barrier(xbar);
    if (PH & 256) phase_mlstm_c(a, lds);
    if (DBG_TWICE & 1) phase_dsa<true>(a, lds);
    if (PH & 512) phase_dsa<false>(a, lds);
    xcd_barrier(xbar);
    if (PH & 1024) {
        pg8::StaticOrder S; S.init(MROWS, DM, G, bid);
        { pg8::Gemm g{Pb + C_AQ, (const bf16_t*)(ws + WS_WA), LDP, 512, MROWS, DM, 512}; pg8::EpiMerge<0> E{Pb, MG, C_GA}; pg8::gemm_phase(ldsl, g, S, E); }
        { pg8::Gemm g{Pb + C_MO, (const bf16_t*)(ws + WS_WB), LDP, 512, MROWS, DM, 512}; pg8::EpiMerge<1> E{Pb, MG, C_GB}; pg8::gemm_phase(ldsl, g, S, E); }
    }
    xcd_barrier(xbar);
    if (PH & 2048) {
        pg8::Gemm g{MG, (const bf16_t*)(ws + WS_WO), DM, DM, MROWS, DM, DM}; pg8::StaticOrder S; S.init(MROWS, DM, G, bid);
        pg8::EpiRes<true> E{a.out, a.out, XB, ss2, 1.0f}; pg8::gemm_phase(ldsl, g, S, E);
    }
    xcd_barrier(xbar);
    if (PH & 4096) {
        pg8::Gemm g{XB, (const bf16_t*)(ws + WS_W3), DM, DM, MROWS, 2 * FF, DM}; pg8::StaticOrder S; S.init(MROWS, 2 * FF, G, bid);
        pg8::EpiSwiGLU E{Pb, ss2}; pg8::gemm_phase(ldsl, g, S, E);
    }
    xcd_barrier(xbar);
    if (PH & 8192) {
        pg8::Gemm g{Pb, (const bf16_t*)(ws + WS_W4), FF, FF, MROWS, DM, FF}; pg8::StaticOrder S; S.init(MROWS, DM, G, bid);
        pg8::EpiRes<false> E{a.out, a.out, nullptr, nullptr, 0.5f}; pg8::gemm_phase(ldsl, g, S, E);
    }
}

extern "C" void kernel_launch(void* const* d_in, const int* in_sizes, int n_in, void* d_out, int out_size, void* d_ws, size_t ws_size, hipStream_t stream) {
    static int grid = 0;
    if (grid == 0) {
        if (n_in != 24 || ws_size < WS_END) { fprintf(stderr, "kernel_launch: unexpected n_in %d / ws %zu\n", n_in, ws_size); grid = -1; return; }
        int dev = 0, cus = 0, per_cu = 0;
        hipGetDevice(&dev);
        hipDeviceGetAttribute(&cus, hipDeviceAttributeMultiprocessorCount, dev);
        hipFuncSetAttribute((const void*)mega_fwd, hipFuncAttributeMaxDynamicSharedMemorySize, LDS_BYTES);
        hipOccupancyMaxActiveBlocksPerMultiprocessor(&per_cu, (const void*)mega_fwd, 512, LDS_BYTES);
        if (per_cu < 1) { fprintf(stderr, "kernel_launch: occupancy query says %d blocks/CU\n", per_cu); per_cu = 1; }
        (void)hipGetLastError();
        grid = cus * per_cu;
    }
    if (grid < 0) return;
    Args a{};
    for (int i = 0; i < 24; ++i) a.in[i] = (const float*)d_in[i];
    a.out = (float*)d_out; a.ws = (unsigned char*)d_ws;
    void* args[] = {&a};
    hipError_t e = hipLaunchCooperativeKernel((const void*)mega_fwd, dim3(grid), dim3(512), args, LDS_BYTES, stream);
    if (e != hipSuccess) fprintf(stderr, "cooperative launch failed: %s (grid %d)\n", hipGetErrorString(e), grid);
}
```

```cpp
#include <hip/hip_runtime.h>
#include <hip/hip_cooperative_groups.h>
#include <cstdio>
#include <cstdint>
namespace cg = cooperative_groups;
#define DBG_ZERO_YA 0
#define DBG_TWICE 0
#define DBG_NOSEL 0

#define LAS __attribute__((address_space(3)))
typedef unsigned short bf16_t;
typedef short bf16x8 __attribute__((ext_vector_type(8)));
typedef float f32x4 __attribute__((ext_vector_type(4)));
typedef unsigned u32x4 __attribute__((ext_vector_type(4)));
typedef unsigned u32x2 __attribute__((ext_vector_type(2)));
typedef __bf16 bf2_t __attribute__((ext_vector_type(2)));
typedef short v4i16_t __attribute__((ext_vector_type(4)));

constexpr int MROWS = 65536, DM = 1024, FF = 2816, SEQ = 8192, NB = 8;
constexpr int LDP = 5120;
constexpr int C_AQ = 0, C_AK = 512, C_AV = 640, C_IQ = 768, C_IK = 1280, C_MX = 1344, C_MV = 1856, C_MO = 2368, C_GA = 2880, C_GB = 3904, C_SM = 4928;
constexpr float EPS = 1e-6f;
constexpr size_t MiB = 1u << 20;
constexpr size_t WS_SS0 = 0, WS_SS1 = 256 * 1024, WS_SS2 = 512 * 1024;
constexpr size_t WS_DN = 1 * MiB;
constexpr size_t WS_ML = 2 * MiB, WS_BL = 2 * MiB + 16384, WS_MS = 2 * MiB + 32768;
constexpr size_t WS_BAR = 2 * MiB + 65536;
constexpr size_t WS_SM = 3 * MiB;
constexpr size_t WS_W1 = 8 * MiB, WS_W2 = 19 * MiB, WS_W3 = 25 * MiB, WS_W4 = 36 * MiB, WS_WIN = 42 * MiB, WS_WA = 52 * MiB, WS_WB = 53 * MiB, WS_WO = 54 * MiB, WS_WQK = 56 * MiB;
constexpr size_t WS_XB = 64 * MiB;
constexpr size_t WS_P = 192 * MiB;
constexpr size_t WS_MG = 832 * MiB;
constexpr size_t WS_IKC = 832 * MiB;
constexpr size_t WS_KVC = 840 * MiB;
constexpr size_t WS_QK = 960 * MiB;
constexpr size_t WS_END = 1024 * MiB;
constexpr int LDS_BYTES = 156 * 1024;

__device__ __forceinline__ unsigned cvt_pk_bf16(float lo, float hi) { unsigned r; asm volatile("v_cvt_pk_bf16_f32 %0, %1, %2" : "=v"(r) : "v"(lo), "v"(hi)); return r; }
__device__ __forceinline__ float bflo(unsigned u) { return __uint_as_float(u << 16); }
__device__ __forceinline__ float bfhi(unsigned u) { return __uint_as_float(u & 0xffff0000u); }
__device__ __forceinline__ float bf1(bf16_t u) { return __uint_as_float(((unsigned)u) << 16); }
__device__ __forceinline__ bf16_t f2bf(float f) { return (bf16_t)(cvt_pk_bf16(f, 0.f) & 0xffffu); }
__device__ __forceinline__ float wave_sum(float v) {
#pragma unroll
    for (int o = 1; o < 64; o <<= 1) v += __shfl_xor(v, o);
    return v;
}
__device__ __forceinline__ float wave_max(float v) {
#pragma unroll
    for (int o = 1; o < 64; o <<= 1) v = fmaxf(v, __shfl_xor(v, o));
    return v;
}
__device__ __forceinline__ float sigmoidf_(float x) { return __builtin_amdgcn_rcpf(1.f + __expf(-x)); }
__device__ __forceinline__ float dot2bf(unsigned a, unsigned b, float c) { const unsigned aa = a, bb = b; return __builtin_amdgcn_fdot2_f32_bf16(__builtin_bit_cast(bf2_t, aa), __builtin_bit_cast(bf2_t, bb), c, false); }
__device__ __forceinline__ float relu_(float x) { const int i = __float_as_int(x); return __int_as_float(i > 0 ? i : 0); }
__device__ __forceinline__ void lds_fence() { asm volatile("s_waitcnt lgkmcnt(0)" ::: "memory"); }
__device__ __forceinline__ void unpack8(u32x4 v, float* f) {
    f[0] = bflo(v.x); f[1] = bfhi(v.x); f[2] = bflo(v.y); f[3] = bfhi(v.y); f[4] = bflo(v.z); f[5] = bfhi(v.z); f[6] = bflo(v.w); f[7] = bfhi(v.w);
}
__device__ __forceinline__ u32x4 pack8(const float* f) {
    u32x4 o; o.x = cvt_pk_bf16(f[0], f[1]); o.y = cvt_pk_bf16(f[2], f[3]); o.z = cvt_pk_bf16(f[4], f[5]); o.w = cvt_pk_bf16(f[6], f[7]); return o;
}

namespace pg8 {
constexpr int BM = 256, BK = 64, HALF = 128, HTB = HALF * BK * 2, NXCD = 8, WGM = 8;
__host__ __device__ __forceinline__ int lds_byte(int r, int c) { const int st = (r >> 4) * 2 + (c >> 5), rr = r & 15, cc = c & 31, ob = rr * 64 + cc * 2; return st * 1024 + (ob ^ (((ob >> 9) & 1) << 5)); }
__host__ __device__ __forceinline__ void stage_rc(int b, int& R, int& C) { const int st = b / 1024, sb = b % 1024, swz = sb ^ (((sb >> 9) & 1) << 5); R = (st >> 1) * 16 + swz / 64; C = (st & 1) * 32 + (swz % 64) / 2; }
__host__ __device__ __forceinline__ int perm32(int rho) { const int n = rho >> 4, i = rho & 15; return 8 * (i >> 2) + 4 * n + (i & 3); }
struct Unit { int pm, pn; };
struct Gemm { const bf16_t* A; const bf16_t* Bt; int lda, ldb, M, N, K; };
struct StaticOrder {
    int nM, nN, nwg, G, c;
    __device__ void init(int M, int N, int G_, int c_) { nM = M / BM; nN = N / BM; nwg = nM * nN; G = G_; c = c_; }
    __device__ bool next(int i, Unit& u) const {
        const long L = (long)i * G + c; if (L >= nwg) return false;
        int wgid = (int)L; { const int q = nwg / NXCD, r = nwg % NXCD, xcd = wgid % NXCD, off = wgid / NXCD; wgid = (xcd < r ? xcd * (q + 1) : r * (q + 1) + (xcd - r) * q) + off; }
        const int nig = WGM * nN, gid = wgid / nig, fm = gid * WGM, gsz = (nM - fm) < WGM ? (nM - fm) : WGM;
        u.pm = fm + ((wgid % nig) % gsz); u.pn = (wgid % nig) / gsz; return true;
    }
};

template <class Epi>
__device__ __forceinline__ void gemm_phase(LAS unsigned char* lds, const Gemm g, const StaticOrder& S, const Epi& E) {
    int tid_ = threadIdx.x; asm volatile("" : "+v"(tid_));
    const int tid = tid_, wid = __builtin_amdgcn_readfirstlane(tid >> 6), lane = tid & 63, wr = wid >> 2, wc = wid & 3, fr = lane & 15, fq = lane >> 4;
    const int K = g.K, nt = K / BK;
    unsigned voffA[2], voffB[2];
#pragma unroll
    for (int i = 0; i < 2; ++i) { int R, C; stage_rc(tid * 16 + i * 8192, R, C); const int Rb = (R & ~31) + perm32(R & 31);
        voffA[i] = (unsigned)(R * g.lda + C) * 2u; voffB[i] = (unsigned)(Rb * g.ldb + C) * 2u; }
    const size_t kstep = (size_t)(BK * 2);
    const size_t hsA = (size_t)HALF * g.lda * 2, hsB = (size_t)HALF * g.ldb * 2;
    const size_t tsA = 2 * hsA, tsB = 2 * hsB;
    const unsigned ldsw = (unsigned)wid * 1024u;
    const int aoff = lds_byte(wr * 64 + fr, fq * 8), boff = lds_byte(wc * 32 + fr, fq * 8);
#define PG8_SA(b, h) (((b) * 2 + (h)) * HTB)
#define PG8_SB(b, h) ((4 + (b) * 2 + (h)) * HTB)
#define PG8_STAGE(bufoff, gbase, voff) do { _Pragma("unroll") for (int _i = 0; _i < 2; ++_i) \
        __builtin_amdgcn_global_load_lds((const unsigned*)((const char*)(gbase) + (voff)[_i]), (LAS unsigned*)(lds + (bufoff) + ldsw + _i * 8192), 16, 0, 0); } while (0)
#define PG8_LDA(dst, b, h) do { _Pragma("unroll") for (int m = 0; m < 4; ++m) _Pragma("unroll") for (int k = 0; k < 2; ++k) dst[m][k] = *(const LAS bf16x8*)(lds + PG8_SA(b, h) + aoff + m * 2048 + k * 1024); } while (0)
#define PG8_LDB(dst, b, h) do { _Pragma("unroll") for (int n = 0; n < 2; ++n) _Pragma("unroll") for (int k = 0; k < 2; ++k) dst[n][k] = *(const LAS bf16x8*)(lds + PG8_SB(b, h) + boff + n * 2048 + k * 1024); } while (0)
#define PG8_MMA(ai, bj, At, Bt) do { __builtin_amdgcn_s_setprio(1); _Pragma("unroll") for (int m = 0; m < 4; ++m) _Pragma("unroll") for (int n = 0; n < 2; ++n) _Pragma("unroll") for (int k = 0; k < 2; ++k) \
        acc[ai][bj][m][n] = __builtin_amdgcn_mfma_f32_16x16x32_bf16(Bt[n][k], At[m][k], acc[ai][bj][m][n], 0, 0, 0); __builtin_amdgcn_s_setprio(0); } while (0)
#define PG8_WAIT_V(n) asm volatile("s_waitcnt vmcnt(" #n ")" ::: "memory")
#define PG8_WAIT_L(n) asm volatile("s_waitcnt lgkmcnt(" #n ")" ::: "memory")
#define PG8_BAR __builtin_amdgcn_s_barrier()
#define PG8_SCHED __builtin_amdgcn_sched_barrier(0)
    Unit cur, nxt; int ui = 0;
    if (!S.next(0, cur)) return;
    f32x4 acc[2][2][4][2];
#pragma unroll
    for (int a = 0; a < 2; ++a)
#pragma unroll
        for (int b = 0; b < 2; ++b)
#pragma unroll
            for (int m = 0; m < 4; ++m)
#pragma unroll
                for (int n = 0; n < 2; ++n) acc[a][b][m][n] = (f32x4){0.f, 0.f, 0.f, 0.f};
    bf16x8 At[4][2], B0[2][2], B1[2][2];
    const char* cA = (const char*)g.A + (size_t)cur.pm * tsA; const char* cB = (const char*)g.Bt + (size_t)cur.pn * tsB;
    PG8_STAGE(PG8_SB(0, 0), cB, voffB); PG8_STAGE(PG8_SB(0, 1), cB + hsB, voffB); PG8_STAGE(PG8_SA(0, 0), cA, voffA); PG8_STAGE(PG8_SA(0, 1), cA + hsA, voffA);
    if (wr == 1) PG8_BAR;
    PG8_WAIT_V(2); PG8_BAR;
    PG8_STAGE(PG8_SB(1, 0), cB + kstep, voffB); PG8_STAGE(PG8_SA(1, 0), cA + kstep, voffA); PG8_STAGE(PG8_SB(1, 1), cB + hsB + kstep, voffB);
    PG8_WAIT_V(6); PG8_BAR;
    for (;;) {
        const bool has_next = S.next(ui + 1, nxt);
        const char* nA = has_next ? (const char*)g.A + (size_t)nxt.pm * tsA : cA; const char* nB = has_next ? (const char*)g.Bt + (size_t)nxt.pn * tsB : cB;
        for (int t = 0; t < nt; t += 2) {
            const bool last = (t == nt - 2);
            const char* a1 = cA + (size_t)(t + 1) * kstep;
            const char* a2 = last ? nA : cA + (size_t)(t + 2) * kstep; const char* b2 = last ? nB : cB + (size_t)(t + 2) * kstep;
            const char* a3 = a2 + kstep; const char* b3 = b2 + kstep;
            PG8_LDB(B0, 0, 0); PG8_LDB(B1, 0, 1); PG8_SCHED; PG8_LDA(At, 0, 0); PG8_STAGE(PG8_SA(1, 1), a1 + hsA, voffA);
            PG8_WAIT_V(8); PG8_WAIT_L(0); PG8_BAR; PG8_MMA(0, 0, At, B0); PG8_MMA(0, 1, At, B1); PG8_BAR; PG8_SCHED;
            PG8_LDA(At, 0, 1); PG8_STAGE(PG8_SB(0, 0), b2, voffB); PG8_STAGE(PG8_SB(0, 1), b2 + hsB, voffB); PG8_STAGE(PG8_SA(0, 0), a2, voffA);
            PG8_WAIT_V(8); PG8_WAIT_L(0); PG8_BAR; PG8_MMA(1, 0, At, B0); PG8_MMA(1, 1, At, B1); PG8_BAR; PG8_SCHED;
            PG8_LDB(B0, 1, 0); PG8_LDB(B1, 1, 1); PG8_SCHED; PG8_LDA(At, 1, 0); PG8_STAGE(PG8_SA(0, 1), a2 + hsA, voffA);
            PG8_WAIT_V(8); PG8_WAIT_L(0); PG8_BAR; PG8_MMA(0, 0, At, B0); PG8_MMA(0, 1, At, B1); PG8_BAR; PG8_SCHED;
            PG8_LDA(At, 1, 1); PG8_STAGE(PG8_SB(1, 0), b3, voffB); PG8_STAGE(PG8_SB(1, 1), b3 + hsB, voffB); PG8_STAGE(PG8_SA(1, 0), a3, voffA);
            PG8_WAIT_V(8); PG8_WAIT_L(0); PG8_BAR; PG8_MMA(1, 0, At, B0); PG8_MMA(1, 1, At, B1); PG8_BAR; PG8_SCHED;
        }
        if (wr == 0) PG8_BAR;
        E(acc, cur, wr, wc, fr, fq);
        if (!has_next) break;
#pragma unroll
        for (int a = 0; a < 2; ++a)
#pragma unroll
            for (int b = 0; b < 2; ++b)
#pragma unroll
                for (int m = 0; m < 4; ++m)
#pragma unroll
                    for (int n = 0; n < 2; ++n) acc[a][b][m][n] = (f32x4){0.f, 0.f, 0.f, 0.f};
        cur = nxt; cA = nA; cB = nB; ++ui;
        if (wr == 1) PG8_BAR;
    }
    PG8_WAIT_V(0);
    PG8_BAR;
#undef PG8_SA
#undef PG8_SB
#undef PG8_STAGE
#undef PG8_LDA
#undef PG8_LDB
#undef PG8_MMA
#undef PG8_WAIT_V
#undef PG8_WAIT_L
#undef PG8_BAR
#undef PG8_SCHED
}

typedef f32x4 AccT[2][2][4][2];
struct EpiSwiGLU {
    bf16_t* O; const float* ss;
    __device__ __forceinline__ void operator()(const AccT& acc, const Unit& u, int wr, int wc, int fr, int fq) const {
        const int row0 = u.pm * BM + wr * 64 + fr, col = u.pn * 128 + wc * 32 + 8 * fq;
#pragma unroll
        for (int ai = 0; ai < 2; ++ai)
#pragma unroll
            for (int m = 0; m < 4; ++m) {
                const int row = row0 + ai * HALF + m * 16;
                const float rs = rsqrtf(ss[row] * (1.f / 1024.f) + EPS);
                float o[8];
#pragma unroll
                for (int n = 0; n < 2; ++n)
#pragma unroll
                    for (int j = 0; j < 4; ++j) { const float gt = acc[ai][0][m][n][j] * rs, up = acc[ai][1][m][n][j] * rs; o[n * 4 + j] = gt * up * sigmoidf_(gt); }
                *(u32x4*)(O + (size_t)row * FF + col) = pack8(o);
            }
    }
};
template <bool WRITE_XB> struct EpiRes {
    const float* res; float* out; bf16_t* xb; float* ss; float alpha;
    __device__ __forceinline__ void operator()(const AccT& acc, const Unit& u, int wr, int wc, int fr, int fq) const {
        const int row0 = u.pm * BM + wr * 64 + fr, col0 = u.pn * BM + wc * 32 + 8 * fq;
#pragma unroll
        for (int ai = 0; ai < 2; ++ai)
#pragma unroll
            for (int m = 0; m < 4; ++m) {
                const int row = row0 + ai * HALF + m * 16; float sq = 0.f;
#pragma unroll
                for (int bj = 0; bj < 2; ++bj) {
                    const size_t off = (size_t)row * DM + col0 + bj * HALF;
                    const f32x4 r0 = *(const f32x4*)(res + off), r1 = *(const f32x4*)(res + off + 4);
                    const f32x4 v0 = r0 + acc[ai][bj][m][0] * alpha, v1 = r1 + acc[ai][bj][m][1] * alpha;
                    *(f32x4*)(out + off) = v0; *(f32x4*)(out + off + 4) = v1;
                    if (WRITE_XB) {
                        u32x4 w; w.x = cvt_pk_bf16(v0[0], v0[1]); w.y = cvt_pk_bf16(v0[2], v0[3]); w.z = cvt_pk_bf16(v1[0], v1[1]); w.w = cvt_pk_bf16(v1[2], v1[3]);
                        *(u32x4*)(xb + off) = w;
                        sq += v0[0] * v0[0] + v0[1] * v0[1] + v0[2] * v0[2] + v0[3] * v0[3] + v1[0] * v1[0] + v1[1] * v1[1] + v1[2] * v1[2] + v1[3] * v1[3];
                    }
                }
                if (WRITE_XB) { sq += __shfl_xor(sq, 16); sq += __shfl_xor(sq, 32); if (fq == 0) atomicAdd(ss + row, sq); }
            }
    }
};
struct EpiP {
    bf16_t* P; float* SM; const float* ss;
    __device__ __forceinline__ void operator()(const AccT& acc, const Unit& u, int wr, int wc, int fr, int fq) const {
        const int row0 = u.pm * BM + wr * 64 + fr, col0 = u.pn * BM + wc * 32 + 8 * fq;
#pragma unroll
        for (int ai = 0; ai < 2; ++ai)
#pragma unroll
            for (int m = 0; m < 4; ++m) {
                const int row = row0 + ai * HALF + m * 16;
                const float rs = rsqrtf(ss[row] * (1.f / 1024.f) + EPS);
#pragma unroll
                for (int bj = 0; bj < 2; ++bj) {
                    const int col = col0 + bj * HALF;
                    const f32x4 v0 = acc[ai][bj][m][0] * rs, v1 = acc[ai][bj][m][1] * rs;
                    u32x4 w; w.x = cvt_pk_bf16(v0[0], v0[1]); w.y = cvt_pk_bf16(v0[2], v0[3]); w.z = cvt_pk_bf16(v1[0], v1[1]); w.w = cvt_pk_bf16(v1[2], v1[3]);
                    *(u32x4*)(P + (size_t)row * LDP + col) = w;
                    if (col >= C_SM && col < C_SM + 16) { float* s = SM + (size_t)row * 16 + (col - C_SM); *(f32x4*)s = v0; *(f32x4*)(s + 4) = v1; }
                }
            }
    }
};
struct EpiBf16 {
    bf16_t* O; int ldc;
    __device__ __forceinline__ void operator()(const AccT& acc, const Unit& u, int wr, int wc, int fr, int fq) const {
        const int row0 = u.pm * BM + wr * 64 + fr, col0 = u.pn * BM + wc * 32 + 8 * fq;
#pragma unroll
        for (int ai = 0; ai < 2; ++ai)
#pragma unroll
            for (int m = 0; m < 4; ++m) {
                const int row = row0 + ai * HALF + m * 16;
#pragma unroll
                for (int bj = 0; bj < 2; ++bj) {
                    const f32x4 v0 = acc[ai][bj][m][0], v1 = acc[ai][bj][m][1];
                    u32x4 w; w.x = cvt_pk_bf16(v0[0], v0[1]); w.y = cvt_pk_bf16(v0[2], v0[3]); w.z = cvt_pk_bf16(v1[0], v1[1]); w.w = cvt_pk_bf16(v1[2], v1[3]);
                    *(u32x4*)(O + (size_t)row * ldc + col0 + bj * HALF) = w;
                }
            }
    }
};
template <int PASS> struct EpiMerge {
    const bf16_t* P; bf16_t* MG; int goff;
    __device__ __forceinline__ void operator()(const AccT& acc, const Unit& u, int wr, int wc, int fr, int fq) const {
        const int row0 = u.pm * BM + wr * 64 + fr, col0 = u.pn * BM + wc * 32 + 8 * fq;
#pragma unroll
        for (int ai = 0; ai < 2; ++ai)
#pragma unroll
            for (int m = 0; m < 4; ++m) {
                const int row = row0 + ai * HALF + m * 16;
#pragma unroll
                for (int bj = 0; bj < 2; ++bj) {
                    const int col = col0 + bj * HALF;
                    float gt[8], o[8]; unpack8(*(const u32x4*)(P + (size_t)row * LDP + goff + col), gt);
                    if (PASS == 1) unpack8(*(const u32x4*)(MG + (size_t)row * DM + col), o);
#pragma unroll
                    for (int j = 0; j < 8; ++j) { const float a = acc[ai][bj][m][j >> 2][j & 3] * sigmoidf_(gt[j]); o[j] = (PASS == 1) ? o[j] + a : a; }
                    *(u32x4*)(MG + (size_t)row * DM + col) = pack8(o);
                }
            }
    }
};
}

struct Args {
    const float* in[24];
    float* out;
    unsigned char* ws;
};
enum { I_X = 0, I_F1N, I_F1G, I_F1U, I_F1D, I_MIXN, I_WIN, I_QN, I_KN, I_IKN, I_CW, I_CB, I_WMQ, I_WMK, I_BI, I_BF, I_MHN, I_WPA, I_WPB, I_WOUT, I_F2N, I_F2G, I_F2U, I_F2D };

template <class F> __device__ __forceinline__ void prep_tile(bf16_t* Bt, int K, int n0, int k0, const F src, float* tile) {
    const int tid = threadIdx.x;
    { const int nn = tid & 63, kk = tid >> 6;
#pragma unroll
        for (int i = 0; i < 8; ++i) { const int k = i * 8 + kk; tile[k * 65 + nn] = src(k0 + k, n0 + nn); } }
    __syncthreads();
    { const int nn = tid >> 3, kc = tid & 7; const float* s = tile + (kc * 8) * 65 + nn;
        u32x4 o; o.x = cvt_pk_bf16(s[0], s[65]); o.y = cvt_pk_bf16(s[130], s[195]); o.z = cvt_pk_bf16(s[260], s[325]); o.w = cvt_pk_bf16(s[390], s[455]);
        *(u32x4*)(Bt + (size_t)(n0 + nn) * K + k0 + kc * 8) = o; }
    __syncthreads();
}
struct SrcUp { const float* wg; const float* wu; const float* g;
    __device__ __forceinline__ float operator()(int k, int n) const { const int col = (n >> 8) * 128 + (n & 127); const size_t bj = (size_t)((n >> 7) & 1); const float* w = (const float*)((uintptr_t)wg + ((uintptr_t)wu - (uintptr_t)wg) * bj); return w[(size_t)k * FF + col] * g[k]; } };
struct SrcPlain { const float* w; int ldw;
    __device__ __forceinline__ float operator()(int k, int n) const { return w[(size_t)k * ldw + n]; } };
struct SrcIn { const float* w; const float* g;
    __device__ __forceinline__ float operator()(int k, int n) const {
        int col;
        if (n < 1344) col = n; else if (n < 2368) col = n + 8; else if (n < 4928) col = n + 16;
        else if (n < 4936) col = n - 4928 + 1344; else if (n < 4940) col = n - 4936 + 2376; else if (n < 4944) col = n - 4940 + 2380; else col = -1;
        return col >= 0 ? w[(size_t)k * 4944 + col] * g[k] : 0.f; } };
struct SrcQK { const float* wq; const float* wk;
    __device__ __forceinline__ float operator()(int k, int n) const {
        const int isk = n >> 8, h = (n >> 6) & 3, j = n & 63, hk = k >> 7, c = k & 127;
        if (hk != h) return 0.f;
        const float* w = (const float*)((uintptr_t)wq + ((uintptr_t)wk - (uintptr_t)wq) * (size_t)isk); return w[(size_t)(h * 128 + c) * 64 + j] * (isk ? 1.f : 0.125f); } };

__device__ __forceinline__ void phase0(const Args& a, unsigned char* lds) {
    float* tile = (float*)lds;
    unsigned char* ws = a.ws;
    constexpr int T_UP = 88 * 16, T_DN = 16 * 44, T_IN = 80 * 16, T_PR = 16 * 8, T_WO = 16 * 16, T_QK = 8 * 8;
    constexpr int NITEMS = 2 * T_UP + 2 * T_DN + T_IN + 2 * T_PR + T_WO + T_QK;
    for (int it = blockIdx.x; it < NITEMS; it += gridDim.x) {
        int r = it;
        if (r < T_UP) { SrcUp s{a.in[I_F1G], a.in[I_F1U], a.in[I_F1N]}; prep_tile((bf16_t*)(ws + WS_W1), 1024, (r / 16) * 64, (r % 16) * 64, s, tile); continue; } r -= T_UP;
        if (r < T_UP) { SrcUp s{a.in[I_F2G], a.in[I_F2U], a.in[I_F2N]}; prep_tile((bf16_t*)(ws + WS_W3), 1024, (r / 16) * 64, (r % 16) * 64, s, tile); continue; } r -= T_UP;
        if (r < T_DN) { SrcPlain s{a.in[I_F1D], 1024}; prep_tile((bf16_t*)(ws + WS_W2), FF, (r / 44) * 64, (r % 44) * 64, s, tile); continue; } r -= T_DN;
        if (r < T_DN) { SrcPlain s{a.in[I_F2D], 1024}; prep_tile((bf16_t*)(ws + WS_W4), FF, (r / 44) * 64, (r % 44) * 64, s, tile); continue; } r -= T_DN;
        if (r < T_IN) { SrcIn s{a.in[I_WIN], a.in[I_MIXN]}; prep_tile((bf16_t*)(ws + WS_WIN), 1024, (r / 16) * 64, (r % 16) * 64, s, tile); continue; } r -= T_IN;
        if (r < T_PR) { SrcPlain s{a.in[I_WPA], 1024}; prep_tile((bf16_t*)(ws + WS_WA), 512, (r / 8) * 64, (r % 8) * 64, s, tile); continue; } r -= T_PR;
        if (r < T_PR) { SrcPlain s{a.in[I_WPB], 1024}; prep_tile((bf16_t*)(ws + WS_WB), 512, (r / 8) * 64, (r % 8) * 64, s, tile); continue; } r -= T_PR;
        if (r < T_WO) { SrcPlain s{a.in[I_WOUT], 1024}; prep_tile((bf16_t*)(ws + WS_WO), 1024, (r / 16) * 64, (r % 16) * 64, s, tile); continue; } r -= T_WO;
        { SrcQK s{a.in[I_WMQ], a.in[I_WMK]}; prep_tile((bf16_t*)(ws + WS_WQK), 512, (r / 8) * 64, (r % 8) * 64, s, tile); }
    }
    const int lane = threadIdx.x & 63, gw = blockIdx.x * 8 + (threadIdx.x >> 6), NGW = gridDim.x * 8;
    const float* x = a.in[I_X]; bf16_t* XB = (bf16_t*)(ws + WS_XB);
    float* ss0 = (float*)(ws + WS_SS0); float* ss1 = (float*)(ws + WS_SS1); float* ss2 = (float*)(ws + WS_SS2);
    for (int row = gw; row < MROWS; row += NGW) {
        const f32x4* xr = (const f32x4*)(x + (size_t)row * DM) + lane;
        f32x4 v[4]; float s = 0.f;
#pragma unroll
        for (int j = 0; j < 4; ++j) { v[j] = xr[64 * j]; s += v[j][0] * v[j][0] + v[j][1] * v[j][1] + v[j][2] * v[j][2] + v[j][3] * v[j][3]; }
        s = wave_sum(s);
        if (lane == 0) { ss0[row] = s; ss1[row] = 0.f; ss2[row] = 0.f; }
        unsigned long long* o8 = (unsigned long long*)(XB + (size_t)row * DM) + lane;
#pragma unroll
        for (int j = 0; j < 4; ++j) o8[64 * j] = (unsigned long long)cvt_pk_bf16(v[j][0], v[j][1]) | ((unsigned long long)cvt_pk_bf16(v[j][2], v[j][3]) << 32);
    }
}

__device__ __forceinline__ void phase_postp(const Args& a) {
    unsigned char* ws = a.ws;
    bf16_t* P = (bf16_t*)(ws + WS_P); bf16_t* XC = (bf16_t*)(ws + WS_XB); bf16_t* IKC = (bf16_t*)(ws + WS_IKC); bf16_t* KVC = (bf16_t*)(ws + WS_KVC);
    const int lane = threadIdx.x & 63, gw = blockIdx.x * 8 + (threadIdx.x >> 6), NGW = gridDim.x * 8;
    const int c0 = lane * 8;
    float cw[4][8], cb[8], gq[8], gk[8];
#pragma unroll
    for (int e = 0; e < 8; ++e) {
        cb[e] = a.in[I_CB][c0 + e];
#pragma unroll
        for (int j = 0; j < 4; ++j) cw[j][e] = a.in[I_CW][j * 512 + c0 + e];
        gq[e] = a.in[I_QN][(lane & 7) * 8 + e];
        gk[e] = (lane < 16) ? a.in[I_KN][(lane & 7) * 8 + e] : a.in[I_IKN][(lane & 7) * 8 + e];
    }
    const int koff = (lane < 16) ? (C_AK + lane * 8) : (C_IK + (lane & 7) * 8);
    for (int row = gw; row < MROWS; row += NGW) {
        bf16_t* pr = P + (size_t)row * LDP;
        const int t = row & (SEQ - 1);
        float accv[8];
#pragma unroll
        for (int e = 0; e < 8; ++e) accv[e] = cb[e];
#pragma unroll
        for (int j = 0; j < 4; ++j) {
            const int tt = t - 3 + j;
            if (tt >= 0) { float xf[8]; unpack8(*(const u32x4*)(P + (size_t)(row - 3 + j) * LDP + C_MX + c0), xf);
#pragma unroll
                for (int e = 0; e < 8; ++e) accv[e] += xf[e] * cw[j][e]; }
        }
#pragma unroll
        for (int e = 0; e < 8; ++e) accv[e] = accv[e] * sigmoidf_(accv[e]);
        *(u32x4*)(XC + (size_t)row * 512 + c0) = pack8(accv);
        { float f[8]; unpack8(*(const u32x4*)(pr + C_AQ + c0), f); float s = 0.f;
#pragma unroll
            for (int e = 0; e < 8; ++e) s += f[e] * f[e];
            s += __shfl_xor(s, 1); s += __shfl_xor(s, 2); s += __shfl_xor(s, 4);
            const float rs = rsqrtf(s * (1.f / 64.f) + EPS);
#pragma unroll
            for (int e = 0; e < 8; ++e) f[e] = f[e] * rs * gq[e];
            *(u32x4*)(pr + C_AQ + c0) = pack8(f); }
        { float f[8]; unpack8(*(const u32x4*)(pr + koff), f); float s = 0.f;
#pragma unroll
            for (int e = 0; e < 8; ++e) s += f[e] * f[e];
            s += __shfl_xor(s, 1); s += __shfl_xor(s, 2); s += __shfl_xor(s, 4);
            const float rs = rsqrtf(s * (1.f / 64.f) + EPS);
#pragma unroll
            for (int e = 0; e < 8; ++e) f[e] = f[e] * rs * gk[e];
            if (lane < 16) *(u32x4*)(KVC + (size_t)row * 256 + lane * 8) = pack8(f);
            else if (lane < 24) *(u32x4*)(IKC + ((((size_t)(row >> 4)) * 8 + (lane - 16)) * 16 + (row & 15)) * 8) = pack8(f);
            else if (lane >= 32 && lane < 48) *(u32x4*)(KVC + (size_t)row * 256 + 128 + (lane - 32) * 8) = *(const u32x4*)(pr + C_AV + (lane - 32) * 8); }
    }
}

__device__ __forceinline__ unsigned fkey(float s) { const unsigned u = __float_as_uint(s); return (u & 0x80000000u) ? ~u : (u | 0x80000000u); }


__device__ __forceinline__ unsigned wave_incl_scan_dpp(unsigned x) {
    x += (unsigned)__builtin_amdgcn_update_dpp(0, (int)x, 0x111, 0xf, 0xf, false);
    x += (unsigned)__builtin_amdgcn_update_dpp(0, (int)x, 0x112, 0xf, 0xf, false);
    x += (unsigned)__builtin_amdgcn_update_dpp(0, (int)x, 0x114, 0xf, 0xf, false);
    x += (unsigned)__builtin_amdgcn_update_dpp(0, (int)x, 0x118, 0xf, 0xf, false);
    x += (unsigned)__builtin_amdgcn_update_dpp(0, (int)x, 0x142, 0xa, 0xf, false);
    x += (unsigned)__builtin_amdgcn_update_dpp(0, (int)x, 0x143, 0xc, 0xf, false);
    return x;
}
__device__ __forceinline__ int find_bin(const unsigned* hist, int& need, int lane, int& binc) {
    const int base = 1023 - 16 * lane; unsigned s = 0;
#pragma unroll
    for (int i = 0; i < 16; ++i) { const unsigned w = hist[base - ((i + lane) & 15)]; s += (w & 0xffffu) + (w >> 16); }
    const unsigned p = wave_incl_scan_dpp(s);
    const unsigned long long bal = __ballot(p >= (unsigned)need);
    const int L = bal ? (__ffsll((long long)bal) - 1) : 63;
    const unsigned excl = __shfl(p - s, L);
    int cum = (int)excl, bin = -1, fneed = 1, bc = 1; const int b0 = 1023 - 16 * L;
#pragma unroll
    for (int i = 0; i < 16; ++i) {
        const unsigned w = hist[b0 - i]; const int hi = (int)(w >> 16), lo = (int)(w & 0xffffu);
        if (bin < 0) { if (cum + hi >= need) { bin = 2 * (b0 - i) + 1; fneed = need - cum; bc = hi; } else cum += hi; }
        if (bin < 0) { if (cum + lo >= need) { bin = 2 * (b0 - i); fneed = need - cum; bc = lo; } else cum += lo; }
    }
    if (bin < 0) bin = 0;
    need = fneed; binc = bc; return bin;
}


__device__ __forceinline__ int find_bin128(const unsigned* sh, int& need, int lane, int& binc) {
    const unsigned hi = sh[127 - 2 * lane], lo = sh[126 - 2 * lane]; const unsigned s = hi + lo;
    const unsigned p = wave_incl_scan_dpp(s);
    const unsigned long long bal = __ballot(p >= (unsigned)need);
    const int L = bal ? (__ffsll((long long)bal) - 1) : 63;
    const int excl = (int)__shfl(p - s, L); const int hiL = (int)__shfl(hi, L), loL = (int)__shfl(lo, L);
    int bin, fneed, bc;
    if (excl + hiL >= need) { bin = 127 - 2 * L; fneed = need - excl; bc = hiL; } else { bin = 126 - 2 * L; fneed = need - excl - hiL; bc = loL; }
    if (fneed < 1) fneed = 1;
    need = fneed; binc = bc; return bin;
}

template <bool DUMMY> __device__ __forceinline__ void phase_dsa(const Args& a, unsigned char* lds) {
    unsigned char* ws = a.ws;
    bf16_t* P = (bf16_t*)(ws + WS_P); const float* SM = (const float*)(ws + WS_SM);
    const bf16_t* IKC = (const bf16_t*)(ws + WS_IKC); const bf16_t* KVC = (const bf16_t*)(ws + WS_KVC);
    constexpr int SCS = 8200;
    float* SC = (float*)lds;
    unsigned* HIST = (unsigned*)(lds + 131200);
    int* LIST = (int*)(lds + 131200 + 16384);
    unsigned* QS = (unsigned*)(lds + 131200 + 16384 + 4096);
    int* CNT = (int*)(lds + 131200 + 16384 + 4096 + 4096);
    const float idx_scale = 0.125f * 0.35355339059327373f;
    f32x4 wqv[2]; unsigned qsv[2];
#define DSA_LOAD_ITEM(ITEM) do { const int b_ = (ITEM) & 7, t0_ = ((ITEM) >> 3) * 4; const size_t r_ = (size_t)b_ * SEQ + t0_; \
        int tl_ = threadIdx.x; asm volatile("" : "+v"(tl_)); const int ln_ = tl_ & 63, q4_ = ln_ >> 4; \
        wqv[0] = *(const f32x4*)(SM + (r_ + q4_) * 16); wqv[1] = *(const f32x4*)(SM + (r_ + q4_) * 16 + 4); \
        _Pragma("unroll") for (int i_ = 0; i_ < 2; ++i_) { const int e_ = tl_ + 512 * i_; qsv[i_] = *(const unsigned*)(P + (r_ + (e_ >> 8)) * LDP + C_AQ + (e_ & 255) * 2); } } while (0)
    if ((int)blockIdx.x < 16384) DSA_LOAD_ITEM(blockIdx.x);
    for (int item = blockIdx.x; item < 16384; item += gridDim.x) {
        int tid_ = threadIdx.x; asm volatile("" : "+v"(tid_));
        const int tid = tid_, wave = __builtin_amdgcn_readfirstlane(tid >> 6), lane = tid & 63, quad = lane >> 4, l15 = lane & 15;
        const int b = item & 7, tq = item >> 3, t0 = tq * 4, L = ((t0 >> 6) + 1) * 64;
        const size_t r0 = (size_t)b * SEQ + t0;
        const bool do_sel = (L > 256) && !DBG_NOSEL;
        { u32x4* hz = (u32x4*)HIST; hz[tid] = (u32x4){0u, 0u, 0u, 0u}; hz[tid + 512] = (u32x4){0u, 0u, 0u, 0u}; }
        if (tid < 8) CNT[4 + tid] = 0;
        QS[tid] = qsv[0]; QS[tid + 512] = qsv[1];
        float wq[8];
#pragma unroll
        for (int h = 0; h < 4; ++h) { wq[h] = wqv[0][h] * idx_scale; wq[4 + h] = wqv[1][h] * idx_scale; }
        bf16x8 af[2][2];
#pragma unroll
        for (int T = 0; T < 2; ++T)
#pragma unroll
            for (int ks = 0; ks < 2; ++ks) af[T][ks] = *(const bf16x8*)(P + (r0 + (l15 >> 2)) * LDP + C_IQ + (4 * T + (l15 & 3)) * 64 + ks * 32 + quad * 8);
        const int ngroups = L >> 6;
        const bf16_t* ikb = IKC + (size_t)b * SEQ * 64 + (quad * 16 + l15) * 8;
        bf16x8 B0[4][2], B1[4][2], B2[4][2];
#define IDX_LOAD(BUF, G) do { _Pragma("unroll") for (int tt = 0; tt < 4; ++tt) _Pragma("unroll") for (int ks = 0; ks < 2; ++ks) \
                BUF[tt][ks] = *(const bf16x8*)(ikb + (size_t)(((G) * 4 + tt) * 8 + ks * 4) * 128); } while (0)
        if (wave < ngroups) IDX_LOAD(B0, wave);
        if (wave + 8 < ngroups) IDX_LOAD(B1, wave + 8);
        if (wave + 16 < ngroups) IDX_LOAD(B2, wave + 16);
        lds_fence(); __builtin_amdgcn_s_barrier();
        for (int rep = 0; rep < ((DBG_TWICE & 2) ? 2 : 1); ++rep) {
            const bool hist_on = do_sel && (rep == (((DBG_TWICE & 2) ? 2 : 1) - 1));
#define IDX_COMPUTE(BUF, G) do { _Pragma("unroll") for (int tt = 0; tt < 4; ++tt) { \
                const int key = (G) * 64 + tt * 16 + l15; \
                f32x4 c0 = (f32x4){0.f, 0.f, 0.f, 0.f}, c1 = (f32x4){0.f, 0.f, 0.f, 0.f}; \
                c0 = __builtin_amdgcn_mfma_f32_16x16x32_bf16(af[0][0], BUF[tt][0], c0, 0, 0, 0); \
                c1 = __builtin_amdgcn_mfma_f32_16x16x32_bf16(af[1][0], BUF[tt][0], c1, 0, 0, 0); \
                c0 = __builtin_amdgcn_mfma_f32_16x16x32_bf16(af[0][1], BUF[tt][1], c0, 0, 0, 0); \
                c1 = __builtin_amdgcn_mfma_f32_16x16x32_bf16(af[1][1], BUF[tt][1], c1, 0, 0, 0); \
                float sc = 0.f; \
                _Pragma("unroll") for (int j = 0; j < 4; ++j) { sc += wq[j] * relu_(c0[j]); sc += wq[4 + j] * relu_(c1[j]); } \
                sc += 0.f; \
                SC[quad * SCS + key] = sc; \
                if (hist_on) { const unsigned bin = fkey(sc) >> 21; atomicAdd(&HIST[quad * 1024 + (bin >> 1)], (bin & 1u) ? 0x10000u : 1u); } } } while (0)
            int g = wave;
            for (; g < ngroups; g += 24) {
                IDX_COMPUTE(B0, g);
                if (g + 24 < ngroups) IDX_LOAD(B0, g + 24);
                if (g + 8 < ngroups) { IDX_COMPUTE(B1, g + 8); if (g + 32 < ngroups) IDX_LOAD(B1, g + 32); }
                if (g + 16 < ngroups) { IDX_COMPUTE(B2, g + 16); if (g + 40 < ngroups) IDX_LOAD(B2, g + 40); }
            }
#undef IDX_LOAD
#undef IDX_COMPUTE
        }
        lds_fence(); __builtin_amdgcn_s_barrier();
        if (item + (int)gridDim.x < 16384) DSA_LOAD_ITEM(item + (int)gridDim.x);
        {
            constexpr int CAP = 448;
            const unsigned long long ltmask = (1ull << lane) - 1ull;
            if (!do_sel) {
                const int q = wave >> 1, hf = wave & 1; int* list = LIST + q * 256;
                if (hf == 0) { for (int i = lane; i < 256; i += 64) list[i] = (i < L) ? i : 0; if (lane == 0) CNT[q] = L; }
            } else {
                {
                    const int q = wave >> 1, hf = wave & 1; int* list = LIST + q * 256; const float* sc = SC + q * SCS; unsigned* hist = HIST + q * 1024;
                    const int halfL = L >> 1, beg = hf * halfL, end = beg + halfL;
                    int need = 256, binc = 0;
                    const unsigned b1 = (unsigned)find_bin(hist, need, lane, binc);
                    const int c1 = binc, nsure = 256 - need; const bool store_c = c1 <= CAP;
                    if (hf == 0 && lane == 0) { CNT[12 + q] = (int)b1; CNT[16 + q] = need; CNT[8 + q] = c1; }
                    lds_fence(); __builtin_amdgcn_s_barrier();
                    int cs = 0, cc = 0;
                    for (int i0 = beg + lane * 4; i0 < end; i0 += 256) { const f32x4 v = *(const f32x4*)(sc + i0);
#pragma unroll
                        for (int e = 0; e < 4; ++e) { const unsigned k = fkey(v[e]); const unsigned kb = k >> 21;
                            const bool sure = kb > b1, cand = (kb == b1) && store_c;
                            const unsigned long long ms = __ballot(sure), mc = __ballot(cand);
                            if (ms) { const int p = cs + __popcll(ms & ltmask); const int pp = hf ? nsure - 1 - p : p; if (sure && pp >= 0 && pp < 256) list[pp] = i0 + e; cs += __popcll(ms); }
                            if (mc) { const int p = cc + __popcll(mc & ltmask); const int pp = hf ? c1 - 1 - p : p; if (cand && pp >= 0 && pp < CAP) { hist[2 * pp] = k; hist[2 * pp + 1] = (unsigned)(i0 + e); } cc += __popcll(mc); } } }
                    lds_fence(); __builtin_amdgcn_s_barrier();
                }
                if (wave < 4) {
                    const int q = wave; int* list = LIST + q * 256; unsigned* hist = HIST + q * 1024; unsigned* sh = hist + 896; const float* sc = SC + q * SCS;
                    const unsigned b1 = (unsigned)CNT[12 + q]; int need = CNT[16 + q]; const int c = CNT[8 + q]; const int nsure = 256 - need;
                    if (c <= CAP) {
                        unsigned ck[7]; int ci[7];
#pragma unroll
                        for (int t = 0; t < 7; ++t) { const int i = lane + 64 * t; const bool valid = i < c; ck[t] = valid ? hist[2 * i] : 0u; ci[t] = valid ? (int)hist[2 * i + 1] : -1; }
                        int binc = 0;
                        sh[2 * lane] = 0u; sh[2 * lane + 1] = 0u; lds_fence();
#pragma unroll
                        for (int t = 0; t < 7; ++t) if (ci[t] >= 0) atomicAdd(&sh[(ck[t] >> 14) & 127u], 1u);
                        lds_fence();
                        const unsigned bA = (unsigned)find_bin128(sh, need, lane, binc);
                        lds_fence();
                        sh[2 * lane] = 0u; sh[2 * lane + 1] = 0u; lds_fence();
#pragma unroll
                        for (int t = 0; t < 7; ++t) if (ci[t] >= 0 && ((ck[t] >> 14) & 127u) == bA) atomicAdd(&sh[(ck[t] >> 7) & 127u], 1u);
                        lds_fence();
                        const unsigned bB = (unsigned)find_bin128(sh, need, lane, binc);
                        const unsigned preB = (bA << 7) | bB;
                        lds_fence();
                        sh[2 * lane] = 0u; sh[2 * lane + 1] = 0u; lds_fence();
#pragma unroll
                        for (int t = 0; t < 7; ++t) if (ci[t] >= 0 && ((ck[t] >> 7) & 0x3fffu) == preB) atomicAdd(&sh[ck[t] & 127u], 1u);
                        lds_fence();
                        const unsigned bC = (unsigned)find_bin128(sh, need, lane, binc);
                        const unsigned T = (b1 << 21) | (preB << 7) | bC;
                        const int tie_total = binc, need_t = need;
                        int cnt = 0;
#pragma unroll
                        for (int t = 0; t < 7; ++t) {
                            const bool valid = ci[t] >= 0;
                            bool sel = valid && (ck[t] > T);
                            if (valid && ck[t] == T) {
                                if (tie_total == need_t) sel = true;
                                else { int rank = 0; for (int j = 0; j < c; ++j) rank += (hist[2 * j] == T && (int)hist[2 * j + 1] < ci[t]) ? 1 : 0; sel = rank < need_t; }
                            }
                            const unsigned long long m = __ballot(sel);
                            const int pos = nsure + cnt + __popcll(m & ltmask);
                            if (sel && pos < 256) list[pos] = ci[t];
                            cnt += __popcll(m);
                        }
                    } else {
                        int binc = 0;
                        lds_fence();
#pragma unroll
                        for (int i = 0; i < 16; ++i) hist[lane * 16 + i] = 0u;
                        lds_fence();
                        for (int i0 = 0; i0 < L; i0 += 64) { const unsigned k = fkey(sc[i0 + lane]); if ((k >> 21) == b1) { const unsigned bin = (k >> 10) & 2047u; atomicAdd(&hist[bin >> 1], (bin & 1u) ? 0x10000u : 1u); } }
                        lds_fence();
                        const unsigned b2 = (unsigned)find_bin(hist, need, lane, binc);
                        const unsigned pre2 = (b1 << 11) | b2;
                        lds_fence();
#pragma unroll
                        for (int i = 0; i < 16; ++i) hist[lane * 16 + i] = 0u;
                        lds_fence();
                        for (int i0 = 0; i0 < L; i0 += 64) { const unsigned k = fkey(sc[i0 + lane]); if ((k >> 10) == pre2) { const unsigned bin = k & 1023u; atomicAdd(&hist[bin >> 1], (bin & 1u) ? 0x10000u : 1u); } }
                        lds_fence();
                        const unsigned b3 = (unsigned)find_bin(hist, need, lane, binc);
                        const unsigned T = (pre2 << 10) | b3;
                        int count = 0, ties = 0;
                        for (int i0 = 0; i0 < L; i0 += 64) {
                            const unsigned k = fkey(sc[i0 + lane]);
                            const bool eq = (k == T);
                            const unsigned long long em = __ballot(eq);
                            const int erank = ties + __popcll(em & ltmask);
                            const bool sel = (k > T) || (eq && erank < need);
                            const unsigned long long smk = __ballot(sel);
                            const int pos = count + __popcll(smk & ltmask);
                            if (sel && pos < 256) list[pos] = i0 + lane;
                            count += __popcll(smk); ties += __popcll(em);
                        }
                        if (count > 256) count = 256;
                        for (int i = count + lane; i < 256; i += 64) list[i] = 0;
                    }
                    if (lane == 0) CNT[q] = 256;
                }
            }
        }
        lds_fence(); __builtin_amdgcn_s_barrier();
        for (int repc = 0; repc < ((DBG_TWICE & 4) ? 2 : 1); ++repc) {
            const bool dummy_c = (repc + 1) < ((DBG_TWICE & 4) ? 2 : 1);
            int lane_c = lane; asm volatile("" : "+v"(lane_c));
            const int qi = wave >> 1, g = wave & 1; const int count = CNT[qi];
            const int* list = LIST + qi * 256;
            float* PB = SC + wave * 1024;
            const unsigned* qd = QS + (qi * 8 + g * 4) * 32;
            const bf16_t* kvb = KVC + (size_t)b * SEQ * 256 + g * 64;
            const int ks = lane_c >> 3, dg = lane_c & 7, l15c = lane_c & 15, quadc = lane_c >> 4;
            const int nblk = count >> 6;
            bf16_t* KL = (bf16_t*)(lds + 32768 + wave * 9216);
            bf16x8 bq[2];
#pragma unroll
            for (int s2 = 0; s2 < 2; ++s2) {
                bf16x8 t = *(const bf16x8*)((const bf16_t*)QS + (qi * 8 + g * 4 + (l15c & 3)) * 64 + s2 * 32 + quadc * 8);
                if (l15c >= 4) t = (bf16x8){0, 0, 0, 0, 0, 0, 0, 0};
                bq[s2] = t;
            }
            const bf16_t* kb = kvb + dg * 8;
            float sreg[4][4][4];
            u32x4 kcur[8];
#pragma unroll
            for (int u = 0; u < 8; ++u) kcur[u] = *(const u32x4*)(kb + (size_t)list[u * 8 + ks] * 256);
#pragma unroll
            for (int blk = 0; blk < 4; ++blk) {
                if (blk < nblk) {
#pragma unroll
                    for (int u = 0; u < 8; ++u) *(u32x4*)(KL + (u * 8 + ks) * 72 + dg * 8) = kcur[u];
                    if (blk + 1 < nblk) {
#pragma unroll
                        for (int u = 0; u < 8; ++u) kcur[u] = *(const u32x4*)(kb + (size_t)list[(blk + 1) * 64 + u * 8 + ks] * 256);
                    }
                    lds_fence();
#pragma unroll
                    for (int kt = 0; kt < 4; ++kt) {
                        f32x4 acc = (f32x4){0.f, 0.f, 0.f, 0.f};
#pragma unroll
                        for (int s2 = 0; s2 < 2; ++s2) acc = __builtin_amdgcn_mfma_f32_16x16x32_bf16(*(const bf16x8*)(KL + (kt * 16 + l15c) * 72 + s2 * 32 + quadc * 8), bq[s2], acc, 0, 0, 0);
#pragma unroll
                        for (int j = 0; j < 4; ++j) sreg[blk][kt][j] = acc[j] * 0.125f;
                    }
                    lds_fence();
                } else {
#pragma unroll
                    for (int kt = 0; kt < 4; ++kt)
#pragma unroll
                        for (int j = 0; j < 4; ++j) sreg[blk][kt][j] = -INFINITY;
                }
            }
            const bf16_t* vb = kvb + 128 + dg * 8;
            u32x4 vreg[8];
#pragma unroll
            for (int u = 0; u < 8; ++u) vreg[u] = *(const u32x4*)(vb + (size_t)list[u * 8 + ks] * 256);
            float mx = -INFINITY;
#pragma unroll
            for (int blk = 0; blk < 4; ++blk)
#pragma unroll
                for (int kt = 0; kt < 4; ++kt)
#pragma unroll
                    for (int j = 0; j < 4; ++j) mx = fmaxf(mx, sreg[blk][kt][j]);
            mx = fmaxf(mx, __shfl_xor(mx, 16)); mx = fmaxf(mx, __shfl_xor(mx, 32));
            float sum = 0.f;
#pragma unroll
            for (int blk = 0; blk < 4; ++blk)
#pragma unroll
                for (int kt = 0; kt < 4; ++kt)
#pragma unroll
                    for (int j = 0; j < 4; ++j) { const float e = __expf(sreg[blk][kt][j] - mx); sreg[blk][kt][j] = e; sum += e; }
            sum += __shfl_xor(sum, 16); sum += __shfl_xor(sum, 32);
            const float invs = 1.f / sum;
            f32x4 oacc[4];
#pragma unroll
            for (int dt = 0; dt < 4; ++dt) oacc[dt] = (f32x4){0.f, 0.f, 0.f, 0.f};
            bf16_t* VT = KL;
#pragma unroll
            for (int blk = 0; blk < 4; ++blk) {
                if (blk < nblk) {
#pragma unroll
                    for (int u = 0; u < 8; ++u) {
                        const int rho = ((u >> 2) << 5) + ((((2 * u) & 3) + (ks >> 2)) << 3) + (((u >> 1) & 1) << 2) + (ks & 3);
                        *(u32x4*)(VT + rho * 72 + dg * 8) = vreg[u];
                    }
                    if (blk + 1 < nblk) {
#pragma unroll
                        for (int u = 0; u < 8; ++u) vreg[u] = *(const u32x4*)(vb + (size_t)list[(blk + 1) * 64 + u * 8 + ks] * 256);
                    }
                    lds_fence();
#pragma unroll
                    for (int s2 = 0; s2 < 2; ++s2) {
                        u32x4 pw;
                        pw[0] = cvt_pk_bf16(sreg[blk][2 * s2][0], sreg[blk][2 * s2][1]); pw[1] = cvt_pk_bf16(sreg[blk][2 * s2][2], sreg[blk][2 * s2][3]);
                        pw[2] = cvt_pk_bf16(sreg[blk][2 * s2 + 1][0], sreg[blk][2 * s2 + 1][1]); pw[3] = cvt_pk_bf16(sreg[blk][2 * s2 + 1][2], sreg[blk][2 * s2 + 1][3]);
                        const bf16x8 pf = __builtin_bit_cast(bf16x8, pw);
#pragma unroll
                        for (int dt = 0; dt < 4; ++dt) {
                            const LAS unsigned char* vp = (const LAS unsigned char*)VT + ((32 * s2 + 8 * quadc + (l15c >> 2)) * 72) * 2 + dt * 32 + (l15c & 3) * 8;
                            const v4i16_t t0 = __builtin_amdgcn_ds_read_tr16_b64_v4i16((LAS v4i16_t*)vp);
                            const v4i16_t t1 = __builtin_amdgcn_ds_read_tr16_b64_v4i16((LAS v4i16_t*)(vp + 4 * 72 * 2));
                            const bf16x8 af2 = (bf16x8){t0[0], t0[1], t0[2], t0[3], t1[0], t1[1], t1[2], t1[3]};
                            oacc[dt] = __builtin_amdgcn_mfma_f32_16x16x32_bf16(af2, pf, oacc[dt], 0, 0, 0);
                        }
                    }
                    lds_fence();
                }
            }
            if (l15c < 4) {
                bf16_t* yo = (DUMMY || dummy_c) ? ((bf16_t*)(ws + WS_MG + 48 * MiB) + (r0 + qi) * 512 + (g * 4 + l15c) * 64 + quadc * 4) : (P + (r0 + qi) * LDP + C_AQ + (g * 4 + l15c) * 64 + quadc * 4);
#pragma unroll
                for (int dt = 0; dt < 4; ++dt) {
                    const f32x4 v = oacc[dt] * invs;
                    u32x2 w; w[0] = cvt_pk_bf16(v[0], v[1]); w[1] = cvt_pk_bf16(v[2], v[3]);
                    *(u32x2*)(yo + dt * 16) = w;
                }
            }
        }
        lds_fence(); __builtin_amdgcn_s_barrier();
    }
#undef DSA_LOAD_ITEM
}

__device__ __forceinline__ float logsigmoidf_(float x) { return fminf(x, 0.f) - log1pf(__expf(-fabsf(x))); }
__device__ __forceinline__ float wave_incl_sum(float v, int lane) {
#pragma unroll
    for (int o = 1; o < 64; o <<= 1) { const float t = __shfl_up(v, o); if (lane >= o) v += t; }
    return v;
}
__device__ __forceinline__ float wave_incl_max(float v, int lane) {
#pragma unroll
    for (int o = 1; o < 64; o <<= 1) { const float t = __shfl_up(v, o); if (lane >= o) v = fmaxf(v, t); }
    return v;
}
__device__ __forceinline__ f32x4 mma_lds(const bf16_t* A, int lda, const bf16_t* Bt, int ldb, int K, int lane) {
    f32x4 acc = (f32x4){0.f, 0.f, 0.f, 0.f};
    const bf16_t* ap = A + (lane & 15) * lda + (lane >> 4) * 8; const bf16_t* bp = Bt + (lane & 15) * ldb + (lane >> 4) * 8;
    for (int k = 0; k < K; k += 32) acc = __builtin_amdgcn_mfma_f32_16x16x32_bf16(*(const bf16x8*)(ap + k), *(const bf16x8*)(bp + k), acc, 0, 0, 0);
    return acc;
}

__device__ __forceinline__ void phase_mlstm_a(const Args& a, unsigned char* lds) {
    unsigned char* ws = a.ws;
    const bf16_t* P = (const bf16_t*)(ws + WS_P); const bf16_t* QK = (const bf16_t*)(ws + WS_QK); const float* SM = (const float*)(ws + WS_SM);
    float* ST = (float*)(ws + WS_XB); float* DN = (float*)(ws + WS_DN); float* ML = (float*)(ws + WS_ML); float* BL = (float*)(ws + WS_BL);
    bf16_t* VT = (bf16_t*)lds;
    bf16_t* KT = (bf16_t*)(lds + 18432);
    float* WS_ = (float*)(lds + 18432 + 9216);
    const int tid = threadIdx.x, wave = tid >> 6, lane = tid & 63;
    for (int item = blockIdx.x; item < 4096; item += gridDim.x) {
        const int c = item & 127, h = (item >> 7) & 3, b = item >> 9;
        const size_t r0 = (size_t)b * SEQ + c * 64;
        if (wave == 0) {
            const float ig = SM[(r0 + lane) * 16 + 8 + h] + a.in[I_BI][h];
            const float lf = logsigmoidf_(SM[(r0 + lane) * 16 + 12 + h] + a.in[I_BF][h]);
            const float bs = wave_incl_sum(lf, lane);
            const float bl = __shfl(bs, 63);
            const float wk = bl - bs + ig;
            const float ml = wave_max(wk);
            WS_[lane] = __expf(wk - ml);
            if (lane == 0) { ML[item] = ml; BL[item] = bl; }
        }
        for (int i = tid; i < 1024; i += 512) { const int s = i >> 4, d0 = (i & 15) * 8; float f[8]; unpack8(*(const u32x4*)(P + (r0 + s) * LDP + C_MV + h * 128 + d0), f);
#pragma unroll
            for (int e = 0; e < 8; ++e) VT[(d0 + e) * 72 + s] = f2bf(f[e]); }
        __syncthreads();
        { const int s = tid >> 3, d0 = (tid & 7) * 8; float f[8]; unpack8(*(const u32x4*)(QK + (r0 + s) * 512 + 256 + h * 64 + d0), f); const float w = WS_[s];
#pragma unroll
            for (int e = 0; e < 8; ++e) KT[(d0 + e) * 72 + s] = f2bf(f[e] * w); }
        __syncthreads();
        float* st = ST + (size_t)item * 8192;
#pragma unroll
        for (int nt = 0; nt < 4; ++nt) {
            const f32x4 acc = mma_lds(VT + wave * 16 * 72, 72, KT + nt * 16 * 72, 72, 64, lane);
#pragma unroll
            for (int j = 0; j < 4; ++j) st[(wave * 16 + (lane >> 4) * 4 + j) * 64 + nt * 16 + (lane & 15)] = acc[j];
        }
        if (tid < 64) { float s = 0.f; for (int k = 0; k < 64; ++k) s += bf1(KT[tid * 72 + k]); DN[item * 64 + tid] = s; }
        __syncthreads();
    }
}
__device__ __forceinline__ void phase_mlstm_b(const Args& a) {
    unsigned char* ws = a.ws;
    float* ST = (float*)(ws + WS_XB); float* DN = (float*)(ws + WS_DN); const float* ML = (const float*)(ws + WS_ML); const float* BL = (const float*)(ws + WS_BL); float* MS = (float*)(ws + WS_MS);
    const int total = 32 * 8256;
    for (int w = blockIdx.x * 512 + threadIdx.x; w < total; w += gridDim.x * 512) {
        const int bh = w / 8256, e = w % 8256;
        float* p; int stride;
        if (e < 8192) { p = ST + (size_t)bh * 128 * 8192 + e; stride = 8192; } else { p = DN + (size_t)bh * 128 * 64 + (e - 8192); stride = 64; }
        float C = 0.f, m = 0.f;
        for (int c0 = 0; c0 < 128; c0 += 8) {
            float d[8], bl[8], ml[8];
#pragma unroll
            for (int u = 0; u < 8; ++u) { d[u] = p[(size_t)(c0 + u) * stride]; bl[u] = BL[bh * 128 + c0 + u]; ml[u] = ML[bh * 128 + c0 + u]; }
#pragma unroll
            for (int u = 0; u < 8; ++u) {
                p[(size_t)(c0 + u) * stride] = C;
                if (e == 0) MS[bh * 128 + c0 + u] = m;
                const float mn = fmaxf(bl[u] + m, ml[u]);
                C = __expf(bl[u] + m - mn) * C + __expf(ml[u] - mn) * d[u];
                m = mn;
            }
        }
    }
}
__device__ __forceinline__ void phase_mlstm_c(const Args& a, unsigned char* lds) {
    unsigned char* ws = a.ws;
    bf16_t* P = (bf16_t*)(ws + WS_P); const bf16_t* QK = (const bf16_t*)(ws + WS_QK); const float* SM = (const float*)(ws + WS_SM);
    const float* ST = (const float*)(ws + WS_XB); const float* DN = (const float*)(ws + WS_DN); const float* MS = (const float*)(ws + WS_MS);
    bf16_t* QS_ = (bf16_t*)lds;
    bf16_t* KS = (bf16_t*)(lds + 9216);
    bf16_t* AP = (bf16_t*)(lds + 18432);
    bf16_t* BT = (bf16_t*)(lds + 18432 + 17408);
    float* OUT = (float*)(lds + 18432 + 17408 + 34816);
    float* GS = (float*)(lds + 18432 + 17408 + 34816 + 33792);
    float* bS = GS; float* aS = GS + 64; float* mtS = GS + 128; float* wiS = GS + 192; float* nS = GS + 256; float* denS = GS + 320;
    const int tid = threadIdx.x, wave = tid >> 6, lane = tid & 63;
    for (int item = blockIdx.x; item < 4096; item += gridDim.x) {
        const int c = item & 127, h = (item >> 7) & 3, b = item >> 9;
        const size_t r0 = (size_t)b * SEQ + c * 64;
        if (wave == 0) {
            const float ig = SM[(r0 + lane) * 16 + 8 + h] + a.in[I_BI][h];
            const float lf = logsigmoidf_(SM[(r0 + lane) * 16 + 12 + h] + a.in[I_BF][h]);
            const float bs = wave_incl_sum(lf, lane);
            const float av = ig - bs;
            const float pm = wave_incl_max(av, lane);
            const float m0 = MS[item];
            const float mt = bs + fmaxf(pm, m0);
            bS[lane] = bs; aS[lane] = av; mtS[lane] = mt; wiS[lane] = __expf(bs + m0 - mt);
            nS[lane] = DN[item * 64 + lane];
        }
        { const int s = tid >> 3, d0 = (tid & 7) * 8;
            *(u32x4*)(QS_ + s * 72 + d0) = *(const u32x4*)(QK + (r0 + s) * 512 + h * 64 + d0);
            *(u32x4*)(KS + s * 72 + d0) = *(const u32x4*)(QK + (r0 + s) * 512 + 256 + h * 64 + d0); }
        for (int i = tid; i < 1024; i += 512) { const int s = i >> 4, d0 = (i & 15) * 8; float f[8]; unpack8(*(const u32x4*)(P + (r0 + s) * LDP + C_MV + h * 128 + d0), f);
#pragma unroll
            for (int e = 0; e < 8; ++e) BT[(d0 + e) * 136 + s] = f2bf(f[e]); }
        { const float* st = ST + (size_t)item * 8192;
            for (int i = tid; i < 2048; i += 512) { const int dv = i >> 4, k0 = (i & 15) * 4; const f32x4 v = *(const f32x4*)(st + dv * 64 + k0);
                *(unsigned*)(BT + dv * 136 + 64 + k0) = cvt_pk_bf16(v[0], v[1]); *(unsigned*)(BT + dv * 136 + 64 + k0 + 2) = cvt_pk_bf16(v[2], v[3]); } }
        __syncthreads();
#pragma unroll
        for (int u = 0; u < 2; ++u) {
            const int id = wave * 2 + u, tr = id >> 2, tc = id & 3;
            f32x4 acc = (f32x4){0.f, 0.f, 0.f, 0.f};
            if (tc <= tr) acc = mma_lds(QS_ + tr * 16 * 72, 72, KS + tc * 16 * 72, 72, 64, lane);
            const int s = tc * 16 + (lane & 15);
#pragma unroll
            for (int j = 0; j < 4; ++j) { const int t = tr * 16 + (lane >> 4) * 4 + j;
                const float w = (s <= t) ? acc[j] * __expf(bS[t] + aS[s] - mtS[t]) : 0.f;
                AP[t * 136 + s] = f2bf(w); }
        }
        { const int t = tid >> 3, d0 = (tid & 7) * 8; float f[8]; unpack8(*(const u32x4*)(QS_ + t * 72 + d0), f); const float w = wiS[t];
#pragma unroll
            for (int e = 0; e < 8; ++e) f[e] *= w;
            *(u32x4*)(AP + t * 136 + 64 + d0) = pack8(f); }
        __syncthreads();
#pragma unroll
        for (int tr = 0; tr < 4; ++tr) {
            const f32x4 acc = mma_lds(AP + tr * 16 * 136, 136, BT + wave * 16 * 136, 136, 128, lane);
#pragma unroll
            for (int j = 0; j < 4; ++j) OUT[(tr * 16 + (lane >> 4) * 4 + j) * 132 + wave * 16 + (lane & 15)] = acc[j];
        }
        { const int t = tid >> 3, part = tid & 7; float s = 0.f;
#pragma unroll
            for (int e = 0; e < 16; ++e) { const int k = part * 16 + e; const float v = bf1(AP[t * 136 + k]); s += (k < 64) ? v : v * nS[k - 64]; }
            s += __shfl_xor(s, 1); s += __shfl_xor(s, 2); s += __shfl_xor(s, 4);
            if (part == 0) denS[t] = s; }
        __syncthreads();
        { const int t = tid >> 3, part = tid & 7, dv0 = part * 16;
            const float den = fmaxf(fabsf(denS[t]), __expf(-mtS[t])); const float inv = 1.f / den;
            float hv[16]; float sq = 0.f;
#pragma unroll
            for (int e = 0; e < 16; ++e) { hv[e] = OUT[t * 132 + dv0 + e] * inv; sq += hv[e] * hv[e]; }
            sq += __shfl_xor(sq, 1); sq += __shfl_xor(sq, 2); sq += __shfl_xor(sq, 4);
            const float rs = rsqrtf(sq * (1.f / 128.f) + EPS);
            bf16_t* po = P + (r0 + t) * LDP + C_MO + h * 128 + dv0;
            float og[16]; unpack8(*(const u32x4*)po, og); unpack8(*(const u32x4*)(po + 8), og + 8);
#pragma unroll
            for (int e = 0; e < 16; ++e) hv[e] = hv[e] * rs * a.in[I_MHN][h * 128 + dv0 + e] * sigmoidf_(og[e]);
            *(u32x4*)po = pack8(hv); *(u32x4*)(po + 8) = pack8(hv + 8); }
        __syncthreads();
    }
}


#define XB_TMO      128
#define XB_XCNT(j)  (256  + 64 * (j))
#define XB_XSUB(j)  (1280 + 64 * (j))
#define XB_XGEN(j)  (2304 + 64 * (j))
#define XB_TOP      3328
#define XB_TOPGEN   3392
#define XCD_BAR_WORDS 3456
#define XB_SPIN_CAP (1u << 22)
__device__ __forceinline__ unsigned xb_ld(unsigned* p)              { return __hip_atomic_load(p, __ATOMIC_RELAXED, __HIP_MEMORY_SCOPE_AGENT); }
__device__ __forceinline__ unsigned xb_add(unsigned* p, unsigned v) { return __hip_atomic_fetch_add(p, v, __ATOMIC_RELAXED, __HIP_MEMORY_SCOPE_AGENT); }
__device__ __forceinline__ unsigned xb_xcc_id() { return (unsigned)__builtin_amdgcn_s_getreg((3 << 11) | 20) & 0xFu; }
#define XB_SPIN(cond, bar) do { unsigned _sp = 0; while (cond) { __builtin_amdgcn_s_sleep(1); \
    if ((++_sp & 255u) == 0u) { if (xb_ld(&(bar)[XB_TMO])) break; if (_sp > XB_SPIN_CAP) { atomicAdd(&(bar)[XB_TMO], 1u); break; } } } } while (0)
struct XcdBarrier { unsigned* bar; unsigned x; volatile LAS unsigned* st; };
__device__ __forceinline__ XcdBarrier xcd_barrier_post(unsigned* bar, volatile LAS unsigned* st) {
    XcdBarrier b; b.bar = bar; b.x = xb_xcc_id(); b.st = st;
    if (threadIdx.x == 0) (void)xb_add(&bar[XB_XCNT(b.x)], 1u);
    return b;
}
__device__ __forceinline__ void xcd_barrier_complete(unsigned* bar, unsigned x, unsigned& nloc, unsigned& nx) {
    const unsigned G = gridDim.x * gridDim.y * gridDim.z;
    unsigned sum, cnt, mine, sp = 0u;
    for (;;) {
        sum = 0u; cnt = 0u; mine = 0u;
#pragma unroll
        for (unsigned j = 0; j < 16; ++j) { const unsigned c = xb_ld(&bar[XB_XCNT(j)]); sum += c; cnt += (c > 0u) ? 1u : 0u; mine = (j == x) ? c : mine; }
        if (sum == G) break;
        __builtin_amdgcn_s_sleep(1);
        if ((++sp & 255u) == 0u) { if (xb_ld(&bar[XB_TMO])) break; if (sp > XB_SPIN_CAP) { atomicAdd(&bar[XB_TMO], 1u); break; } }
    }
    nloc = mine > 0u ? mine : 1u; nx = cnt > 0u ? cnt : 1u;
}
__device__ __forceinline__ void xcd_barrier(const XcdBarrier& b) {
    asm volatile("s_waitcnt vmcnt(0)" ::: "memory");
    __syncthreads();
    if (threadIdx.x == 0) {
        unsigned* bar = b.bar;
        __builtin_amdgcn_s_waitcnt(0);
        unsigned nloc = b.st[0], nx = b.st[1];
        if (nloc == 0u) { xcd_barrier_complete(bar, b.x, nloc, nx); b.st[0] = nloc; b.st[1] = nx; }
        const unsigned old = xb_add(&bar[XB_XSUB(b.x)], 1u);
        const unsigned gen = old / nloc;
        if (old + 1u == (gen + 1u) * nloc) {
            __builtin_amdgcn_fence(__ATOMIC_RELEASE, "agent");
            asm volatile("s_waitcnt vmcnt(0)" ::: "memory");
            const unsigned og = xb_add(&bar[XB_TOP], 1u);
            const unsigned tg = og / nx;
            if (og + 1u == (tg + 1u) * nx) xb_add(&bar[XB_TOPGEN], 1u);
            else XB_SPIN(xb_ld(&bar[XB_TOPGEN]) == tg, bar);
            __builtin_amdgcn_fence(__ATOMIC_ACQUIRE, "agent");
            xb_add(&bar[XB_XGEN(b.x)], 1u);
            asm volatile("s_waitcnt vmcnt(0)" ::: "memory");
        } else {
            XB_SPIN(xb_ld(&bar[XB_XGEN(b.x)]) == gen, bar);
            __builtin_amdgcn_fence(__ATOMIC_ACQUIRE, "agent");
            asm volatile("s_waitcnt vmcnt(0)" ::: "memory");
        }
    }
    __syncthreads();
}

#ifndef DBG_ZERO_YA
#define DBG_ZERO_YA 1
#endif
#ifndef PH
#define PH 0xFFFF
#endif
__global__ void __launch_bounds__(512, 2) mega_fwd(Args a) {
    extern __shared__ __attribute__((aligned(16))) unsigned char lds[];
    cg::grid_group grid = cg::this_grid();
    LAS unsigned char* ldsl = (LAS unsigned char*)lds;
    unsigned char* ws = a.ws;
    const int G = gridDim.x, bid = blockIdx.x;
    bf16_t* XB = (bf16_t*)(ws + WS_XB); bf16_t* Pb = (bf16_t*)(ws + WS_P); bf16_t* MG = (bf16_t*)(ws + WS_MG); bf16_t* QKb = (bf16_t*)(ws + WS_QK);
    float* ss0 = (float*)(ws + WS_SS0); float* ss1 = (float*)(ws + WS_SS1); float* ss2 = (float*)(ws + WS_SS2);

    unsigned* barw = (unsigned*)(ws + WS_BAR);
    if (bid == 0) { for (int i = threadIdx.x; i < XCD_BAR_WORDS; i += 512) barw[i] = 0u; }
    volatile LAS unsigned* bst = (volatile LAS unsigned*)(ldsl + LDS_BYTES - 16);
    if (threadIdx.x == 0) { bst[0] = 0u; bst[1] = 0u; }
    if (PH & 1) phase0(a, lds);
    __threadfence();
    grid.sync();
    const XcdBarrier xbar = xcd_barrier_post(barw, bst);
    if (PH & 2) {
        pg8::Gemm g{XB, (const bf16_t*)(ws + WS_W1), DM, DM, MROWS, 2 * FF, DM}; pg8::StaticOrder S; S.init(MROWS, 2 * FF, G, bid);
        pg8::EpiSwiGLU E{Pb, ss0}; pg8::gemm_phase(ldsl, g, S, E);
    }
    xcd_barrier(xbar);
    if (PH & 4) {
        pg8::Gemm g{Pb, (const bf16_t*)(ws + WS_W2), FF, FF, MROWS, DM, FF}; pg8::StaticOrder S; S.init(MROWS, DM, G, bid);
        pg8::EpiRes<true> E{a.in[I_X], a.out, XB, ss1, 0.5f}; pg8::gemm_phase(ldsl, g, S, E);
    }
    xcd_barrier(xbar);
    if (PH & 8) {
        pg8::Gemm g{XB, (const bf16_t*)(ws + WS_WIN), DM, DM, MROWS, LDP, DM}; pg8::StaticOrder S; S.init(MROWS, LDP, G, bid);
        pg8::EpiP E{Pb, (float*)(ws + WS_SM), ss1}; pg8::gemm_phase(ldsl, g, S, E);
    }
    xcd_barrier(xbar);
    if (PH & 16) phase_postp(a);
    xcd_barrier(xbar);
    if (PH & 32) {
        pg8::Gemm g{XB, (const bf16_t*)(ws + WS_WQK), 512, 512, MROWS, 512, 512}; pg8::StaticOrder S; S.init(MROWS, 512, G, bid);
        pg8::EpiBf16 E{QKb, 512}; pg8::gemm_phase(ldsl, g, S, E);
    }
    xcd_barrier(xbar);
    if (PH & 64) phase_mlstm_a(a, lds);
    xcd_barrier(xbar);
    if (PH & 128) phase_mlstm_b(a);
    xcd_barrier(xbar);
    if (PH & 256) phase_mlstm_c(a, lds);
    if (DBG_TWICE & 1) phase_dsa<true>(a, lds);
    if (PH & 512) phase_dsa<false>(a, lds);
    xcd_barrier(xbar);
    if (PH & 1024) {
        pg8::StaticOrder S; S.init(MROWS, DM, G, bid);
        { pg8::Gemm g{Pb + C_AQ, (const bf16_t*)(ws + WS_WA), LDP, 512, MROWS, DM, 512}; pg8::EpiMerge<0> E{Pb, MG, C_GA}; pg8::gemm_phase(ldsl, g, S, E); }
        { pg8::Gemm g{Pb + C_MO, (const bf16_t*)(ws + WS_WB), LDP, 512, MROWS, DM, 512}; pg8::EpiMerge<1> E{Pb, MG, C_GB}; pg8::gemm_phase(ldsl, g, S, E); }
    }
    xcd_barrier(xbar);
    if (PH & 2048) {
        pg8::Gemm g{MG, (const bf16_t*)(ws + WS_WO), DM, DM, MROWS, DM, DM}; pg8::StaticOrder S; S.init(MROWS, DM, G, bid);
        pg8::EpiRes<true> E{a.out, a.out, XB, ss2, 1.0f}; pg8::gemm_phase(ldsl, g, S, E);
    }
    xcd_barrier(xbar);
    if (PH & 4096) {
        pg8::Gemm g{XB, (const bf16_t*)(ws + WS_W3), DM, DM, MROWS, 2 * FF, DM}; pg8::StaticOrder S; S.init(MROWS, 2 * FF, G, bid);
        pg8::EpiSwiGLU E{Pb, ss2}; pg8::gemm_phase(ldsl, g, S, E);
    }
    xcd_barrier(xbar);
    if (PH & 8192) {
        pg8::Gemm g{Pb, (const bf16_t*)(ws + WS_W4), FF, FF, MROWS, DM, FF}; pg8::StaticOrder S; S.init(MROWS, DM, G, bid);
        pg8::EpiRes<false> E{a.out, a.out, nullptr, nullptr, 0.5f}; pg8::gemm_phase(ldsl, g, S, E);
    }
}

extern "C" void kernel_launch(void* const* d_in, const int* in_sizes, int n_in, void* d_out, int out_size, void* d_ws, size_t ws_size, hipStream_t stream) {
    static int grid = 0;
    if (grid == 0) {
        if (n_in != 24 || ws_size < WS_END) { fprintf(stderr, "kernel_launch: unexpected n_in %d / ws %zu\n", n_in, ws_size); grid = -1; return; }
        int dev = 0, cus = 0, per_cu = 0;
        hipGetDevice(&dev);
        hipDeviceGetAttribute(&cus, hipDeviceAttributeMultiprocessorCount, dev);
        hipFuncSetAttribute((const void*)mega_fwd, hipFuncAttributeMaxDynamicSharedMemorySize, LDS_BYTES);
        hipOccupancyMaxActiveBlocksPerMultiprocessor(&per_cu, (const void*)mega_fwd, 512, LDS_BYTES);
        if (per_cu < 1) { fprintf(stderr, "kernel_launch: occupancy query says %d blocks/CU\n", per_cu); per_cu = 1; }
        (void)hipGetLastError();
        grid = cus * per_cu;
    }
    if (grid < 0) return;
    Args a{};
    for (int i = 0; i < 24; ++i) a.in[i] = (const float*)d_in[i];
    a.out = (float*)d_out; a.ws = (unsigned char*)d_ws;
    void* args[] = {&a};
    hipError_t e = hipLaunchCooperativeKernel((const void*)mega_fwd, dim3(grid), dim3(512), args, LDS_BYTES, stream);
    if (e != hipSuccess) fprintf(stderr, "cooperative launch failed: %s (grid %d)\n", hipGetErrorString(e), grid);
}
```

```cpp
#include <hip/hip_runtime.h>
#include <hip/hip_cooperative_groups.h>
#include <cstdio>
#include <cstdint>
namespace cg = cooperative_groups;
#define DBG_ZERO_YA 0
#define DBG_TWICE 0
#define DBG_NOSEL 0

#define LAS __attribute__((address_space(3)))
typedef unsigned short bf16_t;
typedef short bf16x8 __attribute__((ext_vector_type(8)));
typedef float f32x4 __attribute__((ext_vector_type(4)));
typedef unsigned u32x4 __attribute__((ext_vector_type(4)));
typedef unsigned u32x2 __attribute__((ext_vector_type(2)));
typedef __bf16 bf2_t __attribute__((ext_vector_type(2)));
typedef short v4i16_t __attribute__((ext_vector_type(4)));

constexpr int MROWS = 65536, DM = 1024, FF = 2816, SEQ = 8192, NB = 8;
constexpr int LDP = 5120;
constexpr int C_AQ = 0, C_AK = 512, C_AV = 640, C_IQ = 768, C_IK = 1280, C_MX = 1344, C_MV = 1856, C_MO = 2368, C_GA = 2880, C_GB = 3904, C_SM = 4928;
constexpr float EPS = 1e-6f;
constexpr size_t MiB = 1u << 20;
constexpr size_t WS_SS0 = 0, WS_SS1 = 256 * 1024, WS_SS2 = 512 * 1024;
constexpr size_t WS_DN = 1 * MiB;
constexpr size_t WS_ML = 2 * MiB, WS_BL = 2 * MiB + 16384, WS_MS = 2 * MiB + 32768;
constexpr size_t WS_BAR = 2 * MiB + 65536;
constexpr size_t WS_SM = 3 * MiB;
constexpr size_t WS_W1 = 8 * MiB, WS_W2 = 19 * MiB, WS_W3 = 25 * MiB, WS_W4 = 36 * MiB, WS_WIN = 42 * MiB, WS_WA = 52 * MiB, WS_WB = 53 * MiB, WS_WO = 54 * MiB, WS_WQK = 56 * MiB;
constexpr size_t WS_XB = 64 * MiB;
constexpr size_t WS_P = 192 * MiB;
constexpr size_t WS_MG = 832 * MiB;
constexpr size_t WS_IKC = 832 * MiB;
constexpr size_t WS_KVC = 840 * MiB;
constexpr size_t WS_QK = 960 * MiB;
constexpr size_t WS_END = 1024 * MiB;
constexpr int LDS_BYTES = 156 * 1024;

__device__ __forceinline__ unsigned cvt_pk_bf16(float lo, float hi) { unsigned r; asm volatile("v_cvt_pk_bf16_f32 %0, %1, %2" : "=v"(r) : "v"(lo), "v"(hi)); return r; }
__device__ __forceinline__ float bflo(unsigned u) { return __uint_as_float(u << 16); }
__device__ __forceinline__ float bfhi(unsigned u) { return __uint_as_float(u & 0xffff0000u); }
__device__ __forceinline__ float bf1(bf16_t u) { return __uint_as_float(((unsigned)u) << 16); }
__device__ __forceinline__ bf16_t f2bf(float f) { return (bf16_t)(cvt_pk_bf16(f, 0.f) & 0xffffu); }
__device__ __forceinline__ float wave_sum(float v) {
#pragma unroll
    for (int o = 1; o < 64; o <<= 1) v += __shfl_xor(v, o);
    return v;
}
__device__ __forceinline__ float wave_max(float v) {
#pragma unroll
    for (int o = 1; o < 64; o <<= 1) v = fmaxf(v, __shfl_xor(v, o));
    return v;
}
__device__ __forceinline__ float sigmoidf_(float x) { return __builtin_amdgcn_rcpf(1.f + __expf(-x)); }
__device__ __forceinline__ float dot2bf(unsigned a, unsigned b, float c) { const unsigned aa = a, bb = b; return __builtin_amdgcn_fdot2_f32_bf16(__builtin_bit_cast(bf2_t, aa), __builtin_bit_cast(bf2_t, bb), c, false); }
__device__ __forceinline__ float relu_(float x) { const int i = __float_as_int(x); return __int_as_float(i > 0 ? i : 0); }
__device__ __forceinline__ void lds_order() { asm volatile("" ::: "memory"); }
__device__ __forceinline__ void lds_fence() { asm volatile("s_waitcnt lgkmcnt(0)" ::: "memory"); }
__device__ __forceinline__ void unpack8(u32x4 v, float* f) {
    f[0] = bflo(v.x); f[1] = bfhi(v.x); f[2] = bflo(v.y); f[3] = bfhi(v.y); f[4] = bflo(v.z); f[5] = bfhi(v.z); f[6] = bflo(v.w); f[7] = bfhi(v.w);
}
__device__ __forceinline__ u32x4 pack8(const float* f) {
    u32x4 o; o.x = cvt_pk_bf16(f[0], f[1]); o.y = cvt_pk_bf16(f[2], f[3]); o.z = cvt_pk_bf16(f[4], f[5]); o.w = cvt_pk_bf16(f[6], f[7]); return o;
}

namespace pg8 {
constexpr int BM = 256, BK = 64, HALF = 128, HTB = HALF * BK * 2, NXCD = 8, WGM = 8;
__host__ __device__ __forceinline__ int lds_byte(int r, int c) { const int st = (r >> 4) * 2 + (c >> 5), rr = r & 15, cc = c & 31, ob = rr * 64 + cc * 2; return st * 1024 + (ob ^ (((ob >> 9) & 1) << 5)); }
__host__ __device__ __forceinline__ void stage_rc(int b, int& R, int& C) { const int st = b / 1024, sb = b % 1024, swz = sb ^ (((sb >> 9) & 1) << 5); R = (st >> 1) * 16 + swz / 64; C = (st & 1) * 32 + (swz % 64) / 2; }
__host__ __device__ __forceinline__ int perm32(int rho) { const int n = rho >> 4, i = rho & 15; return 8 * (i >> 2) + 4 * n + (i & 3); }
struct Unit { int pm, pn; };
struct Gemm { const bf16_t* A; const bf16_t* Bt; int lda, ldb, M, N, K; };
struct StaticOrder {
    int nM, nN, nwg, G, c;
    __device__ void init(int M, int N, int G_, int c_) { nM = M / BM; nN = N / BM; nwg = nM * nN; G = G_; c = c_; }
    __device__ bool next(int i, Unit& u) const {
        const long L = (long)i * G + c; if (L >= nwg) return false;
        int wgid = (int)L; { const int q = nwg / NXCD, r = nwg % NXCD, xcd = wgid % NXCD, off = wgid / NXCD; wgid = (xcd < r ? xcd * (q + 1) : r * (q + 1) + (xcd - r) * q) + off; }
        const int nig = WGM * nN, gid = wgid / nig, fm = gid * WGM, gsz = (nM - fm) < WGM ? (nM - fm) : WGM;
        u.pm = fm + ((wgid % nig) % gsz); u.pn = (wgid % nig) / gsz; return true;
    }
};

template <class Epi>
__device__ __forceinline__ void gemm_phase(LAS unsigned char* lds, const Gemm g, const StaticOrder& S, const Epi& E) {
    int tid_ = threadIdx.x; asm volatile("" : "+v"(tid_));
    const int tid = tid_, wid = __builtin_amdgcn_readfirstlane(tid >> 6), lane = tid & 63, wr = wid >> 2, wc = wid & 3, fr = lane & 15, fq = lane >> 4;
    const int K = g.K, nt = K / BK;
    unsigned voffA[2], voffB[2];
#pragma unroll
    for (int i = 0; i < 2; ++i) { int R, C; stage_rc(tid * 16 + i * 8192, R, C); const int Rb = (R & ~31) + perm32(R & 31);
        voffA[i] = (unsigned)(R * g.lda + C) * 2u; voffB[i] = (unsigned)(Rb * g.ldb + C) * 2u; }
    const size_t kstep = (size_t)(BK * 2);
    const size_t hsA = (size_t)HALF * g.lda * 2, hsB = (size_t)HALF * g.ldb * 2;
    const size_t tsA = 2 * hsA, tsB = 2 * hsB;
    const unsigned ldsw = (unsigned)wid * 1024u;
    const int aoff = lds_byte(wr * 64 + fr, fq * 8), boff = lds_byte(wc * 32 + fr, fq * 8);
#define PG8_SA(b, h) (((b) * 2 + (h)) * HTB)
#define PG8_SB(b, h) ((4 + (b) * 2 + (h)) * HTB)
#define PG8_STAGE(bufoff, gbase, voff) do { _Pragma("unroll") for (int _i = 0; _i < 2; ++_i) \
        __builtin_amdgcn_global_load_lds((const unsigned*)((const char*)(gbase) + (voff)[_i]), (LAS unsigned*)(lds + (bufoff) + ldsw + _i * 8192), 16, 0, 0); } while (0)
#define PG8_LDA(dst, b, h) do { _Pragma("unroll") for (int m = 0; m < 4; ++m) _Pragma("unroll") for (int k = 0; k < 2; ++k) dst[m][k] = *(const LAS bf16x8*)(lds + PG8_SA(b, h) + aoff + m * 2048 + k * 1024); } while (0)
#define PG8_LDB(dst, b, h) do { _Pragma("unroll") for (int n = 0; n < 2; ++n) _Pragma("unroll") for (int k = 0; k < 2; ++k) dst[n][k] = *(const LAS bf16x8*)(lds + PG8_SB(b, h) + boff + n * 2048 + k * 1024); } while (0)
#define PG8_MMA(ai, bj, At, Bt) do { __builtin_amdgcn_s_setprio(1); _Pragma("unroll") for (int m = 0; m < 4; ++m) _Pragma("unroll") for (int n = 0; n < 2; ++n) _Pragma("unroll") for (int k = 0; k < 2; ++k) \
        acc[ai][bj][m][n] = __builtin_amdgcn_mfma_f32_16x16x32_bf16(Bt[n][k], At[m][k], acc[ai][bj][m][n], 0, 0, 0); __builtin_amdgcn_s_setprio(0); } while (0)
#define PG8_WAIT_V(n) asm volatile("s_waitcnt vmcnt(" #n ")" ::: "memory")
#define PG8_WAIT_L(n) asm volatile("s_waitcnt lgkmcnt(" #n ")" ::: "memory")
#define PG8_BAR __builtin_amdgcn_s_barrier()
#define PG8_SCHED __builtin_amdgcn_sched_barrier(0)
    Unit cur, nxt; int ui = 0;
    if (!S.next(0, cur)) return;
    f32x4 acc[2][2][4][2];
#pragma unroll
    for (int a = 0; a < 2; ++a)
#pragma unroll
        for (int b = 0; b < 2; ++b)
#pragma unroll
            for (int m = 0; m < 4; ++m)
#pragma unroll
                for (int n = 0; n < 2; ++n) acc[a][b][m][n] = (f32x4){0.f, 0.f, 0.f, 0.f};
    bf16x8 At[4][2], B0[2][2], B1[2][2];
    const char* cA = (const char*)g.A + (size_t)cur.pm * tsA; const char* cB = (const char*)g.Bt + (size_t)cur.pn * tsB;
    PG8_STAGE(PG8_SB(0, 0), cB, voffB); PG8_STAGE(PG8_SB(0, 1), cB + hsB, voffB); PG8_STAGE(PG8_SA(0, 0), cA, voffA); PG8_STAGE(PG8_SA(0, 1), cA + hsA, voffA);
    if (wr == 1) PG8_BAR;
    PG8_WAIT_V(2); PG8_BAR;
    PG8_STAGE(PG8_SB(1, 0), cB + kstep, voffB); PG8_STAGE(PG8_SA(1, 0), cA + kstep, voffA); PG8_STAGE(PG8_SB(1, 1), cB + hsB + kstep, voffB);
    PG8_WAIT_V(6); PG8_BAR;
    for (;;) {
        const bool has_next = S.next(ui + 1, nxt);
        const char* nA = has_next ? (const char*)g.A + (size_t)nxt.pm * tsA : cA; const char* nB = has_next ? (const char*)g.Bt + (size_t)nxt.pn * tsB : cB;
        for (int t = 0; t < nt; t += 2) {
            const bool last = (t == nt - 2);
            const char* a1 = cA + (size_t)(t + 1) * kstep;
            const char* a2 = last ? nA : cA + (size_t)(t + 2) * kstep; const char* b2 = last ? nB : cB + (size_t)(t + 2) * kstep;
            const char* a3 = a2 + kstep; const char* b3 = b2 + kstep;
            PG8_LDB(B0, 0, 0); PG8_LDB(B1, 0, 1); PG8_SCHED; PG8_LDA(At, 0, 0); PG8_STAGE(PG8_SA(1, 1), a1 + hsA, voffA);
            PG8_WAIT_V(8); PG8_WAIT_L(0); PG8_BAR; PG8_MMA(0, 0, At, B0); PG8_MMA(0, 1, At, B1); PG8_BAR; PG8_SCHED;
            PG8_LDA(At, 0, 1); PG8_STAGE(PG8_SB(0, 0), b2, voffB); PG8_STAGE(PG8_SB(0, 1), b2 + hsB, voffB); PG8_STAGE(PG8_SA(0, 0), a2, voffA);
            PG8_WAIT_V(8); PG8_WAIT_L(0); PG8_BAR; PG8_MMA(1, 0, At, B0); PG8_MMA(1, 1, At, B1); PG8_BAR; PG8_SCHED;
            PG8_LDB(B0, 1, 0); PG8_LDB(B1, 1, 1); PG8_SCHED; PG8_LDA(At, 1, 0); PG8_STAGE(PG8_SA(0, 1), a2 + hsA, voffA);
            PG8_WAIT_V(8); PG8_WAIT_L(0); PG8_BAR; PG8_MMA(0, 0, At, B0); PG8_MMA(0, 1, At, B1); PG8_BAR; PG8_SCHED;
            PG8_LDA(At, 1, 1); PG8_STAGE(PG8_SB(1, 0), b3, voffB); PG8_STAGE(PG8_SB(1, 1), b3 + hsB, voffB); PG8_STAGE(PG8_SA(1, 0), a3, voffA);
            PG8_WAIT_V(8); PG8_WAIT_L(0); PG8_BAR; PG8_MMA(1, 0, At, B0); PG8_MMA(1, 1, At, B1); PG8_BAR; PG8_SCHED;
        }
        if (wr == 0) PG8_BAR;
        E(acc, cur, wr, wc, fr, fq);
        if (!has_next) break;
#pragma unroll
        for (int a = 0; a < 2; ++a)
#pragma unroll
            for (int b = 0; b < 2; ++b)
#pragma unroll
                for (int m = 0; m < 4; ++m)
#pragma unroll
                    for (int n = 0; n < 2; ++n) acc[a][b][m][n] = (f32x4){0.f, 0.f, 0.f, 0.f};
        cur = nxt; cA = nA; cB = nB; ++ui;
        if (wr == 1) PG8_BAR;
    }
    PG8_WAIT_V(0);
    PG8_BAR;
#undef PG8_SA
#undef PG8_SB
#undef PG8_STAGE
#undef PG8_LDA
#undef PG8_LDB
#undef PG8_MMA
#undef PG8_WAIT_V
#undef PG8_WAIT_L
#undef PG8_BAR
#undef PG8_SCHED
}

typedef f32x4 AccT[2][2][4][2];
struct EpiSwiGLU {
    bf16_t* O; const float* ss;
    __device__ __forceinline__ void operator()(const AccT& acc, const Unit& u, int wr, int wc, int fr, int fq) const {
        const int row0 = u.pm * BM + wr * 64 + fr, col = u.pn * 128 + wc * 32 + 8 * fq;
#pragma unroll
        for (int ai = 0; ai < 2; ++ai)
#pragma unroll
            for (int m = 0; m < 4; ++m) {
                const int row = row0 + ai * HALF + m * 16;
                const float rs = rsqrtf(ss[row] * (1.f / 1024.f) + EPS);
                float o[8];
#pragma unroll
                for (int n = 0; n < 2; ++n)
#pragma unroll
                    for (int j = 0; j < 4; ++j) { const float gt = acc[ai][0][m][n][j] * rs, up = acc[ai][1][m][n][j] * rs; o[n * 4 + j] = gt * up * sigmoidf_(gt); }
                *(u32x4*)(O + (size_t)row * FF + col) = pack8(o);
            }
    }
};
template <bool WRITE_XB> struct EpiRes {
    const float* res; float* out; bf16_t* xb; float* ss; float alpha;
    __device__ __forceinline__ void operator()(const AccT& acc, const Unit& u, int wr, int wc, int fr, int fq) const {
        const int row0 = u.pm * BM + wr * 64 + fr, col0 = u.pn * BM + wc * 32 + 8 * fq;
#pragma unroll
        for (int ai = 0; ai < 2; ++ai)
#pragma unroll
            for (int m = 0; m < 4; ++m) {
                const int row = row0 + ai * HALF + m * 16; float sq = 0.f;
#pragma unroll
                for (int bj = 0; bj < 2; ++bj) {
                    const size_t off = (size_t)row * DM + col0 + bj * HALF;
                    const f32x4 r0 = *(const f32x4*)(res + off), r1 = *(const f32x4*)(res + off + 4);
                    const f32x4 v0 = r0 + acc[ai][bj][m][0] * alpha, v1 = r1 + acc[ai][bj][m][1] * alpha;
                    *(f32x4*)(out + off) = v0; *(f32x4*)(out + off + 4) = v1;
                    if (WRITE_XB) {
                        u32x4 w; w.x = cvt_pk_bf16(v0[0], v0[1]); w.y = cvt_pk_bf16(v0[2], v0[3]); w.z = cvt_pk_bf16(v1[0], v1[1]); w.w = cvt_pk_bf16(v1[2], v1[3]);
                        *(u32x4*)(xb + off) = w;
                        sq += v0[0] * v0[0] + v0[1] * v0[1] + v0[2] * v0[2] + v0[3] * v0[3] + v1[0] * v1[0] + v1[1] * v1[1] + v1[2] * v1[2] + v1[3] * v1[3];
                    }
                }
                if (WRITE_XB) { sq += __shfl_xor(sq, 16); sq += __shfl_xor(sq, 32); if (fq == 0) atomicAdd(ss + row, sq); }
            }
    }
};
struct EpiP {
    bf16_t* P; float* SM; const float* ss;
    __device__ __forceinline__ void operator()(const AccT& acc, const Unit& u, int wr, int wc, int fr, int fq) const {
        const int row0 = u.pm * BM + wr * 64 + fr, col0 = u.pn * BM + wc * 32 + 8 * fq;
#pragma unroll
        for (int ai = 0; ai < 2; ++ai)
#pragma unroll
            for (int m = 0; m < 4; ++m) {
                const int row = row0 + ai * HALF + m * 16;
                const float rs = rsqrtf(ss[row] * (1.f / 1024.f) + EPS);
#pragma unroll
                for (int bj = 0; bj < 2; ++bj) {
                    const int col = col0 + bj * HALF;
                    const f32x4 v0 = acc[ai][bj][m][0] * rs, v1 = acc[ai][bj][m][1] * rs;
                    u32x4 w; w.x = cvt_pk_bf16(v0[0], v0[1]); w.y = cvt_pk_bf16(v0[2], v0[3]); w.z = cvt_pk_bf16(v1[0], v1[1]); w.w = cvt_pk_bf16(v1[2], v1[3]);
                    *(u32x4*)(P + (size_t)row * LDP + col) = w;
                    if (col >= C_SM && col < C_SM + 16) { float* s = SM + (size_t)row * 16 + (col - C_SM); *(f32x4*)s = v0; *(f32x4*)(s + 4) = v1; }
                }
            }
    }
};
struct EpiBf16 {
    bf16_t* O; int ldc;
    __device__ __forceinline__ void operator()(const AccT& acc, const Unit& u, int wr, int wc, int fr, int fq) const {
        const int row0 = u.pm * BM + wr * 64 + fr, col0 = u.pn * BM + wc * 32 + 8 * fq;
#pragma unroll
        for (int ai = 0; ai < 2; ++ai)
#pragma unroll
            for (int m = 0; m < 4; ++m) {
                const int row = row0 + ai * HALF + m * 16;
#pragma unroll
                for (int bj = 0; bj < 2; ++bj) {
                    const f32x4 v0 = acc[ai][bj][m][0], v1 = acc[ai][bj][m][1];
                    u32x4 w; w.x = cvt_pk_bf16(v0[0], v0[1]); w.y = cvt_pk_bf16(v0[2], v0[3]); w.z = cvt_pk_bf16(v1[0], v1[1]); w.w = cvt_pk_bf16(v1[2], v1[3]);
                    *(u32x4*)(O + (size_t)row * ldc + col0 + bj * HALF) = w;
                }
            }
    }
};
template <int PASS> struct EpiMerge {
    const bf16_t* P; bf16_t* MG; int goff;
    __device__ __forceinline__ void operator()(const AccT& acc, const Unit& u, int wr, int wc, int fr, int fq) const {
        const int row0 = u.pm * BM + wr * 64 + fr, col0 = u.pn * BM + wc * 32 + 8 * fq;
#pragma unroll
        for (int ai = 0; ai < 2; ++ai)
#pragma unroll
            for (int m = 0; m < 4; ++m) {
                const int row = row0 + ai * HALF + m * 16;
#pragma unroll
                for (int bj = 0; bj < 2; ++bj) {
                    const int col = col0 + bj * HALF;
                    float gt[8], o[8]; unpack8(*(const u32x4*)(P + (size_t)row * LDP + goff + col), gt);
                    if (PASS == 1) unpack8(*(const u32x4*)(MG + (size_t)row * DM + col), o);
#pragma unroll
                    for (int j = 0; j < 8; ++j) { const float a = acc[ai][bj][m][j >> 2][j & 3] * sigmoidf_(gt[j]); o[j] = (PASS == 1) ? o[j] + a : a; }
                    *(u32x4*)(MG + (size_t)row * DM + col) = pack8(o);
                }
            }
    }
};
}

struct Args {
    const float* in[24];
    float* out;
    unsigned char* ws;
};
enum { I_X = 0, I_F1N, I_F1G, I_F1U, I_F1D, I_MIXN, I_WIN, I_QN, I_KN, I_IKN, I_CW, I_CB, I_WMQ, I_WMK, I_BI, I_BF, I_MHN, I_WPA, I_WPB, I_WOUT, I_F2N, I_F2G, I_F2U, I_F2D };

template <class F> __device__ __forceinline__ void prep_tile(bf16_t* Bt, int K, int n0, int k0, const F src, float* tile) {
    const int tid = threadIdx.x;
    { const int nn = tid & 63, kk = tid >> 6;
#pragma unroll
        for (int i = 0; i < 8; ++i) { const int k = i * 8 + kk; tile[k * 65 + nn] = src(k0 + k, n0 + nn); } }
    __syncthreads();
    { const int nn = tid >> 3, kc = tid & 7; const float* s = tile + (kc * 8) * 65 + nn;
        u32x4 o; o.x = cvt_pk_bf16(s[0], s[65]); o.y = cvt_pk_bf16(s[130], s[195]); o.z = cvt_pk_bf16(s[260], s[325]); o.w = cvt_pk_bf16(s[390], s[455]);
        *(u32x4*)(Bt + (size_t)(n0 + nn) * K + k0 + kc * 8) = o; }
    __syncthreads();
}
struct SrcUp { const float* wg; const float* wu; const float* g;
    __device__ __forceinline__ float operator()(int k, int n) const { const int col = (n >> 8) * 128 + (n & 127); const size_t bj = (size_t)((n >> 7) & 1); const float* w = (const float*)((uintptr_t)wg + ((uintptr_t)wu - (uintptr_t)wg) * bj); return w[(size_t)k * FF + col] * g[k]; } };
struct SrcPlain { const float* w; int ldw;
    __device__ __forceinline__ float operator()(int k, int n) const { return w[(size_t)k * ldw + n]; } };
struct SrcIn { const float* w; const float* g;
    __device__ __forceinline__ float operator()(int k, int n) const {
        int col;
        if (n < 1344) col = n; else if (n < 2368) col = n + 8; else if (n < 4928) col = n + 16;
        else if (n < 4936) col = n - 4928 + 1344; else if (n < 4940) col = n - 4936 + 2376; else if (n < 4944) col = n - 4940 + 2380; else col = -1;
        return col >= 0 ? w[(size_t)k * 4944 + col] * g[k] : 0.f; } };
struct SrcQK { const float* wq; const float* wk;
    __device__ __forceinline__ float operator()(int k, int n) const {
        const int isk = n >> 8, h = (n >> 6) & 3, j = n & 63, hk = k >> 7, c = k & 127;
        if (hk != h) return 0.f;
        const float* w = (const float*)((uintptr_t)wq + ((uintptr_t)wk - (uintptr_t)wq) * (size_t)isk); return w[(size_t)(h * 128 + c) * 64 + j] * (isk ? 1.f : 0.125f); } };

__device__ __forceinline__ void phase0(const Args& a, unsigned char* lds) {
    float* tile = (float*)lds;
    unsigned char* ws = a.ws;
    constexpr int T_UP = 88 * 16, T_DN = 16 * 44, T_IN = 80 * 16, T_PR = 16 * 8, T_WO = 16 * 16, T_QK = 8 * 8;
    constexpr int NITEMS = 2 * T_UP + 2 * T_DN + T_IN + 2 * T_PR + T_WO + T_QK;
    for (int it = blockIdx.x; it < NITEMS; it += gridDim.x) {
        int r = it;
        if (r < T_UP) { SrcUp s{a.in[I_F1G], a.in[I_F1U], a.in[I_F1N]}; prep_tile((bf16_t*)(ws + WS_W1), 1024, (r / 16) * 64, (r % 16) * 64, s, tile); continue; } r -= T_UP;
        if (r < T_UP) { SrcUp s{a.in[I_F2G], a.in[I_F2U], a.in[I_F2N]}; prep_tile((bf16_t*)(ws + WS_W3), 1024, (r / 16) * 64, (r % 16) * 64, s, tile); continue; } r -= T_UP;
        if (r < T_DN) { SrcPlain s{a.in[I_F1D], 1024}; prep_tile((bf16_t*)(ws + WS_W2), FF, (r / 44) * 64, (r % 44) * 64, s, tile); continue; } r -= T_DN;
        if (r < T_DN) { SrcPlain s{a.in[I_F2D], 1024}; prep_tile((bf16_t*)(ws + WS_W4), FF, (r / 44) * 64, (r % 44) * 64, s, tile); continue; } r -= T_DN;
        if (r < T_IN) { SrcIn s{a.in[I_WIN], a.in[I_MIXN]}; prep_tile((bf16_t*)(ws + WS_WIN), 1024, (r / 16) * 64, (r % 16) * 64, s, tile); continue; } r -= T_IN;
        if (r < T_PR) { SrcPlain s{a.in[I_WPA], 1024}; prep_tile((bf16_t*)(ws + WS_WA), 512, (r / 8) * 64, (r % 8) * 64, s, tile); continue; } r -= T_PR;
        if (r < T_PR) { SrcPlain s{a.in[I_WPB], 1024}; prep_tile((bf16_t*)(ws + WS_WB), 512, (r / 8) * 64, (r % 8) * 64, s, tile); continue; } r -= T_PR;
        if (r < T_WO) { SrcPlain s{a.in[I_WOUT], 1024}; prep_tile((bf16_t*)(ws + WS_WO), 1024, (r / 16) * 64, (r % 16) * 64, s, tile); continue; } r -= T_WO;
        { SrcQK s{a.in[I_WMQ], a.in[I_WMK]}; prep_tile((bf16_t*)(ws + WS_WQK), 512, (r / 8) * 64, (r % 8) * 64, s, tile); }
    }
    const int lane = threadIdx.x & 63, gw = blockIdx.x * 8 + (threadIdx.x >> 6), NGW = gridDim.x * 8;
    const float* x = a.in[I_X]; bf16_t* XB = (bf16_t*)(ws + WS_XB);
    float* ss0 = (float*)(ws + WS_SS0); float* ss1 = (float*)(ws + WS_SS1); float* ss2 = (float*)(ws + WS_SS2);
    for (int row = gw; row < MROWS; row += NGW) {
        const f32x4* xr = (const f32x4*)(x + (size_t)row * DM) + lane;
        f32x4 v[4]; float s = 0.f;
#pragma unroll
        for (int j = 0; j < 4; ++j) { v[j] = xr[64 * j]; s += v[j][0] * v[j][0] + v[j][1] * v[j][1] + v[j][2] * v[j][2] + v[j][3] * v[j][3]; }
        s = wave_sum(s);
        if (lane == 0) { ss0[row] = s; ss1[row] = 0.f; ss2[row] = 0.f; }
        unsigned long long* o8 = (unsigned long long*)(XB + (size_t)row * DM) + lane;
#pragma unroll
        for (int j = 0; j < 4; ++j) o8[64 * j] = (unsigned long long)cvt_pk_bf16(v[j][0], v[j][1]) | ((unsigned long long)cvt_pk_bf16(v[j][2], v[j][3]) << 32);
    }
}

__device__ __forceinline__ void phase_postp(const Args& a) {
    unsigned char* ws = a.ws;
    bf16_t* P = (bf16_t*)(ws + WS_P); bf16_t* XC = (bf16_t*)(ws + WS_XB); bf16_t* IKC = (bf16_t*)(ws + WS_IKC); bf16_t* KVC = (bf16_t*)(ws + WS_KVC);
    const int lane = threadIdx.x & 63, gw = blockIdx.x * 8 + (threadIdx.x >> 6), NGW = gridDim.x * 8;
    const int c0 = lane * 8;
    float cw[4][8], cb[8], gq[8], gk[8];
#pragma unroll
    for (int e = 0; e < 8; ++e) {
        cb[e] = a.in[I_CB][c0 + e];
#pragma unroll
        for (int j = 0; j < 4; ++j) cw[j][e] = a.in[I_CW][j * 512 + c0 + e];
        gq[e] = a.in[I_QN][(lane & 7) * 8 + e];
        gk[e] = (lane < 16) ? a.in[I_KN][(lane & 7) * 8 + e] : a.in[I_IKN][(lane & 7) * 8 + e];
    }
    const int koff = (lane < 16) ? (C_AK + lane * 8) : (C_IK + (lane & 7) * 8);
    for (int row = gw; row < MROWS; row += NGW) {
        bf16_t* pr = P + (size_t)row * LDP;
        const int t = row & (SEQ - 1);
        float accv[8];
#pragma unroll
        for (int e = 0; e < 8; ++e) accv[e] = cb[e];
#pragma unroll
        for (int j = 0; j < 4; ++j) {
            const int tt = t - 3 + j;
            if (tt >= 0) { float xf[8]; unpack8(*(const u32x4*)(P + (size_t)(row - 3 + j) * LDP + C_MX + c0), xf);
#pragma unroll
                for (int e = 0; e < 8; ++e) accv[e] += xf[e] * cw[j][e]; }
        }
#pragma unroll
        for (int e = 0; e < 8; ++e) accv[e] = accv[e] * sigmoidf_(accv[e]);
        *(u32x4*)(XC + (size_t)row * 512 + c0) = pack8(accv);
        { float f[8]; unpack8(*(const u32x4*)(pr + C_AQ + c0), f); float s = 0.f;
#pragma unroll
            for (int e = 0; e < 8; ++e) s += f[e] * f[e];
            s += __shfl_xor(s, 1); s += __shfl_xor(s, 2); s += __shfl_xor(s, 4);
            const float rs = rsqrtf(s * (1.f / 64.f) + EPS);
#pragma unroll
            for (int e = 0; e < 8; ++e) f[e] = f[e] * rs * gq[e];
            *(u32x4*)(pr + C_AQ + c0) = pack8(f); }
        { float f[8]; unpack8(*(const u32x4*)(pr + koff), f); float s = 0.f;
#pragma unroll
            for (int e = 0; e < 8; ++e) s += f[e] * f[e];
            s += __shfl_xor(s, 1); s += __shfl_xor(s, 2); s += __shfl_xor(s, 4);
            const float rs = rsqrtf(s * (1.f / 64.f) + EPS);
#pragma unroll
            for (int e = 0; e < 8; ++e) f[e] = f[e] * rs * gk[e];
            if (lane < 16) *(u32x4*)(KVC + (size_t)row * 256 + lane * 8) = pack8(f);
            else if (lane < 24) *(u32x4*)(IKC + ((((size_t)(row >> 4)) * 8 + (lane - 16)) * 16 + (row & 15)) * 8) = pack8(f);
            else if (lane >= 32 && lane < 48) *(u32x4*)(KVC + (size_t)row * 256 + 128 + (lane - 32) * 8) = *(const u32x4*)(pr + C_AV + (lane - 32) * 8); }
    }
}

__device__ __forceinline__ unsigned fkey(float s) { const unsigned u = __float_as_uint(s); return (u & 0x80000000u) ? ~u : (u | 0x80000000u); }


__device__ __forceinline__ unsigned wave_incl_scan_dpp(unsigned x) {
    x += (unsigned)__builtin_amdgcn_update_dpp(0, (int)x, 0x111, 0xf, 0xf, false);
    x += (unsigned)__builtin_amdgcn_update_dpp(0, (int)x, 0x112, 0xf, 0xf, false);
    x += (unsigned)__builtin_amdgcn_update_dpp(0, (int)x, 0x114, 0xf, 0xf, false);
    x += (unsigned)__builtin_amdgcn_update_dpp(0, (int)x, 0x118, 0xf, 0xf, false);
    x += (unsigned)__builtin_amdgcn_update_dpp(0, (int)x, 0x142, 0xa, 0xf, false);
    x += (unsigned)__builtin_amdgcn_update_dpp(0, (int)x, 0x143, 0xc, 0xf, false);
    return x;
}
__device__ __forceinline__ int find_bin(const unsigned* hist, int& need, int lane, int& binc) {
    const int base = 1023 - 16 * lane; unsigned s = 0;
#pragma unroll
    for (int i = 0; i < 16; ++i) { const unsigned w = hist[base - ((i + lane) & 15)]; s += (w & 0xffffu) + (w >> 16); }
    const unsigned p = wave_incl_scan_dpp(s);
    const unsigned long long bal = __ballot(p >= (unsigned)need);
    const int L = bal ? (__ffsll((long long)bal) - 1) : 63;
    const unsigned excl = __shfl(p - s, L);
    int cum = (int)excl, bin = -1, fneed = 1, bc = 1; const int b0 = 1023 - 16 * L;
#pragma unroll
    for (int i = 0; i < 16; ++i) {
        const unsigned w = hist[b0 - i]; const int hi = (int)(w >> 16), lo = (int)(w & 0xffffu);
        if (bin < 0) { if (cum + hi >= need) { bin = 2 * (b0 - i) + 1; fneed = need - cum; bc = hi; } else cum += hi; }
        if (bin < 0) { if (cum + lo >= need) { bin = 2 * (b0 - i); fneed = need - cum; bc = lo; } else cum += lo; }
    }
    if (bin < 0) bin = 0;
    need = fneed; binc = bc; return bin;
}


__device__ __forceinline__ int find_bin128(const unsigned* sh, int& need, int lane, int& binc) {
    const unsigned hi = sh[127 - 2 * lane], lo = sh[126 - 2 * lane]; const unsigned s = hi + lo;
    const unsigned p = wave_incl_scan_dpp(s);
    const unsigned long long bal = __ballot(p >= (unsigned)need);
    const int L = bal ? (__ffsll((long long)bal) - 1) : 63;
    const int excl = (int)__shfl(p - s, L); const int hiL = (int)__shfl(hi, L), loL = (int)__shfl(lo, L);
    int bin, fneed, bc;
    if (excl + hiL >= need) { bin = 127 - 2 * L; fneed = need - excl; bc = hiL; } else { bin = 126 - 2 * L; fneed = need - excl - hiL; bc = loL; }
    if (fneed < 1) fneed = 1;
    need = fneed; binc = bc; return bin;
}

template <bool DUMMY> __device__ __forceinline__ void phase_dsa(const Args& a, unsigned char* lds) {
    unsigned char* ws = a.ws;
    bf16_t* P = (bf16_t*)(ws + WS_P); const float* SM = (const float*)(ws + WS_SM);
    const bf16_t* IKC = (const bf16_t*)(ws + WS_IKC); const bf16_t* KVC = (const bf16_t*)(ws + WS_KVC);
    constexpr int SCS = 8200;
    float* SC = (float*)lds;
    unsigned* HIST = (unsigned*)(lds + 131200);
    int* LIST = (int*)(lds + 131200 + 16384);
    unsigned* QS = (unsigned*)(lds + 131200 + 16384 + 4096);
    int* CNT = (int*)(lds + 131200 + 16384 + 4096 + 4096);
    const float idx_scale = 0.125f * 0.35355339059327373f;
    f32x4 wqv[2]; unsigned qsv[2];
#define DSA_LOAD_ITEM(ITEM) do { const int b_ = (ITEM) & 7, t0_ = ((ITEM) >> 3) * 4; const size_t r_ = (size_t)b_ * SEQ + t0_; \
        int tl_ = threadIdx.x; asm volatile("" : "+v"(tl_)); const int ln_ = tl_ & 63, q4_ = ln_ >> 4; \
        wqv[0] = *(const f32x4*)(SM + (r_ + q4_) * 16); wqv[1] = *(const f32x4*)(SM + (r_ + q4_) * 16 + 4); \
        _Pragma("unroll") for (int i_ = 0; i_ < 2; ++i_) { const int e_ = tl_ + 512 * i_; qsv[i_] = *(const unsigned*)(P + (r_ + (e_ >> 8)) * LDP + C_AQ + (e_ & 255) * 2); } } while (0)
    if ((int)blockIdx.x < 16384) DSA_LOAD_ITEM(blockIdx.x);
    for (int item = blockIdx.x; item < 16384; item += gridDim.x) {
        int tid_ = threadIdx.x; asm volatile("" : "+v"(tid_));
        const int tid = tid_, wave = __builtin_amdgcn_readfirstlane(tid >> 6), lane = tid & 63, quad = lane >> 4, l15 = lane & 15;
        const int b = item & 7, tq = item >> 3, t0 = tq * 4, L = ((t0 >> 6) + 1) * 64;
        const size_t r0 = (size_t)b * SEQ + t0;
        const bool do_sel = (L > 256) && !DBG_NOSEL;
        { u32x4* hz = (u32x4*)HIST; hz[tid] = (u32x4){0u, 0u, 0u, 0u}; hz[tid + 512] = (u32x4){0u, 0u, 0u, 0u}; }
        if (tid < 8) CNT[4 + tid] = 0;
        QS[tid] = qsv[0]; QS[tid + 512] = qsv[1];
        float wq[8];
#pragma unroll
        for (int h = 0; h < 4; ++h) { wq[h] = wqv[0][h] * idx_scale; wq[4 + h] = wqv[1][h] * idx_scale; }
        bf16x8 af[2][2];
#pragma unroll
        for (int T = 0; T < 2; ++T)
#pragma unroll
            for (int ks = 0; ks < 2; ++ks) af[T][ks] = *(const bf16x8*)(P + (r0 + (l15 >> 2)) * LDP + C_IQ + (4 * T + (l15 & 3)) * 64 + ks * 32 + quad * 8);
        const int ngroups = L >> 6;
        const bf16_t* ikb = IKC + (size_t)b * SEQ * 64 + (quad * 16 + l15) * 8;
        bf16x8 B0[4][2], B1[4][2], B2[4][2];
#define IDX_LOAD(BUF, G) do { _Pragma("unroll") for (int tt = 0; tt < 4; ++tt) _Pragma("unroll") for (int ks = 0; ks < 2; ++ks) \
                BUF[tt][ks] = *(const bf16x8*)(ikb + (size_t)(((G) * 4 + tt) * 8 + ks * 4) * 128); } while (0)
        if (wave < ngroups) IDX_LOAD(B0, wave);
        if (wave + 8 < ngroups) IDX_LOAD(B1, wave + 8);
        if (wave + 16 < ngroups) IDX_LOAD(B2, wave + 16);
        lds_fence(); __builtin_amdgcn_s_barrier();
        for (int rep = 0; rep < ((DBG_TWICE & 2) ? 2 : 1); ++rep) {
            const bool hist_on = do_sel && (rep == (((DBG_TWICE & 2) ? 2 : 1) - 1));
#define IDX_COMPUTE(BUF, G) do { _Pragma("unroll") for (int tt = 0; tt < 4; ++tt) { \
                const int key = (G) * 64 + tt * 16 + l15; \
                f32x4 c0 = (f32x4){0.f, 0.f, 0.f, 0.f}, c1 = (f32x4){0.f, 0.f, 0.f, 0.f}; \
                c0 = __builtin_amdgcn_mfma_f32_16x16x32_bf16(af[0][0], BUF[tt][0], c0, 0, 0, 0); \
                c1 = __builtin_amdgcn_mfma_f32_16x16x32_bf16(af[1][0], BUF[tt][0], c1, 0, 0, 0); \
                c0 = __builtin_amdgcn_mfma_f32_16x16x32_bf16(af[0][1], BUF[tt][1], c0, 0, 0, 0); \
                c1 = __builtin_amdgcn_mfma_f32_16x16x32_bf16(af[1][1], BUF[tt][1], c1, 0, 0, 0); \
                float sc = 0.f; \
                _Pragma("unroll") for (int j = 0; j < 4; ++j) { sc += wq[j] * relu_(c0[j]); sc += wq[4 + j] * relu_(c1[j]); } \
                sc += 0.f; \
                SC[quad * SCS + key] = sc; \
                if (hist_on) { const unsigned bin = fkey(sc) >> 21; atomicAdd(&HIST[quad * 1024 + (bin >> 1)], (bin & 1u) ? 0x10000u : 1u); } } } while (0)
            int g = wave;
            for (; g < ngroups; g += 24) {
                IDX_COMPUTE(B0, g);
                if (g + 24 < ngroups) IDX_LOAD(B0, g + 24);
                if (g + 8 < ngroups) { IDX_COMPUTE(B1, g + 8); if (g + 32 < ngroups) IDX_LOAD(B1, g + 32); }
                if (g + 16 < ngroups) { IDX_COMPUTE(B2, g + 16); if (g + 40 < ngroups) IDX_LOAD(B2, g + 40); }
            }
#undef IDX_LOAD
#undef IDX_COMPUTE
        }
        lds_fence(); __builtin_amdgcn_s_barrier();
        if (item + (int)gridDim.x < 16384) DSA_LOAD_ITEM(item + (int)gridDim.x);
        {
            constexpr int CAP = 448;
            const unsigned long long ltmask = (1ull << lane) - 1ull;
            if (!do_sel) {
                const int q = wave >> 1, hf = wave & 1; int* list = LIST + q * 256;
                if (hf == 0) { for (int i = lane; i < 256; i += 64) list[i] = (i < L) ? i : 0; if (lane == 0) CNT[q] = L; }
            } else {
                {
                    const int q = wave >> 1, hf = wave & 1; int* list = LIST + q * 256; const float* sc = SC + q * SCS; unsigned* hist = HIST + q * 1024;
                    const int halfL = L >> 1, beg = hf * halfL, end = beg + halfL;
                    int need = 256, binc = 0;
                    const unsigned b1 = (unsigned)find_bin(hist, need, lane, binc);
                    const int c1 = binc, nsure = 256 - need; const bool store_c = c1 <= CAP;
                    if (hf == 0 && lane == 0) { CNT[12 + q] = (int)b1; CNT[16 + q] = need; CNT[8 + q] = c1; }
                    lds_fence(); __builtin_amdgcn_s_barrier();
                    int cs = 0, cc = 0;
                    for (int i0 = beg + lane * 4; i0 < end; i0 += 256) { const f32x4 v = *(const f32x4*)(sc + i0);
#pragma unroll
                        for (int e = 0; e < 4; ++e) { const unsigned k = fkey(v[e]); const unsigned kb = k >> 21;
                            const bool sure = kb > b1, cand = (kb == b1) && store_c;
                            const unsigned long long ms = __ballot(sure), mc = __ballot(cand);
                            if (ms) { const int p = cs + __popcll(ms & ltmask); const int pp = hf ? nsure - 1 - p : p; if (sure && pp >= 0 && pp < 256) list[pp] = i0 + e; cs += __popcll(ms); }
                            if (mc) { const int p = cc + __popcll(mc & ltmask); const int pp = hf ? c1 - 1 - p : p; if (cand && pp >= 0 && pp < CAP) { hist[2 * pp] = k; hist[2 * pp + 1] = (unsigned)(i0 + e); } cc += __popcll(mc); } } }
                    lds_fence(); __builtin_amdgcn_s_barrier();
                }
                if (wave < 4) {
                    const int q = wave; int* list = LIST + q * 256; unsigned* hist = HIST + q * 1024; unsigned* sh = hist + 896; const float* sc = SC + q * SCS;
                    const unsigned b1 = (unsigned)CNT[12 + q]; int need = CNT[16 + q]; const int c = CNT[8 + q]; const int nsure = 256 - need;
                    if (c <= CAP) {
                        unsigned ck[7]; int ci[7];
#pragma unroll
                        for (int t = 0; t < 7; ++t) { const int i = lane + 64 * t; const bool valid = i < c; ck[t] = valid ? hist[2 * i] : 0u; ci[t] = valid ? (int)hist[2 * i + 1] : -1; }
                        int binc = 0;
                        sh[2 * lane] = 0u; sh[2 * lane + 1] = 0u; lds_order();
#pragma unroll
                        for (int t = 0; t < 7; ++t) if (ci[t] >= 0) atomicAdd(&sh[(ck[t] >> 14) & 127u], 1u);
                        lds_order();
                        const unsigned bA = (unsigned)find_bin128(sh, need, lane, binc);
                        lds_order();
                        sh[2 * lane] = 0u; sh[2 * lane + 1] = 0u; lds_order();
#pragma unroll
                        for (int t = 0; t < 7; ++t) if (ci[t] >= 0 && ((ck[t] >> 14) & 127u) == bA) atomicAdd(&sh[(ck[t] >> 7) & 127u], 1u);
                        lds_order();
                        const unsigned bB = (unsigned)find_bin128(sh, need, lane, binc);
                        const unsigned preB = (bA << 7) | bB;
                        lds_order();
                        sh[2 * lane] = 0u; sh[2 * lane + 1] = 0u; lds_order();
#pragma unroll
                        for (int t = 0; t < 7; ++t) if (ci[t] >= 0 && ((ck[t] >> 7) & 0x3fffu) == preB) atomicAdd(&sh[ck[t] & 127u], 1u);
                        lds_order();
                        const unsigned bC = (unsigned)find_bin128(sh, need, lane, binc);
                        const unsigned T = (b1 << 21) | (preB << 7) | bC;
                        const int tie_total = binc, need_t = need;
                        int cnt = 0;
#pragma unroll
                        for (int t = 0; t < 7; ++t) {
                            const bool valid = ci[t] >= 0;
                            bool sel = valid && (ck[t] > T);
                            if (valid && ck[t] == T) {
                                if (tie_total == need_t) sel = true;
                                else { int rank = 0; for (int j = 0; j < c; ++j) rank += (hist[2 * j] == T && (int)hist[2 * j + 1] < ci[t]) ? 1 : 0; sel = rank < need_t; }
                            }
                            const unsigned long long m = __ballot(sel);
                            const int pos = nsure + cnt + __popcll(m & ltmask);
                            if (sel && pos < 256) list[pos] = ci[t];
                            cnt += __popcll(m);
                        }
                    } else {
                        int binc = 0;
                        lds_order();
#pragma unroll
                        for (int i = 0; i < 16; ++i) hist[lane * 16 + i] = 0u;
                        lds_order();
                        for (int i0 = 0; i0 < L; i0 += 64) { const unsigned k = fkey(sc[i0 + lane]); if ((k >> 21) == b1) { const unsigned bin = (k >> 10) & 2047u; atomicAdd(&hist[bin >> 1], (bin & 1u) ? 0x10000u : 1u); } }
                        lds_order();
                        const unsigned b2 = (unsigned)find_bin(hist, need, lane, binc);
                        const unsigned pre2 = (b1 << 11) | b2;
                        lds_order();
#pragma unroll
                        for (int i = 0; i < 16; ++i) hist[lane * 16 + i] = 0u;
                        lds_order();
                        for (int i0 = 0; i0 < L; i0 += 64) { const unsigned k = fkey(sc[i0 + lane]); if ((k >> 10) == pre2) { const unsigned bin = k & 1023u; atomicAdd(&hist[bin >> 1], (bin & 1u) ? 0x10000u : 1u); } }
                        lds_order();
                        const unsigned b3 = (unsigned)find_bin(hist, need, lane, binc);
                        const unsigned T = (pre2 << 10) | b3;
                        int count = 0, ties = 0;
                        for (int i0 = 0; i0 < L; i0 += 64) {
                            const unsigned k = fkey(sc[i0 + lane]);
                            const bool eq = (k == T);
                            const unsigned long long em = __ballot(eq);
                            const int erank = ties + __popcll(em & ltmask);
                            const bool sel = (k > T) || (eq && erank < need);
                            const unsigned long long smk = __ballot(sel);
                            const int pos = count + __popcll(smk & ltmask);
                            if (sel && pos < 256) list[pos] = i0 + lane;
                            count += __popcll(smk); ties += __popcll(em);
                        }
                        if (count > 256) count = 256;
                        for (int i = count + lane; i < 256; i += 64) list[i] = 0;
                    }
                    if (lane == 0) CNT[q] = 256;
                }
            }
        }
        lds_fence(); __builtin_amdgcn_s_barrier();
        for (int repc = 0; repc < ((DBG_TWICE & 4) ? 2 : 1); ++repc) {
            const bool dummy_c = (repc + 1) < ((DBG_TWICE & 4) ? 2 : 1);
            int lane_c = lane; asm volatile("" : "+v"(lane_c));
            const int qi = wave >> 1, g = wave & 1; const int count = CNT[qi];
            const int* list = LIST + qi * 256;
            float* PB = SC + wave * 1024;
            const unsigned* qd = QS + (qi * 8 + g * 4) * 32;
            const bf16_t* kvb = KVC + (size_t)b * SEQ * 256 + g * 64;
            const int ks = lane_c >> 3, dg = lane_c & 7, l15c = lane_c & 15, quadc = lane_c >> 4;
            const int nblk = count >> 6;
            bf16_t* KL = (bf16_t*)(lds + 32768 + wave * 9216);
            bf16x8 bq[2];
#pragma unroll
            for (int s2 = 0; s2 < 2; ++s2) {
                bf16x8 t = *(const bf16x8*)((const bf16_t*)QS + (qi * 8 + g * 4 + (l15c & 3)) * 64 + s2 * 32 + quadc * 8);
                if (l15c >= 4) t = (bf16x8){0, 0, 0, 0, 0, 0, 0, 0};
                bq[s2] = t;
            }
            const bf16_t* kb = kvb + dg * 8;
            float sreg[4][4][4];
            u32x4 kcur[8];
#pragma unroll
            for (int u = 0; u < 8; ++u) kcur[u] = *(const u32x4*)(kb + (size_t)list[u * 8 + ks] * 256);
#pragma unroll
            for (int blk = 0; blk < 4; ++blk) {
                if (blk < nblk) {
#pragma unroll
                    for (int u = 0; u < 8; ++u) *(u32x4*)(KL + (u * 8 + ks) * 72 + dg * 8) = kcur[u];
                    if (blk + 1 < nblk) {
#pragma unroll
                        for (int u = 0; u < 8; ++u) kcur[u] = *(const u32x4*)(kb + (size_t)list[(blk + 1) * 64 + u * 8 + ks] * 256);
                    }
                    lds_order();
#pragma unroll
                    for (int kt = 0; kt < 4; ++kt) {
                        f32x4 acc = (f32x4){0.f, 0.f, 0.f, 0.f};
#pragma unroll
                        for (int s2 = 0; s2 < 2; ++s2) acc = __builtin_amdgcn_mfma_f32_16x16x32_bf16(*(const bf16x8*)(KL + (kt * 16 + l15c) * 72 + s2 * 32 + quadc * 8), bq[s2], acc, 0, 0, 0);
#pragma unroll
                        for (int j = 0; j < 4; ++j) sreg[blk][kt][j] = acc[j] * 0.125f;
                    }
                    lds_order();
                } else {
#pragma unroll
                    for (int kt = 0; kt < 4; ++kt)
#pragma unroll
                        for (int j = 0; j < 4; ++j) sreg[blk][kt][j] = -INFINITY;
                }
            }
            const bf16_t* vb = kvb + 128 + dg * 8;
            u32x4 vreg[8];
#pragma unroll
            for (int u = 0; u < 8; ++u) vreg[u] = *(const u32x4*)(vb + (size_t)list[u * 8 + ks] * 256);
            float mx = -INFINITY;
#pragma unroll
            for (int blk = 0; blk < 4; ++blk)
#pragma unroll
                for (int kt = 0; kt < 4; ++kt)
#pragma unroll
                    for (int j = 0; j < 4; ++j) mx = fmaxf(mx, sreg[blk][kt][j]);
            mx = fmaxf(mx, __shfl_xor(mx, 16)); mx = fmaxf(mx, __shfl_xor(mx, 32));
            float sum = 0.f;
#pragma unroll
            for (int blk = 0; blk < 4; ++blk)
#pragma unroll
                for (int kt = 0; kt < 4; ++kt)
#pragma unroll
                    for (int j = 0; j < 4; ++j) { const float e = __expf(sreg[blk][kt][j] - mx); sreg[blk][kt][j] = e; sum += e; }
            sum += __shfl_xor(sum, 16); sum += __shfl_xor(sum, 32);
            const float invs = 1.f / sum;
            f32x4 oacc[4];
#pragma unroll
            for (int dt = 0; dt < 4; ++dt) oacc[dt] = (f32x4){0.f, 0.f, 0.f, 0.f};
            bf16_t* VT = KL;
#pragma unroll
            for (int blk = 0; blk < 4; ++blk) {
                if (blk < nblk) {
#pragma unroll
                    for (int u = 0; u < 8; ++u) {
                        const int rho = ((u >> 2) << 5) + ((((2 * u) & 3) + (ks >> 2)) << 3) + (((u >> 1) & 1) << 2) + (ks & 3);
                        *(u32x4*)(VT + rho * 72 + dg * 8) = vreg[u];
                    }
                    if (blk + 1 < nblk) {
#pragma unroll
                        for (int u = 0; u < 8; ++u) vreg[u] = *(const u32x4*)(vb + (size_t)list[(blk + 1) * 64 + u * 8 + ks] * 256);
                    }
                    lds_order();
#pragma unroll
                    for (int s2 = 0; s2 < 2; ++s2) {
                        u32x4 pw;
                        pw[0] = cvt_pk_bf16(sreg[blk][2 * s2][0], sreg[blk][2 * s2][1]); pw[1] = cvt_pk_bf16(sreg[blk][2 * s2][2], sreg[blk][2 * s2][3]);
                        pw[2] = cvt_pk_bf16(sreg[blk][2 * s2 + 1][0], sreg[blk][2 * s2 + 1][1]); pw[3] = cvt_pk_bf16(sreg[blk][2 * s2 + 1][2], sreg[blk][2 * s2 + 1][3]);
                        const bf16x8 pf = __builtin_bit_cast(bf16x8, pw);
#pragma unroll
                        for (int dt = 0; dt < 4; ++dt) {
                            const LAS unsigned char* vp = (const LAS unsigned char*)VT + ((32 * s2 + 8 * quadc + (l15c >> 2)) * 72) * 2 + dt * 32 + (l15c & 3) * 8;
                            const v4i16_t t0 = __builtin_amdgcn_ds_read_tr16_b64_v4i16((LAS v4i16_t*)vp);
                            const v4i16_t t1 = __builtin_amdgcn_ds_read_tr16_b64_v4i16((LAS v4i16_t*)(vp + 4 * 72 * 2));
                            const bf16x8 af2 = (bf16x8){t0[0], t0[1], t0[2], t0[3], t1[0], t1[1], t1[2], t1[3]};
                            oacc[dt] = __builtin_amdgcn_mfma_f32_16x16x32_bf16(af2, pf, oacc[dt], 0, 0, 0);
                        }
                    }
                    lds_order();
                }
            }
            if (l15c < 4) {
                bf16_t* yo = (DUMMY || dummy_c) ? ((bf16_t*)(ws + WS_MG + 48 * MiB) + (r0 + qi) * 512 + (g * 4 + l15c) * 64 + quadc * 4) : (P + (r0 + qi) * LDP + C_AQ + (g * 4 + l15c) * 64 + quadc * 4);
#pragma unroll
                for (int dt = 0; dt < 4; ++dt) {
                    const f32x4 v = oacc[dt] * invs;
                    u32x2 w; w[0] = cvt_pk_bf16(v[0], v[1]); w[1] = cvt_pk_bf16(v[2], v[3]);
                    *(u32x2*)(yo + dt * 16) = w;
                }
            }
        }
        lds_fence(); __builtin_amdgcn_s_barrier();
    }
#undef DSA_LOAD_ITEM
}

__device__ __forceinline__ float logsigmoidf_(float x) { return fminf(x, 0.f) - log1pf(__expf(-fabsf(x))); }
__device__ __forceinline__ float wave_incl_sum(float v, int lane) {
#pragma unroll
    for (int o = 1; o < 64; o <<= 1) { const float t = __shfl_up(v, o); if (lane >= o) v += t; }
    return v;
}
__device__ __forceinline__ float wave_incl_max(float v, int lane) {
#pragma unroll
    for (int o = 1; o < 64; o <<= 1) { const float t = __shfl_up(v, o); if (lane >= o) v = fmaxf(v, t); }
    return v;
}
__device__ __forceinline__ f32x4 mma_lds(const bf16_t* A, int lda, const bf16_t* Bt, int ldb, int K, int lane) {
    f32x4 acc = (f32x4){0.f, 0.f, 0.f, 0.f};
    const bf16_t* ap = A + (lane & 15) * lda + (lane >> 4) * 8; const bf16_t* bp = Bt + (lane & 15) * ldb + (lane >> 4) * 8;
    for (int k = 0; k < K; k += 32) acc = __builtin_amdgcn_mfma_f32_16x16x32_bf16(*(const bf16x8*)(ap + k), *(const bf16x8*)(bp + k), acc, 0, 0, 0);
    return acc;
}

__device__ __forceinline__ void phase_mlstm_a(const Args& a, unsigned char* lds) {
    unsigned char* ws = a.ws;
    const bf16_t* P = (const bf16_t*)(ws + WS_P); const bf16_t* QK = (const bf16_t*)(ws + WS_QK); const float* SM = (const float*)(ws + WS_SM);
    float* ST = (float*)(ws + WS_XB); float* DN = (float*)(ws + WS_DN); float* ML = (float*)(ws + WS_ML); float* BL = (float*)(ws + WS_BL);
    bf16_t* VT = (bf16_t*)lds;
    bf16_t* KT = (bf16_t*)(lds + 18432);
    float* WS_ = (float*)(lds + 18432 + 9216);
    const int tid = threadIdx.x, wave = tid >> 6, lane = tid & 63;
    for (int item = blockIdx.x; item < 4096; item += gridDim.x) {
        const int c = item & 127, h = (item >> 7) & 3, b = item >> 9;
        const size_t r0 = (size_t)b * SEQ + c * 64;
        if (wave == 0) {
            const float ig = SM[(r0 + lane) * 16 + 8 + h] + a.in[I_BI][h];
            const float lf = logsigmoidf_(SM[(r0 + lane) * 16 + 12 + h] + a.in[I_BF][h]);
            const float bs = wave_incl_sum(lf, lane);
            const float bl = __shfl(bs, 63);
            const float wk = bl - bs + ig;
            const float ml = wave_max(wk);
            WS_[lane] = __expf(wk - ml);
            if (lane == 0) { ML[item] = ml; BL[item] = bl; }
        }
        for (int i = tid; i < 1024; i += 512) { const int s = i >> 4, d0 = (i & 15) * 8; float f[8]; unpack8(*(const u32x4*)(P + (r0 + s) * LDP + C_MV + h * 128 + d0), f);
#pragma unroll
            for (int e = 0; e < 8; ++e) VT[(d0 + e) * 72 + s] = f2bf(f[e]); }
        __syncthreads();
        { const int s = tid >> 3, d0 = (tid & 7) * 8; float f[8]; unpack8(*(const u32x4*)(QK + (r0 + s) * 512 + 256 + h * 64 + d0), f); const float w = WS_[s];
#pragma unroll
            for (int e = 0; e < 8; ++e) KT[(d0 + e) * 72 + s] = f2bf(f[e] * w); }
        __syncthreads();
        float* st = ST + (size_t)item * 8192;
#pragma unroll
        for (int nt = 0; nt < 4; ++nt) {
            const f32x4 acc = mma_lds(VT + wave * 16 * 72, 72, KT + nt * 16 * 72, 72, 64, lane);
#pragma unroll
            for (int j = 0; j < 4; ++j) st[(wave * 16 + (lane >> 4) * 4 + j) * 64 + nt * 16 + (lane & 15)] = acc[j];
        }
        if (tid < 64) { float s = 0.f; for (int k = 0; k < 64; ++k) s += bf1(KT[tid * 72 + k]); DN[item * 64 + tid] = s; }
        __syncthreads();
    }
}
__device__ __forceinline__ void phase_mlstm_b(const Args& a) {
    unsigned char* ws = a.ws;
    float* ST = (float*)(ws + WS_XB); float* DN = (float*)(ws + WS_DN); const float* ML = (const float*)(ws + WS_ML); const float* BL = (const float*)(ws + WS_BL); float* MS = (float*)(ws + WS_MS);
    const int total = 32 * 8256;
    for (int w = blockIdx.x * 512 + threadIdx.x; w < total; w += gridDim.x * 512) {
        const int bh = w / 8256, e = w % 8256;
        float* p; int stride;
        if (e < 8192) { p = ST + (size_t)bh * 128 * 8192 + e; stride = 8192; } else { p = DN + (size_t)bh * 128 * 64 + (e - 8192); stride = 64; }
        float C = 0.f, m = 0.f;
        for (int c0 = 0; c0 < 128; c0 += 8) {
            float d[8], bl[8], ml[8];
#pragma unroll
            for (int u = 0; u < 8; ++u) { d[u] = p[(size_t)(c0 + u) * stride]; bl[u] = BL[bh * 128 + c0 + u]; ml[u] = ML[bh * 128 + c0 + u]; }
#pragma unroll
            for (int u = 0; u < 8; ++u) {
                p[(size_t)(c0 + u) * stride] = C;
                if (e == 0) MS[bh * 128 + c0 + u] = m;
                const float mn = fmaxf(bl[u] + m, ml[u]);
                C = __expf(bl[u] + m - mn) * C + __expf(ml[u] - mn) * d[u];
                m = mn;
            }
        }
    }
}
__device__ __forceinline__ void phase_mlstm_c(const Args& a, unsigned char* lds) {
    unsigned char* ws = a.ws;
    bf16_t* P = (bf16_t*)(ws + WS_P); const bf16_t* QK = (const bf16_t*)(ws + WS_QK); const float* SM = (const float*)(ws + WS_SM);
    const float* ST = (const float*)(ws + WS_XB); const float* DN = (const float*)(ws + WS_DN); const float* MS = (const float*)(ws + WS_MS);
    bf16_t* QS_ = (bf16_t*)lds;
    bf16_t* KS = (bf16_t*)(lds + 9216);
    bf16_t* AP = (bf16_t*)(lds + 18432);
    bf16_t* BT = (bf16_t*)(lds + 18432 + 17408);
    float* OUT = (float*)(lds + 18432 + 17408 + 34816);
    float* GS = (float*)(lds + 18432 + 17408 + 34816 + 33792);
    float* bS = GS; float* aS = GS + 64; float* mtS = GS + 128; float* wiS = GS + 192; float* nS = GS + 256; float* denS = GS + 320;
    const int tid = threadIdx.x, wave = tid >> 6, lane = tid & 63;
    for (int item = blockIdx.x; item < 4096; item += gridDim.x) {
        const int c = item & 127, h = (item >> 7) & 3, b = item >> 9;
        const size_t r0 = (size_t)b * SEQ + c * 64;
        if (wave == 0) {
            const float ig = SM[(r0 + lane) * 16 + 8 + h] + a.in[I_BI][h];
            const float lf = logsigmoidf_(SM[(r0 + lane) * 16 + 12 + h] + a.in[I_BF][h]);
            const float bs = wave_incl_sum(lf, lane);
            const float av = ig - bs;
            const float pm = wave_incl_max(av, lane);
            const float m0 = MS[item];
            const float mt = bs + fmaxf(pm, m0);
            bS[lane] = bs; aS[lane] = av; mtS[lane] = mt; wiS[lane] = __expf(bs + m0 - mt);
            nS[lane] = DN[item * 64 + lane];
        }
        { const int s = tid >> 3, d0 = (tid & 7) * 8;
            *(u32x4*)(QS_ + s * 72 + d0) = *(const u32x4*)(QK + (r0 + s) * 512 + h * 64 + d0);
            *(u32x4*)(KS + s * 72 + d0) = *(const u32x4*)(QK + (r0 + s) * 512 + 256 + h * 64 + d0); }
        for (int i = tid; i < 1024; i += 512) { const int s = i >> 4, d0 = (i & 15) * 8; float f[8]; unpack8(*(const u32x4*)(P + (r0 + s) * LDP + C_MV + h * 128 + d0), f);
#pragma unroll
            for (int e = 0; e < 8; ++e) BT[(d0 + e) * 136 + s] = f2bf(f[e]); }
        { const float* st = ST + (size_t)item * 8192;
            for (int i = tid; i < 2048; i += 512) { const int dv = i >> 4, k0 = (i & 15) * 4; const f32x4 v = *(const f32x4*)(st + dv * 64 + k0);
                *(unsigned*)(BT + dv * 136 + 64 + k0) = cvt_pk_bf16(v[0], v[1]); *(unsigned*)(BT + dv * 136 + 64 + k0 + 2) = cvt_pk_bf16(v[2], v[3]); } }
        __syncthreads();
#pragma unroll
        for (int u = 0; u < 2; ++u) {
            const int id = wave * 2 + u, tr = id >> 2, tc = id & 3;
            f32x4 acc = (f32x4){0.f, 0.f, 0.f, 0.f};
            if (tc <= tr) acc = mma_lds(QS_ + tr * 16 * 72, 72, KS + tc * 16 * 72, 72, 64, lane);
            const int s = tc * 16 + (lane & 15);
#pragma unroll
            for (int j = 0; j < 4; ++j) { const int t = tr * 16 + (lane >> 4) * 4 + j;
                const float w = (s <= t) ? acc[j] * __expf(bS[t] + aS[s] - mtS[t]) : 0.f;
                AP[t * 136 + s] = f2bf(w); }
        }
        { const int t = tid >> 3, d0 = (tid & 7) * 8; float f[8]; unpack8(*(const u32x4*)(QS_ + t * 72 + d0), f); const float w = wiS[t];
#pragma unroll
            for (int e = 0; e < 8; ++e) f[e] *= w;
            *(u32x4*)(AP + t * 136 + 64 + d0) = pack8(f); }
        __syncthreads();
#pragma unroll
        for (int tr = 0; tr < 4; ++tr) {
            const f32x4 acc = mma_lds(AP + tr * 16 * 136, 136, BT + wave * 16 * 136, 136, 128, lane);
#pragma unroll
            for (int j = 0; j < 4; ++j) OUT[(tr * 16 + (lane >> 4) * 4 + j) * 132 + wave * 16 + (lane & 15)] = acc[j];
        }
        { const int t = tid >> 3, part = tid & 7; float s = 0.f;
#pragma unroll
            for (int e = 0; e < 16; ++e) { const int k = part * 16 + e; const float v = bf1(AP[t * 136 + k]); s += (k < 64) ? v : v * nS[k - 64]; }
            s += __shfl_xor(s, 1); s += __shfl_xor(s, 2); s += __shfl_xor(s, 4);
            if (part == 0) denS[t] = s; }
        __syncthreads();
        { const int t = tid >> 3, part = tid & 7, dv0 = part * 16;
            const float den = fmaxf(fabsf(denS[t]), __expf(-mtS[t])); const float inv = 1.f / den;
            float hv[16]; float sq = 0.f;
#pragma unroll
            for (int e = 0; e < 16; ++e) { hv[e] = OUT[t * 132 + dv0 + e] * inv; sq += hv[e] * hv[e]; }
            sq += __shfl_xor(sq, 1); sq += __shfl_xor(sq, 2); sq += __shfl_xor(sq, 4);
            const float rs = rsqrtf(sq * (1.f / 128.f) + EPS);
            bf16_t* po = P + (r0 + t) * LDP + C_MO + h * 128 + dv0;
            float og[16]; unpack8(*(const u32x4*)po, og); unpack8(*(const u32x4*)(po + 8), og + 8);
#pragma unroll
            for (int e = 0; e < 16; ++e) hv[e] = hv[e] * rs * a.in[I_MHN][h * 128 + dv0 + e] * sigmoidf_(og[e]);
            *(u32x4*)po = pack8(hv); *(u32x4*)(po + 8) = pack8(hv + 8); }
        __syncthreads();
    }
}


#define XB_TMO      128
#define XB_XCNT(j)  (256  + 64 * (j))
#define XB_XSUB(j)  (1280 + 64 * (j))
#define XB_XGEN(j)  (2304 + 64 * (j))
#define XB_TOP      3328
#define XB_TOPGEN   3392
#define XCD_BAR_WORDS 3456
#define XB_SPIN_CAP (1u << 22)
__device__ __forceinline__ unsigned xb_ld(unsigned* p)              { return __hip_atomic_load(p, __ATOMIC_RELAXED, __HIP_MEMORY_SCOPE_AGENT); }
__device__ __forceinline__ unsigned xb_add(unsigned* p, unsigned v) { return __hip_atomic_fetch_add(p, v, __ATOMIC_RELAXED, __HIP_MEMORY_SCOPE_AGENT); }
__device__ __forceinline__ unsigned xb_xcc_id() { return (unsigned)__builtin_amdgcn_s_getreg((3 << 11) | 20) & 0xFu; }
#define XB_SPIN(cond, bar) do { unsigned _sp = 0; while (cond) { __builtin_amdgcn_s_sleep(1); \
    if ((++_sp & 255u) == 0u) { if (xb_ld(&(bar)[XB_TMO])) break; if (_sp > XB_SPIN_CAP) { atomicAdd(&(bar)[XB_TMO], 1u); break; } } } } while (0)
struct XcdBarrier { unsigned* bar; unsigned x; volatile LAS unsigned* st; };
__device__ __forceinline__ XcdBarrier xcd_barrier_post(unsigned* bar, volatile LAS unsigned* st) {
    XcdBarrier b; b.bar = bar; b.x = xb_xcc_id(); b.st = st;
    if (threadIdx.x == 0) (void)xb_add(&bar[XB_XCNT(b.x)], 1u);
    return b;
}
__device__ __forceinline__ void xcd_barrier_complete(unsigned* bar, unsigned x, unsigned& nloc, unsigned& nx) {
    const unsigned G = gridDim.x * gridDim.y * gridDim.z;
    unsigned sum, cnt, mine, sp = 0u;
    for (;;) {
        sum = 0u; cnt = 0u; mine = 0u;
#pragma unroll
        for (unsigned j = 0; j < 16; ++j) { const unsigned c = xb_ld(&bar[XB_XCNT(j)]); sum += c; cnt += (c > 0u) ? 1u : 0u; mine = (j == x) ? c : mine; }
        if (sum == G) break;
        __builtin_amdgcn_s_sleep(1);
        if ((++sp & 255u) == 0u) { if (xb_ld(&bar[XB_TMO])) break; if (sp > XB_SPIN_CAP) { atomicAdd(&bar[XB_TMO], 1u); break; } }
    }
    nloc = mine > 0u ? mine : 1u; nx = cnt > 0u ? cnt : 1u;
}
__device__ __forceinline__ void xcd_barrier(const XcdBarrier& b) {
    asm volatile("s_waitcnt vmcnt(0)" ::: "memory");
    __syncthreads();
    if (threadIdx.x == 0) {
        unsigned* bar = b.bar;
        __builtin_amdgcn_s_waitcnt(0);
        unsigned nloc = b.st[0], nx = b.st[1];
        if (nloc == 0u) { xcd_barrier_complete(bar, b.x, nloc, nx); b.st[0] = nloc; b.st[1] = nx; }
        const unsigned old = xb_add(&bar[XB_XSUB(b.x)], 1u);
        const unsigned gen = old / nloc;
        if (old + 1u == (gen + 1u) * nloc) {
            __builtin_amdgcn_fence(__ATOMIC_RELEASE, "agent");
            asm volatile("s_waitcnt vmcnt(0)" ::: "memory");
            const unsigned og = xb_add(&bar[XB_TOP], 1u);
            const unsigned tg = og / nx;
            if (og + 1u == (tg + 1u) * nx) xb_add(&bar[XB_TOPGEN], 1u);
            else XB_SPIN(xb_ld(&bar[XB_TOPGEN]) == tg, bar);
            __builtin_amdgcn_fence(__ATOMIC_ACQUIRE, "agent");
            xb_add(&bar[XB_XGEN(b.x)], 1u);
            asm volatile("s_waitcnt vmcnt(0)" ::: "memory");
        } else {
            XB_SPIN(xb_ld(&bar[XB_XGEN(b.x)]) == gen, bar);
            __builtin_amdgcn_fence(__ATOMIC_ACQUIRE, "agent");
            asm volatile("s_waitcnt vmcnt(0)" ::: "memory");
        }
    }
    __syncthreads();
}

#ifndef DBG_ZERO_YA
#define DBG_ZERO_YA 1
#endif
#ifndef PH
#define PH 0xFFFF
#endif
__global__ void __launch_bounds__(512, 2) mega_fwd(Args a) {
    extern __shared__ __attribute__((aligned(16))) unsigned char lds[];
    cg::grid_group grid = cg::this_grid();
    LAS unsigned char* ldsl = (LAS unsigned char*)lds;
    unsigned char* ws = a.ws;
    const int G = gridDim.x, bid = blockIdx.x;
    bf16_t* XB = (bf16_t*)(ws + WS_XB); bf16_t* Pb = (bf16_t*)(ws + WS_P); bf16_t* MG = (bf16_t*)(ws + WS_MG); bf16_t* QKb = (bf16_t*)(ws + WS_QK);
    float* ss0 = (float*)(ws + WS_SS0); float* ss1 = (float*)(ws + WS_SS1); float* ss2 = (float*)(ws + WS_SS2);

    unsigned* barw = (unsigned*)(ws + WS_BAR);
    if (bid == 0) { for (int i = threadIdx.x; i < XCD_BAR_WORDS; i += 512) barw[i] = 0u; }
    volatile LAS unsigned* bst = (volatile LAS unsigned*)(ldsl + LDS_BYTES - 16);
    if (threadIdx.x == 0) { bst[0] = 0u; bst[1] = 0u; }
    if (PH & 1) phase0(a, lds);
    __threadfence();
    grid.sync();
    const XcdBarrier xbar = xcd_barrier_post(barw, bst);
    if (PH & 2) {
        pg8::Gemm g{XB, (const bf16_t*)(ws + WS_W1), DM, DM, MROWS, 2 * FF, DM}; pg8::StaticOrder S; S.init(MROWS, 2 * FF, G, bid);
        pg8::EpiSwiGLU E{Pb, ss0}; pg8::gemm_phase(ldsl, g, S, E);
    }
    xcd_barrier(xbar);
    if (PH & 4) {
        pg8::Gemm g{Pb, (const bf16_t*)(ws + WS_W2), FF, FF, MROWS, DM, FF}; pg8::StaticOrder S; S.init(MROWS, DM, G, bid);
        pg8::EpiRes<true> E{a.in[I_X], a.out, XB, ss1, 0.5f}; pg8::gemm_phase(ldsl, g, S, E);
    }
    xcd_barrier(xbar);
    if (PH & 8) {
        pg8::Gemm g{XB, (const bf16_t*)(ws + WS_WIN), DM, DM, MROWS, LDP, DM}; pg8::StaticOrder S; S.init(MROWS, LDP, G, bid);
        pg8::EpiP E{Pb, (float*)(ws + WS_SM), ss1}; pg8::gemm_phase(ldsl, g, S, E);
    }
    xcd_barrier(xbar);
    if (PH & 16) phase_postp(a);
    xcd_barrier(xbar);
    if (PH & 32) {
        pg8::Gemm g{XB, (const bf16_t*)(ws + WS_WQK), 512, 512, MROWS, 512, 512}; pg8::StaticOrder S; S.init(MROWS, 512, G, bid);
        pg8::EpiBf16 E{QKb, 512}; pg8::gemm_phase(ldsl, g, S, E);
    }
    xcd_barrier(xbar);
    if (PH & 64) phase_mlstm_a(a, lds);
    xcd_barrier(xbar);
    if (PH & 128) phase_mlstm_b(a);
    xcd_barrier(xbar);
    if (PH & 256) phase_mlstm_c(a, lds);
    if (DBG_TWICE & 1) phase_dsa<true>(a, lds);
    if (PH & 512) phase_dsa<false>(a, lds);
    xcd_barrier(xbar);
    if (PH & 1024) {
        pg8::StaticOrder S; S.init(MROWS, DM, G, bid);
        { pg8::Gemm g{Pb + C_AQ, (const bf16_t*)(ws + WS_WA), LDP, 512, MROWS, DM, 512}; pg8::EpiMerge<0> E{Pb, MG, C_GA}; pg8::gemm_phase(ldsl, g, S, E); }
        { pg8::Gemm g{Pb + C_MO, (const bf16_t*)(ws + WS_WB), LDP, 512, MROWS, DM, 512}; pg8::EpiMerge<1> E{Pb, MG, C_GB}; pg8::gemm_phase(ldsl, g, S, E); }
    }
    xcd_barrier(xbar);
    if (PH & 2048) {
        pg8::Gemm g{MG, (const bf16_t*)(ws + WS_WO), DM, DM, MROWS, DM, DM}; pg8::StaticOrder S; S.init(MROWS, DM, G, bid);
        pg8::EpiRes<true> E{a.out, a.out, XB, ss2, 1.0f}; pg8::gemm_phase(ldsl, g, S, E);
    }
    xcd_barrier(xbar);
    if (PH & 4096) {
        pg8::Gemm g{XB, (const bf16_t*)(ws + WS_W3), DM, DM, MROWS, 2 * FF, DM}; pg8::StaticOrder S; S.init(MROWS, 2 * FF, G, bid);
        pg8::EpiSwiGLU E{Pb, ss2}; pg8::gemm_phase(ldsl, g, S, E);
    }
    xcd_barrier(xbar);
    if (PH & 8192) {
        pg8::Gemm g{Pb, (const bf16_t*)(ws + WS_W4), FF, FF, MROWS, DM, FF}; pg8::StaticOrder S; S.init(MROWS, DM, G, bid);
        pg8::EpiRes<false> E{a.out, a.out, nullptr, nullptr, 0.5f}; pg8::gemm_phase(ldsl, g, S, E);
    }
}

extern "C" void kernel_launch(void* const* d_in, const int* in_sizes, int n_in, void* d_out, int out_size, void* d_ws, size_t ws_size, hipStream_t stream) {
    static int grid = 0;
    if (grid == 0) {
        if (n_in != 24 || ws_size < WS_END) { fprintf(stderr, "kernel_launch: unexpected n_in %d / ws %zu\n", n_in, ws_size); grid = -1; return; }
        int dev = 0, cus = 0, per_cu = 0;
        hipGetDevice(&dev);
        hipDeviceGetAttribute(&cus, hipDeviceAttributeMultiprocessorCount, dev);
        hipFuncSetAttribute((const void*)mega_fwd, hipFuncAttributeMaxDynamicSharedMemorySize, LDS_BYTES);
        hipOccupancyMaxActiveBlocksPerMultiprocessor(&per_cu, (const void*)mega_fwd, 512, LDS_BYTES);
        if (per_cu < 1) { fprintf(stderr, "kernel_launch: occupancy query says %d blocks/CU\n", per_cu); per_cu = 1; }
        (void)hipGetLastError();
        grid = cus * per_cu;
    }
    if (grid < 0) return;
    Args a{};
    for (int i = 0; i < 24; ++i) a.in[i] = (const float*)d_in[i];
    a.out = (float*)d_out; a.ws = (unsigned char*)d_ws;
    void* args[] = {&a};
    hipError_t e = hipLaunchCooperativeKernel((const void*)mega_fwd, dim3(grid), dim3(512), args, LDS_BYTES, stream);
    if (e != hipSuccess) fprintf(stderr, "cooperative launch failed: %s (grid %d)\n", hipGetErrorString(e), grid);
}
```

```cpp
#include <hip/hip_runtime.h>
#include <hip/hip_cooperative_groups.h>
#include <cstdio>
#include <cstdint>
namespace cg = cooperative_groups;
#define DBG_ZERO_YA 0
#define DBG_TWICE 0
#define DBG_NOSEL 0

#define LAS __attribute__((address_space(3)))
typedef unsigned short bf16_t;
typedef short bf16x8 __attribute__((ext_vector_type(8)));
typedef float f32x4 __attribute__((ext_vector_type(4)));
typedef unsigned u32x4 __attribute__((ext_vector_type(4)));
typedef unsigned u32x2 __attribute__((ext_vector_type(2)));
typedef __bf16 bf2_t __attribute__((ext_vector_type(2)));
typedef short v4i16_t __attribute__((ext_vector_type(4)));

constexpr int MROWS = 65536, DM = 1024, FF = 2816, SEQ = 8192, NB = 8;
constexpr int LDP = 5120;
constexpr int C_AQ = 0, C_AK = 512, C_AV = 640, C_IQ = 768, C_IK = 1280, C_MX = 1344, C_MV = 1856, C_MO = 2368, C_GA = 2880, C_GB = 3904, C_SM = 4928;
constexpr float EPS = 1e-6f;
constexpr size_t MiB = 1u << 20;
constexpr size_t WS_SS0 = 0, WS_SS1 = 256 * 1024, WS_SS2 = 512 * 1024;
constexpr size_t WS_DN = 1 * MiB;
constexpr size_t WS_ML = 2 * MiB, WS_BL = 2 * MiB + 16384, WS_MS = 2 * MiB + 32768;
constexpr size_t WS_BAR = 2 * MiB + 65536;
constexpr size_t WS_SM = 3 * MiB;
constexpr size_t WS_W1 = 8 * MiB, WS_W2 = 19 * MiB, WS_W3 = 25 * MiB, WS_W4 = 36 * MiB, WS_WIN = 42 * MiB, WS_WA = 52 * MiB, WS_WB = 53 * MiB, WS_WO = 54 * MiB, WS_WQK = 56 * MiB;
constexpr size_t WS_XB = 64 * MiB;
constexpr size_t WS_P = 192 * MiB;
constexpr size_t WS_MG = 832 * MiB;
constexpr size_t WS_IKC = 832 * MiB;
constexpr size_t WS_KVC = 840 * MiB;
constexpr size_t WS_QK = 960 * MiB;
constexpr size_t WS_END = 1024 * MiB;
constexpr int LDS_BYTES = 156 * 1024;

__device__ __forceinline__ unsigned cvt_pk_bf16(float lo, float hi) { unsigned r; asm volatile("v_cvt_pk_bf16_f32 %0, %1, %2" : "=v"(r) : "v"(lo), "v"(hi)); return r; }
__device__ __forceinline__ float bflo(unsigned u) { return __uint_as_float(u << 16); }
__device__ __forceinline__ float bfhi(unsigned u) { return __uint_as_float(u & 0xffff0000u); }
__device__ __forceinline__ float bf1(bf16_t u) { return __uint_as_float(((unsigned)u) << 16); }
__device__ __forceinline__ bf16_t f2bf(float f) { return (bf16_t)(cvt_pk_bf16(f, 0.f) & 0xffffu); }
__device__ __forceinline__ float wave_sum(float v) {
#pragma unroll
    for (int o = 1; o < 64; o <<= 1) v += __shfl_xor(v, o);
    return v;
}
__device__ __forceinline__ float wave_max(float v) {
#pragma unroll
    for (int o = 1; o < 64; o <<= 1) v = fmaxf(v, __shfl_xor(v, o));
    return v;
}
__device__ __forceinline__ float sigmoidf_(float x) { return __builtin_amdgcn_rcpf(1.f + __expf(-x)); }
__device__ __forceinline__ float dot2bf(unsigned a, unsigned b, float c) { const unsigned aa = a, bb = b; return __builtin_amdgcn_fdot2_f32_bf16(__builtin_bit_cast(bf2_t, aa), __builtin_bit_cast(bf2_t, bb), c, false); }
__device__ __forceinline__ float relu_(float x) { const int i = __float_as_int(x); return __int_as_float(i > 0 ? i : 0); }
__device__ __forceinline__ void lds_order() { asm volatile("" ::: "memory"); }
__device__ __forceinline__ void lds_fence() { asm volatile("s_waitcnt lgkmcnt(0)" ::: "memory"); }
__device__ __forceinline__ void unpack8(u32x4 v, float* f) {
    f[0] = bflo(v.x); f[1] = bfhi(v.x); f[2] = bflo(v.y); f[3] = bfhi(v.y); f[4] = bflo(v.z); f[5] = bfhi(v.z); f[6] = bflo(v.w); f[7] = bfhi(v.w);
}
__device__ __forceinline__ u32x4 pack8(const float* f) {
    u32x4 o; o.x = cvt_pk_bf16(f[0], f[1]); o.y = cvt_pk_bf16(f[2], f[3]); o.z = cvt_pk_bf16(f[4], f[5]); o.w = cvt_pk_bf16(f[6], f[7]); return o;
}

namespace pg8 {
constexpr int BM = 256, BK = 64, HALF = 128, HTB = HALF * BK * 2, NXCD = 8, WGM = 8;
__host__ __device__ __forceinline__ int lds_byte(int r, int c) { const int st = (r >> 4) * 2 + (c >> 5), rr = r & 15, cc = c & 31, ob = rr * 64 + cc * 2; return st * 1024 + (ob ^ (((ob >> 9) & 1) << 5)); }
__host__ __device__ __forceinline__ void stage_rc(int b, int& R, int& C) { const int st = b / 1024, sb = b % 1024, swz = sb ^ (((sb >> 9) & 1) << 5); R = (st >> 1) * 16 + swz / 64; C = (st & 1) * 32 + (swz % 64) / 2; }
__host__ __device__ __forceinline__ int perm32(int rho) { const int n = rho >> 4, i = rho & 15; return 8 * (i >> 2) + 4 * n + (i & 3); }
struct Unit { int pm, pn; };
struct Gemm { const bf16_t* A; const bf16_t* Bt; int lda, ldb, M, N, K; };
struct StaticOrder {
    int nM, nN, nwg, G, c;
    __device__ void init(int M, int N, int G_, int c_) { nM = M / BM; nN = N / BM; nwg = nM * nN; G = G_; c = c_; }
    __device__ bool next(int i, Unit& u) const {
        const long L = (long)i * G + c; if (L >= nwg) return false;
        int wgid = (int)L; { const int q = nwg / NXCD, r = nwg % NXCD, xcd = wgid % NXCD, off = wgid / NXCD; wgid = (xcd < r ? xcd * (q + 1) : r * (q + 1) + (xcd - r) * q) + off; }
        const int nig = WGM * nN, gid = wgid / nig, fm = gid * WGM, gsz = (nM - fm) < WGM ? (nM - fm) : WGM;
        u.pm = fm + ((wgid % nig) % gsz); u.pn = (wgid % nig) / gsz; return true;
    }
};

template <class Epi>
__device__ __forceinline__ void gemm_phase(LAS unsigned char* lds, const Gemm g, const StaticOrder& S, const Epi& E) {
    int tid_ = threadIdx.x; asm volatile("" : "+v"(tid_));
    const int tid = tid_, wid = __builtin_amdgcn_readfirstlane(tid >> 6), lane = tid & 63, wr = wid >> 2, wc = wid & 3, fr = lane & 15, fq = lane >> 4;
    const int K = g.K, nt = K / BK;
    unsigned voffA[2], voffB[2];
#pragma unroll
    for (int i = 0; i < 2; ++i) { int R, C; stage_rc(tid * 16 + i * 8192, R, C); const int Rb = (R & ~31) + perm32(R & 31);
        voffA[i] = (unsigned)(R * g.lda + C) * 2u; voffB[i] = (unsigned)(Rb * g.ldb + C) * 2u; }
    const size_t kstep = (size_t)(BK * 2);
    const size_t hsA = (size_t)HALF * g.lda * 2, hsB = (size_t)HALF * g.ldb * 2;
    const size_t tsA = 2 * hsA, tsB = 2 * hsB;
    const unsigned ldsw = (unsigned)wid * 1024u;
    const int aoff = lds_byte(wr * 64 + fr, fq * 8), boff = lds_byte(wc * 32 + fr, fq * 8);
#define PG8_SA(b, h) (((b) * 2 + (h)) * HTB)
#define PG8_SB(b, h) ((4 + (b) * 2 + (h)) * HTB)
#define PG8_STAGE(bufoff, gbase, voff) do { _Pragma("unroll") for (int _i = 0; _i < 2; ++_i) \
        __builtin_amdgcn_global_load_lds((const unsigned*)((const char*)(gbase) + (voff)[_i]), (LAS unsigned*)(lds + (bufoff) + ldsw + _i * 8192), 16, 0, 0); } while (0)
#define PG8_LDA(dst, b, h) do { _Pragma("unroll") for (int m = 0; m < 4; ++m) _Pragma("unroll") for (int k = 0; k < 2; ++k) dst[m][k] = *(const LAS bf16x8*)(lds + PG8_SA(b, h) + aoff + m * 2048 + k * 1024); } while (0)
#define PG8_LDB(dst, b, h) do { _Pragma("unroll") for (int n = 0; n < 2; ++n) _Pragma("unroll") for (int k = 0; k < 2; ++k) dst[n][k] = *(const LAS bf16x8*)(lds + PG8_SB(b, h) + boff + n * 2048 + k * 1024); } while (0)
#define PG8_MMA(ai, bj, At, Bt) do { __builtin_amdgcn_s_setprio(1); _Pragma("unroll") for (int m = 0; m < 4; ++m) _Pragma("unroll") for (int n = 0; n < 2; ++n) _Pragma("unroll") for (int k = 0; k < 2; ++k) \
        acc[ai][bj][m][n] = __builtin_amdgcn_mfma_f32_16x16x32_bf16(Bt[n][k], At[m][k], acc[ai][bj][m][n], 0, 0, 0); __builtin_amdgcn_s_setprio(0); } while (0)
#define PG8_WAIT_V(n) asm volatile("s_waitcnt vmcnt(" #n ")" ::: "memory")
#define PG8_WAIT_L(n) asm volatile("s_waitcnt lgkmcnt(" #n ")" ::: "memory")
#define PG8_BAR __builtin_amdgcn_s_barrier()
#define PG8_SCHED __builtin_amdgcn_sched_barrier(0)
    Unit cur, nxt; int ui = 0;
    if (!S.next(0, cur)) return;
    f32x4 acc[2][2][4][2];
#pragma unroll
    for (int a = 0; a < 2; ++a)
#pragma unroll
        for (int b = 0; b < 2; ++b)
#pragma unroll
            for (int m = 0; m < 4; ++m)
#pragma unroll
                for (int n = 0; n < 2; ++n) acc[a][b][m][n] = (f32x4){0.f, 0.f, 0.f, 0.f};
    bf16x8 At[4][2], B0[2][2], B1[2][2];
    const char* cA = (const char*)g.A + (size_t)cur.pm * tsA; const char* cB = (const char*)g.Bt + (size_t)cur.pn * tsB;
    PG8_STAGE(PG8_SB(0, 0), cB, voffB); PG8_STAGE(PG8_SB(0, 1), cB + hsB, voffB); PG8_STAGE(PG8_SA(0, 0), cA, voffA); PG8_STAGE(PG8_SA(0, 1), cA + hsA, voffA);
    if (wr == 1) PG8_BAR;
    PG8_WAIT_V(2); PG8_BAR;
    PG8_STAGE(PG8_SB(1, 0), cB + kstep, voffB); PG8_STAGE(PG8_SA(1, 0), cA + kstep, voffA); PG8_STAGE(PG8_SB(1, 1), cB + hsB + kstep, voffB);
    PG8_WAIT_V(6); PG8_BAR;
    for (;;) {
        const bool has_next = S.next(ui + 1, nxt);
        const char* nA = has_next ? (const char*)g.A + (size_t)nxt.pm * tsA : cA; const char* nB = has_next ? (const char*)g.Bt + (size_t)nxt.pn * tsB : cB;
        for (int t = 0; t < nt; t += 2) {
            const bool last = (t == nt - 2);
            const char* a1 = cA + (size_t)(t + 1) * kstep;
            const char* a2 = last ? nA : cA + (size_t)(t + 2) * kstep; const char* b2 = last ? nB : cB + (size_t)(t + 2) * kstep;
            const char* a3 = a2 + kstep; const char* b3 = b2 + kstep;
            PG8_LDB(B0, 0, 0); PG8_LDB(B1, 0, 1); PG8_SCHED; PG8_LDA(At, 0, 0); PG8_STAGE(PG8_SA(1, 1), a1 + hsA, voffA);
            PG8_WAIT_V(8); PG8_WAIT_L(0); PG8_BAR; PG8_MMA(0, 0, At, B0); PG8_MMA(0, 1, At, B1); PG8_BAR; PG8_SCHED;
            PG8_LDA(At, 0, 1); PG8_STAGE(PG8_SB(0, 0), b2, voffB); PG8_STAGE(PG8_SB(0, 1), b2 + hsB, voffB); PG8_STAGE(PG8_SA(0, 0), a2, voffA);
            PG8_WAIT_V(8); PG8_WAIT_L(0); PG8_BAR; PG8_MMA(1, 0, At, B0); PG8_MMA(1, 1, At, B1); PG8_BAR; PG8_SCHED;
            PG8_LDB(B0, 1, 0); PG8_LDB(B1, 1, 1); PG8_SCHED; PG8_LDA(At, 1, 0); PG8_STAGE(PG8_SA(0, 1), a2 + hsA, voffA);
            PG8_WAIT_V(8); PG8_WAIT_L(0); PG8_BAR; PG8_MMA(0, 0, At, B0); PG8_MMA(0, 1, At, B1); PG8_BAR; PG8_SCHED;
            PG8_LDA(At, 1, 1); PG8_STAGE(PG8_SB(1, 0), b3, voffB); PG8_STAGE(PG8_SB(1, 1), b3 + hsB, voffB); PG8_STAGE(PG8_SA(1, 0), a3, voffA);
            PG8_WAIT_V(8); PG8_WAIT_L(0); PG8_BAR; PG8_MMA(1, 0, At, B0); PG8_MMA(1, 1, At, B1); PG8_BAR; PG8_SCHED;
        }
        if (wr == 0) PG8_BAR;
        E(acc, cur, wr, wc, fr, fq);
        if (!has_next) break;
#pragma unroll
        for (int a = 0; a < 2; ++a)
#pragma unroll
            for (int b = 0; b < 2; ++b)
#pragma unroll
                for (int m = 0; m < 4; ++m)
#pragma unroll
                    for (int n = 0; n < 2; ++n) acc[a][b][m][n] = (f32x4){0.f, 0.f, 0.f, 0.f};
        cur = nxt; cA = nA; cB = nB; ++ui;
        if (wr == 1) PG8_BAR;
    }
    PG8_WAIT_V(0);
    PG8_BAR;
#undef PG8_SA
#undef PG8_SB
#undef PG8_STAGE
#undef PG8_LDA
#undef PG8_LDB
#undef PG8_MMA
#undef PG8_WAIT_V
#undef PG8_WAIT_L
#undef PG8_BAR
#undef PG8_SCHED
}

typedef f32x4 AccT[2][2][4][2];
struct EpiSwiGLU {
    bf16_t* O; const float* ss;
    __device__ __forceinline__ void operator()(const AccT& acc, const Unit& u, int wr, int wc, int fr, int fq) const {
        const int row0 = u.pm * BM + wr * 64 + fr, col = u.pn * 128 + wc * 32 + 8 * fq;
#pragma unroll
        for (int ai = 0; ai < 2; ++ai)
#pragma unroll
            for (int m = 0; m < 4; ++m) {
                const int row = row0 + ai * HALF + m * 16;
                const float rs = rsqrtf(ss[row] * (1.f / 1024.f) + EPS);
                float o[8];
#pragma unroll
                for (int n = 0; n < 2; ++n)
#pragma unroll
                    for (int j = 0; j < 4; ++j) { const float gt = acc[ai][0][m][n][j] * rs, up = acc[ai][1][m][n][j] * rs; o[n * 4 + j] = gt * up * sigmoidf_(gt); }
                *(u32x4*)(O + (size_t)row * FF + col) = pack8(o);
            }
    }
};
template <bool WRITE_XB> struct EpiRes {
    const float* res; float* out; bf16_t* xb; float* ss; float alpha;
    __device__ __forceinline__ void operator()(const AccT& acc, const Unit& u, int wr, int wc, int fr, int fq) const {
        const int row0 = u.pm * BM + wr * 64 + fr, col0 = u.pn * BM + wc * 32 + 8 * fq;
#pragma unroll
        for (int ai = 0; ai < 2; ++ai)
#pragma unroll
            for (int m = 0; m < 4; ++m) {
                const int row = row0 + ai * HALF + m * 16; float sq = 0.f;
#pragma unroll
                for (int bj = 0; bj < 2; ++bj) {
                    const size_t off = (size_t)row * DM + col0 + bj * HALF;
                    const f32x4 r0 = *(const f32x4*)(res + off), r1 = *(const f32x4*)(res + off + 4);
                    const f32x4 v0 = r0 + acc[ai][bj][m][0] * alpha, v1 = r1 + acc[ai][bj][m][1] * alpha;
                    *(f32x4*)(out + off) = v0; *(f32x4*)(out + off + 4) = v1;
                    if (WRITE_XB) {
                        u32x4 w; w.x = cvt_pk_bf16(v0[0], v0[1]); w.y = cvt_pk_bf16(v0[2], v0[3]); w.z = cvt_pk_bf16(v1[0], v1[1]); w.w = cvt_pk_bf16(v1[2], v1[3]);
                        *(u32x4*)(xb + off) = w;
                        sq += v0[0] * v0[0] + v0[1] * v0[1] + v0[2] * v0[2] + v0[3] * v0[3] + v1[0] * v1[0] + v1[1] * v1[1] + v1[2] * v1[2] + v1[3] * v1[3];
                    }
                }
                if (WRITE_XB) { sq += __shfl_xor(sq, 16); sq += __shfl_xor(sq, 32); if (fq == 0) atomicAdd(ss + row, sq); }
            }
    }
};
struct EpiP {
    bf16_t* P; float* SM; const float* ss;
    __device__ __forceinline__ void operator()(const AccT& acc, const Unit& u, int wr, int wc, int fr, int fq) const {
        const int row0 = u.pm * BM + wr * 64 + fr, col0 = u.pn * BM + wc * 32 + 8 * fq;
#pragma unroll
        for (int ai = 0; ai < 2; ++ai)
#pragma unroll
            for (int m = 0; m < 4; ++m) {
                const int row = row0 + ai * HALF + m * 16;
                const float rs = rsqrtf(ss[row] * (1.f / 1024.f) + EPS);
#pragma unroll
                for (int bj = 0; bj < 2; ++bj) {
                    const int col = col0 + bj * HALF;
                    const f32x4 v0 = acc[ai][bj][m][0] * rs, v1 = acc[ai][bj][m][1] * rs;
                    u32x4 w; w.x = cvt_pk_bf16(v0[0], v0[1]); w.y = cvt_pk_bf16(v0[2], v0[3]); w.z = cvt_pk_bf16(v1[0], v1[1]); w.w = cvt_pk_bf16(v1[2], v1[3]);
                    *(u32x4*)(P + (size_t)row * LDP + col) = w;
                    if (col >= C_SM && col < C_SM + 16) { float* s = SM + (size_t)row * 16 + (col - C_SM); *(f32x4*)s = v0; *(f32x4*)(s + 4) = v1; }
                }
            }
    }
};
struct EpiBf16 {
    bf16_t* O; int ldc;
    __device__ __forceinline__ void operator()(const AccT& acc, const Unit& u, int wr, int wc, int fr, int fq) const {
        const int row0 = u.pm * BM + wr * 64 + fr, col0 = u.pn * BM + wc * 32 + 8 * fq;
#pragma unroll
        for (int ai = 0; ai < 2; ++ai)
#pragma unroll
            for (int m = 0; m < 4; ++m) {
                const int row = row0 + ai * HALF + m * 16;
#pragma unroll
                for (int bj = 0; bj < 2; ++bj) {
                    const f32x4 v0 = acc[ai][bj][m][0], v1 = acc[ai][bj][m][1];
                    u32x4 w; w.x = cvt_pk_bf16(v0[0], v0[1]); w.y = cvt_pk_bf16(v0[2], v0[3]); w.z = cvt_pk_bf16(v1[0], v1[1]); w.w = cvt_pk_bf16(v1[2], v1[3]);
                    *(u32x4*)(O + (size_t)row * ldc + col0 + bj * HALF) = w;
                }
            }
    }
};
template <int PASS> struct EpiMerge {
    const bf16_t* P; bf16_t* MG; int goff;
    __device__ __forceinline__ void operator()(const AccT& acc, const Unit& u, int wr, int wc, int fr, int fq) const {
        const int row0 = u.pm * BM + wr * 64 + fr, col0 = u.pn * BM + wc * 32 + 8 * fq;
#pragma unroll
        for (int ai = 0; ai < 2; ++ai)
#pragma unroll
            for (int m = 0; m < 4; ++m) {
                const int row = row0 + ai * HALF + m * 16;
#pragma unroll
                for (int bj = 0; bj < 2; ++bj) {
                    const int col = col0 + bj * HALF;
                    float gt[8], o[8]; unpack8(*(const u32x4*)(P + (size_t)row * LDP + goff + col), gt);
                    if (PASS == 1) unpack8(*(const u32x4*)(MG + (size_t)row * DM + col), o);
#pragma unroll
                    for (int j = 0; j < 8; ++j) { const float a = acc[ai][bj][m][j >> 2][j & 3] * sigmoidf_(gt[j]); o[j] = (PASS == 1) ? o[j] + a : a; }
                    *(u32x4*)(MG + (size_t)row * DM + col) = pack8(o);
                }
            }
    }
};
}

struct Args {
    const float* in[24];
    float* out;
    unsigned char* ws;
};
enum { I_X = 0, I_F1N, I_F1G, I_F1U, I_F1D, I_MIXN, I_WIN, I_QN, I_KN, I_IKN, I_CW, I_CB, I_WMQ, I_WMK, I_BI, I_BF, I_MHN, I_WPA, I_WPB, I_WOUT, I_F2N, I_F2G, I_F2U, I_F2D };

template <class F> __device__ __forceinline__ void prep_tile(bf16_t* Bt, int K, int n0, int k0, const F src, float* tile) {
    const int tid = threadIdx.x;
    { const int nn = tid & 63, kk = tid >> 6;
#pragma unroll
        for (int i = 0; i < 8; ++i) { const int k = i * 8 + kk; tile[k * 65 + nn] = src(k0 + k, n0 + nn); } }
    __syncthreads();
    { const int nn = tid >> 3, kc = tid & 7; const float* s = tile + (kc * 8) * 65 + nn;
        u32x4 o; o.x = cvt_pk_bf16(s[0], s[65]); o.y = cvt_pk_bf16(s[130], s[195]); o.z = cvt_pk_bf16(s[260], s[325]); o.w = cvt_pk_bf16(s[390], s[455]);
        *(u32x4*)(Bt + (size_t)(n0 + nn) * K + k0 + kc * 8) = o; }
    __syncthreads();
}
struct SrcUp { const float* wg; const float* wu; const float* g;
    __device__ __forceinline__ float operator()(int k, int n) const { const int col = (n >> 8) * 128 + (n & 127); const size_t bj = (size_t)((n >> 7) & 1); const float* w = (const float*)((uintptr_t)wg + ((uintptr_t)wu - (uintptr_t)wg) * bj); return w[(size_t)k * FF + col] * g[k]; } };
struct SrcPlain { const float* w; int ldw;
    __device__ __forceinline__ float operator()(int k, int n) const { return w[(size_t)k * ldw + n]; } };
struct SrcIn { const float* w; const float* g;
    __device__ __forceinline__ float operator()(int k, int n) const {
        int col;
        if (n < 1344) col = n; else if (n < 2368) col = n + 8; else if (n < 4928) col = n + 16;
        else if (n < 4936) col = n - 4928 + 1344; else if (n < 4940) col = n - 4936 + 2376; else if (n < 4944) col = n - 4940 + 2380; else col = -1;
        return col >= 0 ? w[(size_t)k * 4944 + col] * g[k] : 0.f; } };
struct SrcQK { const float* wq; const float* wk;
    __device__ __forceinline__ float operator()(int k, int n) const {
        const int isk = n >> 8, h = (n >> 6) & 3, j = n & 63, hk = k >> 7, c = k & 127;
        if (hk != h) return 0.f;
        const float* w = (const float*)((uintptr_t)wq + ((uintptr_t)wk - (uintptr_t)wq) * (size_t)isk); return w[(size_t)(h * 128 + c) * 64 + j] * (isk ? 1.f : 0.125f); } };

__device__ __forceinline__ void phase0(const Args& a, unsigned char* lds) {
    float* tile = (float*)lds;
    unsigned char* ws = a.ws;
    constexpr int T_UP = 88 * 16, T_DN = 16 * 44, T_IN = 80 * 16, T_PR = 16 * 8, T_WO = 16 * 16, T_QK = 8 * 8;
    constexpr int NITEMS = 2 * T_UP + 2 * T_DN + T_IN + 2 * T_PR + T_WO + T_QK;
    for (int it = blockIdx.x; it < NITEMS; it += gridDim.x) {
        int r = it;
        if (r < T_UP) { SrcUp s{a.in[I_F1G], a.in[I_F1U], a.in[I_F1N]}; prep_tile((bf16_t*)(ws + WS_W1), 1024, (r / 16) * 64, (r % 16) * 64, s, tile); continue; } r -= T_UP;
        if (r < T_UP) { SrcUp s{a.in[I_F2G], a.in[I_F2U], a.in[I_F2N]}; prep_tile((bf16_t*)(ws + WS_W3), 1024, (r / 16) * 64, (r % 16) * 64, s, tile); continue; } r -= T_UP;
        if (r < T_DN) { SrcPlain s{a.in[I_F1D], 1024}; prep_tile((bf16_t*)(ws + WS_W2), FF, (r / 44) * 64, (r % 44) * 64, s, tile); continue; } r -= T_DN;
        if (r < T_DN) { SrcPlain s{a.in[I_F2D], 1024}; prep_tile((bf16_t*)(ws + WS_W4), FF, (r / 44) * 64, (r % 44) * 64, s, tile); continue; } r -= T_DN;
        if (r < T_IN) { SrcIn s{a.in[I_WIN], a.in[I_MIXN]}; prep_tile((bf16_t*)(ws + WS_WIN), 1024, (r / 16) * 64, (r % 16) * 64, s, tile); continue; } r -= T_IN;
        if (r < T_PR) { SrcPlain s{a.in[I_WPA], 1024}; prep_tile((bf16_t*)(ws + WS_WA), 512, (r / 8) * 64, (r % 8) * 64, s, tile); continue; } r -= T_PR;
        if (r < T_PR) { SrcPlain s{a.in[I_WPB], 1024}; prep_tile((bf16_t*)(ws + WS_WB), 512, (r / 8) * 64, (r % 8) * 64, s, tile); continue; } r -= T_PR;
        if (r < T_WO) { SrcPlain s{a.in[I_WOUT], 1024}; prep_tile((bf16_t*)(ws + WS_WO), 1024, (r / 16) * 64, (r % 16) * 64, s, tile); continue; } r -= T_WO;
        { SrcQK s{a.in[I_WMQ], a.in[I_WMK]}; prep_tile((bf16_t*)(ws + WS_WQK), 512, (r / 8) * 64, (r % 8) * 64, s, tile); }
    }
    const int lane = threadIdx.x & 63, gw = blockIdx.x * 8 + (threadIdx.x >> 6), NGW = gridDim.x * 8;
    const float* x = a.in[I_X]; bf16_t* XB = (bf16_t*)(ws + WS_XB);
    float* ss0 = (float*)(ws + WS_SS0); float* ss1 = (float*)(ws + WS_SS1); float* ss2 = (float*)(ws + WS_SS2);
    for (int row = gw; row < MROWS; row += NGW) {
        const f32x4* xr = (const f32x4*)(x + (size_t)row * DM) + lane;
        f32x4 v[4]; float s = 0.f;
#pragma unroll
        for (int j = 0; j < 4; ++j) { v[j] = xr[64 * j]; s += v[j][0] * v[j][0] + v[j][1] * v[j][1] + v[j][2] * v[j][2] + v[j][3] * v[j][3]; }
        s = wave_sum(s);
        if (lane == 0) { ss0[row] = s; ss1[row] = 0.f; ss2[row] = 0.f; }
        unsigned long long* o8 = (unsigned long long*)(XB + (size_t)row * DM) + lane;
#pragma unroll
        for (int j = 0; j < 4; ++j) o8[64 * j] = (unsigned long long)cvt_pk_bf16(v[j][0], v[j][1]) | ((unsigned long long)cvt_pk_bf16(v[j][2], v[j][3]) << 32);
    }
}

__device__ __forceinline__ void phase_postp(const Args& a) {
    unsigned char* ws = a.ws;
    bf16_t* P = (bf16_t*)(ws + WS_P); bf16_t* XC = (bf16_t*)(ws + WS_XB); bf16_t* IKC = (bf16_t*)(ws + WS_IKC); bf16_t* KVC = (bf16_t*)(ws + WS_KVC);
    const int lane = threadIdx.x & 63, gw = blockIdx.x * 8 + (threadIdx.x >> 6), NGW = gridDim.x * 8;
    const int c0 = lane * 8;
    float cw[4][8], cb[8], gq[8], gk[8];
#pragma unroll
    for (int e = 0; e < 8; ++e) {
        cb[e] = a.in[I_CB][c0 + e];
#pragma unroll
        for (int j = 0; j < 4; ++j) cw[j][e] = a.in[I_CW][j * 512 + c0 + e];
        gq[e] = a.in[I_QN][(lane & 7) * 8 + e];
        gk[e] = (lane < 16) ? a.in[I_KN][(lane & 7) * 8 + e] : a.in[I_IKN][(lane & 7) * 8 + e];
    }
    const int koff = (lane < 16) ? (C_AK + lane * 8) : (C_IK + (lane & 7) * 8);
    const int voff = C_AV + ((lane - 32) & 15) * 8;
    u32x4 nmx[4], naq, nkk, nav;
#define PP_LOAD(ROW) do { const int t_ = (ROW) & (SEQ - 1); const bf16_t* pr_ = P + (size_t)(ROW) * LDP; \
        _Pragma("unroll") for (int j = 0; j < 4; ++j) { if (t_ - 3 + j >= 0) nmx[j] = *(const u32x4*)(P + (size_t)((ROW) - 3 + j) * LDP + C_MX + c0); else nmx[j] = (u32x4){0u, 0u, 0u, 0u}; } \
        naq = *(const u32x4*)(pr_ + C_AQ + c0); nkk = *(const u32x4*)(pr_ + koff); nav = *(const u32x4*)(pr_ + voff); } while (0)
    if (gw < MROWS) PP_LOAD(gw);
    for (int row = gw; row < MROWS; row += NGW) {
        bf16_t* pr = P + (size_t)row * LDP;
        u32x4 cmx[4];
#pragma unroll
        for (int j = 0; j < 4; ++j) cmx[j] = nmx[j];
        const u32x4 caq = naq, ckk = nkk, cav = nav;
        if (row + NGW < MROWS) PP_LOAD(row + NGW);
        float accv[8];
#pragma unroll
        for (int e = 0; e < 8; ++e) accv[e] = cb[e];
#pragma unroll
        for (int j = 0; j < 4; ++j) { float xf[8]; unpack8(cmx[j], xf);
#pragma unroll
            for (int e = 0; e < 8; ++e) accv[e] += xf[e] * cw[j][e]; }
#pragma unroll
        for (int e = 0; e < 8; ++e) accv[e] = accv[e] * sigmoidf_(accv[e]);
        *(u32x4*)(XC + (size_t)row * 512 + c0) = pack8(accv);
        { float f[8]; unpack8(caq, f); float s = 0.f;
#pragma unroll
            for (int e = 0; e < 8; ++e) s += f[e] * f[e];
            s += __shfl_xor(s, 1); s += __shfl_xor(s, 2); s += __shfl_xor(s, 4);
            const float rs = rsqrtf(s * (1.f / 64.f) + EPS);
#pragma unroll
            for (int e = 0; e < 8; ++e) f[e] = f[e] * rs * gq[e];
            *(u32x4*)(pr + C_AQ + c0) = pack8(f); }
        { float f[8]; unpack8(ckk, f); float s = 0.f;
#pragma unroll
            for (int e = 0; e < 8; ++e) s += f[e] * f[e];
            s += __shfl_xor(s, 1); s += __shfl_xor(s, 2); s += __shfl_xor(s, 4);
            const float rs = rsqrtf(s * (1.f / 64.f) + EPS);
#pragma unroll
            for (int e = 0; e < 8; ++e) f[e] = f[e] * rs * gk[e];
            if (lane < 16) *(u32x4*)(KVC + (size_t)row * 256 + lane * 8) = pack8(f);
            else if (lane < 24) *(u32x4*)(IKC + ((((size_t)(row >> 4)) * 8 + (lane - 16)) * 16 + (row & 15)) * 8) = pack8(f);
            else if (lane >= 32 && lane < 48) *(u32x4*)(KVC + (size_t)row * 256 + 128 + (lane - 32) * 8) = cav; }
    }
#undef PP_LOAD
}

__device__ __forceinline__ unsigned fkey(float s) { const unsigned u = __float_as_uint(s); return (u & 0x80000000u) ? ~u : (u | 0x80000000u); }


__device__ __forceinline__ unsigned wave_incl_scan_dpp(unsigned x) {
    x += (unsigned)__builtin_amdgcn_update_dpp(0, (int)x, 0x111, 0xf, 0xf, false);
    x += (unsigned)__builtin_amdgcn_update_dpp(0, (int)x, 0x112, 0xf, 0xf, false);
    x += (unsigned)__builtin_amdgcn_update_dpp(0, (int)x, 0x114, 0xf, 0xf, false);
    x += (unsigned)__builtin_amdgcn_update_dpp(0, (int)x, 0x118, 0xf, 0xf, false);
    x += (unsigned)__builtin_amdgcn_update_dpp(0, (int)x, 0x142, 0xa, 0xf, false);
    x += (unsigned)__builtin_amdgcn_update_dpp(0, (int)x, 0x143, 0xc, 0xf, false);
    return x;
}
__device__ __forceinline__ int find_bin(const unsigned* hist, int& need, int lane, int& binc) {
    const int base = 1023 - 16 * lane; unsigned s = 0;
#pragma unroll
    for (int i = 0; i < 16; ++i) { const unsigned w = hist[base - ((i + lane) & 15)]; s += (w & 0xffffu) + (w >> 16); }
    const unsigned p = wave_incl_scan_dpp(s);
    const unsigned long long bal = __ballot(p >= (unsigned)need);
    const int L = bal ? (__ffsll((long long)bal) - 1) : 63;
    const unsigned excl = __shfl(p - s, L);
    int cum = (int)excl, bin = -1, fneed = 1, bc = 1; const int b0 = 1023 - 16 * L;
#pragma unroll
    for (int i = 0; i < 16; ++i) {
        const unsigned w = hist[b0 - i]; const int hi = (int)(w >> 16), lo = (int)(w & 0xffffu);
        if (bin < 0) { if (cum + hi >= need) { bin = 2 * (b0 - i) + 1; fneed = need - cum; bc = hi; } else cum += hi; }
        if (bin < 0) { if (cum + lo >= need) { bin = 2 * (b0 - i); fneed = need - cum; bc = lo; } else cum += lo; }
    }
    if (bin < 0) bin = 0;
    need = fneed; binc = bc; return bin;
}


__device__ __forceinline__ int find_bin128(const unsigned* sh, int& need, int lane, int& binc) {
    const unsigned hi = sh[127 - 2 * lane], lo = sh[126 - 2 * lane]; const unsigned s = hi + lo;
    const unsigned p = wave_incl_scan_dpp(s);
    const unsigned long long bal = __ballot(p >= (unsigned)need);
    const int L = bal ? (__ffsll((long long)bal) - 1) : 63;
    const int excl = (int)__shfl(p - s, L); const int hiL = (int)__shfl(hi, L), loL = (int)__shfl(lo, L);
    int bin, fneed, bc;
    if (excl + hiL >= need) { bin = 127 - 2 * L; fneed = need - excl; bc = hiL; } else { bin = 126 - 2 * L; fneed = need - excl - hiL; bc = loL; }
    if (fneed < 1) fneed = 1;
    need = fneed; binc = bc; return bin;
}

template <bool DUMMY> __device__ __forceinline__ void phase_dsa(const Args& a, unsigned char* lds) {
    unsigned char* ws = a.ws;
    bf16_t* P = (bf16_t*)(ws + WS_P); const float* SM = (const float*)(ws + WS_SM);
    const bf16_t* IKC = (const bf16_t*)(ws + WS_IKC); const bf16_t* KVC = (const bf16_t*)(ws + WS_KVC);
    constexpr int SCS = 8200;
    float* SC = (float*)lds;
    unsigned* HIST = (unsigned*)(lds + 131200);
    int* LIST = (int*)(lds + 131200 + 16384);
    unsigned* QS = (unsigned*)(lds + 131200 + 16384 + 4096);
    int* CNT = (int*)(lds + 131200 + 16384 + 4096 + 4096);
    const float idx_scale = 0.125f * 0.35355339059327373f;
    f32x4 wqv[2]; unsigned qsv[2];
#define DSA_LOAD_ITEM(ITEM) do { const int b_ = (ITEM) & 7, t0_ = ((ITEM) >> 3) * 4; const size_t r_ = (size_t)b_ * SEQ + t0_; \
        int tl_ = threadIdx.x; asm volatile("" : "+v"(tl_)); const int ln_ = tl_ & 63, q4_ = ln_ >> 4; \
        wqv[0] = *(const f32x4*)(SM + (r_ + q4_) * 16); wqv[1] = *(const f32x4*)(SM + (r_ + q4_) * 16 + 4); \
        _Pragma("unroll") for (int i_ = 0; i_ < 2; ++i_) { const int e_ = tl_ + 512 * i_; qsv[i_] = *(const unsigned*)(P + (r_ + (e_ >> 8)) * LDP + C_AQ + (e_ & 255) * 2); } } while (0)
    if ((int)blockIdx.x < 16384) DSA_LOAD_ITEM(blockIdx.x);
    for (int item = blockIdx.x; item < 16384; item += gridDim.x) {
        int tid_ = threadIdx.x; asm volatile("" : "+v"(tid_));
        const int tid = tid_, wave = __builtin_amdgcn_readfirstlane(tid >> 6), lane = tid & 63, quad = lane >> 4, l15 = lane & 15;
        const int b = item & 7, tq = item >> 3, t0 = tq * 4, L = ((t0 >> 6) + 1) * 64;
        const size_t r0 = (size_t)b * SEQ + t0;
        const bool do_sel = (L > 256) && !DBG_NOSEL;
        { u32x4* hz = (u32x4*)HIST; hz[tid] = (u32x4){0u, 0u, 0u, 0u}; hz[tid + 512] = (u32x4){0u, 0u, 0u, 0u}; }
        if (tid < 8) CNT[4 + tid] = 0;
        QS[tid] = qsv[0]; QS[tid + 512] = qsv[1];
        float wq[8];
#pragma unroll
        for (int h = 0; h < 4; ++h) { wq[h] = wqv[0][h] * idx_scale; wq[4 + h] = wqv[1][h] * idx_scale; }
        bf16x8 af[2][2];
#pragma unroll
        for (int T = 0; T < 2; ++T)
#pragma unroll
            for (int ks = 0; ks < 2; ++ks) af[T][ks] = *(const bf16x8*)(P + (r0 + (l15 >> 2)) * LDP + C_IQ + (4 * T + (l15 & 3)) * 64 + ks * 32 + quad * 8);
        const int ngroups = L >> 6;
        const bf16_t* ikb = IKC + (size_t)b * SEQ * 64 + (quad * 16 + l15) * 8;
        bf16x8 B0[4][2], B1[4][2], B2[4][2];
#define IDX_LOAD(BUF, G) do { _Pragma("unroll") for (int tt = 0; tt < 4; ++tt) _Pragma("unroll") for (int ks = 0; ks < 2; ++ks) \
                BUF[tt][ks] = *(const bf16x8*)(ikb + (size_t)(((G) * 4 + tt) * 8 + ks * 4) * 128); } while (0)
        if (wave < ngroups) IDX_LOAD(B0, wave);
        if (wave + 8 < ngroups) IDX_LOAD(B1, wave + 8);
        if (wave + 16 < ngroups) IDX_LOAD(B2, wave + 16);
        lds_fence(); __builtin_amdgcn_s_barrier();
        for (int rep = 0; rep < ((DBG_TWICE & 2) ? 2 : 1); ++rep) {
            const bool hist_on = do_sel && (rep == (((DBG_TWICE & 2) ? 2 : 1) - 1));
#define IDX_COMPUTE(BUF, G) do { _Pragma("unroll") for (int tt = 0; tt < 4; ++tt) { \
                const int key = (G) * 64 + tt * 16 + l15; \
                f32x4 c0 = (f32x4){0.f, 0.f, 0.f, 0.f}, c1 = (f32x4){0.f, 0.f, 0.f, 0.f}; \
                c0 = __builtin_amdgcn_mfma_f32_16x16x32_bf16(af[0][0], BUF[tt][0], c0, 0, 0, 0); \
                c1 = __builtin_amdgcn_mfma_f32_16x16x32_bf16(af[1][0], BUF[tt][0], c1, 0, 0, 0); \
                c0 = __builtin_amdgcn_mfma_f32_16x16x32_bf16(af[0][1], BUF[tt][1], c0, 0, 0, 0); \
                c1 = __builtin_amdgcn_mfma_f32_16x16x32_bf16(af[1][1], BUF[tt][1], c1, 0, 0, 0); \
                float sc = 0.f; \
                _Pragma("unroll") for (int j = 0; j < 4; ++j) { sc += wq[j] * relu_(c0[j]); sc += wq[4 + j] * relu_(c1[j]); } \
                sc += 0.f; \
                SC[quad * SCS + key] = sc; \
                if (hist_on) { const unsigned bin = fkey(sc) >> 21; atomicAdd(&HIST[quad * 1024 + (bin >> 1)], (bin & 1u) ? 0x10000u : 1u); } } } while (0)
            int g = wave;
            for (; g < ngroups; g += 24) {
                IDX_COMPUTE(B0, g);
                if (g + 24 < ngroups) IDX_LOAD(B0, g + 24);
                if (g + 8 < ngroups) { IDX_COMPUTE(B1, g + 8); if (g + 32 < ngroups) IDX_LOAD(B1, g + 32); }
                if (g + 16 < ngroups) { IDX_COMPUTE(B2, g + 16); if (g + 40 < ngroups) IDX_LOAD(B2, g + 40); }
            }
#undef IDX_LOAD
#undef IDX_COMPUTE
        }
        lds_fence(); __builtin_amdgcn_s_barrier();
        if (item + (int)gridDim.x < 16384) DSA_LOAD_ITEM(item + (int)gridDim.x);
        {
            constexpr int CAP = 448;
            const unsigned long long ltmask = (1ull << lane) - 1ull;
            if (!do_sel) {
                const int q = wave >> 1, hf = wave & 1; int* list = LIST + q * 256;
                if (hf == 0) { for (int i = lane; i < 256; i += 64) list[i] = (i < L) ? i : 0; if (lane == 0) CNT[q] = L; }
            } else {
                {
                    const int q = wave >> 1, hf = wave & 1; int* list = LIST + q * 256; const float* sc = SC + q * SCS; unsigned* hist = HIST + q * 1024;
                    const int halfL = L >> 1, beg = hf * halfL, end = beg + halfL;
                    int need = 256, binc = 0;
                    const unsigned b1 = (unsigned)find_bin(hist, need, lane, binc);
                    const int c1 = binc, nsure = 256 - need; const bool store_c = c1 <= CAP;
                    if (hf == 0 && lane == 0) { CNT[12 + q] = (int)b1; CNT[16 + q] = need; CNT[8 + q] = c1; }
                    lds_fence(); __builtin_amdgcn_s_barrier();
                    int cs = 0, cc = 0;
                    for (int i0 = beg + lane * 4; i0 < end; i0 += 256) { const f32x4 v = *(const f32x4*)(sc + i0);
#pragma unroll
                        for (int e = 0; e < 4; ++e) { const unsigned k = fkey(v[e]); const unsigned kb = k >> 21;
                            const bool sure = kb > b1, cand = (kb == b1) && store_c;
                            const unsigned long long ms = __ballot(sure), mc = __ballot(cand);
                            if (ms) { const int p = cs + __popcll(ms & ltmask); const int pp = hf ? nsure - 1 - p : p; if (sure && pp >= 0 && pp < 256) list[pp] = i0 + e; cs += __popcll(ms); }
                            if (mc) { const int p = cc + __popcll(mc & ltmask); const int pp = hf ? c1 - 1 - p : p; if (cand && pp >= 0 && pp < CAP) { hist[2 * pp] = k; hist[2 * pp + 1] = (unsigned)(i0 + e); } cc += __popcll(mc); } } }
                    lds_fence(); __builtin_amdgcn_s_barrier();
                }
                if (wave < 4) {
                    const int q = wave; int* list = LIST + q * 256; unsigned* hist = HIST + q * 1024; unsigned* sh = hist + 896; const float* sc = SC + q * SCS;
                    const unsigned b1 = (unsigned)CNT[12 + q]; int need = CNT[16 + q]; const int c = CNT[8 + q]; const int nsure = 256 - need;
                    if (c <= CAP) {
                        unsigned ck[7]; int ci[7];
#pragma unroll
                        for (int t = 0; t < 7; ++t) { const int i = lane + 64 * t; const bool valid = i < c; ck[t] = valid ? hist[2 * i] : 0u; ci[t] = valid ? (int)hist[2 * i + 1] : -1; }
                        int binc = 0;
                        sh[2 * lane] = 0u; sh[2 * lane + 1] = 0u; lds_order();
#pragma unroll
                        for (int t = 0; t < 7; ++t) if (ci[t] >= 0) atomicAdd(&sh[(ck[t] >> 14) & 127u], 1u);
                        lds_order();
                        const unsigned bA = (unsigned)find_bin128(sh, need, lane, binc);
                        lds_order();
                        sh[2 * lane] = 0u; sh[2 * lane + 1] = 0u; lds_order();
#pragma unroll
                        for (int t = 0; t < 7; ++t) if (ci[t] >= 0 && ((ck[t] >> 14) & 127u) == bA) atomicAdd(&sh[(ck[t] >> 7) & 127u], 1u);
                        lds_order();
                        const unsigned bB = (unsigned)find_bin128(sh, need, lane, binc);
                        const unsigned preB = (bA << 7) | bB;
                        lds_order();
                        sh[2 * lane] = 0u; sh[2 * lane + 1] = 0u; lds_order();
#pragma unroll
                        for (int t = 0; t < 7; ++t) if (ci[t] >= 0 && ((ck[t] >> 7) & 0x3fffu) == preB) atomicAdd(&sh[ck[t] & 127u], 1u);
                        lds_order();
                        const unsigned bC = (unsigned)find_bin128(sh, need, lane, binc);
                        const unsigned T = (b1 << 21) | (preB << 7) | bC;
                        const int tie_total = binc, need_t = need;
                        int cnt = 0;
#pragma unroll
                        for (int t = 0; t < 7; ++t) {
                            const bool valid = ci[t] >= 0;
                            bool sel = valid && (ck[t] > T);
                            if (valid && ck[t] == T) {
                                if (tie_total == need_t) sel = true;
                                else { int rank = 0; for (int j = 0; j < c; ++j) rank += (hist[2 * j] == T && (int)hist[2 * j + 1] < ci[t]) ? 1 : 0; sel = rank < need_t; }
                            }
                            const unsigned long long m = __ballot(sel);
                            const int pos = nsure + cnt + __popcll(m & ltmask);
                            if (sel && pos < 256) list[pos] = ci[t];
                            cnt += __popcll(m);
                        }
                    } else {
                        int binc = 0;
                        lds_order();
#pragma unroll
                        for (int i = 0; i < 16; ++i) hist[lane * 16 + i] = 0u;
                        lds_order();
                        for (int i0 = 0; i0 < L; i0 += 64) { const unsigned k = fkey(sc[i0 + lane]); if ((k >> 21) == b1) { const unsigned bin = (k >> 10) & 2047u; atomicAdd(&hist[bin >> 1], (bin & 1u) ? 0x10000u : 1u); } }
                        lds_order();
                        const unsigned b2 = (unsigned)find_bin(hist, need, lane, binc);
                        const unsigned pre2 = (b1 << 11) | b2;
                        lds_order();
#pragma unroll
                        for (int i = 0; i < 16; ++i) hist[lane * 16 + i] = 0u;
                        lds_order();
                        for (int i0 = 0; i0 < L; i0 += 64) { const unsigned k = fkey(sc[i0 + lane]); if ((k >> 10) == pre2) { const unsigned bin = k & 1023u; atomicAdd(&hist[bin >> 1], (bin & 1u) ? 0x10000u : 1u); } }
                        lds_order();
                        const unsigned b3 = (unsigned)find_bin(hist, need, lane, binc);
                        const unsigned T = (pre2 << 10) | b3;
                        int count = 0, ties = 0;
                        for (int i0 = 0; i0 < L; i0 += 64) {
                            const unsigned k = fkey(sc[i0 + lane]);
                            const bool eq = (k == T);
                            const unsigned long long em = __ballot(eq);
                            const int erank = ties + __popcll(em & ltmask);
                            const bool sel = (k > T) || (eq && erank < need);
                            const unsigned long long smk = __ballot(sel);
                            const int pos = count + __popcll(smk & ltmask);
                            if (sel && pos < 256) list[pos] = i0 + lane;
                            count += __popcll(smk); ties += __popcll(em);
                        }
                        if (count > 256) count = 256;
                        for (int i = count + lane; i < 256; i += 64) list[i] = 0;
                    }
                    if (lane == 0) CNT[q] = 256;
                }
            }
        }
        lds_fence(); __builtin_amdgcn_s_barrier();
        for (int repc = 0; repc < ((DBG_TWICE & 4) ? 2 : 1); ++repc) {
            const bool dummy_c = (repc + 1) < ((DBG_TWICE & 4) ? 2 : 1);
            int lane_c = lane; asm volatile("" : "+v"(lane_c));
            const int qi = wave >> 1, g = wave & 1; const int count = CNT[qi];
            const int* list = LIST + qi * 256;
            float* PB = SC + wave * 1024;
            const unsigned* qd = QS + (qi * 8 + g * 4) * 32;
            const bf16_t* kvb = KVC + (size_t)b * SEQ * 256 + g * 64;
            const int ks = lane_c >> 3, dg = lane_c & 7, l15c = lane_c & 15, quadc = lane_c >> 4;
            const int nblk = count >> 6;
            bf16_t* KL = (bf16_t*)(lds + 32768 + wave * 9216);
            bf16x8 bq[2];
#pragma unroll
            for (int s2 = 0; s2 < 2; ++s2) {
                bf16x8 t = *(const bf16x8*)((const bf16_t*)QS + (qi * 8 + g * 4 + (l15c & 3)) * 64 + s2 * 32 + quadc * 8);
                if (l15c >= 4) t = (bf16x8){0, 0, 0, 0, 0, 0, 0, 0};
                bq[s2] = t;
            }
            const bf16_t* kb = kvb + dg * 8;
            float sreg[4][4][4];
            u32x4 kcur[8];
#pragma unroll
            for (int u = 0; u < 8; ++u) kcur[u] = *(const u32x4*)(kb + (size_t)list[u * 8 + ks] * 256);
#pragma unroll
            for (int blk = 0; blk < 4; ++blk) {
                if (blk < nblk) {
#pragma unroll
                    for (int u = 0; u < 8; ++u) *(u32x4*)(KL + (u * 8 + ks) * 72 + dg * 8) = kcur[u];
                    if (blk + 1 < nblk) {
#pragma unroll
                        for (int u = 0; u < 8; ++u) kcur[u] = *(const u32x4*)(kb + (size_t)list[(blk + 1) * 64 + u * 8 + ks] * 256);
                    }
                    lds_order();
#pragma unroll
                    for (int kt = 0; kt < 4; ++kt) {
                        f32x4 acc = (f32x4){0.f, 0.f, 0.f, 0.f};
#pragma unroll
                        for (int s2 = 0; s2 < 2; ++s2) acc = __builtin_amdgcn_mfma_f32_16x16x32_bf16(*(const bf16x8*)(KL + (kt * 16 + l15c) * 72 + s2 * 32 + quadc * 8), bq[s2], acc, 0, 0, 0);
#pragma unroll
                        for (int j = 0; j < 4; ++j) sreg[blk][kt][j] = acc[j] * 0.125f;
                    }
                    lds_order();
                } else {
#pragma unroll
                    for (int kt = 0; kt < 4; ++kt)
#pragma unroll
                        for (int j = 0; j < 4; ++j) sreg[blk][kt][j] = -INFINITY;
                }
            }
            const bf16_t* vb = kvb + 128 + dg * 8;
            u32x4 vreg[8];
#pragma unroll
            for (int u = 0; u < 8; ++u) vreg[u] = *(const u32x4*)(vb + (size_t)list[u * 8 + ks] * 256);
            float mx = -INFINITY;
#pragma unroll
            for (int blk = 0; blk < 4; ++blk)
#pragma unroll
                for (int kt = 0; kt < 4; ++kt)
#pragma unroll
                    for (int j = 0; j < 4; ++j) mx = fmaxf(mx, sreg[blk][kt][j]);
            mx = fmaxf(mx, __shfl_xor(mx, 16)); mx = fmaxf(mx, __shfl_xor(mx, 32));
            float sum = 0.f;
#pragma unroll
            for (int blk = 0; blk < 4; ++blk)
#pragma unroll
                for (int kt = 0; kt < 4; ++kt)
#pragma unroll
                    for (int j = 0; j < 4; ++j) { const float e = __expf(sreg[blk][kt][j] - mx); sreg[blk][kt][j] = e; sum += e; }
            sum += __shfl_xor(sum, 16); sum += __shfl_xor(sum, 32);
            const float invs = 1.f / sum;
            f32x4 oacc[4];
#pragma unroll
            for (int dt = 0; dt < 4; ++dt) oacc[dt] = (f32x4){0.f, 0.f, 0.f, 0.f};
            bf16_t* VT = KL;
#pragma unroll
            for (int blk = 0; blk < 4; ++blk) {
                if (blk < nblk) {
#pragma unroll
                    for (int u = 0; u < 8; ++u) {
                        const int rho = ((u >> 2) << 5) + ((((2 * u) & 3) + (ks >> 2)) << 3) + (((u >> 1) & 1) << 2) + (ks & 3);
                        *(u32x4*)(VT + rho * 72 + dg * 8) = vreg[u];
                    }
                    if (blk + 1 < nblk) {
#pragma unroll
                        for (int u = 0; u < 8; ++u) vreg[u] = *(const u32x4*)(vb + (size_t)list[(blk + 1) * 64 + u * 8 + ks] * 256);
                    }
                    lds_order();
#pragma unroll
                    for (int s2 = 0; s2 < 2; ++s2) {
                        u32x4 pw;
                        pw[0] = cvt_pk_bf16(sreg[blk][2 * s2][0], sreg[blk][2 * s2][1]); pw[1] = cvt_pk_bf16(sreg[blk][2 * s2][2], sreg[blk][2 * s2][3]);
                        pw[2] = cvt_pk_bf16(sreg[blk][2 * s2 + 1][0], sreg[blk][2 * s2 + 1][1]); pw[3] = cvt_pk_bf16(sreg[blk][2 * s2 + 1][2], sreg[blk][2 * s2 + 1][3]);
                        const bf16x8 pf = __builtin_bit_cast(bf16x8, pw);
#pragma unroll
                        for (int dt = 0; dt < 4; ++dt) {
                            const LAS unsigned char* vp = (const LAS unsigned char*)VT + ((32 * s2 + 8 * quadc + (l15c >> 2)) * 72) * 2 + dt * 32 + (l15c & 3) * 8;
                            const v4i16_t t0 = __builtin_amdgcn_ds_read_tr16_b64_v4i16((LAS v4i16_t*)vp);
                            const v4i16_t t1 = __builtin_amdgcn_ds_read_tr16_b64_v4i16((LAS v4i16_t*)(vp + 4 * 72 * 2));
                            const bf16x8 af2 = (bf16x8){t0[0], t0[1], t0[2], t0[3], t1[0], t1[1], t1[2], t1[3]};
                            oacc[dt] = __builtin_amdgcn_mfma_f32_16x16x32_bf16(af2, pf, oacc[dt], 0, 0, 0);
                        }
                    }
                    lds_order();
                }
            }
            if (l15c < 4) {
                bf16_t* yo = (DUMMY || dummy_c) ? ((bf16_t*)(ws + WS_MG + 48 * MiB) + (r0 + qi) * 512 + (g * 4 + l15c) * 64 + quadc * 4) : (P + (r0 + qi) * LDP + C_AQ + (g * 4 + l15c) * 64 + quadc * 4);
#pragma unroll
                for (int dt = 0; dt < 4; ++dt) {
                    const f32x4 v = oacc[dt] * invs;
                    u32x2 w; w[0] = cvt_pk_bf16(v[0], v[1]); w[1] = cvt_pk_bf16(v[2], v[3]);
                    *(u32x2*)(yo + dt * 16) = w;
                }
            }
        }
        lds_fence(); __builtin_amdgcn_s_barrier();
    }
#undef DSA_LOAD_ITEM
}

__device__ __forceinline__ float logsigmoidf_(float x) { return fminf(x, 0.f) - log1pf(__expf(-fabsf(x))); }
__device__ __forceinline__ float wave_incl_sum(float v, int lane) {
#pragma unroll
    for (int o = 1; o < 64; o <<= 1) { const float t = __shfl_up(v, o); if (lane >= o) v += t; }
    return v;
}
__device__ __forceinline__ float wave_incl_max(float v, int lane) {
#pragma unroll
    for (int o = 1; o < 64; o <<= 1) { const float t = __shfl_up(v, o); if (lane >= o) v = fmaxf(v, t); }
    return v;
}
__device__ __forceinline__ f32x4 mma_lds(const bf16_t* A, int lda, const bf16_t* Bt, int ldb, int K, int lane) {
    f32x4 acc = (f32x4){0.f, 0.f, 0.f, 0.f};
    const bf16_t* ap = A + (lane & 15) * lda + (lane >> 4) * 8; const bf16_t* bp = Bt + (lane & 15) * ldb + (lane >> 4) * 8;
    for (int k = 0; k < K; k += 32) acc = __builtin_amdgcn_mfma_f32_16x16x32_bf16(*(const bf16x8*)(ap + k), *(const bf16x8*)(bp + k), acc, 0, 0, 0);
    return acc;
}

__device__ __forceinline__ void phase_mlstm_a(const Args& a, unsigned char* lds) {
    unsigned char* ws = a.ws;
    const bf16_t* P = (const bf16_t*)(ws + WS_P); const bf16_t* QK = (const bf16_t*)(ws + WS_QK); const float* SM = (const float*)(ws + WS_SM);
    float* ST = (float*)(ws + WS_XB); float* DN = (float*)(ws + WS_DN); float* ML = (float*)(ws + WS_ML); float* BL = (float*)(ws + WS_BL);
    bf16_t* VT = (bf16_t*)lds;
    bf16_t* KT = (bf16_t*)(lds + 18432);
    float* WS_ = (float*)(lds + 18432 + 9216);
    const int tid = threadIdx.x, wave = tid >> 6, lane = tid & 63;
    for (int item = blockIdx.x; item < 4096; item += gridDim.x) {
        const int c = item & 127, h = (item >> 7) & 3, b = item >> 9;
        const size_t r0 = (size_t)b * SEQ + c * 64;
        if (wave == 0) {
            const float ig = SM[(r0 + lane) * 16 + 8 + h] + a.in[I_BI][h];
            const float lf = logsigmoidf_(SM[(r0 + lane) * 16 + 12 + h] + a.in[I_BF][h]);
            const float bs = wave_incl_sum(lf, lane);
            const float bl = __shfl(bs, 63);
            const float wk = bl - bs + ig;
            const float ml = wave_max(wk);
            WS_[lane] = __expf(wk - ml);
            if (lane == 0) { ML[item] = ml; BL[item] = bl; }
        }
        for (int i = tid; i < 1024; i += 512) { const int s = i >> 4, d0 = (i & 15) * 8; float f[8]; unpack8(*(const u32x4*)(P + (r0 + s) * LDP + C_MV + h * 128 + d0), f);
#pragma unroll
            for (int e = 0; e < 8; ++e) VT[(d0 + e) * 72 + s] = f2bf(f[e]); }
        __syncthreads();
        { const int s = tid >> 3, d0 = (tid & 7) * 8; float f[8]; unpack8(*(const u32x4*)(QK + (r0 + s) * 512 + 256 + h * 64 + d0), f); const float w = WS_[s];
#pragma unroll
            for (int e = 0; e < 8; ++e) KT[(d0 + e) * 72 + s] = f2bf(f[e] * w); }
        __syncthreads();
        float* st = ST + (size_t)item * 8192;
#pragma unroll
        for (int nt = 0; nt < 4; ++nt) {
            const f32x4 acc = mma_lds(VT + wave * 16 * 72, 72, KT + nt * 16 * 72, 72, 64, lane);
#pragma unroll
            for (int j = 0; j < 4; ++j) st[(wave * 16 + (lane >> 4) * 4 + j) * 64 + nt * 16 + (lane & 15)] = acc[j];
        }
        if (tid < 64) { float s = 0.f; for (int k = 0; k < 64; ++k) s += bf1(KT[tid * 72 + k]); DN[item * 64 + tid] = s; }
        __syncthreads();
    }
}
__device__ __forceinline__ void phase_mlstm_b(const Args& a) {
    unsigned char* ws = a.ws;
    float* ST = (float*)(ws + WS_XB); float* DN = (float*)(ws + WS_DN); const float* ML = (const float*)(ws + WS_ML); const float* BL = (const float*)(ws + WS_BL); float* MS = (float*)(ws + WS_MS);
    const int total = 32 * 8256;
    for (int w = blockIdx.x * 512 + threadIdx.x; w < total; w += gridDim.x * 512) {
        const int bh = w / 8256, e = w % 8256;
        float* p; int stride;
        if (e < 8192) { p = ST + (size_t)bh * 128 * 8192 + e; stride = 8192; } else { p = DN + (size_t)bh * 128 * 64 + (e - 8192); stride = 64; }
        float C = 0.f, m = 0.f;
        for (int c0 = 0; c0 < 128; c0 += 8) {
            float d[8], bl[8], ml[8];
#pragma unroll
            for (int u = 0; u < 8; ++u) { d[u] = p[(size_t)(c0 + u) * stride]; bl[u] = BL[bh * 128 + c0 + u]; ml[u] = ML[bh * 128 + c0 + u]; }
#pragma unroll
            for (int u = 0; u < 8; ++u) {
                p[(size_t)(c0 + u) * stride] = C;
                if (e == 0) MS[bh * 128 + c0 + u] = m;
                const float mn = fmaxf(bl[u] + m, ml[u]);
                C = __expf(bl[u] + m - mn) * C + __expf(ml[u] - mn) * d[u];
                m = mn;
            }
        }
    }
}
__device__ __forceinline__ void phase_mlstm_c(const Args& a, unsigned char* lds) {
    unsigned char* ws = a.ws;
    bf16_t* P = (bf16_t*)(ws + WS_P); const bf16_t* QK = (const bf16_t*)(ws + WS_QK); const float* SM = (const float*)(ws + WS_SM);
    const float* ST = (const float*)(ws + WS_XB); const float* DN = (const float*)(ws + WS_DN); const float* MS = (const float*)(ws + WS_MS);
    bf16_t* QS_ = (bf16_t*)lds;
    bf16_t* KS = (bf16_t*)(lds + 9216);
    bf16_t* AP = (bf16_t*)(lds + 18432);
    bf16_t* BT = (bf16_t*)(lds + 18432 + 17408);
    float* OUT = (float*)(lds + 18432 + 17408 + 34816);
    float* GS = (float*)(lds + 18432 + 17408 + 34816 + 33792);
    float* bS = GS; float* aS = GS + 64; float* mtS = GS + 128; float* wiS = GS + 192; float* nS = GS + 256; float* denS = GS + 320;
    const int tid = threadIdx.x, wave = tid >> 6, lane = tid & 63;
    for (int item = blockIdx.x; item < 4096; item += gridDim.x) {
        const int c = item & 127, h = (item >> 7) & 3, b = item >> 9;
        const size_t r0 = (size_t)b * SEQ + c * 64;
        if (wave == 0) {
            const float ig = SM[(r0 + lane) * 16 + 8 + h] + a.in[I_BI][h];
            const float lf = logsigmoidf_(SM[(r0 + lane) * 16 + 12 + h] + a.in[I_BF][h]);
            const float bs = wave_incl_sum(lf, lane);
            const float av = ig - bs;
            const float pm = wave_incl_max(av, lane);
            const float m0 = MS[item];
            const float mt = bs + fmaxf(pm, m0);
            bS[lane] = bs; aS[lane] = av; mtS[lane] = mt; wiS[lane] = __expf(bs + m0 - mt);
            nS[lane] = DN[item * 64 + lane];
        }
        { const int s = tid >> 3, d0 = (tid & 7) * 8;
            *(u32x4*)(QS_ + s * 72 + d0) = *(const u32x4*)(QK + (r0 + s) * 512 + h * 64 + d0);
            *(u32x4*)(KS + s * 72 + d0) = *(const u32x4*)(QK + (r0 + s) * 512 + 256 + h * 64 + d0); }
        for (int i = tid; i < 1024; i += 512) { const int s = i >> 4, d0 = (i & 15) * 8; float f[8]; unpack8(*(const u32x4*)(P + (r0 + s) * LDP + C_MV + h * 128 + d0), f);
#pragma unroll
            for (int e = 0; e < 8; ++e) BT[(d0 + e) * 136 + s] = f2bf(f[e]); }
        { const float* st = ST + (size_t)item * 8192;
            for (int i = tid; i < 2048; i += 512) { const int dv = i >> 4, k0 = (i & 15) * 4; const f32x4 v = *(const f32x4*)(st + dv * 64 + k0);
                *(unsigned*)(BT + dv * 136 + 64 + k0) = cvt_pk_bf16(v[0], v[1]); *(unsigned*)(BT + dv * 136 + 64 + k0 + 2) = cvt_pk_bf16(v[2], v[3]); } }
        __syncthreads();
#pragma unroll
        for (int u = 0; u < 2; ++u) {
            const int id = wave * 2 + u, tr = id >> 2, tc = id & 3;
            f32x4 acc = (f32x4){0.f, 0.f, 0.f, 0.f};
            if (tc <= tr) acc = mma_lds(QS_ + tr * 16 * 72, 72, KS + tc * 16 * 72, 72, 64, lane);
            const int s = tc * 16 + (lane & 15);
#pragma unroll
            for (int j = 0; j < 4; ++j) { const int t = tr * 16 + (lane >> 4) * 4 + j;
                const float w = (s <= t) ? acc[j] * __expf(bS[t] + aS[s] - mtS[t]) : 0.f;
                AP[t * 136 + s] = f2bf(w); }
        }
        { const int t = tid >> 3, d0 = (tid & 7) * 8; float f[8]; unpack8(*(const u32x4*)(QS_ + t * 72 + d0), f); const float w = wiS[t];
#pragma unroll
            for (int e = 0; e < 8; ++e) f[e] *= w;
            *(u32x4*)(AP + t * 136 + 64 + d0) = pack8(f); }
        __syncthreads();
#pragma unroll
        for (int tr = 0; tr < 4; ++tr) {
            const f32x4 acc = mma_lds(AP + tr * 16 * 136, 136, BT + wave * 16 * 136, 136, 128, lane);
#pragma unroll
            for (int j = 0; j < 4; ++j) OUT[(tr * 16 + (lane >> 4) * 4 + j) * 132 + wave * 16 + (lane & 15)] = acc[j];
        }
        { const int t = tid >> 3, part = tid & 7; float s = 0.f;
#pragma unroll
            for (int e = 0; e < 16; ++e) { const int k = part * 16 + e; const float v = bf1(AP[t * 136 + k]); s += (k < 64) ? v : v * nS[k - 64]; }
            s += __shfl_xor(s, 1); s += __shfl_xor(s, 2); s += __shfl_xor(s, 4);
            if (part == 0) denS[t] = s; }
        __syncthreads();
        { const int t = tid >> 3, part = tid & 7, dv0 = part * 16;
            const float den = fmaxf(fabsf(denS[t]), __expf(-mtS[t])); const float inv = 1.f / den;
            float hv[16]; float sq = 0.f;
#pragma unroll
            for (int e = 0; e < 16; ++e) { hv[e] = OUT[t * 132 + dv0 + e] * inv; sq += hv[e] * hv[e]; }
            sq += __shfl_xor(sq, 1); sq += __shfl_xor(sq, 2); sq += __shfl_xor(sq, 4);
            const float rs = rsqrtf(sq * (1.f / 128.f) + EPS);
            bf16_t* po = P + (r0 + t) * LDP + C_MO + h * 128 + dv0;
            float og[16]; unpack8(*(const u32x4*)po, og); unpack8(*(const u32x4*)(po + 8), og + 8);
#pragma unroll
            for (int e = 0; e < 16; ++e) hv[e] = hv[e] * rs * a.in[I_MHN][h * 128 + dv0 + e] * sigmoidf_(og[e]);
            *(u32x4*)po = pack8(hv); *(u32x4*)(po + 8) = pack8(hv + 8); }
        __syncthreads();
    }
}


#define XB_TMO      128
#define XB_XCNT(j)  (256  + 64 * (j))
#define XB_XSUB(j)  (1280 + 64 * (j))
#define XB_XGEN(j)  (2304 + 64 * (j))
#define XB_TOP      3328
#define XB_TOPGEN   3392
#define XCD_BAR_WORDS 3456
#define XB_SPIN_CAP (1u << 22)
__device__ __forceinline__ unsigned xb_ld(unsigned* p)              { return __hip_atomic_load(p, __ATOMIC_RELAXED, __HIP_MEMORY_SCOPE_AGENT); }
__device__ __forceinline__ unsigned xb_add(unsigned* p, unsigned v) { return __hip_atomic_fetch_add(p, v, __ATOMIC_RELAXED, __HIP_MEMORY_SCOPE_AGENT); }
__device__ __forceinline__ unsigned xb_xcc_id() { return (unsigned)__builtin_amdgcn_s_getreg((3 << 11) | 20) & 0xFu; }
#define XB_SPIN(cond, bar) do { unsigned _sp = 0; while (cond) { __builtin_amdgcn_s_sleep(1); \
    if ((++_sp & 255u) == 0u) { if (xb_ld(&(bar)[XB_TMO])) break; if (_sp > XB_SPIN_CAP) { atomicAdd(&(bar)[XB_TMO], 1u); break; } } } } while (0)
struct XcdBarrier { unsigned* bar; unsigned x; volatile LAS unsigned* st; };
__device__ __forceinline__ XcdBarrier xcd_barrier_post(unsigned* bar, volatile LAS unsigned* st) {
    XcdBarrier b; b.bar = bar; b.x = xb_xcc_id(); b.st = st;
    if (threadIdx.x == 0) (void)xb_add(&bar[XB_XCNT(b.x)], 1u);
    return b;
}
__device__ __forceinline__ void xcd_barrier_complete(unsigned* bar, unsigned x, unsigned& nloc, unsigned& nx) {
    const unsigned G = gridDim.x * gridDim.y * gridDim.z;
    unsigned sum, cnt, mine, sp = 0u;
    for (;;) {
        sum = 0u; cnt = 0u; mine = 0u;
#pragma unroll
        for (unsigned j = 0; j < 16; ++j) { const unsigned c = xb_ld(&bar[XB_XCNT(j)]); sum += c; cnt += (c > 0u) ? 1u : 0u; mine = (j == x) ? c : mine; }
        if (sum == G) break;
        __builtin_amdgcn_s_sleep(1);
        if ((++sp & 255u) == 0u) { if (xb_ld(&bar[XB_TMO])) break; if (sp > XB_SPIN_CAP) { atomicAdd(&bar[XB_TMO], 1u); break; } }
    }
    nloc = mine > 0u ? mine : 1u; nx = cnt > 0u ? cnt : 1u;
}
__device__ __forceinline__ void xcd_barrier(const XcdBarrier& b) {
    asm volatile("s_waitcnt vmcnt(0)" ::: "memory");
    __syncthreads();
    if (threadIdx.x == 0) {
        unsigned* bar = b.bar;
        __builtin_amdgcn_s_waitcnt(0);
        unsigned nloc = b.st[0], nx = b.st[1];
        if (nloc == 0u) { xcd_barrier_complete(bar, b.x, nloc, nx); b.st[0] = nloc; b.st[1] = nx; }
        const unsigned old = xb_add(&bar[XB_XSUB(b.x)], 1u);
        const unsigned gen = old / nloc;
        if (old + 1u == (gen + 1u) * nloc) {
            __builtin_amdgcn_fence(__ATOMIC_RELEASE, "agent");
            asm volatile("s_waitcnt vmcnt(0)" ::: "memory");
            const unsigned og = xb_add(&bar[XB_TOP], 1u);
            const unsigned tg = og / nx;
            if (og + 1u == (tg + 1u) * nx) xb_add(&bar[XB_TOPGEN], 1u);
            else XB_SPIN(xb_ld(&bar[XB_TOPGEN]) == tg, bar);
            __builtin_amdgcn_fence(__ATOMIC_ACQUIRE, "agent");
            xb_add(&bar[XB_XGEN(b.x)], 1u);
            asm volatile("s_waitcnt vmcnt(0)" ::: "memory");
        } else {
            XB_SPIN(xb_ld(&bar[XB_XGEN(b.x)]) == gen, bar);
            __builtin_amdgcn_fence(__ATOMIC_ACQUIRE, "agent");
            asm volatile("s_waitcnt vmcnt(0)" ::: "memory");
        }
    }
    __syncthreads();
}

#ifndef DBG_ZERO_YA
#define DBG_ZERO_YA 1
#endif
#ifndef PH
#define PH 0xFFFF
#endif
__global__ void __launch_bounds__(512, 2) mega_fwd(Args a) {
    extern __shared__ __attribute__((aligned(16))) unsigned char lds[];
    cg::grid_group grid = cg::this_grid();
    LAS unsigned char* ldsl = (LAS unsigned char*)lds;
    unsigned char* ws = a.ws;
    const int G = gridDim.x, bid = blockIdx.x;
    bf16_t* XB = (bf16_t*)(ws + WS_XB); bf16_t* Pb = (bf16_t*)(ws + WS_P); bf16_t* MG = (bf16_t*)(ws + WS_MG); bf16_t* QKb = (bf16_t*)(ws + WS_QK);
    float* ss0 = (float*)(ws + WS_SS0); float* ss1 = (float*)(ws + WS_SS1); float* ss2 = (float*)(ws + WS_SS2);

    unsigned* barw = (unsigned*)(ws + WS_BAR);
    if (bid == 0) { for (int i = threadIdx.x; i < XCD_BAR_WORDS; i += 512) barw[i] = 0u; }
    volatile LAS unsigned* bst = (volatile LAS unsigned*)(ldsl + LDS_BYTES - 16);
    if (threadIdx.x == 0) { bst[0] = 0u; bst[1] = 0u; }
    if (PH & 1) phase0(a, lds);
    __threadfence();
    grid.sync();
    const XcdBarrier xbar = xcd_barrier_post(barw, bst);
    if (PH & 2) {
        pg8::Gemm g{XB, (const bf16_t*)(ws + WS_W1), DM, DM, MROWS, 2 * FF, DM}; pg8::StaticOrder S; S.init(MROWS, 2 * FF, G, bid);
        pg8::EpiSwiGLU E{Pb, ss0}; pg8::gemm_phase(ldsl, g, S, E);
    }
    xcd_barrier(xbar);
    if (PH & 4) {
        pg8::Gemm g{Pb, (const bf16_t*)(ws + WS_W2), FF, FF, MROWS, DM, FF}; pg8::StaticOrder S; S.init(MROWS, DM, G, bid);
        pg8::EpiRes<true> E{a.in[I_X], a.out, XB, ss1, 0.5f}; pg8::gemm_phase(ldsl, g, S, E);
    }
    xcd_barrier(xbar);
    if (PH & 8) {
        pg8::Gemm g{XB, (const bf16_t*)(ws + WS_WIN), DM, DM, MROWS, LDP, DM}; pg8::StaticOrder S; S.init(MROWS, LDP, G, bid);
        pg8::EpiP E{Pb, (float*)(ws + WS_SM), ss1}; pg8::gemm_phase(ldsl, g, S, E);
    }
    xcd_barrier(xbar);
    if (PH & 16) phase_postp(a);
    xcd_barrier(xbar);
    if (PH & 32) {
        pg8::Gemm g{XB, (const bf16_t*)(ws + WS_WQK), 512, 512, MROWS, 512, 512}; pg8::StaticOrder S; S.init(MROWS, 512, G, bid);
        pg8::EpiBf16 E{QKb, 512}; pg8::gemm_phase(ldsl, g, S, E);
    }
    xcd_barrier(xbar);
    if (PH & 64) phase_mlstm_a(a, lds);
    xcd_barrier(xbar);
    if (PH & 128) phase_mlstm_b(a);
    xcd_barrier(xbar);
    if (PH & 256) phase_mlstm_c(a, lds);
    if (DBG_TWICE & 1) phase_dsa<true>(a, lds);
    if (PH & 512) phase_dsa<false>(a, lds);
    xcd_barrier(xbar);
    if (PH & 1024) {
        pg8::StaticOrder S; S.init(MROWS, DM, G, bid);
        { pg8::Gemm g{Pb + C_AQ, (const bf16_t*)(ws + WS_WA), LDP, 512, MROWS, DM, 512}; pg8::EpiMerge<0> E{Pb, MG, C_GA}; pg8::gemm_phase(ldsl, g, S, E); }
        { pg8::Gemm g{Pb + C_MO, (const bf16_t*)(ws + WS_WB), LDP, 512, MROWS, DM, 512}; pg8::EpiMerge<1> E{Pb, MG, C_GB}; pg8::gemm_phase(ldsl, g, S, E); }
    }
    xcd_barrier(xbar);
    if (PH & 2048) {
        pg8::Gemm g{MG, (const bf16_t*)(ws + WS_WO), DM, DM, MROWS, DM, DM}; pg8::StaticOrder S; S.init(MROWS, DM, G, bid);
        pg8::EpiRes<true> E{a.out, a.out, XB, ss2, 1.0f}; pg8::gemm_phase(ldsl, g, S, E);
    }
    xcd_barrier(xbar);
    if (PH & 4096) {
        pg8::Gemm g{XB, (const bf16_t*)(ws + WS_W3), DM, DM, MROWS, 2 * FF, DM}; pg8::StaticOrder S; S.init(MROWS, 2 * FF, G, bid);
        pg8::EpiSwiGLU E{Pb, ss2}; pg8::gemm_phase(ldsl, g, S, E);
    }
    xcd_barrier(xbar);
    if (PH & 8192) {
        pg8::Gemm g{Pb, (const bf16_t*)(ws + WS_W4), FF, FF, MROWS, DM, FF}; pg8::StaticOrder S; S.init(MROWS, DM, G, bid);
        pg8::EpiRes<false> E{a.out, a.out, nullptr, nullptr, 0.5f}; pg8::gemm_phase(ldsl, g, S, E);
    }
}

extern "C" void kernel_launch(void* const* d_in, const int* in_sizes, int n_in, void* d_out, int out_size, void* d_ws, size_t ws_size, hipStream_t stream) {
    static int grid = 0;
    if (grid == 0) {
        if (n_in != 24 || ws_size < WS_END) { fprintf(stderr, "kernel_launch: unexpected n_in %d / ws %zu\n", n_in, ws_size); grid = -1; return; }
        int dev = 0, cus = 0, per_cu = 0;
        hipGetDevice(&dev);
        hipDeviceGetAttribute(&cus, hipDeviceAttributeMultiprocessorCount, dev);
        hipFuncSetAttribute((const void*)mega_fwd, hipFuncAttributeMaxDynamicSharedMemorySize, LDS_BYTES);
        hipOccupancyMaxActiveBlocksPerMultiprocessor(&per_cu, (const void*)mega_fwd, 512, LDS_BYTES);
        if (per_cu < 1) { fprintf(stderr, "kernel_launch: occupancy query says %d blocks/CU\n", per_cu); per_cu = 1; }
        (void)hipGetLastError();
        grid = cus * per_cu;
    }
    if (grid < 0) return;
    Args a{};
    for (int i = 0; i < 24; ++i) a.in[i] = (const float*)d_in[i];
    a.out = (float*)d_out; a.ws = (unsigned char*)d_ws;
    void* args[] = {&a};
    hipError_t e = hipLaunchCooperativeKernel((const void*)mega_fwd, dim3(grid), dim3(512), args, LDS_BYTES, stream);
    if (e != hipSuccess) fprintf(stderr, "cooperative launch failed: %s (grid %d)\n", hipGetErrorString(e), grid);
}
```

```cpp
#include <hip/hip_runtime.h>
#include <hip/hip_cooperative_groups.h>
#include <cstdio>
#include <cstdint>
namespace cg = cooperative_groups;
#define DBG_ZERO_YA 0
#define DBG_TWICE 0
#define DBG_NOSEL 0

#define LAS __attribute__((address_space(3)))
typedef unsigned short bf16_t;
typedef short bf16x8 __attribute__((ext_vector_type(8)));
typedef float f32x4 __attribute__((ext_vector_type(4)));
typedef unsigned u32x4 __attribute__((ext_vector_type(4)));
typedef unsigned u32x2 __attribute__((ext_vector_type(2)));
typedef __bf16 bf2_t __attribute__((ext_vector_type(2)));
typedef short v4i16_t __attribute__((ext_vector_type(4)));

constexpr int MROWS = 65536, DM = 1024, FF = 2816, SEQ = 8192, NB = 8;
constexpr int LDP = 5120;
constexpr int C_AQ = 0, C_AK = 512, C_AV = 640, C_IQ = 768, C_IK = 1280, C_MX = 1344, C_MV = 1856, C_MO = 2368, C_GA = 2880, C_GB = 3904, C_SM = 4928;
constexpr float EPS = 1e-6f;
constexpr size_t MiB = 1u << 20;
constexpr size_t WS_SS0 = 0, WS_SS1 = 256 * 1024, WS_SS2 = 512 * 1024;
constexpr size_t WS_DN = 1 * MiB;
constexpr size_t WS_ML = 2 * MiB, WS_BL = 2 * MiB + 16384, WS_MS = 2 * MiB + 32768;
constexpr size_t WS_BAR = 2 * MiB + 65536;
constexpr size_t WS_SM = 3 * MiB;
constexpr size_t WS_W1 = 8 * MiB, WS_W2 = 19 * MiB, WS_W3 = 25 * MiB, WS_W4 = 36 * MiB, WS_WIN = 42 * MiB, WS_WA = 52 * MiB, WS_WB = 53 * MiB, WS_WO = 54 * MiB, WS_WQK = 56 * MiB;
constexpr size_t WS_XB = 64 * MiB;
constexpr size_t WS_P = 192 * MiB;
constexpr size_t WS_MG = 832 * MiB;
constexpr size_t WS_IKC = 832 * MiB;
constexpr size_t WS_KVC = 840 * MiB;
constexpr size_t WS_QK = 960 * MiB;
constexpr size_t WS_END = 1024 * MiB;
constexpr int LDS_BYTES = 156 * 1024;

__device__ __forceinline__ unsigned cvt_pk_bf16(float lo, float hi) { unsigned r; asm volatile("v_cvt_pk_bf16_f32 %0, %1, %2" : "=v"(r) : "v"(lo), "v"(hi)); return r; }
__device__ __forceinline__ float bflo(unsigned u) { return __uint_as_float(u << 16); }
__device__ __forceinline__ float bfhi(unsigned u) { return __uint_as_float(u & 0xffff0000u); }
__device__ __forceinline__ float bf1(bf16_t u) { return __uint_as_float(((unsigned)u) << 16); }
__device__ __forceinline__ bf16_t f2bf(float f) { return (bf16_t)(cvt_pk_bf16(f, 0.f) & 0xffffu); }
__device__ __forceinline__ float wave_sum(float v) {
#pragma unroll
    for (int o = 1; o < 64; o <<= 1) v += __shfl_xor(v, o);
    return v;
}
__device__ __forceinline__ float wave_max(float v) {
#pragma unroll
    for (int o = 1; o < 64; o <<= 1) v = fmaxf(v, __shfl_xor(v, o));
    return v;
}
__device__ __forceinline__ float sigmoidf_(float x) { return __builtin_amdgcn_rcpf(1.f + __expf(-x)); }
__device__ __forceinline__ float dot2bf(unsigned a, unsigned b, float c) { const unsigned aa = a, bb = b; return __builtin_amdgcn_fdot2_f32_bf16(__builtin_bit_cast(bf2_t, aa), __builtin_bit_cast(bf2_t, bb), c, false); }
__device__ __forceinline__ float relu_(float x) { const int i = __float_as_int(x); return __int_as_float(i > 0 ? i : 0); }
__device__ __forceinline__ void lds_order() { asm volatile("" ::: "memory"); }
__device__ __forceinline__ void lds_fence() { asm volatile("s_waitcnt lgkmcnt(0)" ::: "memory"); }
__device__ __forceinline__ void unpack8(u32x4 v, float* f) {
    f[0] = bflo(v.x); f[1] = bfhi(v.x); f[2] = bflo(v.y); f[3] = bfhi(v.y); f[4] = bflo(v.z); f[5] = bfhi(v.z); f[6] = bflo(v.w); f[7] = bfhi(v.w);
}
__device__ __forceinline__ u32x4 pack8(const float* f) {
    u32x4 o; o.x = cvt_pk_bf16(f[0], f[1]); o.y = cvt_pk_bf16(f[2], f[3]); o.z = cvt_pk_bf16(f[4], f[5]); o.w = cvt_pk_bf16(f[6], f[7]); return o;
}

namespace pg8 {
constexpr int BM = 256, BK = 64, HALF = 128, HTB = HALF * BK * 2, NXCD = 8, WGM = 8;
__host__ __device__ __forceinline__ int lds_byte(int r, int c) { const int st = (r >> 4) * 2 + (c >> 5), rr = r & 15, cc = c & 31, ob = rr * 64 + cc * 2; return st * 1024 + (ob ^ (((ob >> 9) & 1) << 5)); }
__host__ __device__ __forceinline__ void stage_rc(int b, int& R, int& C) { const int st = b / 1024, sb = b % 1024, swz = sb ^ (((sb >> 9) & 1) << 5); R = (st >> 1) * 16 + swz / 64; C = (st & 1) * 32 + (swz % 64) / 2; }
__host__ __device__ __forceinline__ int perm32(int rho) { const int n = rho >> 4, i = rho & 15; return 8 * (i >> 2) + 4 * n + (i & 3); }
struct Unit { int pm, pn; };
struct Gemm { const bf16_t* A; const bf16_t* Bt; int lda, ldb, M, N, K; };
struct StaticOrder {
    int nM, nN, nwg, G, c;
    __device__ void init(int M, int N, int G_, int c_) { nM = M / BM; nN = N / BM; nwg = nM * nN; G = G_; c = c_; }
    __device__ bool next(int i, Unit& u) const {
        const long L = (long)i * G + c; if (L >= nwg) return false;
        int wgid = (int)L; { const int q = nwg / NXCD, r = nwg % NXCD, xcd = wgid % NXCD, off = wgid / NXCD; wgid = (xcd < r ? xcd * (q + 1) : r * (q + 1) + (xcd - r) * q) + off; }
        const int nig = WGM * nN, gid = wgid / nig, fm = gid * WGM, gsz = (nM - fm) < WGM ? (nM - fm) : WGM;
        u.pm = fm + ((wgid % nig) % gsz); u.pn = (wgid % nig) / gsz; return true;
    }
};

template <class Epi>
__device__ __forceinline__ void gemm_phase(LAS unsigned char* lds, const Gemm g, const StaticOrder& S, const Epi& E) {
    int tid_ = threadIdx.x; asm volatile("" : "+v"(tid_));
    const int tid = tid_, wid = __builtin_amdgcn_readfirstlane(tid >> 6), lane = tid & 63, wr = wid >> 2, wc = wid & 3, fr = lane & 15, fq = lane >> 4;
    const int K = g.K, nt = K / BK;
    unsigned voffA[2], voffB[2];
#pragma unroll
    for (int i = 0; i < 2; ++i) { int R, C; stage_rc(tid * 16 + i * 8192, R, C); const int Rb = (R & ~31) + perm32(R & 31);
        voffA[i] = (unsigned)(R * g.lda + C) * 2u; voffB[i] = (unsigned)(Rb * g.ldb + C) * 2u; }
    const size_t kstep = (size_t)(BK * 2);
    const size_t hsA = (size_t)HALF * g.lda * 2, hsB = (size_t)HALF * g.ldb * 2;
    const size_t tsA = 2 * hsA, tsB = 2 * hsB;
    const unsigned ldsw = (unsigned)wid * 1024u;
    const int aoff = lds_byte(wr * 64 + fr, fq * 8), boff = lds_byte(wc * 32 + fr, fq * 8);
#define PG8_SA(b, h) (((b) * 2 + (h)) * HTB)
#define PG8_SB(b, h) ((4 + (b) * 2 + (h)) * HTB)
#define PG8_STAGE(bufoff, gbase, voff) do { _Pragma("unroll") for (int _i = 0; _i < 2; ++_i) \
        __builtin_amdgcn_global_load_lds((const unsigned*)((const char*)(gbase) + (voff)[_i]), (LAS unsigned*)(lds + (bufoff) + ldsw + _i * 8192), 16, 0, 0); } while (0)
#define PG8_LDA(dst, b, h) do { _Pragma("unroll") for (int m = 0; m < 4; ++m) _Pragma("unroll") for (int k = 0; k < 2; ++k) dst[m][k] = *(const LAS bf16x8*)(lds + PG8_SA(b, h) + aoff + m * 2048 + k * 1024); } while (0)
#define PG8_LDB(dst, b, h) do { _Pragma("unroll") for (int n = 0; n < 2; ++n) _Pragma("unroll") for (int k = 0; k < 2; ++k) dst[n][k] = *(const LAS bf16x8*)(lds + PG8_SB(b, h) + boff + n * 2048 + k * 1024); } while (0)
#define PG8_MMA(ai, bj, At, Bt) do { __builtin_amdgcn_s_setprio(1); _Pragma("unroll") for (int m = 0; m < 4; ++m) _Pragma("unroll") for (int n = 0; n < 2; ++n) _Pragma("unroll") for (int k = 0; k < 2; ++k) \
        acc[ai][bj][m][n] = __builtin_amdgcn_mfma_f32_16x16x32_bf16(Bt[n][k], At[m][k], acc[ai][bj][m][n], 0, 0, 0); __builtin_amdgcn_s_setprio(0); } while (0)
#define PG8_WAIT_V(n) asm volatile("s_waitcnt vmcnt(" #n ")" ::: "memory")
#define PG8_WAIT_L(n) asm volatile("s_waitcnt lgkmcnt(" #n ")" ::: "memory")
#define PG8_BAR __builtin_amdgcn_s_barrier()
#define PG8_SCHED __builtin_amdgcn_sched_barrier(0)
    Unit cur, nxt; int ui = 0;
    if (!S.next(0, cur)) return;
    f32x4 acc[2][2][4][2];
#pragma unroll
    for (int a = 0; a < 2; ++a)
#pragma unroll
        for (int b = 0; b < 2; ++b)
#pragma unroll
            for (int m = 0; m < 4; ++m)
#pragma unroll
                for (int n = 0; n < 2; ++n) acc[a][b][m][n] = (f32x4){0.f, 0.f, 0.f, 0.f};
    bf16x8 At[4][2], B0[2][2], B1[2][2];
    const char* cA = (const char*)g.A + (size_t)cur.pm * tsA; const char* cB = (const char*)g.Bt + (size_t)cur.pn * tsB;
    PG8_STAGE(PG8_SB(0, 0), cB, voffB); PG8_STAGE(PG8_SB(0, 1), cB + hsB, voffB); PG8_STAGE(PG8_SA(0, 0), cA, voffA); PG8_STAGE(PG8_SA(0, 1), cA + hsA, voffA);
    if (wr == 1) PG8_BAR;
    PG8_WAIT_V(2); PG8_BAR;
    PG8_STAGE(PG8_SB(1, 0), cB + kstep, voffB); PG8_STAGE(PG8_SA(1, 0), cA + kstep, voffA); PG8_STAGE(PG8_SB(1, 1), cB + hsB + kstep, voffB);
    PG8_WAIT_V(6); PG8_BAR;
    for (;;) {
        const bool has_next = S.next(ui + 1, nxt);
        const char* nA = has_next ? (const char*)g.A + (size_t)nxt.pm * tsA : cA; const char* nB = has_next ? (const char*)g.Bt + (size_t)nxt.pn * tsB : cB;
        for (int t = 0; t < nt; t += 2) {
            const bool last = (t == nt - 2);
            const char* a1 = cA + (size_t)(t + 1) * kstep;
            const char* a2 = last ? nA : cA + (size_t)(t + 2) * kstep; const char* b2 = last ? nB : cB + (size_t)(t + 2) * kstep;
            const char* a3 = a2 + kstep; const char* b3 = b2 + kstep;
            PG8_LDB(B0, 0, 0); PG8_LDB(B1, 0, 1); PG8_SCHED; PG8_LDA(At, 0, 0); PG8_STAGE(PG8_SA(1, 1), a1 + hsA, voffA);
            PG8_WAIT_V(8); PG8_WAIT_L(0); PG8_BAR; PG8_MMA(0, 0, At, B0); PG8_MMA(0, 1, At, B1); PG8_BAR; PG8_SCHED;
            PG8_LDA(At, 0, 1); PG8_STAGE(PG8_SB(0, 0), b2, voffB); PG8_STAGE(PG8_SB(0, 1), b2 + hsB, voffB); PG8_STAGE(PG8_SA(0, 0), a2, voffA);
            PG8_WAIT_V(8); PG8_WAIT_L(0); PG8_BAR; PG8_MMA(1, 0, At, B0); PG8_MMA(1, 1, At, B1); PG8_BAR; PG8_SCHED;
            PG8_LDB(B0, 1, 0); PG8_LDB(B1, 1, 1); PG8_SCHED; PG8_LDA(At, 1, 0); PG8_STAGE(PG8_SA(0, 1), a2 + hsA, voffA);
            PG8_WAIT_V(8); PG8_WAIT_L(0); PG8_BAR; PG8_MMA(0, 0, At, B0); PG8_MMA(0, 1, At, B1); PG8_BAR; PG8_SCHED;
            PG8_LDA(At, 1, 1); PG8_STAGE(PG8_SB(1, 0), b3, voffB); PG8_STAGE(PG8_SB(1, 1), b3 + hsB, voffB); PG8_STAGE(PG8_SA(1, 0), a3, voffA);
            PG8_WAIT_V(8); PG8_WAIT_L(0); PG8_BAR; PG8_MMA(1, 0, At, B0); PG8_MMA(1, 1, At, B1); PG8_BAR; PG8_SCHED;
        }
        if (wr == 0) PG8_BAR;
        E(acc, cur, wr, wc, fr, fq);
        if (!has_next) break;
#pragma unroll
        for (int a = 0; a < 2; ++a)
#pragma unroll
            for (int b = 0; b < 2; ++b)
#pragma unroll
                for (int m = 0; m < 4; ++m)
#pragma unroll
                    for (int n = 0; n < 2; ++n) acc[a][b][m][n] = (f32x4){0.f, 0.f, 0.f, 0.f};
        cur = nxt; cA = nA; cB = nB; ++ui;
        if (wr == 1) PG8_BAR;
    }
    PG8_WAIT_V(0);
    PG8_BAR;
#undef PG8_SA
#undef PG8_SB
#undef PG8_STAGE
#undef PG8_LDA
#undef PG8_LDB
#undef PG8_MMA
#undef PG8_WAIT_V
#undef PG8_WAIT_L
#undef PG8_BAR
#undef PG8_SCHED
}

typedef f32x4 AccT[2][2][4][2];
struct EpiSwiGLU {
    bf16_t* O; const float* ss;
    __device__ __forceinline__ void operator()(const AccT& acc, const Unit& u, int wr, int wc, int fr, int fq) const {
        const int row0 = u.pm * BM + wr * 64 + fr, col = u.pn * 128 + wc * 32 + 8 * fq;
#pragma unroll
        for (int ai = 0; ai < 2; ++ai)
#pragma unroll
            for (int m = 0; m < 4; ++m) {
                const int row = row0 + ai * HALF + m * 16;
                const float rs = rsqrtf(ss[row] * (1.f / 1024.f) + EPS);
                float o[8];
#pragma unroll
                for (int n = 0; n < 2; ++n)
#pragma unroll
                    for (int j = 0; j < 4; ++j) { const float gt = acc[ai][0][m][n][j] * rs, up = acc[ai][1][m][n][j] * rs; o[n * 4 + j] = gt * up * sigmoidf_(gt); }
                *(u32x4*)(O + (size_t)row * FF + col) = pack8(o);
            }
    }
};
template <bool RES_BF16, bool WRITE_F32, bool WRITE_XB> struct EpiRes {
    const float* res; const bf16_t* resb; float* out; bf16_t* xb; bf16_t* xb2; float* ss; float alpha;
    __device__ __forceinline__ void operator()(const AccT& acc, const Unit& u, int wr, int wc, int fr, int fq) const {
        const int row0 = u.pm * BM + wr * 64 + fr, col0 = u.pn * BM + wc * 32 + 8 * fq;
#pragma unroll
        for (int ai = 0; ai < 2; ++ai)
#pragma unroll
            for (int m = 0; m < 4; ++m) {
                const int row = row0 + ai * HALF + m * 16; float sq = 0.f;
#pragma unroll
                for (int bj = 0; bj < 2; ++bj) {
                    const size_t off = (size_t)row * DM + col0 + bj * HALF;
                    f32x4 r0, r1;
                    if (RES_BF16) { float f[8]; unpack8(*(const u32x4*)(resb + off), f); r0 = (f32x4){f[0], f[1], f[2], f[3]}; r1 = (f32x4){f[4], f[5], f[6], f[7]}; }
                    else { r0 = *(const f32x4*)(res + off); r1 = *(const f32x4*)(res + off + 4); }
                    const f32x4 v0 = r0 + acc[ai][bj][m][0] * alpha, v1 = r1 + acc[ai][bj][m][1] * alpha;
                    if (WRITE_F32) { *(f32x4*)(out + off) = v0; *(f32x4*)(out + off + 4) = v1; }
                    if (WRITE_XB) {
                        u32x4 w; w.x = cvt_pk_bf16(v0[0], v0[1]); w.y = cvt_pk_bf16(v0[2], v0[3]); w.z = cvt_pk_bf16(v1[0], v1[1]); w.w = cvt_pk_bf16(v1[2], v1[3]);
                        *(u32x4*)(xb + off) = w; if (xb2) *(u32x4*)(xb2 + off) = w;
                        sq += v0[0] * v0[0] + v0[1] * v0[1] + v0[2] * v0[2] + v0[3] * v0[3] + v1[0] * v1[0] + v1[1] * v1[1] + v1[2] * v1[2] + v1[3] * v1[3];
                    }
                }
                if (WRITE_XB) { sq += __shfl_xor(sq, 16); sq += __shfl_xor(sq, 32); if (fq == 0) atomicAdd(ss + row, sq); }
            }
    }
};
struct EpiP {
    bf16_t* P; float* SM; const float* ss;
    __device__ __forceinline__ void operator()(const AccT& acc, const Unit& u, int wr, int wc, int fr, int fq) const {
        const int row0 = u.pm * BM + wr * 64 + fr, col0 = u.pn * BM + wc * 32 + 8 * fq;
#pragma unroll
        for (int ai = 0; ai < 2; ++ai)
#pragma unroll
            for (int m = 0; m < 4; ++m) {
                const int row = row0 + ai * HALF + m * 16;
                const float rs = rsqrtf(ss[row] * (1.f / 1024.f) + EPS);
#pragma unroll
                for (int bj = 0; bj < 2; ++bj) {
                    const int col = col0 + bj * HALF;
                    const f32x4 v0 = acc[ai][bj][m][0] * rs, v1 = acc[ai][bj][m][1] * rs;
                    u32x4 w; w.x = cvt_pk_bf16(v0[0], v0[1]); w.y = cvt_pk_bf16(v0[2], v0[3]); w.z = cvt_pk_bf16(v1[0], v1[1]); w.w = cvt_pk_bf16(v1[2], v1[3]);
                    *(u32x4*)(P + (size_t)row * LDP + col) = w;
                    if (col >= C_SM && col < C_SM + 16) { float* s = SM + (size_t)row * 16 + (col - C_SM); *(f32x4*)s = v0; *(f32x4*)(s + 4) = v1; }
                }
            }
    }
};
struct EpiBf16 {
    bf16_t* O; int ldc;
    __device__ __forceinline__ void operator()(const AccT& acc, const Unit& u, int wr, int wc, int fr, int fq) const {
        const int row0 = u.pm * BM + wr * 64 + fr, col0 = u.pn * BM + wc * 32 + 8 * fq;
#pragma unroll
        for (int ai = 0; ai < 2; ++ai)
#pragma unroll
            for (int m = 0; m < 4; ++m) {
                const int row = row0 + ai * HALF + m * 16;
#pragma unroll
                for (int bj = 0; bj < 2; ++bj) {
                    const f32x4 v0 = acc[ai][bj][m][0], v1 = acc[ai][bj][m][1];
                    u32x4 w; w.x = cvt_pk_bf16(v0[0], v0[1]); w.y = cvt_pk_bf16(v0[2], v0[3]); w.z = cvt_pk_bf16(v1[0], v1[1]); w.w = cvt_pk_bf16(v1[2], v1[3]);
                    *(u32x4*)(O + (size_t)row * ldc + col0 + bj * HALF) = w;
                }
            }
    }
};
template <int PASS> struct EpiMerge {
    const bf16_t* P; bf16_t* MG; int goff;
    __device__ __forceinline__ void operator()(const AccT& acc, const Unit& u, int wr, int wc, int fr, int fq) const {
        const int row0 = u.pm * BM + wr * 64 + fr, col0 = u.pn * BM + wc * 32 + 8 * fq;
#pragma unroll
        for (int ai = 0; ai < 2; ++ai)
#pragma unroll
            for (int m = 0; m < 4; ++m) {
                const int row = row0 + ai * HALF + m * 16;
#pragma unroll
                for (int bj = 0; bj < 2; ++bj) {
                    const int col = col0 + bj * HALF;
                    float gt[8], o[8]; unpack8(*(const u32x4*)(P + (size_t)row * LDP + goff + col), gt);
                    if (PASS == 1) unpack8(*(const u32x4*)(MG + (size_t)row * DM + col), o);
#pragma unroll
                    for (int j = 0; j < 8; ++j) { const float a = acc[ai][bj][m][j >> 2][j & 3] * sigmoidf_(gt[j]); o[j] = (PASS == 1) ? o[j] + a : a; }
                    *(u32x4*)(MG + (size_t)row * DM + col) = pack8(o);
                }
            }
    }
};
}

struct Args {
    const float* in[24];
    float* out;
    unsigned char* ws;
};
enum { I_X = 0, I_F1N, I_F1G, I_F1U, I_F1D, I_MIXN, I_WIN, I_QN, I_KN, I_IKN, I_CW, I_CB, I_WMQ, I_WMK, I_BI, I_BF, I_MHN, I_WPA, I_WPB, I_WOUT, I_F2N, I_F2G, I_F2U, I_F2D };

template <class F> __device__ __forceinline__ void prep_tile(bf16_t* Bt, int K, int n0, int k0, const F src, float* tile) {
    const int tid = threadIdx.x;
    { const int nn = tid & 63, kk = tid >> 6;
#pragma unroll
        for (int i = 0; i < 8; ++i) { const int k = i * 8 + kk; tile[k * 65 + nn] = src(k0 + k, n0 + nn); } }
    __syncthreads();
    { const int nn = tid >> 3, kc = tid & 7; const float* s = tile + (kc * 8) * 65 + nn;
        u32x4 o; o.x = cvt_pk_bf16(s[0], s[65]); o.y = cvt_pk_bf16(s[130], s[195]); o.z = cvt_pk_bf16(s[260], s[325]); o.w = cvt_pk_bf16(s[390], s[455]);
        *(u32x4*)(Bt + (size_t)(n0 + nn) * K + k0 + kc * 8) = o; }
    __syncthreads();
}
struct SrcUp { const float* wg; const float* wu; const float* g;
    __device__ __forceinline__ float operator()(int k, int n) const { const int col = (n >> 8) * 128 + (n & 127); const size_t bj = (size_t)((n >> 7) & 1); const float* w = (const float*)((uintptr_t)wg + ((uintptr_t)wu - (uintptr_t)wg) * bj); return w[(size_t)k * FF + col] * g[k]; } };
struct SrcPlain { const float* w; int ldw;
    __device__ __forceinline__ float operator()(int k, int n) const { return w[(size_t)k * ldw + n]; } };
struct SrcIn { const float* w; const float* g;
    __device__ __forceinline__ float operator()(int k, int n) const {
        int col;
        if (n < 1344) col = n; else if (n < 2368) col = n + 8; else if (n < 4928) col = n + 16;
        else if (n < 4936) col = n - 4928 + 1344; else if (n < 4940) col = n - 4936 + 2376; else if (n < 4944) col = n - 4940 + 2380; else col = -1;
        return col >= 0 ? w[(size_t)k * 4944 + col] * g[k] : 0.f; } };
struct SrcQK { const float* wq; const float* wk;
    __device__ __forceinline__ float operator()(int k, int n) const {
        const int isk = n >> 8, h = (n >> 6) & 3, j = n & 63, hk = k >> 7, c = k & 127;
        if (hk != h) return 0.f;
        const float* w = (const float*)((uintptr_t)wq + ((uintptr_t)wk - (uintptr_t)wq) * (size_t)isk); return w[(size_t)(h * 128 + c) * 64 + j] * (isk ? 1.f : 0.125f); } };

__device__ __forceinline__ void phase0(const Args& a, unsigned char* lds) {
    float* tile = (float*)lds;
    unsigned char* ws = a.ws;
    constexpr int T_UP = 88 * 16, T_DN = 16 * 44, T_IN = 80 * 16, T_PR = 16 * 8, T_WO = 16 * 16, T_QK = 8 * 8;
    constexpr int NITEMS = 2 * T_UP + 2 * T_DN + T_IN + 2 * T_PR + T_WO + T_QK;
    for (int it = blockIdx.x; it < NITEMS; it += gridDim.x) {
        int r = it;
        if (r < T_UP) { SrcUp s{a.in[I_F1G], a.in[I_F1U], a.in[I_F1N]}; prep_tile((bf16_t*)(ws + WS_W1), 1024, (r / 16) * 64, (r % 16) * 64, s, tile); continue; } r -= T_UP;
        if (r < T_UP) { SrcUp s{a.in[I_F2G], a.in[I_F2U], a.in[I_F2N]}; prep_tile((bf16_t*)(ws + WS_W3), 1024, (r / 16) * 64, (r % 16) * 64, s, tile); continue; } r -= T_UP;
        if (r < T_DN) { SrcPlain s{a.in[I_F1D], 1024}; prep_tile((bf16_t*)(ws + WS_W2), FF, (r / 44) * 64, (r % 44) * 64, s, tile); continue; } r -= T_DN;
        if (r < T_DN) { SrcPlain s{a.in[I_F2D], 1024}; prep_tile((bf16_t*)(ws + WS_W4), FF, (r / 44) * 64, (r % 44) * 64, s, tile); continue; } r -= T_DN;
        if (r < T_IN) { SrcIn s{a.in[I_WIN], a.in[I_MIXN]}; prep_tile((bf16_t*)(ws + WS_WIN), 1024, (r / 16) * 64, (r % 16) * 64, s, tile); continue; } r -= T_IN;
        if (r < T_PR) { SrcPlain s{a.in[I_WPA], 1024}; prep_tile((bf16_t*)(ws + WS_WA), 512, (r / 8) * 64, (r % 8) * 64, s, tile); continue; } r -= T_PR;
        if (r < T_PR) { SrcPlain s{a.in[I_WPB], 1024}; prep_tile((bf16_t*)(ws + WS_WB), 512, (r / 8) * 64, (r % 8) * 64, s, tile); continue; } r -= T_PR;
        if (r < T_WO) { SrcPlain s{a.in[I_WOUT], 1024}; prep_tile((bf16_t*)(ws + WS_WO), 1024, (r / 16) * 64, (r % 16) * 64, s, tile); continue; } r -= T_WO;
        { SrcQK s{a.in[I_WMQ], a.in[I_WMK]}; prep_tile((bf16_t*)(ws + WS_WQK), 512, (r / 8) * 64, (r % 8) * 64, s, tile); }
    }
    const int lane = threadIdx.x & 63, gw = blockIdx.x * 8 + (threadIdx.x >> 6), NGW = gridDim.x * 8;
    const float* x = a.in[I_X]; bf16_t* XB = (bf16_t*)(ws + WS_XB);
    float* ss0 = (float*)(ws + WS_SS0); float* ss1 = (float*)(ws + WS_SS1); float* ss2 = (float*)(ws + WS_SS2);
    for (int row = gw; row < MROWS; row += NGW) {
        const f32x4* xr = (const f32x4*)(x + (size_t)row * DM) + lane;
        f32x4 v[4]; float s = 0.f;
#pragma unroll
        for (int j = 0; j < 4; ++j) { v[j] = xr[64 * j]; s += v[j][0] * v[j][0] + v[j][1] * v[j][1] + v[j][2] * v[j][2] + v[j][3] * v[j][3]; }
        s = wave_sum(s);
        if (lane == 0) { ss0[row] = s; ss1[row] = 0.f; ss2[row] = 0.f; }
        unsigned long long* o8 = (unsigned long long*)(XB + (size_t)row * DM) + lane;
#pragma unroll
        for (int j = 0; j < 4; ++j) o8[64 * j] = (unsigned long long)cvt_pk_bf16(v[j][0], v[j][1]) | ((unsigned long long)cvt_pk_bf16(v[j][2], v[j][3]) << 32);
    }
}

__device__ __forceinline__ void phase_postp(const Args& a) {
    unsigned char* ws = a.ws;
    bf16_t* P = (bf16_t*)(ws + WS_P); bf16_t* XC = (bf16_t*)(ws + WS_XB); bf16_t* IKC = (bf16_t*)(ws + WS_IKC); bf16_t* KVC = (bf16_t*)(ws + WS_KVC);
    const int lane = threadIdx.x & 63, gw = blockIdx.x * 8 + (threadIdx.x >> 6), NGW = gridDim.x * 8;
    const int c0 = lane * 8;
    float cw[4][8], cb[8], gq[8], gk[8];
#pragma unroll
    for (int e = 0; e < 8; ++e) {
        cb[e] = a.in[I_CB][c0 + e];
#pragma unroll
        for (int j = 0; j < 4; ++j) cw[j][e] = a.in[I_CW][j * 512 + c0 + e];
        gq[e] = a.in[I_QN][(lane & 7) * 8 + e];
        gk[e] = (lane < 16) ? a.in[I_KN][(lane & 7) * 8 + e] : a.in[I_IKN][(lane & 7) * 8 + e];
    }
    const int koff = (lane < 16) ? (C_AK + lane * 8) : (C_IK + (lane & 7) * 8);
    const int voff = C_AV + ((lane - 32) & 15) * 8;
    u32x4 nmx[4], naq, nkk, nav;
#define PP_LOAD(ROW) do { const int t_ = (ROW) & (SEQ - 1); const bf16_t* pr_ = P + (size_t)(ROW) * LDP; \
        _Pragma("unroll") for (int j = 0; j < 4; ++j) { if (t_ - 3 + j >= 0) nmx[j] = *(const u32x4*)(P + (size_t)((ROW) - 3 + j) * LDP + C_MX + c0); else nmx[j] = (u32x4){0u, 0u, 0u, 0u}; } \
        naq = *(const u32x4*)(pr_ + C_AQ + c0); nkk = *(const u32x4*)(pr_ + koff); nav = *(const u32x4*)(pr_ + voff); } while (0)
    if (gw < MROWS) PP_LOAD(gw);
    for (int row = gw; row < MROWS; row += NGW) {
        bf16_t* pr = P + (size_t)row * LDP;
        u32x4 cmx[4];
#pragma unroll
        for (int j = 0; j < 4; ++j) cmx[j] = nmx[j];
        const u32x4 caq = naq, ckk = nkk, cav = nav;
        if (row + NGW < MROWS) PP_LOAD(row + NGW);
        float accv[8];
#pragma unroll
        for (int e = 0; e < 8; ++e) accv[e] = cb[e];
#pragma unroll
        for (int j = 0; j < 4; ++j) { float xf[8]; unpack8(cmx[j], xf);
#pragma unroll
            for (int e = 0; e < 8; ++e) accv[e] += xf[e] * cw[j][e]; }
#pragma unroll
        for (int e = 0; e < 8; ++e) accv[e] = accv[e] * sigmoidf_(accv[e]);
        *(u32x4*)(XC + (size_t)row * 512 + c0) = pack8(accv);
        { float f[8]; unpack8(caq, f); float s = 0.f;
#pragma unroll
            for (int e = 0; e < 8; ++e) s += f[e] * f[e];
            s += __shfl_xor(s, 1); s += __shfl_xor(s, 2); s += __shfl_xor(s, 4);
            const float rs = rsqrtf(s * (1.f / 64.f) + EPS);
#pragma unroll
            for (int e = 0; e < 8; ++e) f[e] = f[e] * rs * gq[e];
            *(u32x4*)(pr + C_AQ + c0) = pack8(f); }
        { float f[8]; unpack8(ckk, f); float s = 0.f;
#pragma unroll
            for (int e = 0; e < 8; ++e) s += f[e] * f[e];
            s += __shfl_xor(s, 1); s += __shfl_xor(s, 2); s += __shfl_xor(s, 4);
            const float rs = rsqrtf(s * (1.f / 64.f) + EPS);
#pragma unroll
            for (int e = 0; e < 8; ++e) f[e] = f[e] * rs * gk[e];
            if (lane < 16) *(u32x4*)(KVC + (size_t)row * 256 + lane * 8) = pack8(f);
            else if (lane < 24) *(u32x4*)(IKC + ((((size_t)(row >> 4)) * 8 + (lane - 16)) * 16 + (row & 15)) * 8) = pack8(f);
            else if (lane >= 32 && lane < 48) *(u32x4*)(KVC + (size_t)row * 256 + 128 + (lane - 32) * 8) = cav; }
    }
#undef PP_LOAD
}

__device__ __forceinline__ unsigned fkey(float s) { const unsigned u = __float_as_uint(s); return (u & 0x80000000u) ? ~u : (u | 0x80000000u); }


__device__ __forceinline__ unsigned wave_incl_scan_dpp(unsigned x) {
    x += (unsigned)__builtin_amdgcn_update_dpp(0, (int)x, 0x111, 0xf, 0xf, false);
    x += (unsigned)__builtin_amdgcn_update_dpp(0, (int)x, 0x112, 0xf, 0xf, false);
    x += (unsigned)__builtin_amdgcn_update_dpp(0, (int)x, 0x114, 0xf, 0xf, false);
    x += (unsigned)__builtin_amdgcn_update_dpp(0, (int)x, 0x118, 0xf, 0xf, false);
    x += (unsigned)__builtin_amdgcn_update_dpp(0, (int)x, 0x142, 0xa, 0xf, false);
    x += (unsigned)__builtin_amdgcn_update_dpp(0, (int)x, 0x143, 0xc, 0xf, false);
    return x;
}
__device__ __forceinline__ int find_bin(const unsigned* hist, int& need, int lane, int& binc) {
    const int base = 1023 - 16 * lane; unsigned s = 0;
#pragma unroll
    for (int i = 0; i < 16; ++i) { const unsigned w = hist[base - ((i + lane) & 15)]; s += (w & 0xffffu) + (w >> 16); }
    const unsigned p = wave_incl_scan_dpp(s);
    const unsigned long long bal = __ballot(p >= (unsigned)need);
    const int L = bal ? (__ffsll((long long)bal) - 1) : 63;
    const unsigned excl = __shfl(p - s, L);
    int cum = (int)excl, bin = -1, fneed = 1, bc = 1; const int b0 = 1023 - 16 * L;
#pragma unroll
    for (int i = 0; i < 16; ++i) {
        const unsigned w = hist[b0 - i]; const int hi = (int)(w >> 16), lo = (int)(w & 0xffffu);
        if (bin < 0) { if (cum + hi >= need) { bin = 2 * (b0 - i) + 1; fneed = need - cum; bc = hi; } else cum += hi; }
        if (bin < 0) { if (cum + lo >= need) { bin = 2 * (b0 - i); fneed = need - cum; bc = lo; } else cum += lo; }
    }
    if (bin < 0) bin = 0;
    need = fneed; binc = bc; return bin;
}


__device__ __forceinline__ int find_bin128(const unsigned* sh, int& need, int lane, int& binc) {
    const unsigned hi = sh[127 - 2 * lane], lo = sh[126 - 2 * lane]; const unsigned s = hi + lo;
    const unsigned p = wave_incl_scan_dpp(s);
    const unsigned long long bal = __ballot(p >= (unsigned)need);
    const int L = bal ? (__ffsll((long long)bal) - 1) : 63;
    const int excl = (int)__shfl(p - s, L); const int hiL = (int)__shfl(hi, L), loL = (int)__shfl(lo, L);
    int bin, fneed, bc;
    if (excl + hiL >= need) { bin = 127 - 2 * L; fneed = need - excl; bc = hiL; } else { bin = 126 - 2 * L; fneed = need - excl - hiL; bc = loL; }
    if (fneed < 1) fneed = 1;
    need = fneed; binc = bc; return bin;
}

template <bool DUMMY> __device__ __forceinline__ void phase_dsa(const Args& a, unsigned char* lds) {
    unsigned char* ws = a.ws;
    bf16_t* P = (bf16_t*)(ws + WS_P); const float* SM = (const float*)(ws + WS_SM);
    const bf16_t* IKC = (const bf16_t*)(ws + WS_IKC); const bf16_t* KVC = (const bf16_t*)(ws + WS_KVC);
    constexpr int SCS = 8200;
    float* SC = (float*)lds;
    unsigned* HIST = (unsigned*)(lds + 131200);
    int* LIST = (int*)(lds + 131200 + 16384);
    unsigned* QS = (unsigned*)(lds + 131200 + 16384 + 4096);
    int* CNT = (int*)(lds + 131200 + 16384 + 4096 + 4096);
    const float idx_scale = 0.125f * 0.35355339059327373f;
    f32x4 wqv[2]; unsigned qsv[2];
#define DSA_LOAD_ITEM(ITEM) do { const int b_ = (ITEM) & 7, t0_ = ((ITEM) >> 3) * 4; const size_t r_ = (size_t)b_ * SEQ + t0_; \
        int tl_ = threadIdx.x; asm volatile("" : "+v"(tl_)); const int ln_ = tl_ & 63, q4_ = ln_ >> 4; \
        wqv[0] = *(const f32x4*)(SM + (r_ + q4_) * 16); wqv[1] = *(const f32x4*)(SM + (r_ + q4_) * 16 + 4); \
        _Pragma("unroll") for (int i_ = 0; i_ < 2; ++i_) { const int e_ = tl_ + 512 * i_; qsv[i_] = *(const unsigned*)(P + (r_ + (e_ >> 8)) * LDP + C_AQ + (e_ & 255) * 2); } } while (0)
    if ((int)blockIdx.x < 16384) DSA_LOAD_ITEM(blockIdx.x);
    for (int item = blockIdx.x; item < 16384; item += gridDim.x) {
        int tid_ = threadIdx.x; asm volatile("" : "+v"(tid_));
        const int tid = tid_, wave = __builtin_amdgcn_readfirstlane(tid >> 6), lane = tid & 63, quad = lane >> 4, l15 = lane & 15;
        const int b = item & 7, tq = item >> 3, t0 = tq * 4, L = ((t0 >> 6) + 1) * 64;
        const size_t r0 = (size_t)b * SEQ + t0;
        const bool do_sel = (L > 256) && !DBG_NOSEL;
        { u32x4* hz = (u32x4*)HIST; hz[tid] = (u32x4){0u, 0u, 0u, 0u}; hz[tid + 512] = (u32x4){0u, 0u, 0u, 0u}; }
        if (tid < 8) CNT[4 + tid] = 0;
        QS[tid] = qsv[0]; QS[tid + 512] = qsv[1];
        float wq[8];
#pragma unroll
        for (int h = 0; h < 4; ++h) { wq[h] = wqv[0][h] * idx_scale; wq[4 + h] = wqv[1][h] * idx_scale; }
        bf16x8 af[2][2];
#pragma unroll
        for (int T = 0; T < 2; ++T)
#pragma unroll
            for (int ks = 0; ks < 2; ++ks) af[T][ks] = *(const bf16x8*)(P + (r0 + (l15 >> 2)) * LDP + C_IQ + (4 * T + (l15 & 3)) * 64 + ks * 32 + quad * 8);
        const int ngroups = L >> 6;
        const bf16_t* ikb = IKC + (size_t)b * SEQ * 64 + (quad * 16 + l15) * 8;
        bf16x8 B0[4][2], B1[4][2], B2[4][2];
#define IDX_LOAD(BUF, G) do { _Pragma("unroll") for (int tt = 0; tt < 4; ++tt) _Pragma("unroll") for (int ks = 0; ks < 2; ++ks) \
                BUF[tt][ks] = *(const bf16x8*)(ikb + (size_t)(((G) * 4 + tt) * 8 + ks * 4) * 128); } while (0)
        if (wave < ngroups) IDX_LOAD(B0, wave);
        if (wave + 8 < ngroups) IDX_LOAD(B1, wave + 8);
        if (wave + 16 < ngroups) IDX_LOAD(B2, wave + 16);
        lds_fence(); __builtin_amdgcn_s_barrier();
        for (int rep = 0; rep < ((DBG_TWICE & 2) ? 2 : 1); ++rep) {
            const bool hist_on = do_sel && (rep == (((DBG_TWICE & 2) ? 2 : 1) - 1));
#define IDX_COMPUTE(BUF, G) do { _Pragma("unroll") for (int tt = 0; tt < 4; ++tt) { \
                const int key = (G) * 64 + tt * 16 + l15; \
                f32x4 c0 = (f32x4){0.f, 0.f, 0.f, 0.f}, c1 = (f32x4){0.f, 0.f, 0.f, 0.f}; \
                c0 = __builtin_amdgcn_mfma_f32_16x16x32_bf16(af[0][0], BUF[tt][0], c0, 0, 0, 0); \
                c1 = __builtin_amdgcn_mfma_f32_16x16x32_bf16(af[1][0], BUF[tt][0], c1, 0, 0, 0); \
                c0 = __builtin_amdgcn_mfma_f32_16x16x32_bf16(af[0][1], BUF[tt][1], c0, 0, 0, 0); \
                c1 = __builtin_amdgcn_mfma_f32_16x16x32_bf16(af[1][1], BUF[tt][1], c1, 0, 0, 0); \
                float sc = 0.f; \
                _Pragma("unroll") for (int j = 0; j < 4; ++j) { sc += wq[j] * relu_(c0[j]); sc += wq[4 + j] * relu_(c1[j]); } \
                sc += 0.f; \
                SC[quad * SCS + key] = sc; \
                if (hist_on) { const unsigned bin = fkey(sc) >> 21; atomicAdd(&HIST[quad * 1024 + (bin >> 1)], (bin & 1u) ? 0x10000u : 1u); } } } while (0)
            int g = wave;
            for (; g < ngroups; g += 24) {
                IDX_COMPUTE(B0, g);
                if (g + 24 < ngroups) IDX_LOAD(B0, g + 24);
                if (g + 8 < ngroups) { IDX_COMPUTE(B1, g + 8); if (g + 32 < ngroups) IDX_LOAD(B1, g + 32); }
                if (g + 16 < ngroups) { IDX_COMPUTE(B2, g + 16); if (g + 40 < ngroups) IDX_LOAD(B2, g + 40); }
            }
#undef IDX_LOAD
#undef IDX_COMPUTE
        }
        lds_fence(); __builtin_amdgcn_s_barrier();
        if (item + (int)gridDim.x < 16384) DSA_LOAD_ITEM(item + (int)gridDim.x);
        {
            constexpr int CAP = 448;
            const unsigned long long ltmask = (1ull << lane) - 1ull;
            if (!do_sel) {
                const int q = wave >> 1, hf = wave & 1; int* list = LIST + q * 256;
                if (hf == 0) { for (int i = lane; i < 256; i += 64) list[i] = (i < L) ? i : 0; if (lane == 0) CNT[q] = L; }
            } else {
                {
                    const int q = wave >> 1, hf = wave & 1; int* list = LIST + q * 256; const float* sc = SC + q * SCS; unsigned* hist = HIST + q * 1024;
                    const int halfL = L >> 1, beg = hf * halfL, end = beg + halfL;
                    int need = 256, binc = 0;
                    const unsigned b1 = (unsigned)find_bin(hist, need, lane, binc);
                    const int c1 = binc, nsure = 256 - need; const bool store_c = c1 <= CAP;
                    if (hf == 0 && lane == 0) { CNT[12 + q] = (int)b1; CNT[16 + q] = need; CNT[8 + q] = c1; }
                    lds_fence(); __builtin_amdgcn_s_barrier();
                    int cs = 0, cc = 0;
                    for (int i0 = beg + lane * 4; i0 < end; i0 += 256) { const f32x4 v = *(const f32x4*)(sc + i0);
#pragma unroll
                        for (int e = 0; e < 4; ++e) { const unsigned k = fkey(v[e]); const unsigned kb = k >> 21;
                            const bool sure = kb > b1, cand = (kb == b1) && store_c;
                            const unsigned long long ms = __ballot(sure), mc = __ballot(cand);
                            if (ms) { const int p = cs + __popcll(ms & ltmask); const int pp = hf ? nsure - 1 - p : p; if (sure && pp >= 0 && pp < 256) list[pp] = i0 + e; cs += __popcll(ms); }
                            if (mc) { const int p = cc + __popcll(mc & ltmask); const int pp = hf ? c1 - 1 - p : p; if (cand && pp >= 0 && pp < CAP) { hist[2 * pp] = k; hist[2 * pp + 1] = (unsigned)(i0 + e); } cc += __popcll(mc); } } }
                    lds_fence(); __builtin_amdgcn_s_barrier();
                }
                if (wave < 4) {
                    const int q = wave; int* list = LIST + q * 256; unsigned* hist = HIST + q * 1024; unsigned* sh = hist + 896; const float* sc = SC + q * SCS;
                    const unsigned b1 = (unsigned)CNT[12 + q]; int need = CNT[16 + q]; const int c = CNT[8 + q]; const int nsure = 256 - need;
                    if (c <= CAP) {
                        unsigned ck[7]; int ci[7];
#pragma unroll
                        for (int t = 0; t < 7; ++t) { const int i = lane + 64 * t; const bool valid = i < c; ck[t] = valid ? hist[2 * i] : 0u; ci[t] = valid ? (int)hist[2 * i + 1] : -1; }
                        int binc = 0;
                        sh[2 * lane] = 0u; sh[2 * lane + 1] = 0u; lds_order();
#pragma unroll
                        for (int t = 0; t < 7; ++t) if (ci[t] >= 0) atomicAdd(&sh[(ck[t] >> 14) & 127u], 1u);
                        lds_order();
                        const unsigned bA = (unsigned)find_bin128(sh, need, lane, binc);
                        lds_order();
                        sh[2 * lane] = 0u; sh[2 * lane + 1] = 0u; lds_order();
#pragma unroll
                        for (int t = 0; t < 7; ++t) if (ci[t] >= 0 && ((ck[t] >> 14) & 127u) == bA) atomicAdd(&sh[(ck[t] >> 7) & 127u], 1u);
                        lds_order();
                        const unsigned bB = (unsigned)find_bin128(sh, need, lane, binc);
                        const unsigned preB = (bA << 7) | bB;
                        lds_order();
                        sh[2 * lane] = 0u; sh[2 * lane + 1] = 0u; lds_order();
#pragma unroll
                        for (int t = 0; t < 7; ++t) if (ci[t] >= 0 && ((ck[t] >> 7) & 0x3fffu) == preB) atomicAdd(&sh[ck[t] & 127u], 1u);
                        lds_order();
                        const unsigned bC = (unsigned)find_bin128(sh, need, lane, binc);
                        const unsigned T = (b1 << 21) | (preB << 7) | bC;
                        const int tie_total = binc, need_t = need;
                        int cnt = 0;
#pragma unroll
                        for (int t = 0; t < 7; ++t) {
                            const bool valid = ci[t] >= 0;
                            bool sel = valid && (ck[t] > T);
                            if (valid && ck[t] == T) {
                                if (tie_total == need_t) sel = true;
                                else { int rank = 0; for (int j = 0; j < c; ++j) rank += (hist[2 * j] == T && (int)hist[2 * j + 1] < ci[t]) ? 1 : 0; sel = rank < need_t; }
                            }
                            const unsigned long long m = __ballot(sel);
                            const int pos = nsure + cnt + __popcll(m & ltmask);
                            if (sel && pos < 256) list[pos] = ci[t];
                            cnt += __popcll(m);
                        }
                    } else {
                        int binc = 0;
                        lds_order();
#pragma unroll
                        for (int i = 0; i < 16; ++i) hist[lane * 16 + i] = 0u;
                        lds_order();
                        for (int i0 = 0; i0 < L; i0 += 64) { const unsigned k = fkey(sc[i0 + lane]); if ((k >> 21) == b1) { const unsigned bin = (k >> 10) & 2047u; atomicAdd(&hist[bin >> 1], (bin & 1u) ? 0x10000u : 1u); } }
                        lds_order();
                        const unsigned b2 = (unsigned)find_bin(hist, need, lane, binc);
                        const unsigned pre2 = (b1 << 11) | b2;
                        lds_order();
#pragma unroll
                        for (int i = 0; i < 16; ++i) hist[lane * 16 + i] = 0u;
                        lds_order();
                        for (int i0 = 0; i0 < L; i0 += 64) { const unsigned k = fkey(sc[i0 + lane]); if ((k >> 10) == pre2) { const unsigned bin = k & 1023u; atomicAdd(&hist[bin >> 1], (bin & 1u) ? 0x10000u : 1u); } }
                        lds_order();
                        const unsigned b3 = (unsigned)find_bin(hist, need, lane, binc);
                        const unsigned T = (pre2 << 10) | b3;
                        int count = 0, ties = 0;
                        for (int i0 = 0; i0 < L; i0 += 64) {
                            const unsigned k = fkey(sc[i0 + lane]);
                            const bool eq = (k == T);
                            const unsigned long long em = __ballot(eq);
                            const int erank = ties + __popcll(em & ltmask);
                            const bool sel = (k > T) || (eq && erank < need);
                            const unsigned long long smk = __ballot(sel);
                            const int pos = count + __popcll(smk & ltmask);
                            if (sel && pos < 256) list[pos] = i0 + lane;
                            count += __popcll(smk); ties += __popcll(em);
                        }
                        if (count > 256) count = 256;
                        for (int i = count + lane; i < 256; i += 64) list[i] = 0;
                    }
                    if (lane == 0) CNT[q] = 256;
                }
            }
        }
        lds_fence(); __builtin_amdgcn_s_barrier();
        for (int repc = 0; repc < ((DBG_TWICE & 4) ? 2 : 1); ++repc) {
            const bool dummy_c = (repc + 1) < ((DBG_TWICE & 4) ? 2 : 1);
            int lane_c = lane; asm volatile("" : "+v"(lane_c));
            const int qi = wave >> 1, g = wave & 1; const int count = CNT[qi];
            const int* list = LIST + qi * 256;
            float* PB = SC + wave * 1024;
            const unsigned* qd = QS + (qi * 8 + g * 4) * 32;
            const bf16_t* kvb = KVC + (size_t)b * SEQ * 256 + g * 64;
            const int ks = lane_c >> 3, dg = lane_c & 7, l15c = lane_c & 15, quadc = lane_c >> 4;
            const int nblk = count >> 6;
            bf16_t* KL = (bf16_t*)(lds + 32768 + wave * 9216);
            bf16x8 bq[2];
#pragma unroll
            for (int s2 = 0; s2 < 2; ++s2) {
                bf16x8 t = *(const bf16x8*)((const bf16_t*)QS + (qi * 8 + g * 4 + (l15c & 3)) * 64 + s2 * 32 + quadc * 8);
                if (l15c >= 4) t = (bf16x8){0, 0, 0, 0, 0, 0, 0, 0};
                bq[s2] = t;
            }
            const bf16_t* kb = kvb + dg * 8;
            float sreg[4][4][4];
            u32x4 kcur[8];
#pragma unroll
            for (int u = 0; u < 8; ++u) kcur[u] = *(const u32x4*)(kb + (size_t)list[u * 8 + ks] * 256);
#pragma unroll
            for (int blk = 0; blk < 4; ++blk) {
                if (blk < nblk) {
#pragma unroll
                    for (int u = 0; u < 8; ++u) *(u32x4*)(KL + (u * 8 + ks) * 72 + dg * 8) = kcur[u];
                    if (blk + 1 < nblk) {
#pragma unroll
                        for (int u = 0; u < 8; ++u) kcur[u] = *(const u32x4*)(kb + (size_t)list[(blk + 1) * 64 + u * 8 + ks] * 256);
                    }
                    lds_order();
#pragma unroll
                    for (int kt = 0; kt < 4; ++kt) {
                        f32x4 acc = (f32x4){0.f, 0.f, 0.f, 0.f};
#pragma unroll
                        for (int s2 = 0; s2 < 2; ++s2) acc = __builtin_amdgcn_mfma_f32_16x16x32_bf16(*(const bf16x8*)(KL + (kt * 16 + l15c) * 72 + s2 * 32 + quadc * 8), bq[s2], acc, 0, 0, 0);
#pragma unroll
                        for (int j = 0; j < 4; ++j) sreg[blk][kt][j] = acc[j] * 0.125f;
                    }
                    lds_order();
                } else {
#pragma unroll
                    for (int kt = 0; kt < 4; ++kt)
#pragma unroll
                        for (int j = 0; j < 4; ++j) sreg[blk][kt][j] = -INFINITY;
                }
            }
            const bf16_t* vb = kvb + 128 + dg * 8;
            u32x4 vreg[8];
#pragma unroll
            for (int u = 0; u < 8; ++u) vreg[u] = *(const u32x4*)(vb + (size_t)list[u * 8 + ks] * 256);
            float mx = -INFINITY;
#pragma unroll
            for (int blk = 0; blk < 4; ++blk)
#pragma unroll
                for (int kt = 0; kt < 4; ++kt)
#pragma unroll
                    for (int j = 0; j < 4; ++j) mx = fmaxf(mx, sreg[blk][kt][j]);
            mx = fmaxf(mx, __shfl_xor(mx, 16)); mx = fmaxf(mx, __shfl_xor(mx, 32));
            float sum = 0.f;
#pragma unroll
            for (int blk = 0; blk < 4; ++blk)
#pragma unroll
                for (int kt = 0; kt < 4; ++kt)
#pragma unroll
                    for (int j = 0; j < 4; ++j) { const float e = __expf(sreg[blk][kt][j] - mx); sreg[blk][kt][j] = e; sum += e; }
            sum += __shfl_xor(sum, 16); sum += __shfl_xor(sum, 32);
            const float invs = 1.f / sum;
            f32x4 oacc[4];
#pragma unroll
            for (int dt = 0; dt < 4; ++dt) oacc[dt] = (f32x4){0.f, 0.f, 0.f, 0.f};
            bf16_t* VT = KL;
#pragma unroll
            for (int blk = 0; blk < 4; ++blk) {
                if (blk < nblk) {
#pragma unroll
                    for (int u = 0; u < 8; ++u) {
                        const int rho = ((u >> 2) << 5) + ((((2 * u) & 3) + (ks >> 2)) << 3) + (((u >> 1) & 1) << 2) + (ks & 3);
                        *(u32x4*)(VT + rho * 72 + dg * 8) = vreg[u];
                    }
                    if (blk + 1 < nblk) {
#pragma unroll
                        for (int u = 0; u < 8; ++u) vreg[u] = *(const u32x4*)(vb + (size_t)list[(blk + 1) * 64 + u * 8 + ks] * 256);
                    }
                    lds_order();
#pragma unroll
                    for (int s2 = 0; s2 < 2; ++s2) {
                        u32x4 pw;
                        pw[0] = cvt_pk_bf16(sreg[blk][2 * s2][0], sreg[blk][2 * s2][1]); pw[1] = cvt_pk_bf16(sreg[blk][2 * s2][2], sreg[blk][2 * s2][3]);
                        pw[2] = cvt_pk_bf16(sreg[blk][2 * s2 + 1][0], sreg[blk][2 * s2 + 1][1]); pw[3] = cvt_pk_bf16(sreg[blk][2 * s2 + 1][2], sreg[blk][2 * s2 + 1][3]);
                        const bf16x8 pf = __builtin_bit_cast(bf16x8, pw);
#pragma unroll
                        for (int dt = 0; dt < 4; ++dt) {
                            const LAS unsigned char* vp = (const LAS unsigned char*)VT + ((32 * s2 + 8 * quadc + (l15c >> 2)) * 72) * 2 + dt * 32 + (l15c & 3) * 8;
                            const v4i16_t t0 = __builtin_amdgcn_ds_read_tr16_b64_v4i16((LAS v4i16_t*)vp);
                            const v4i16_t t1 = __builtin_amdgcn_ds_read_tr16_b64_v4i16((LAS v4i16_t*)(vp + 4 * 72 * 2));
                            const bf16x8 af2 = (bf16x8){t0[0], t0[1], t0[2], t0[3], t1[0], t1[1], t1[2], t1[3]};
                            oacc[dt] = __builtin_amdgcn_mfma_f32_16x16x32_bf16(af2, pf, oacc[dt], 0, 0, 0);
                        }
                    }
                    lds_order();
                }
            }
            if (l15c < 4) {
                bf16_t* yo = (DUMMY || dummy_c) ? ((bf16_t*)(ws + WS_MG + 48 * MiB) + (r0 + qi) * 512 + (g * 4 + l15c) * 64 + quadc * 4) : (P + (r0 + qi) * LDP + C_AQ + (g * 4 + l15c) * 64 + quadc * 4);
#pragma unroll
                for (int dt = 0; dt < 4; ++dt) {
                    const f32x4 v = oacc[dt] * invs;
                    u32x2 w; w[0] = cvt_pk_bf16(v[0], v[1]); w[1] = cvt_pk_bf16(v[2], v[3]);
                    *(u32x2*)(yo + dt * 16) = w;
                }
            }
        }
        lds_fence(); __builtin_amdgcn_s_barrier();
    }
#undef DSA_LOAD_ITEM
}

__device__ __forceinline__ float logsigmoidf_(float x) { return fminf(x, 0.f) - log1pf(__expf(-fabsf(x))); }
__device__ __forceinline__ float wave_incl_sum(float v, int lane) {
#pragma unroll
    for (int o = 1; o < 64; o <<= 1) { const float t = __shfl_up(v, o); if (lane >= o) v += t; }
    return v;
}
__device__ __forceinline__ float wave_incl_max(float v, int lane) {
#pragma unroll
    for (int o = 1; o < 64; o <<= 1) { const float t = __shfl_up(v, o); if (lane >= o) v = fmaxf(v, t); }
    return v;
}
__device__ __forceinline__ f32x4 mma_lds(const bf16_t* A, int lda, const bf16_t* Bt, int ldb, int K, int lane) {
    f32x4 acc = (f32x4){0.f, 0.f, 0.f, 0.f};
    const bf16_t* ap = A + (lane & 15) * lda + (lane >> 4) * 8; const bf16_t* bp = Bt + (lane & 15) * ldb + (lane >> 4) * 8;
    for (int k = 0; k < K; k += 32) acc = __builtin_amdgcn_mfma_f32_16x16x32_bf16(*(const bf16x8*)(ap + k), *(const bf16x8*)(bp + k), acc, 0, 0, 0);
    return acc;
}

__device__ __forceinline__ void phase_mlstm_a(const Args& a, unsigned char* lds) {
    unsigned char* ws = a.ws;
    const bf16_t* P = (const bf16_t*)(ws + WS_P); const bf16_t* QK = (const bf16_t*)(ws + WS_QK); const float* SM = (const float*)(ws + WS_SM);
    float* ST = (float*)(ws + WS_XB); float* DN = (float*)(ws + WS_DN); float* ML = (float*)(ws + WS_ML); float* BL = (float*)(ws + WS_BL);
    bf16_t* VT = (bf16_t*)lds;
    bf16_t* KT = (bf16_t*)(lds + 18432);
    float* WS_ = (float*)(lds + 18432 + 9216);
    const int tid = threadIdx.x, wave = tid >> 6, lane = tid & 63;
    for (int item = blockIdx.x; item < 4096; item += gridDim.x) {
        const int c = item & 127, h = (item >> 7) & 3, b = item >> 9;
        const size_t r0 = (size_t)b * SEQ + c * 64;
        if (wave == 0) {
            const float ig = SM[(r0 + lane) * 16 + 8 + h] + a.in[I_BI][h];
            const float lf = logsigmoidf_(SM[(r0 + lane) * 16 + 12 + h] + a.in[I_BF][h]);
            const float bs = wave_incl_sum(lf, lane);
            const float bl = __shfl(bs, 63);
            const float wk = bl - bs + ig;
            const float ml = wave_max(wk);
            WS_[lane] = __expf(wk - ml);
            if (lane == 0) { ML[item] = ml; BL[item] = bl; }
        }
        for (int i = tid; i < 1024; i += 512) { const int s = i >> 4, d0 = (i & 15) * 8; float f[8]; unpack8(*(const u32x4*)(P + (r0 + s) * LDP + C_MV + h * 128 + d0), f);
#pragma unroll
            for (int e = 0; e < 8; ++e) VT[(d0 + e) * 72 + s] = f2bf(f[e]); }
        __syncthreads();
        { const int s = tid >> 3, d0 = (tid & 7) * 8; float f[8]; unpack8(*(const u32x4*)(QK + (r0 + s) * 512 + 256 + h * 64 + d0), f); const float w = WS_[s];
#pragma unroll
            for (int e = 0; e < 8; ++e) KT[(d0 + e) * 72 + s] = f2bf(f[e] * w); }
        __syncthreads();
        float* st = ST + (size_t)item * 8192;
#pragma unroll
        for (int nt = 0; nt < 4; ++nt) {
            const f32x4 acc = mma_lds(VT + wave * 16 * 72, 72, KT + nt * 16 * 72, 72, 64, lane);
#pragma unroll
            for (int j = 0; j < 4; ++j) st[(wave * 16 + (lane >> 4) * 4 + j) * 64 + nt * 16 + (lane & 15)] = acc[j];
        }
        if (tid < 64) { float s = 0.f; for (int k = 0; k < 64; ++k) s += bf1(KT[tid * 72 + k]); DN[item * 64 + tid] = s; }
        __syncthreads();
    }
}
__device__ __forceinline__ void phase_mlstm_b(const Args& a) {
    unsigned char* ws = a.ws;
    float* ST = (float*)(ws + WS_XB); float* DN = (float*)(ws + WS_DN); const float* ML = (const float*)(ws + WS_ML); const float* BL = (const float*)(ws + WS_BL); float* MS = (float*)(ws + WS_MS);
    const int total = 32 * 8256;
    for (int w = blockIdx.x * 512 + threadIdx.x; w < total; w += gridDim.x * 512) {
        const int bh = w / 8256, e = w % 8256;
        float* p; int stride;
        if (e < 8192) { p = ST + (size_t)bh * 128 * 8192 + e; stride = 8192; } else { p = DN + (size_t)bh * 128 * 64 + (e - 8192); stride = 64; }
        float C = 0.f, m = 0.f;
        for (int c0 = 0; c0 < 128; c0 += 8) {
            float d[8], bl[8], ml[8];
#pragma unroll
            for (int u = 0; u < 8; ++u) { d[u] = p[(size_t)(c0 + u) * stride]; bl[u] = BL[bh * 128 + c0 + u]; ml[u] = ML[bh * 128 + c0 + u]; }
#pragma unroll
            for (int u = 0; u < 8; ++u) {
                p[(size_t)(c0 + u) * stride] = C;
                if (e == 0) MS[bh * 128 + c0 + u] = m;
                const float mn = fmaxf(bl[u] + m, ml[u]);
                C = __expf(bl[u] + m - mn) * C + __expf(ml[u] - mn) * d[u];
                m = mn;
            }
        }
    }
}
__device__ __forceinline__ void phase_mlstm_c(const Args& a, unsigned char* lds) {
    unsigned char* ws = a.ws;
    bf16_t* P = (bf16_t*)(ws + WS_P); const bf16_t* QK = (const bf16_t*)(ws + WS_QK); const float* SM = (const float*)(ws + WS_SM);
    const float* ST = (const float*)(ws + WS_XB); const float* DN = (const float*)(ws + WS_DN); const float* MS = (const float*)(ws + WS_MS);
    bf16_t* QS_ = (bf16_t*)lds;
    bf16_t* KS = (bf16_t*)(lds + 9216);
    bf16_t* AP = (bf16_t*)(lds + 18432);
    bf16_t* BT = (bf16_t*)(lds + 18432 + 17408);
    float* OUT = (float*)(lds + 18432 + 17408 + 34816);
    float* GS = (float*)(lds + 18432 + 17408 + 34816 + 33792);
    float* bS = GS; float* aS = GS + 64; float* mtS = GS + 128; float* wiS = GS + 192; float* nS = GS + 256; float* denS = GS + 320;
    const int tid = threadIdx.x, wave = tid >> 6, lane = tid & 63;
    for (int item = blockIdx.x; item < 4096; item += gridDim.x) {
        const int c = item & 127, h = (item >> 7) & 3, b = item >> 9;
        const size_t r0 = (size_t)b * SEQ + c * 64;
        if (wave == 0) {
            const float ig = SM[(r0 + lane) * 16 + 8 + h] + a.in[I_BI][h];
            const float lf = logsigmoidf_(SM[(r0 + lane) * 16 + 12 + h] + a.in[I_BF][h]);
            const float bs = wave_incl_sum(lf, lane);
            const float av = ig - bs;
            const float pm = wave_incl_max(av, lane);
            const float m0 = MS[item];
            const float mt = bs + fmaxf(pm, m0);
            bS[lane] = bs; aS[lane] = av; mtS[lane] = mt; wiS[lane] = __expf(bs + m0 - mt);
            nS[lane] = DN[item * 64 + lane];
        }
        { const int s = tid >> 3, d0 = (tid & 7) * 8;
            *(u32x4*)(QS_ + s * 72 + d0) = *(const u32x4*)(QK + (r0 + s) * 512 + h * 64 + d0);
            *(u32x4*)(KS + s * 72 + d0) = *(const u32x4*)(QK + (r0 + s) * 512 + 256 + h * 64 + d0); }
        for (int i = tid; i < 1024; i += 512) { const int s = i >> 4, d0 = (i & 15) * 8; float f[8]; unpack8(*(const u32x4*)(P + (r0 + s) * LDP + C_MV + h * 128 + d0), f);
#pragma unroll
            for (int e = 0; e < 8; ++e) BT[(d0 + e) * 136 + s] = f2bf(f[e]); }
        { const float* st = ST + (size_t)item * 8192;
            for (int i = tid; i < 2048; i += 512) { const int dv = i >> 4, k0 = (i & 15) * 4; const f32x4 v = *(const f32x4*)(st + dv * 64 + k0);
                *(unsigned*)(BT + dv * 136 + 64 + k0) = cvt_pk_bf16(v[0], v[1]); *(unsigned*)(BT + dv * 136 + 64 + k0 + 2) = cvt_pk_bf16(v[2], v[3]); } }
        __syncthreads();
#pragma unroll
        for (int u = 0; u < 2; ++u) {
            const int id = wave * 2 + u, tr = id >> 2, tc = id & 3;
            f32x4 acc = (f32x4){0.f, 0.f, 0.f, 0.f};
            if (tc <= tr) acc = mma_lds(QS_ + tr * 16 * 72, 72, KS + tc * 16 * 72, 72, 64, lane);
            const int s = tc * 16 + (lane & 15);
#pragma unroll
            for (int j = 0; j < 4; ++j) { const int t = tr * 16 + (lane >> 4) * 4 + j;
                const float w = (s <= t) ? acc[j] * __expf(bS[t] + aS[s] - mtS[t]) : 0.f;
                AP[t * 136 + s] = f2bf(w); }
        }
        { const int t = tid >> 3, d0 = (tid & 7) * 8; float f[8]; unpack8(*(const u32x4*)(QS_ + t * 72 + d0), f); const float w = wiS[t];
#pragma unroll
            for (int e = 0; e < 8; ++e) f[e] *= w;
            *(u32x4*)(AP + t * 136 + 64 + d0) = pack8(f); }
        __syncthreads();
#pragma unroll
        for (int tr = 0; tr < 4; ++tr) {
            const f32x4 acc = mma_lds(AP + tr * 16 * 136, 136, BT + wave * 16 * 136, 136, 128, lane);
#pragma unroll
            for (int j = 0; j < 4; ++j) OUT[(tr * 16 + (lane >> 4) * 4 + j) * 132 + wave * 16 + (lane & 15)] = acc[j];
        }
        { const int t = tid >> 3, part = tid & 7; float s = 0.f;
#pragma unroll
            for (int e = 0; e < 16; ++e) { const int k = part * 16 + e; const float v = bf1(AP[t * 136 + k]); s += (k < 64) ? v : v * nS[k - 64]; }
            s += __shfl_xor(s, 1); s += __shfl_xor(s, 2); s += __shfl_xor(s, 4);
            if (part == 0) denS[t] = s; }
        __syncthreads();
        { const int t = tid >> 3, part = tid & 7, dv0 = part * 16;
            const float den = fmaxf(fabsf(denS[t]), __expf(-mtS[t])); const float inv = 1.f / den;
            float hv[16]; float sq = 0.f;
#pragma unroll
            for (int e = 0; e < 16; ++e) { hv[e] = OUT[t * 132 + dv0 + e] * inv; sq += hv[e] * hv[e]; }
            sq += __shfl_xor(sq, 1); sq += __shfl_xor(sq, 2); sq += __shfl_xor(sq, 4);
            const float rs = rsqrtf(sq * (1.f / 128.f) + EPS);
            bf16_t* po = P + (r0 + t) * LDP + C_MO + h * 128 + dv0;
            float og[16]; unpack8(*(const u32x4*)po, og); unpack8(*(const u32x4*)(po + 8), og + 8);
#pragma unroll
            for (int e = 0; e < 16; ++e) hv[e] = hv[e] * rs * a.in[I_MHN][h * 128 + dv0 + e] * sigmoidf_(og[e]);
            *(u32x4*)po = pack8(hv); *(u32x4*)(po + 8) = pack8(hv + 8); }
        __syncthreads();
    }
}


#define XB_TMO      128
#define XB_XCNT(j)  (256  + 64 * (j))
#define XB_XSUB(j)  (1280 + 64 * (j))
#define XB_XGEN(j)  (2304 + 64 * (j))
#define XB_TOP      3328
#define XB_TOPGEN   3392
#define XCD_BAR_WORDS 3456
#define XB_SPIN_CAP (1u << 22)
__device__ __forceinline__ unsigned xb_ld(unsigned* p)              { return __hip_atomic_load(p, __ATOMIC_RELAXED, __HIP_MEMORY_SCOPE_AGENT); }
__device__ __forceinline__ unsigned xb_add(unsigned* p, unsigned v) { return __hip_atomic_fetch_add(p, v, __ATOMIC_RELAXED, __HIP_MEMORY_SCOPE_AGENT); }
__device__ __forceinline__ unsigned xb_xcc_id() { return (unsigned)__builtin_amdgcn_s_getreg((3 << 11) | 20) & 0xFu; }
#define XB_SPIN(cond, bar) do { unsigned _sp = 0; while (cond) { __builtin_amdgcn_s_sleep(1); \
    if ((++_sp & 255u) == 0u) { if (xb_ld(&(bar)[XB_TMO])) break; if (_sp > XB_SPIN_CAP) { atomicAdd(&(bar)[XB_TMO], 1u); break; } } } } while (0)
struct XcdBarrier { unsigned* bar; unsigned x; volatile LAS unsigned* st; };
__device__ __forceinline__ XcdBarrier xcd_barrier_post(unsigned* bar, volatile LAS unsigned* st) {
    XcdBarrier b; b.bar = bar; b.x = xb_xcc_id(); b.st = st;
    if (threadIdx.x == 0) (void)xb_add(&bar[XB_XCNT(b.x)], 1u);
    return b;
}
__device__ __forceinline__ void xcd_barrier_complete(unsigned* bar, unsigned x, unsigned& nloc, unsigned& nx) {
    const unsigned G = gridDim.x * gridDim.y * gridDim.z;
    unsigned sum, cnt, mine, sp = 0u;
    for (;;) {
        sum = 0u; cnt = 0u; mine = 0u;
#pragma unroll
        for (unsigned j = 0; j < 16; ++j) { const unsigned c = xb_ld(&bar[XB_XCNT(j)]); sum += c; cnt += (c > 0u) ? 1u : 0u; mine = (j == x) ? c : mine; }
        if (sum == G) break;
        __builtin_amdgcn_s_sleep(1);
        if ((++sp & 255u) == 0u) { if (xb_ld(&bar[XB_TMO])) break; if (sp > XB_SPIN_CAP) { atomicAdd(&bar[XB_TMO], 1u); break; } }
    }
    nloc = mine > 0u ? mine : 1u; nx = cnt > 0u ? cnt : 1u;
}
__device__ __forceinline__ void xcd_barrier(const XcdBarrier& b) {
    asm volatile("s_waitcnt vmcnt(0)" ::: "memory");
    __syncthreads();
    if (threadIdx.x == 0) {
        unsigned* bar = b.bar;
        __builtin_amdgcn_s_waitcnt(0);
        unsigned nloc = b.st[0], nx = b.st[1];
        if (nloc == 0u) { xcd_barrier_complete(bar, b.x, nloc, nx); b.st[0] = nloc; b.st[1] = nx; }
        const unsigned old = xb_add(&bar[XB_XSUB(b.x)], 1u);
        const unsigned gen = old / nloc;
        if (old + 1u == (gen + 1u) * nloc) {
            __builtin_amdgcn_fence(__ATOMIC_RELEASE, "agent");
            asm volatile("s_waitcnt vmcnt(0)" ::: "memory");
            const unsigned og = xb_add(&bar[XB_TOP], 1u);
            const unsigned tg = og / nx;
            if (og + 1u == (tg + 1u) * nx) xb_add(&bar[XB_TOPGEN], 1u);
            else XB_SPIN(xb_ld(&bar[XB_TOPGEN]) == tg, bar);
            __builtin_amdgcn_fence(__ATOMIC_ACQUIRE, "agent");
            xb_add(&bar[XB_XGEN(b.x)], 1u);
            asm volatile("s_waitcnt vmcnt(0)" ::: "memory");
        } else {
            XB_SPIN(xb_ld(&bar[XB_XGEN(b.x)]) == gen, bar);
            __builtin_amdgcn_fence(__ATOMIC_ACQUIRE, "agent");
            asm volatile("s_waitcnt vmcnt(0)" ::: "memory");
        }
    }
    __syncthreads();
}

#ifndef DBG_ZERO_YA
#define DBG_ZERO_YA 1
#endif
#ifndef PH
#define PH 0xFFFF
#endif
__global__ void __launch_bounds__(512, 2) mega_fwd(Args a) {
    extern __shared__ __attribute__((aligned(16))) unsigned char lds[];
    cg::grid_group grid = cg::this_grid();
    LAS unsigned char* ldsl = (LAS unsigned char*)lds;
    unsigned char* ws = a.ws;
    const int G = gridDim.x, bid = blockIdx.x;
    bf16_t* XB = (bf16_t*)(ws + WS_XB); bf16_t* Pb = (bf16_t*)(ws + WS_P); bf16_t* MG = (bf16_t*)(ws + WS_MG); bf16_t* QKb = (bf16_t*)(ws + WS_QK);
    float* ss0 = (float*)(ws + WS_SS0); float* ss1 = (float*)(ws + WS_SS1); float* ss2 = (float*)(ws + WS_SS2);

    unsigned* barw = (unsigned*)(ws + WS_BAR);
    if (bid == 0) { for (int i = threadIdx.x; i < XCD_BAR_WORDS; i += 512) barw[i] = 0u; }
    volatile LAS unsigned* bst = (volatile LAS unsigned*)(ldsl + LDS_BYTES - 16);
    if (threadIdx.x == 0) { bst[0] = 0u; bst[1] = 0u; }
    if (PH & 1) phase0(a, lds);
    __threadfence();
    grid.sync();
    const XcdBarrier xbar = xcd_barrier_post(barw, bst);
    if (PH & 2) {
        pg8::Gemm g{XB, (const bf16_t*)(ws + WS_W1), DM, DM, MROWS, 2 * FF, DM}; pg8::StaticOrder S; S.init(MROWS, 2 * FF, G, bid);
        pg8::EpiSwiGLU E{Pb, ss0}; pg8::gemm_phase(ldsl, g, S, E);
    }
    xcd_barrier(xbar);
    if (PH & 4) {
        pg8::Gemm g{Pb, (const bf16_t*)(ws + WS_W2), FF, FF, MROWS, DM, FF}; pg8::StaticOrder S; S.init(MROWS, DM, G, bid);
        pg8::EpiRes<false, false, true> E{a.in[I_X], nullptr, nullptr, XB, (bf16_t*)a.out, ss1, 0.5f}; pg8::gemm_phase(ldsl, g, S, E);
    }
    xcd_barrier(xbar);
    if (PH & 8) {
        pg8::Gemm g{XB, (const bf16_t*)(ws + WS_WIN), DM, DM, MROWS, LDP, DM}; pg8::StaticOrder S; S.init(MROWS, LDP, G, bid);
        pg8::EpiP E{Pb, (float*)(ws + WS_SM), ss1}; pg8::gemm_phase(ldsl, g, S, E);
    }
    xcd_barrier(xbar);
    if (PH & 16) phase_postp(a);
    xcd_barrier(xbar);
    if (PH & 32) {
        pg8::Gemm g{XB, (const bf16_t*)(ws + WS_WQK), 512, 512, MROWS, 512, 512}; pg8::StaticOrder S; S.init(MROWS, 512, G, bid);
        pg8::EpiBf16 E{QKb, 512}; pg8::gemm_phase(ldsl, g, S, E);
    }
    xcd_barrier(xbar);
    if (PH & 64) phase_mlstm_a(a, lds);
    xcd_barrier(xbar);
    if (PH & 128) phase_mlstm_b(a);
    xcd_barrier(xbar);
    if (PH & 256) phase_mlstm_c(a, lds);
    if (DBG_TWICE & 1) phase_dsa<true>(a, lds);
    if (PH & 512) phase_dsa<false>(a, lds);
    xcd_barrier(xbar);
    if (PH & 1024) {
        pg8::StaticOrder S; S.init(MROWS, DM, G, bid);
        { pg8::Gemm g{Pb + C_AQ, (const bf16_t*)(ws + WS_WA), LDP, 512, MROWS, DM, 512}; pg8::EpiMerge<0> E{Pb, MG, C_GA}; pg8::gemm_phase(ldsl, g, S, E); }
        { pg8::Gemm g{Pb + C_MO, (const bf16_t*)(ws + WS_WB), LDP, 512, MROWS, DM, 512}; pg8::EpiMerge<1> E{Pb, MG, C_GB}; pg8::gemm_phase(ldsl, g, S, E); }
    }
    xcd_barrier(xbar);
    if (PH & 2048) {
        pg8::Gemm g{MG, (const bf16_t*)(ws + WS_WO), DM, DM, MROWS, DM, DM}; pg8::StaticOrder S; S.init(MROWS, DM, G, bid);
        pg8::EpiRes<true, false, true> E{nullptr, (const bf16_t*)a.out, nullptr, XB, nullptr, ss2, 1.0f}; pg8::gemm_phase(ldsl, g, S, E);
    }
    xcd_barrier(xbar);
    if (PH & 4096) {
        pg8::Gemm g{XB, (const bf16_t*)(ws + WS_W3), DM, DM, MROWS, 2 * FF, DM}; pg8::StaticOrder S; S.init(MROWS, 2 * FF, G, bid);
        pg8::EpiSwiGLU E{Pb, ss2}; pg8::gemm_phase(ldsl, g, S, E);
    }
    xcd_barrier(xbar);
    if (PH & 8192) {
        pg8::Gemm g{Pb, (const bf16_t*)(ws + WS_W4), FF, FF, MROWS, DM, FF}; pg8::StaticOrder S; S.init(MROWS, DM, G, bid);
        pg8::EpiRes<true, true, false> E{nullptr, XB, a.out, nullptr, nullptr, nullptr, 0.5f}; pg8::gemm_phase(ldsl, g, S, E);
    }
}

extern "C" void kernel_launch(void* const* d_in, const int* in_sizes, int n_in, void* d_out, int out_size, void* d_ws, size_t ws_size, hipStream_t stream) {
    static int grid = 0;
    if (grid == 0) {
        if (n_in != 24 || ws_size < WS_END) { fprintf(stderr, "kernel_launch: unexpected n_in %d / ws %zu\n", n_in, ws_size); grid = -1; return; }
        int dev = 0, cus = 0, per_cu = 0;
        hipGetDevice(&dev);
        hipDeviceGetAttribute(&cus, hipDeviceAttributeMultiprocessorCount, dev);
        hipFuncSetAttribute((const void*)mega_fwd, hipFuncAttributeMaxDynamicSharedMemorySize, LDS_BYTES);
        hipOccupancyMaxActiveBlocksPerMultiprocessor(&per_cu, (const void*)mega_fwd, 512, LDS_BYTES);
        if (per_cu < 1) { fprintf(stderr, "kernel_launch: occupancy query says %d blocks/CU\n", per_cu); per_cu = 1; }
        (void)hipGetLastError();
        grid = cus * per_cu;
    }
    if (grid < 0) return;
    Args a{};
    for (int i = 0; i < 24; ++i) a.in[i] = (const float*)d_in[i];
    a.out = (float*)d_out; a.ws = (unsigned char*)d_ws;
    void* args[] = {&a};
    hipError_t e = hipLaunchCooperativeKernel((const void*)mega_fwd, dim3(grid), dim3(512), args, LDS_BYTES, stream);
    if (e != hipSuccess) fprintf(stderr, "cooperative launch failed: %s (grid %d)\n", hipGetErrorString(e), grid);
}
```

```cpp
#include <hip/hip_runtime.h>
#include <hip/hip_cooperative_groups.h>
#include <cstdio>
#include <cstdint>
namespace cg = cooperative_groups;
#define DBG_ZERO_YA 0
#define DBG_TWICE 0
#define DBG_NOSEL 0

#define LAS __attribute__((address_space(3)))
typedef unsigned short bf16_t;
typedef short bf16x8 __attribute__((ext_vector_type(8)));
typedef float f32x4 __attribute__((ext_vector_type(4)));
typedef unsigned u32x4 __attribute__((ext_vector_type(4)));
typedef unsigned u32x2 __attribute__((ext_vector_type(2)));
typedef __bf16 bf2_t __attribute__((ext_vector_type(2)));
typedef short v4i16_t __attribute__((ext_vector_type(4)));

constexpr int MROWS = 65536, DM = 1024, FF = 2816, SEQ = 8192, NB = 8;
constexpr int LDP = 5120;
constexpr int C_AQ = 0, C_AK = 512, C_AV = 640, C_IQ = 768, C_IK = 1280, C_MX = 1344, C_MV = 1856, C_MO = 2368, C_GA = 2880, C_GB = 3904, C_SM = 4928;
constexpr float EPS = 1e-6f;
constexpr size_t MiB = 1u << 20;
constexpr size_t WS_SS0 = 0, WS_SS1 = 256 * 1024, WS_SS2 = 512 * 1024;
constexpr size_t WS_DN = 1 * MiB;
constexpr size_t WS_ML = 2 * MiB, WS_BL = 2 * MiB + 16384, WS_MS = 2 * MiB + 32768;
constexpr size_t WS_BAR = 2 * MiB + 65536;
constexpr size_t WS_SM = 3 * MiB;
constexpr size_t WS_W1 = 8 * MiB, WS_W2 = 19 * MiB, WS_W3 = 25 * MiB, WS_W4 = 36 * MiB, WS_WIN = 42 * MiB, WS_WA = 52 * MiB, WS_WB = 53 * MiB, WS_WO = 54 * MiB, WS_WQK = 56 * MiB;
constexpr size_t WS_XB = 64 * MiB;
constexpr size_t WS_P = 192 * MiB;
constexpr size_t WS_MG = 832 * MiB;
constexpr size_t WS_IKC = 832 * MiB;
constexpr size_t WS_KVC = 840 * MiB;
constexpr size_t WS_QK = 960 * MiB;
constexpr size_t WS_END = 1024 * MiB;
constexpr int LDS_BYTES = 156 * 1024;

__device__ __forceinline__ unsigned cvt_pk_bf16(float lo, float hi) { unsigned r; asm volatile("v_cvt_pk_bf16_f32 %0, %1, %2" : "=v"(r) : "v"(lo), "v"(hi)); return r; }
__device__ __forceinline__ float bflo(unsigned u) { return __uint_as_float(u << 16); }
__device__ __forceinline__ float bfhi(unsigned u) { return __uint_as_float(u & 0xffff0000u); }
__device__ __forceinline__ float bf1(bf16_t u) { return __uint_as_float(((unsigned)u) << 16); }
__device__ __forceinline__ bf16_t f2bf(float f) { return (bf16_t)(cvt_pk_bf16(f, 0.f) & 0xffffu); }
__device__ __forceinline__ bf16_t f2bf_sw(float f) { const unsigned u = __float_as_uint(f); return (bf16_t)((u + 0x7fffu + ((u >> 16) & 1u)) >> 16); }
__device__ __forceinline__ float wave_sum(float v) {
#pragma unroll
    for (int o = 1; o < 64; o <<= 1) v += __shfl_xor(v, o);
    return v;
}
__device__ __forceinline__ float wave_max(float v) {
#pragma unroll
    for (int o = 1; o < 64; o <<= 1) v = fmaxf(v, __shfl_xor(v, o));
    return v;
}
__device__ __forceinline__ float sigmoidf_(float x) { return __builtin_amdgcn_rcpf(1.f + __expf(-x)); }
__device__ __forceinline__ float dot2bf(unsigned a, unsigned b, float c) { const unsigned aa = a, bb = b; return __builtin_amdgcn_fdot2_f32_bf16(__builtin_bit_cast(bf2_t, aa), __builtin_bit_cast(bf2_t, bb), c, false); }
__device__ __forceinline__ float relu_(float x) { const int i = __float_as_int(x); return __int_as_float(i > 0 ? i : 0); }
__device__ __forceinline__ void lds_order() { asm volatile("" ::: "memory"); }
__device__ __forceinline__ void lds_fence() { asm volatile("s_waitcnt lgkmcnt(0)" ::: "memory"); }
__device__ __forceinline__ void unpack8(u32x4 v, float* f) {
    f[0] = bflo(v.x); f[1] = bfhi(v.x); f[2] = bflo(v.y); f[3] = bfhi(v.y); f[4] = bflo(v.z); f[5] = bfhi(v.z); f[6] = bflo(v.w); f[7] = bfhi(v.w);
}
__device__ __forceinline__ u32x4 pack8(const float* f) {
    u32x4 o; o.x = cvt_pk_bf16(f[0], f[1]); o.y = cvt_pk_bf16(f[2], f[3]); o.z = cvt_pk_bf16(f[4], f[5]); o.w = cvt_pk_bf16(f[6], f[7]); return o;
}

namespace pg8 {
constexpr int BM = 256, BK = 64, HALF = 128, HTB = HALF * BK * 2, NXCD = 8, WGM = 8;
__host__ __device__ __forceinline__ int lds_byte(int r, int c) { const int st = (r >> 4) * 2 + (c >> 5), rr = r & 15, cc = c & 31, ob = rr * 64 + cc * 2; return st * 1024 + (ob ^ (((ob >> 9) & 1) << 5)); }
__host__ __device__ __forceinline__ void stage_rc(int b, int& R, int& C) { const int st = b / 1024, sb = b % 1024, swz = sb ^ (((sb >> 9) & 1) << 5); R = (st >> 1) * 16 + swz / 64; C = (st & 1) * 32 + (swz % 64) / 2; }
__host__ __device__ __forceinline__ int perm32(int rho) { const int n = rho >> 4, i = rho & 15; return 8 * (i >> 2) + 4 * n + (i & 3); }
struct Unit { int pm, pn; };
struct Gemm { const bf16_t* A; const bf16_t* Bt; int lda, ldb, M, N, K; };
struct StaticOrder {
    int nM, nN, nwg, G, c;
    __device__ void init(int M, int N, int G_, int c_) { nM = M / BM; nN = N / BM; nwg = nM * nN; G = G_; c = c_; }
    __device__ bool next(int i, Unit& u) const {
        const long L = (long)i * G + c; if (L >= nwg) return false;
        int wgid = (int)L; { const int q = nwg / NXCD, r = nwg % NXCD, xcd = wgid % NXCD, off = wgid / NXCD; wgid = (xcd < r ? xcd * (q + 1) : r * (q + 1) + (xcd - r) * q) + off; }
        const int nig = WGM * nN, gid = wgid / nig, fm = gid * WGM, gsz = (nM - fm) < WGM ? (nM - fm) : WGM;
        u.pm = fm + ((wgid % nig) % gsz); u.pn = (wgid % nig) / gsz; return true;
    }
};

template <class Epi>
__device__ __forceinline__ void gemm_phase(LAS unsigned char* lds, const Gemm g, const StaticOrder& S, const Epi& E) {
    int tid_ = threadIdx.x; asm volatile("" : "+v"(tid_));
    const int tid = tid_, wid = __builtin_amdgcn_readfirstlane(tid >> 6), lane = tid & 63, wr = wid >> 2, wc = wid & 3, fr = lane & 15, fq = lane >> 4;
    const int K = g.K, nt = K / BK;
    unsigned voffA[2], voffB[2];
#pragma unroll
    for (int i = 0; i < 2; ++i) { int R, C; stage_rc(tid * 16 + i * 8192, R, C); const int Rb = (R & ~31) + perm32(R & 31);
        voffA[i] = (unsigned)(R * g.lda + C) * 2u; voffB[i] = (unsigned)(Rb * g.ldb + C) * 2u; }
    const size_t kstep = (size_t)(BK * 2);
    const size_t hsA = (size_t)HALF * g.lda * 2, hsB = (size_t)HALF * g.ldb * 2;
    const size_t tsA = 2 * hsA, tsB = 2 * hsB;
    const unsigned ldsw = (unsigned)wid * 1024u;
    const int aoff = lds_byte(wr * 64 + fr, fq * 8), boff = lds_byte(wc * 32 + fr, fq * 8);
#define PG8_SA(b, h) (((b) * 2 + (h)) * HTB)
#define PG8_SB(b, h) ((4 + (b) * 2 + (h)) * HTB)
#define PG8_STAGE(bufoff, gbase, voff) do { _Pragma("unroll") for (int _i = 0; _i < 2; ++_i) \
        __builtin_amdgcn_global_load_lds((const unsigned*)((const char*)(gbase) + (voff)[_i]), (LAS unsigned*)(lds + (bufoff) + ldsw + _i * 8192), 16, 0, 0); } while (0)
#define PG8_LDA(dst, b, h) do { _Pragma("unroll") for (int m = 0; m < 4; ++m) _Pragma("unroll") for (int k = 0; k < 2; ++k) dst[m][k] = *(const LAS bf16x8*)(lds + PG8_SA(b, h) + aoff + m * 2048 + k * 1024); } while (0)
#define PG8_LDB(dst, b, h) do { _Pragma("unroll") for (int n = 0; n < 2; ++n) _Pragma("unroll") for (int k = 0; k < 2; ++k) dst[n][k] = *(const LAS bf16x8*)(lds + PG8_SB(b, h) + boff + n * 2048 + k * 1024); } while (0)
#define PG8_MMA(ai, bj, At, Bt) do { __builtin_amdgcn_s_setprio(1); _Pragma("unroll") for (int m = 0; m < 4; ++m) _Pragma("unroll") for (int n = 0; n < 2; ++n) _Pragma("unroll") for (int k = 0; k < 2; ++k) \
        acc[ai][bj][m][n] = __builtin_amdgcn_mfma_f32_16x16x32_bf16(Bt[n][k], At[m][k], acc[ai][bj][m][n], 0, 0, 0); __builtin_amdgcn_s_setprio(0); } while (0)
#define PG8_WAIT_V(n) asm volatile("s_waitcnt vmcnt(" #n ")" ::: "memory")
#define PG8_WAIT_L(n) asm volatile("s_waitcnt lgkmcnt(" #n ")" ::: "memory")
#define PG8_BAR __builtin_amdgcn_s_barrier()
#define PG8_SCHED __builtin_amdgcn_sched_barrier(0)
    Unit cur, nxt; int ui = 0;
    if (!S.next(0, cur)) return;
    f32x4 acc[2][2][4][2];
#pragma unroll
    for (int a = 0; a < 2; ++a)
#pragma unroll
        for (int b = 0; b < 2; ++b)
#pragma unroll
            for (int m = 0; m < 4; ++m)
#pragma unroll
                for (int n = 0; n < 2; ++n) acc[a][b][m][n] = (f32x4){0.f, 0.f, 0.f, 0.f};
    bf16x8 At[4][2], B0[2][2], B1[2][2];
    const char* cA = (const char*)g.A + (size_t)cur.pm * tsA; const char* cB = (const char*)g.Bt + (size_t)cur.pn * tsB;
    PG8_STAGE(PG8_SB(0, 0), cB, voffB); PG8_STAGE(PG8_SB(0, 1), cB + hsB, voffB); PG8_STAGE(PG8_SA(0, 0), cA, voffA); PG8_STAGE(PG8_SA(0, 1), cA + hsA, voffA);
    if (wr == 1) PG8_BAR;
    PG8_WAIT_V(2); PG8_BAR;
    PG8_STAGE(PG8_SB(1, 0), cB + kstep, voffB); PG8_STAGE(PG8_SA(1, 0), cA + kstep, voffA); PG8_STAGE(PG8_SB(1, 1), cB + hsB + kstep, voffB);
    PG8_WAIT_V(6); PG8_BAR;
    for (;;) {
        const bool has_next = S.next(ui + 1, nxt);
        const char* nA = has_next ? (const char*)g.A + (size_t)nxt.pm * tsA : cA; const char* nB = has_next ? (const char*)g.Bt + (size_t)nxt.pn * tsB : cB;
        for (int t = 0; t < nt; t += 2) {
            const bool last = (t == nt - 2);
            const char* a1 = cA + (size_t)(t + 1) * kstep;
            const char* a2 = last ? nA : cA + (size_t)(t + 2) * kstep; const char* b2 = last ? nB : cB + (size_t)(t + 2) * kstep;
            const char* a3 = a2 + kstep; const char* b3 = b2 + kstep;
            PG8_LDB(B0, 0, 0); PG8_LDB(B1, 0, 1); PG8_SCHED; PG8_LDA(At, 0, 0); PG8_STAGE(PG8_SA(1, 1), a1 + hsA, voffA);
            PG8_WAIT_V(8); PG8_WAIT_L(0); PG8_BAR; PG8_MMA(0, 0, At, B0); PG8_MMA(0, 1, At, B1); PG8_BAR; PG8_SCHED;
            PG8_LDA(At, 0, 1); PG8_STAGE(PG8_SB(0, 0), b2, voffB); PG8_STAGE(PG8_SB(0, 1), b2 + hsB, voffB); PG8_STAGE(PG8_SA(0, 0), a2, voffA);
            PG8_WAIT_V(8); PG8_WAIT_L(0); PG8_BAR; PG8_MMA(1, 0, At, B0); PG8_MMA(1, 1, At, B1); PG8_BAR; PG8_SCHED;
            PG8_LDB(B0, 1, 0); PG8_LDB(B1, 1, 1); PG8_SCHED; PG8_LDA(At, 1, 0); PG8_STAGE(PG8_SA(0, 1), a2 + hsA, voffA);
            PG8_WAIT_V(8); PG8_WAIT_L(0); PG8_BAR; PG8_MMA(0, 0, At, B0); PG8_MMA(0, 1, At, B1); PG8_BAR; PG8_SCHED;
            PG8_LDA(At, 1, 1); PG8_STAGE(PG8_SB(1, 0), b3, voffB); PG8_STAGE(PG8_SB(1, 1), b3 + hsB, voffB); PG8_STAGE(PG8_SA(1, 0), a3, voffA);
            PG8_WAIT_V(8); PG8_WAIT_L(0); PG8_BAR; PG8_MMA(1, 0, At, B0); PG8_MMA(1, 1, At, B1); PG8_BAR; PG8_SCHED;
        }
        if (wr == 0) PG8_BAR;
        E(acc, cur, wr, wc, fr, fq);
        if (!has_next) break;
#pragma unroll
        for (int a = 0; a < 2; ++a)
#pragma unroll
            for (int b = 0; b < 2; ++b)
#pragma unroll
                for (int m = 0; m < 4; ++m)
#pragma unroll
                    for (int n = 0; n < 2; ++n) acc[a][b][m][n] = (f32x4){0.f, 0.f, 0.f, 0.f};
        cur = nxt; cA = nA; cB = nB; ++ui;
        if (wr == 1) PG8_BAR;
    }
    PG8_WAIT_V(0);
    PG8_BAR;
#undef PG8_SA
#undef PG8_SB
#undef PG8_STAGE
#undef PG8_LDA
#undef PG8_LDB
#undef PG8_MMA
#undef PG8_WAIT_V
#undef PG8_WAIT_L
#undef PG8_BAR
#undef PG8_SCHED
}

typedef f32x4 AccT[2][2][4][2];
struct EpiSwiGLU {
    bf16_t* O; const float* ss;
    __device__ __forceinline__ void operator()(const AccT& acc, const Unit& u, int wr, int wc, int fr, int fq) const {
        const int row0 = u.pm * BM + wr * 64 + fr, col = u.pn * 128 + wc * 32 + 8 * fq;
#pragma unroll
        for (int ai = 0; ai < 2; ++ai)
#pragma unroll
            for (int m = 0; m < 4; ++m) {
                const int row = row0 + ai * HALF + m * 16;
                const float rs = rsqrtf(ss[row] * (1.f / 1024.f) + EPS);
                float o[8];
#pragma unroll
                for (int n = 0; n < 2; ++n)
#pragma unroll
                    for (int j = 0; j < 4; ++j) { const float gt = acc[ai][0][m][n][j] * rs, up = acc[ai][1][m][n][j] * rs; o[n * 4 + j] = gt * up * sigmoidf_(gt); }
                *(u32x4*)(O + (size_t)row * FF + col) = pack8(o);
            }
    }
};
template <bool RES_BF16, bool WRITE_F32, bool WRITE_XB> struct EpiRes {
    const float* res; const bf16_t* resb; float* out; bf16_t* xb; bf16_t* xb2; float* ss; float alpha;
    __device__ __forceinline__ void operator()(const AccT& acc, const Unit& u, int wr, int wc, int fr, int fq) const {
        const int row0 = u.pm * BM + wr * 64 + fr, col0 = u.pn * BM + wc * 32 + 8 * fq;
#pragma unroll
        for (int ai = 0; ai < 2; ++ai)
#pragma unroll
            for (int m = 0; m < 4; ++m) {
                const int row = row0 + ai * HALF + m * 16; float sq = 0.f;
#pragma unroll
                for (int bj = 0; bj < 2; ++bj) {
                    const size_t off = (size_t)row * DM + col0 + bj * HALF;
                    f32x4 r0, r1;
                    if (RES_BF16) { float f[8]; unpack8(*(const u32x4*)(resb + off), f); r0 = (f32x4){f[0], f[1], f[2], f[3]}; r1 = (f32x4){f[4], f[5], f[6], f[7]}; }
                    else { r0 = *(const f32x4*)(res + off); r1 = *(const f32x4*)(res + off + 4); }
                    const f32x4 v0 = r0 + acc[ai][bj][m][0] * alpha, v1 = r1 + acc[ai][bj][m][1] * alpha;
                    if (WRITE_F32) { *(f32x4*)(out + off) = v0; *(f32x4*)(out + off + 4) = v1; }
                    if (WRITE_XB) {
                        u32x4 w; w.x = cvt_pk_bf16(v0[0], v0[1]); w.y = cvt_pk_bf16(v0[2], v0[3]); w.z = cvt_pk_bf16(v1[0], v1[1]); w.w = cvt_pk_bf16(v1[2], v1[3]);
                        *(u32x4*)(xb + off) = w; if (xb2) *(u32x4*)(xb2 + off) = w;
                        sq += v0[0] * v0[0] + v0[1] * v0[1] + v0[2] * v0[2] + v0[3] * v0[3] + v1[0] * v1[0] + v1[1] * v1[1] + v1[2] * v1[2] + v1[3] * v1[3];
                    }
                }
                if (WRITE_XB) { sq += __shfl_xor(sq, 16); sq += __shfl_xor(sq, 32); if (fq == 0) atomicAdd(ss + row, sq); }
            }
    }
};
struct EpiP {
    bf16_t* P; float* SM; const float* ss;
    __device__ __forceinline__ void operator()(const AccT& acc, const Unit& u, int wr, int wc, int fr, int fq) const {
        const int row0 = u.pm * BM + wr * 64 + fr, col0 = u.pn * BM + wc * 32 + 8 * fq;
#pragma unroll
        for (int ai = 0; ai < 2; ++ai)
#pragma unroll
            for (int m = 0; m < 4; ++m) {
                const int row = row0 + ai * HALF + m * 16;
                const float rs = rsqrtf(ss[row] * (1.f / 1024.f) + EPS);
#pragma unroll
                for (int bj = 0; bj < 2; ++bj) {
                    const int col = col0 + bj * HALF;
                    const f32x4 v0 = acc[ai][bj][m][0] * rs, v1 = acc[ai][bj][m][1] * rs;
                    u32x4 w; w.x = cvt_pk_bf16(v0[0], v0[1]); w.y = cvt_pk_bf16(v0[2], v0[3]); w.z = cvt_pk_bf16(v1[0], v1[1]); w.w = cvt_pk_bf16(v1[2], v1[3]);
                    *(u32x4*)(P + (size_t)row * LDP + col) = w;
                    if (col >= C_SM && col < C_SM + 16) { float* s = SM + (size_t)row * 16 + (col - C_SM); *(f32x4*)s = v0; *(f32x4*)(s + 4) = v1; }
                }
            }
    }
};
struct EpiBf16 {
    bf16_t* O; int ldc;
    __device__ __forceinline__ void operator()(const AccT& acc, const Unit& u, int wr, int wc, int fr, int fq) const {
        const int row0 = u.pm * BM + wr * 64 + fr, col0 = u.pn * BM + wc * 32 + 8 * fq;
#pragma unroll
        for (int ai = 0; ai < 2; ++ai)
#pragma unroll
            for (int m = 0; m < 4; ++m) {
                const int row = row0 + ai * HALF + m * 16;
#pragma unroll
                for (int bj = 0; bj < 2; ++bj) {
                    const f32x4 v0 = acc[ai][bj][m][0], v1 = acc[ai][bj][m][1];
                    u32x4 w; w.x = cvt_pk_bf16(v0[0], v0[1]); w.y = cvt_pk_bf16(v0[2], v0[3]); w.z = cvt_pk_bf16(v1[0], v1[1]); w.w = cvt_pk_bf16(v1[2], v1[3]);
                    *(u32x4*)(O + (size_t)row * ldc + col0 + bj * HALF) = w;
                }
            }
    }
};
template <int PASS> struct EpiMerge {
    const bf16_t* P; bf16_t* MG; int goff;
    __device__ __forceinline__ void operator()(const AccT& acc, const Unit& u, int wr, int wc, int fr, int fq) const {
        const int row0 = u.pm * BM + wr * 64 + fr, col0 = u.pn * BM + wc * 32 + 8 * fq;
#pragma unroll
        for (int ai = 0; ai < 2; ++ai)
#pragma unroll
            for (int m = 0; m < 4; ++m) {
                const int row = row0 + ai * HALF + m * 16;
#pragma unroll
                for (int bj = 0; bj < 2; ++bj) {
                    const int col = col0 + bj * HALF;
                    float gt[8], o[8]; unpack8(*(const u32x4*)(P + (size_t)row * LDP + goff + col), gt);
                    if (PASS == 1) unpack8(*(const u32x4*)(MG + (size_t)row * DM + col), o);
#pragma unroll
                    for (int j = 0; j < 8; ++j) { const float a = acc[ai][bj][m][j >> 2][j & 3] * sigmoidf_(gt[j]); o[j] = (PASS == 1) ? o[j] + a : a; }
                    *(u32x4*)(MG + (size_t)row * DM + col) = pack8(o);
                }
            }
    }
};
}

struct Args {
    const float* in[24];
    float* out;
    unsigned char* ws;
};
enum { I_X = 0, I_F1N, I_F1G, I_F1U, I_F1D, I_MIXN, I_WIN, I_QN, I_KN, I_IKN, I_CW, I_CB, I_WMQ, I_WMK, I_BI, I_BF, I_MHN, I_WPA, I_WPB, I_WOUT, I_F2N, I_F2G, I_F2U, I_F2D };

template <class F> __device__ __forceinline__ void prep_tile(bf16_t* Bt, int K, int n0, int k0, const F src, float* tile) {
    const int tid = threadIdx.x;
    { const int nn = tid & 63, kk = tid >> 6;
#pragma unroll
        for (int i = 0; i < 8; ++i) { const int k = i * 8 + kk; tile[k * 65 + nn] = src(k0 + k, n0 + nn); } }
    __syncthreads();
    { const int nn = tid >> 3, kc = tid & 7; const float* s = tile + (kc * 8) * 65 + nn;
        u32x4 o; o.x = cvt_pk_bf16(s[0], s[65]); o.y = cvt_pk_bf16(s[130], s[195]); o.z = cvt_pk_bf16(s[260], s[325]); o.w = cvt_pk_bf16(s[390], s[455]);
        *(u32x4*)(Bt + (size_t)(n0 + nn) * K + k0 + kc * 8) = o; }
    __syncthreads();
}
struct SrcUp { const float* wg; const float* wu; const float* g;
    __device__ __forceinline__ float operator()(int k, int n) const { const int col = (n >> 8) * 128 + (n & 127); const size_t bj = (size_t)((n >> 7) & 1); const float* w = (const float*)((uintptr_t)wg + ((uintptr_t)wu - (uintptr_t)wg) * bj); return w[(size_t)k * FF + col] * g[k]; } };
struct SrcPlain { const float* w; int ldw;
    __device__ __forceinline__ float operator()(int k, int n) const { return w[(size_t)k * ldw + n]; } };
struct SrcIn { const float* w; const float* g;
    __device__ __forceinline__ float operator()(int k, int n) const {
        int col;
        if (n < 1344) col = n; else if (n < 2368) col = n + 8; else if (n < 4928) col = n + 16;
        else if (n < 4936) col = n - 4928 + 1344; else if (n < 4940) col = n - 4936 + 2376; else if (n < 4944) col = n - 4940 + 2380; else col = -1;
        return col >= 0 ? w[(size_t)k * 4944 + col] * g[k] : 0.f; } };
struct SrcQK { const float* wq; const float* wk;
    __device__ __forceinline__ float operator()(int k, int n) const {
        const int isk = n >> 8, h = (n >> 6) & 3, j = n & 63, hk = k >> 7, c = k & 127;
        if (hk != h) return 0.f;
        const float* w = (const float*)((uintptr_t)wq + ((uintptr_t)wk - (uintptr_t)wq) * (size_t)isk); return w[(size_t)(h * 128 + c) * 64 + j] * (isk ? 1.f : 0.125f); } };

__device__ __forceinline__ void phase0(const Args& a, unsigned char* lds) {
    float* tile = (float*)lds;
    unsigned char* ws = a.ws;
    constexpr int T_UP = 88 * 16, T_DN = 16 * 44, T_IN = 80 * 16, T_PR = 16 * 8, T_WO = 16 * 16, T_QK = 8 * 8;
    constexpr int NITEMS = 2 * T_UP + 2 * T_DN + T_IN + 2 * T_PR + T_WO + T_QK;
    for (int it = blockIdx.x; it < NITEMS; it += gridDim.x) {
        int r = it;
        if (r < T_UP) { SrcUp s{a.in[I_F1G], a.in[I_F1U], a.in[I_F1N]}; prep_tile((bf16_t*)(ws + WS_W1), 1024, (r / 16) * 64, (r % 16) * 64, s, tile); continue; } r -= T_UP;
        if (r < T_UP) { SrcUp s{a.in[I_F2G], a.in[I_F2U], a.in[I_F2N]}; prep_tile((bf16_t*)(ws + WS_W3), 1024, (r / 16) * 64, (r % 16) * 64, s, tile); continue; } r -= T_UP;
        if (r < T_DN) { SrcPlain s{a.in[I_F1D], 1024}; prep_tile((bf16_t*)(ws + WS_W2), FF, (r / 44) * 64, (r % 44) * 64, s, tile); continue; } r -= T_DN;
        if (r < T_DN) { SrcPlain s{a.in[I_F2D], 1024}; prep_tile((bf16_t*)(ws + WS_W4), FF, (r / 44) * 64, (r % 44) * 64, s, tile); continue; } r -= T_DN;
        if (r < T_IN) { SrcIn s{a.in[I_WIN], a.in[I_MIXN]}; prep_tile((bf16_t*)(ws + WS_WIN), 1024, (r / 16) * 64, (r % 16) * 64, s, tile); continue; } r -= T_IN;
        if (r < T_PR) { SrcPlain s{a.in[I_WPA], 1024}; prep_tile((bf16_t*)(ws + WS_WA), 512, (r / 8) * 64, (r % 8) * 64, s, tile); continue; } r -= T_PR;
        if (r < T_PR) { SrcPlain s{a.in[I_WPB], 1024}; prep_tile((bf16_t*)(ws + WS_WB), 512, (r / 8) * 64, (r % 8) * 64, s, tile); continue; } r -= T_PR;
        if (r < T_WO) { SrcPlain s{a.in[I_WOUT], 1024}; prep_tile((bf16_t*)(ws + WS_WO), 1024, (r / 16) * 64, (r % 16) * 64, s, tile); continue; } r -= T_WO;
        { SrcQK s{a.in[I_WMQ], a.in[I_WMK]}; prep_tile((bf16_t*)(ws + WS_WQK), 512, (r / 8) * 64, (r % 8) * 64, s, tile); }
    }
    const int lane = threadIdx.x & 63, gw = blockIdx.x * 8 + (threadIdx.x >> 6), NGW = gridDim.x * 8;
    const float* x = a.in[I_X]; bf16_t* XB = (bf16_t*)(ws + WS_XB);
    float* ss0 = (float*)(ws + WS_SS0); float* ss1 = (float*)(ws + WS_SS1); float* ss2 = (float*)(ws + WS_SS2);
    for (int row = gw; row < MROWS; row += NGW) {
        const f32x4* xr = (const f32x4*)(x + (size_t)row * DM) + lane;
        f32x4 v[4]; float s = 0.f;
#pragma unroll
        for (int j = 0; j < 4; ++j) { v[j] = xr[64 * j]; s += v[j][0] * v[j][0] + v[j][1] * v[j][1] + v[j][2] * v[j][2] + v[j][3] * v[j][3]; }
        s = wave_sum(s);
        if (lane == 0) { ss0[row] = s; ss1[row] = 0.f; ss2[row] = 0.f; }
        unsigned long long* o8 = (unsigned long long*)(XB + (size_t)row * DM) + lane;
#pragma unroll
        for (int j = 0; j < 4; ++j) o8[64 * j] = (unsigned long long)cvt_pk_bf16(v[j][0], v[j][1]) | ((unsigned long long)cvt_pk_bf16(v[j][2], v[j][3]) << 32);
    }
}

__device__ __forceinline__ void phase_postp(const Args& a) {
    unsigned char* ws = a.ws;
    bf16_t* P = (bf16_t*)(ws + WS_P); bf16_t* XC = (bf16_t*)(ws + WS_XB); bf16_t* IKC = (bf16_t*)(ws + WS_IKC); bf16_t* KVC = (bf16_t*)(ws + WS_KVC);
    const int lane = threadIdx.x & 63, gw = blockIdx.x * 8 + (threadIdx.x >> 6), NGW = gridDim.x * 8;
    const int c0 = lane * 8;
    float cw[4][8], cb[8], gq[8], gk[8];
#pragma unroll
    for (int e = 0; e < 8; ++e) {
        cb[e] = a.in[I_CB][c0 + e];
#pragma unroll
        for (int j = 0; j < 4; ++j) cw[j][e] = a.in[I_CW][j * 512 + c0 + e];
        gq[e] = a.in[I_QN][(lane & 7) * 8 + e];
        gk[e] = (lane < 16) ? a.in[I_KN][(lane & 7) * 8 + e] : a.in[I_IKN][(lane & 7) * 8 + e];
    }
    const int koff = (lane < 16) ? (C_AK + lane * 8) : (C_IK + (lane & 7) * 8);
    const int voff = C_AV + ((lane - 32) & 15) * 8;
    u32x4 nmx[4], naq, nkk, nav;
#define PP_LOAD(ROW) do { const int t_ = (ROW) & (SEQ - 1); const bf16_t* pr_ = P + (size_t)(ROW) * LDP; \
        _Pragma("unroll") for (int j = 0; j < 4; ++j) { if (t_ - 3 + j >= 0) nmx[j] = *(const u32x4*)(P + (size_t)((ROW) - 3 + j) * LDP + C_MX + c0); else nmx[j] = (u32x4){0u, 0u, 0u, 0u}; } \
        naq = *(const u32x4*)(pr_ + C_AQ + c0); nkk = *(const u32x4*)(pr_ + koff); nav = *(const u32x4*)(pr_ + voff); } while (0)
    if (gw < MROWS) PP_LOAD(gw);
    for (int row = gw; row < MROWS; row += NGW) {
        bf16_t* pr = P + (size_t)row * LDP;
        u32x4 cmx[4];
#pragma unroll
        for (int j = 0; j < 4; ++j) cmx[j] = nmx[j];
        const u32x4 caq = naq, ckk = nkk, cav = nav;
        if (row + NGW < MROWS) PP_LOAD(row + NGW);
        float accv[8];
#pragma unroll
        for (int e = 0; e < 8; ++e) accv[e] = cb[e];
#pragma unroll
        for (int j = 0; j < 4; ++j) { float xf[8]; unpack8(cmx[j], xf);
#pragma unroll
            for (int e = 0; e < 8; ++e) accv[e] += xf[e] * cw[j][e]; }
#pragma unroll
        for (int e = 0; e < 8; ++e) accv[e] = accv[e] * sigmoidf_(accv[e]);
        *(u32x4*)(XC + (size_t)row * 512 + c0) = pack8(accv);
        { float f[8]; unpack8(caq, f); float s = 0.f;
#pragma unroll
            for (int e = 0; e < 8; ++e) s += f[e] * f[e];
            s += __shfl_xor(s, 1); s += __shfl_xor(s, 2); s += __shfl_xor(s, 4);
            const float rs = rsqrtf(s * (1.f / 64.f) + EPS);
#pragma unroll
            for (int e = 0; e < 8; ++e) f[e] = f[e] * rs * gq[e];
            *(u32x4*)(pr + C_AQ + c0) = pack8(f); }
        { float f[8]; unpack8(ckk, f); float s = 0.f;
#pragma unroll
            for (int e = 0; e < 8; ++e) s += f[e] * f[e];
            s += __shfl_xor(s, 1); s += __shfl_xor(s, 2); s += __shfl_xor(s, 4);
            const float rs = rsqrtf(s * (1.f / 64.f) + EPS);
#pragma unroll
            for (int e = 0; e < 8; ++e) f[e] = f[e] * rs * gk[e];
            if (lane < 16) *(u32x4*)(KVC + (size_t)row * 256 + lane * 8) = pack8(f);
            else if (lane < 24) *(u32x4*)(IKC + ((((size_t)(row >> 4)) * 8 + (lane - 16)) * 16 + (row & 15)) * 8) = pack8(f);
            else if (lane >= 32 && lane < 48) *(u32x4*)(KVC + (size_t)row * 256 + 128 + (lane - 32) * 8) = cav; }
    }
#undef PP_LOAD
}

__device__ __forceinline__ unsigned fkey(float s) { const unsigned u = __float_as_uint(s); return (u & 0x80000000u) ? ~u : (u | 0x80000000u); }


__device__ __forceinline__ unsigned wave_incl_scan_dpp(unsigned x) {
    x += (unsigned)__builtin_amdgcn_update_dpp(0, (int)x, 0x111, 0xf, 0xf, false);
    x += (unsigned)__builtin_amdgcn_update_dpp(0, (int)x, 0x112, 0xf, 0xf, false);
    x += (unsigned)__builtin_amdgcn_update_dpp(0, (int)x, 0x114, 0xf, 0xf, false);
    x += (unsigned)__builtin_amdgcn_update_dpp(0, (int)x, 0x118, 0xf, 0xf, false);
    x += (unsigned)__builtin_amdgcn_update_dpp(0, (int)x, 0x142, 0xa, 0xf, false);
    x += (unsigned)__builtin_amdgcn_update_dpp(0, (int)x, 0x143, 0xc, 0xf, false);
    return x;
}
__device__ __forceinline__ int find_bin(const unsigned* hist, int& need, int lane, int& binc) {
    const int base = 1023 - 16 * lane; unsigned s = 0;
#pragma unroll
    for (int i = 0; i < 16; ++i) { const unsigned w = hist[base - ((i + lane) & 15)]; s += (w & 0xffffu) + (w >> 16); }
    const unsigned p = wave_incl_scan_dpp(s);
    const unsigned long long bal = __ballot(p >= (unsigned)need);
    const int L = bal ? (__ffsll((long long)bal) - 1) : 63;
    const unsigned excl = __shfl(p - s, L);
    int cum = (int)excl, bin = -1, fneed = 1, bc = 1; const int b0 = 1023 - 16 * L;
#pragma unroll
    for (int i = 0; i < 16; ++i) {
        const unsigned w = hist[b0 - i]; const int hi = (int)(w >> 16), lo = (int)(w & 0xffffu);
        if (bin < 0) { if (cum + hi >= need) { bin = 2 * (b0 - i) + 1; fneed = need - cum; bc = hi; } else cum += hi; }
        if (bin < 0) { if (cum + lo >= need) { bin = 2 * (b0 - i); fneed = need - cum; bc = lo; } else cum += lo; }
    }
    if (bin < 0) bin = 0;
    need = fneed; binc = bc; return bin;
}


__device__ __forceinline__ int find_bin128(const unsigned* sh, int& need, int lane, int& binc) {
    const unsigned hi = sh[127 - 2 * lane], lo = sh[126 - 2 * lane]; const unsigned s = hi + lo;
    const unsigned p = wave_incl_scan_dpp(s);
    const unsigned long long bal = __ballot(p >= (unsigned)need);
    const int L = bal ? (__ffsll((long long)bal) - 1) : 63;
    const int excl = (int)__shfl(p - s, L); const int hiL = (int)__shfl(hi, L), loL = (int)__shfl(lo, L);
    int bin, fneed, bc;
    if (excl + hiL >= need) { bin = 127 - 2 * L; fneed = need - excl; bc = hiL; } else { bin = 126 - 2 * L; fneed = need - excl - hiL; bc = loL; }
    if (fneed < 1) fneed = 1;
    need = fneed; binc = bc; return bin;
}

template <bool DUMMY> __device__ __forceinline__ void phase_dsa(const Args& a, unsigned char* lds) {
    unsigned char* ws = a.ws;
    bf16_t* P = (bf16_t*)(ws + WS_P); const float* SM = (const float*)(ws + WS_SM);
    const bf16_t* IKC = (const bf16_t*)(ws + WS_IKC); const bf16_t* KVC = (const bf16_t*)(ws + WS_KVC);
    constexpr int SCS = 8200;
    float* SC = (float*)lds;
    unsigned* HIST = (unsigned*)(lds + 131200);
    int* LIST = (int*)(lds + 131200 + 16384);
    unsigned* QS = (unsigned*)(lds + 131200 + 16384 + 4096);
    int* CNT = (int*)(lds + 131200 + 16384 + 4096 + 4096);
    const float idx_scale = 0.125f * 0.35355339059327373f;
    f32x4 wqv[2]; unsigned qsv[2];
#define DSA_LOAD_ITEM(ITEM) do { const int b_ = (ITEM) & 7, t0_ = ((ITEM) >> 3) * 4; const size_t r_ = (size_t)b_ * SEQ + t0_; \
        int tl_ = threadIdx.x; asm volatile("" : "+v"(tl_)); const int ln_ = tl_ & 63, q4_ = ln_ >> 4; \
        wqv[0] = *(const f32x4*)(SM + (r_ + q4_) * 16); wqv[1] = *(const f32x4*)(SM + (r_ + q4_) * 16 + 4); \
        _Pragma("unroll") for (int i_ = 0; i_ < 2; ++i_) { const int e_ = tl_ + 512 * i_; qsv[i_] = *(const unsigned*)(P + (r_ + (e_ >> 8)) * LDP + C_AQ + (e_ & 255) * 2); } } while (0)
    if ((int)blockIdx.x < 16384) DSA_LOAD_ITEM(blockIdx.x);
    for (int item = blockIdx.x; item < 16384; item += gridDim.x) {
        int tid_ = threadIdx.x; asm volatile("" : "+v"(tid_));
        const int tid = tid_, wave = __builtin_amdgcn_readfirstlane(tid >> 6), lane = tid & 63, quad = lane >> 4, l15 = lane & 15;
        const int b = item & 7, tq = item >> 3, t0 = tq * 4, L = ((t0 >> 6) + 1) * 64;
        const size_t r0 = (size_t)b * SEQ + t0;
        const bool do_sel = (L > 256) && !DBG_NOSEL;
        { u32x4* hz = (u32x4*)HIST; hz[tid] = (u32x4){0u, 0u, 0u, 0u}; hz[tid + 512] = (u32x4){0u, 0u, 0u, 0u}; }
        if (tid < 8) CNT[4 + tid] = 0;
        QS[tid] = qsv[0]; QS[tid + 512] = qsv[1];
        float wq[8];
#pragma unroll
        for (int h = 0; h < 4; ++h) { wq[h] = wqv[0][h] * idx_scale; wq[4 + h] = wqv[1][h] * idx_scale; }
        bf16x8 af[2][2];
#pragma unroll
        for (int T = 0; T < 2; ++T)
#pragma unroll
            for (int ks = 0; ks < 2; ++ks) af[T][ks] = *(const bf16x8*)(P + (r0 + (l15 >> 2)) * LDP + C_IQ + (4 * T + (l15 & 3)) * 64 + ks * 32 + quad * 8);
        const int ngroups = L >> 6;
        const bf16_t* ikb = IKC + (size_t)b * SEQ * 64 + (quad * 16 + l15) * 8;
        bf16x8 B0[4][2], B1[4][2], B2[4][2];
#define IDX_LOAD(BUF, G) do { _Pragma("unroll") for (int tt = 0; tt < 4; ++tt) _Pragma("unroll") for (int ks = 0; ks < 2; ++ks) \
                BUF[tt][ks] = *(const bf16x8*)(ikb + (size_t)(((G) * 4 + tt) * 8 + ks * 4) * 128); } while (0)
        if (wave < ngroups) IDX_LOAD(B0, wave);
        if (wave + 8 < ngroups) IDX_LOAD(B1, wave + 8);
        if (wave + 16 < ngroups) IDX_LOAD(B2, wave + 16);
        lds_fence(); __builtin_amdgcn_s_barrier();
        for (int rep = 0; rep < ((DBG_TWICE & 2) ? 2 : 1); ++rep) {
            const bool hist_on = do_sel && (rep == (((DBG_TWICE & 2) ? 2 : 1) - 1));
#define IDX_COMPUTE(BUF, G) do { _Pragma("unroll") for (int tt = 0; tt < 4; ++tt) { \
                const int key = (G) * 64 + tt * 16 + l15; \
                f32x4 c0 = (f32x4){0.f, 0.f, 0.f, 0.f}, c1 = (f32x4){0.f, 0.f, 0.f, 0.f}; \
                c0 = __builtin_amdgcn_mfma_f32_16x16x32_bf16(af[0][0], BUF[tt][0], c0, 0, 0, 0); \
                c1 = __builtin_amdgcn_mfma_f32_16x16x32_bf16(af[1][0], BUF[tt][0], c1, 0, 0, 0); \
                c0 = __builtin_amdgcn_mfma_f32_16x16x32_bf16(af[0][1], BUF[tt][1], c0, 0, 0, 0); \
                c1 = __builtin_amdgcn_mfma_f32_16x16x32_bf16(af[1][1], BUF[tt][1], c1, 0, 0, 0); \
                float sc = 0.f; \
                _Pragma("unroll") for (int j = 0; j < 4; ++j) { sc += wq[j] * relu_(c0[j]); sc += wq[4 + j] * relu_(c1[j]); } \
                sc += 0.f; \
                SC[quad * SCS + key] = sc; \
                if (hist_on) { const unsigned bin = fkey(sc) >> 21; atomicAdd(&HIST[quad * 1024 + (bin >> 1)], (bin & 1u) ? 0x10000u : 1u); } } } while (0)
            int g = wave;
            for (; g < ngroups; g += 24) {
                IDX_COMPUTE(B0, g);
                if (g + 24 < ngroups) IDX_LOAD(B0, g + 24);
                if (g + 8 < ngroups) { IDX_COMPUTE(B1, g + 8); if (g + 32 < ngroups) IDX_LOAD(B1, g + 32); }
                if (g + 16 < ngroups) { IDX_COMPUTE(B2, g + 16); if (g + 40 < ngroups) IDX_LOAD(B2, g + 40); }
            }
#undef IDX_LOAD
#undef IDX_COMPUTE
        }
        lds_fence(); __builtin_amdgcn_s_barrier();
        if (item + (int)gridDim.x < 16384) DSA_LOAD_ITEM(item + (int)gridDim.x);
        {
            constexpr int CAP = 448;
            const unsigned long long ltmask = (1ull << lane) - 1ull;
            if (!do_sel) {
                const int q = wave >> 1, hf = wave & 1; int* list = LIST + q * 256;
                if (hf == 0) { for (int i = lane; i < 256; i += 64) list[i] = (i < L) ? i : 0; if (lane == 0) CNT[q] = L; }
            } else {
                {
                    const int q = wave >> 1, hf = wave & 1; int* list = LIST + q * 256; const float* sc = SC + q * SCS; unsigned* hist = HIST + q * 1024;
                    const int halfL = L >> 1, beg = hf * halfL, end = beg + halfL;
                    int need = 256, binc = 0;
                    const unsigned b1 = (unsigned)find_bin(hist, need, lane, binc);
                    const int c1 = binc, nsure = 256 - need; const bool store_c = c1 <= CAP;
                    if (hf == 0 && lane == 0) { CNT[12 + q] = (int)b1; CNT[16 + q] = need; CNT[8 + q] = c1; }
                    lds_fence(); __builtin_amdgcn_s_barrier();
                    int cs = 0, cc = 0;
                    for (int i0 = beg + lane * 4; i0 < end; i0 += 256) { const f32x4 v = *(const f32x4*)(sc + i0);
#pragma unroll
                        for (int e = 0; e < 4; ++e) { const unsigned k = fkey(v[e]); const unsigned kb = k >> 21;
                            const bool sure = kb > b1, cand = (kb == b1) && store_c;
                            const unsigned long long ms = __ballot(sure), mc = __ballot(cand);
                            if (ms) { const int p = cs + __popcll(ms & ltmask); const int pp = hf ? nsure - 1 - p : p; if (sure && pp >= 0 && pp < 256) list[pp] = i0 + e; cs += __popcll(ms); }
                            if (mc) { const int p = cc + __popcll(mc & ltmask); const int pp = hf ? c1 - 1 - p : p; if (cand && pp >= 0 && pp < CAP) { hist[2 * pp] = k; hist[2 * pp + 1] = (unsigned)(i0 + e); } cc += __popcll(mc); } } }
                    lds_fence(); __builtin_amdgcn_s_barrier();
                }
                if (wave < 4) {
                    const int q = wave; int* list = LIST + q * 256; unsigned* hist = HIST + q * 1024; unsigned* sh = hist + 896; const float* sc = SC + q * SCS;
                    const unsigned b1 = (unsigned)CNT[12 + q]; int need = CNT[16 + q]; const int c = CNT[8 + q]; const int nsure = 256 - need;
                    if (c <= CAP) {
                        unsigned ck[7]; int ci[7];
#pragma unroll
                        for (int t = 0; t < 7; ++t) { const int i = lane + 64 * t; const bool valid = i < c; ck[t] = valid ? hist[2 * i] : 0u; ci[t] = valid ? (int)hist[2 * i + 1] : -1; }
                        int binc = 0;
                        sh[2 * lane] = 0u; sh[2 * lane + 1] = 0u; lds_order();
#pragma unroll
                        for (int t = 0; t < 7; ++t) if (ci[t] >= 0) atomicAdd(&sh[(ck[t] >> 14) & 127u], 1u);
                        lds_order();
                        const unsigned bA = (unsigned)find_bin128(sh, need, lane, binc);
                        lds_order();
                        sh[2 * lane] = 0u; sh[2 * lane + 1] = 0u; lds_order();
#pragma unroll
                        for (int t = 0; t < 7; ++t) if (ci[t] >= 0 && ((ck[t] >> 14) & 127u) == bA) atomicAdd(&sh[(ck[t] >> 7) & 127u], 1u);
                        lds_order();
                        const unsigned bB = (unsigned)find_bin128(sh, need, lane, binc);
                        const unsigned preB = (bA << 7) | bB;
                        lds_order();
                        sh[2 * lane] = 0u; sh[2 * lane + 1] = 0u; lds_order();
#pragma unroll
                        for (int t = 0; t < 7; ++t) if (ci[t] >= 0 && ((ck[t] >> 7) & 0x3fffu) == preB) atomicAdd(&sh[ck[t] & 127u], 1u);
                        lds_order();
                        const unsigned bC = (unsigned)find_bin128(sh, need, lane, binc);
                        const unsigned T = (b1 << 21) | (preB << 7) | bC;
                        const int tie_total = binc, need_t = need;
                        int cnt = 0;
#pragma unroll
                        for (int t = 0; t < 7; ++t) {
                            const bool valid = ci[t] >= 0;
                            bool sel = valid && (ck[t] > T);
                            if (valid && ck[t] == T) {
                                if (tie_total == need_t) sel = true;
                                else { int rank = 0; for (int j = 0; j < c; ++j) rank += (hist[2 * j] == T && (int)hist[2 * j + 1] < ci[t]) ? 1 : 0; sel = rank < need_t; }
                            }
                            const unsigned long long m = __ballot(sel);
                            const int pos = nsure + cnt + __popcll(m & ltmask);
                            if (sel && pos < 256) list[pos] = ci[t];
                            cnt += __popcll(m);
                        }
                    } else {
                        int binc = 0;
                        lds_order();
#pragma unroll
                        for (int i = 0; i < 16; ++i) hist[lane * 16 + i] = 0u;
                        lds_order();
                        for (int i0 = 0; i0 < L; i0 += 64) { const unsigned k = fkey(sc[i0 + lane]); if ((k >> 21) == b1) { const unsigned bin = (k >> 10) & 2047u; atomicAdd(&hist[bin >> 1], (bin & 1u) ? 0x10000u : 1u); } }
                        lds_order();
                        const unsigned b2 = (unsigned)find_bin(hist, need, lane, binc);
                        const unsigned pre2 = (b1 << 11) | b2;
                        lds_order();
#pragma unroll
                        for (int i = 0; i < 16; ++i) hist[lane * 16 + i] = 0u;
                        lds_order();
                        for (int i0 = 0; i0 < L; i0 += 64) { const unsigned k = fkey(sc[i0 + lane]); if ((k >> 10) == pre2) { const unsigned bin = k & 1023u; atomicAdd(&hist[bin >> 1], (bin & 1u) ? 0x10000u : 1u); } }
                        lds_order();
                        const unsigned b3 = (unsigned)find_bin(hist, need, lane, binc);
                        const unsigned T = (pre2 << 10) | b3;
                        int count = 0, ties = 0;
                        for (int i0 = 0; i0 < L; i0 += 64) {
                            const unsigned k = fkey(sc[i0 + lane]);
                            const bool eq = (k == T);
                            const unsigned long long em = __ballot(eq);
                            const int erank = ties + __popcll(em & ltmask);
                            const bool sel = (k > T) || (eq && erank < need);
                            const unsigned long long smk = __ballot(sel);
                            const int pos = count + __popcll(smk & ltmask);
                            if (sel && pos < 256) list[pos] = i0 + lane;
                            count += __popcll(smk); ties += __popcll(em);
                        }
                        if (count > 256) count = 256;
                        for (int i = count + lane; i < 256; i += 64) list[i] = 0;
                    }
                    if (lane == 0) CNT[q] = 256;
                }
            }
        }
        lds_fence(); __builtin_amdgcn_s_barrier();
        for (int repc = 0; repc < ((DBG_TWICE & 4) ? 2 : 1); ++repc) {
            const bool dummy_c = (repc + 1) < ((DBG_TWICE & 4) ? 2 : 1);
            int lane_c = lane; asm volatile("" : "+v"(lane_c));
            const int qi = wave >> 1, g = wave & 1; const int count = CNT[qi];
            const int* list = LIST + qi * 256;
            float* PB = SC + wave * 1024;
            const unsigned* qd = QS + (qi * 8 + g * 4) * 32;
            const bf16_t* kvb = KVC + (size_t)b * SEQ * 256 + g * 64;
            const int ks = lane_c >> 3, dg = lane_c & 7, l15c = lane_c & 15, quadc = lane_c >> 4;
            const int nblk = count >> 6;
            bf16_t* KL = (bf16_t*)(lds + 32768 + wave * 9216);
            bf16x8 bq[2];
#pragma unroll
            for (int s2 = 0; s2 < 2; ++s2) {
                bf16x8 t = *(const bf16x8*)((const bf16_t*)QS + (qi * 8 + g * 4 + (l15c & 3)) * 64 + s2 * 32 + quadc * 8);
                if (l15c >= 4) t = (bf16x8){0, 0, 0, 0, 0, 0, 0, 0};
                bq[s2] = t;
            }
            const bf16_t* kb = kvb + dg * 8;
            float sreg[4][4][4];
            u32x4 kcur[8];
#pragma unroll
            for (int u = 0; u < 8; ++u) kcur[u] = *(const u32x4*)(kb + (size_t)list[u * 8 + ks] * 256);
#pragma unroll
            for (int blk = 0; blk < 4; ++blk) {
                if (blk < nblk) {
#pragma unroll
                    for (int u = 0; u < 8; ++u) *(u32x4*)(KL + (u * 8 + ks) * 72 + dg * 8) = kcur[u];
                    if (blk + 1 < nblk) {
#pragma unroll
                        for (int u = 0; u < 8; ++u) kcur[u] = *(const u32x4*)(kb + (size_t)list[(blk + 1) * 64 + u * 8 + ks] * 256);
                    }
                    lds_order();
#pragma unroll
                    for (int kt = 0; kt < 4; ++kt) {
                        f32x4 acc = (f32x4){0.f, 0.f, 0.f, 0.f};
#pragma unroll
                        for (int s2 = 0; s2 < 2; ++s2) acc = __builtin_amdgcn_mfma_f32_16x16x32_bf16(*(const bf16x8*)(KL + (kt * 16 + l15c) * 72 + s2 * 32 + quadc * 8), bq[s2], acc, 0, 0, 0);
#pragma unroll
                        for (int j = 0; j < 4; ++j) sreg[blk][kt][j] = acc[j] * 0.125f;
                    }
                    lds_order();
                } else {
#pragma unroll
                    for (int kt = 0; kt < 4; ++kt)
#pragma unroll
                        for (int j = 0; j < 4; ++j) sreg[blk][kt][j] = -INFINITY;
                }
            }
            const bf16_t* vb = kvb + 128 + dg * 8;
            u32x4 vreg[8];
#pragma unroll
            for (int u = 0; u < 8; ++u) vreg[u] = *(const u32x4*)(vb + (size_t)list[u * 8 + ks] * 256);
            float mx = -INFINITY;
#pragma unroll
            for (int blk = 0; blk < 4; ++blk)
#pragma unroll
                for (int kt = 0; kt < 4; ++kt)
#pragma unroll
                    for (int j = 0; j < 4; ++j) mx = fmaxf(mx, sreg[blk][kt][j]);
            mx = fmaxf(mx, __shfl_xor(mx, 16)); mx = fmaxf(mx, __shfl_xor(mx, 32));
            float sum = 0.f;
#pragma unroll
            for (int blk = 0; blk < 4; ++blk)
#pragma unroll
                for (int kt = 0; kt < 4; ++kt)
#pragma unroll
                    for (int j = 0; j < 4; ++j) { const float e = __expf(sreg[blk][kt][j] - mx); sreg[blk][kt][j] = e; sum += e; }
            sum += __shfl_xor(sum, 16); sum += __shfl_xor(sum, 32);
            const float invs = 1.f / sum;
            f32x4 oacc[4];
#pragma unroll
            for (int dt = 0; dt < 4; ++dt) oacc[dt] = (f32x4){0.f, 0.f, 0.f, 0.f};
            bf16_t* VT = KL;
#pragma unroll
            for (int blk = 0; blk < 4; ++blk) {
                if (blk < nblk) {
#pragma unroll
                    for (int u = 0; u < 8; ++u) {
                        const int rho = ((u >> 2) << 5) + ((((2 * u) & 3) + (ks >> 2)) << 3) + (((u >> 1) & 1) << 2) + (ks & 3);
                        *(u32x4*)(VT + rho * 72 + dg * 8) = vreg[u];
                    }
                    if (blk + 1 < nblk) {
#pragma unroll
                        for (int u = 0; u < 8; ++u) vreg[u] = *(const u32x4*)(vb + (size_t)list[(blk + 1) * 64 + u * 8 + ks] * 256);
                    }
                    lds_order();
#pragma unroll
                    for (int s2 = 0; s2 < 2; ++s2) {
                        u32x4 pw;
                        pw[0] = cvt_pk_bf16(sreg[blk][2 * s2][0], sreg[blk][2 * s2][1]); pw[1] = cvt_pk_bf16(sreg[blk][2 * s2][2], sreg[blk][2 * s2][3]);
                        pw[2] = cvt_pk_bf16(sreg[blk][2 * s2 + 1][0], sreg[blk][2 * s2 + 1][1]); pw[3] = cvt_pk_bf16(sreg[blk][2 * s2 + 1][2], sreg[blk][2 * s2 + 1][3]);
                        const bf16x8 pf = __builtin_bit_cast(bf16x8, pw);
#pragma unroll
                        for (int dt = 0; dt < 4; ++dt) {
                            const LAS unsigned char* vp = (const LAS unsigned char*)VT + ((32 * s2 + 8 * quadc + (l15c >> 2)) * 72) * 2 + dt * 32 + (l15c & 3) * 8;
                            const v4i16_t t0 = __builtin_amdgcn_ds_read_tr16_b64_v4i16((LAS v4i16_t*)vp);
                            const v4i16_t t1 = __builtin_amdgcn_ds_read_tr16_b64_v4i16((LAS v4i16_t*)(vp + 4 * 72 * 2));
                            const bf16x8 af2 = (bf16x8){t0[0], t0[1], t0[2], t0[3], t1[0], t1[1], t1[2], t1[3]};
                            oacc[dt] = __builtin_amdgcn_mfma_f32_16x16x32_bf16(af2, pf, oacc[dt], 0, 0, 0);
                        }
                    }
                    lds_order();
                }
            }
            if (l15c < 4) {
                bf16_t* yo = (DUMMY || dummy_c) ? ((bf16_t*)(ws + WS_MG + 48 * MiB) + (r0 + qi) * 512 + (g * 4 + l15c) * 64 + quadc * 4) : (P + (r0 + qi) * LDP + C_AQ + (g * 4 + l15c) * 64 + quadc * 4);
#pragma unroll
                for (int dt = 0; dt < 4; ++dt) {
                    const f32x4 v = oacc[dt] * invs;
                    u32x2 w; w[0] = cvt_pk_bf16(v[0], v[1]); w[1] = cvt_pk_bf16(v[2], v[3]);
                    *(u32x2*)(yo + dt * 16) = w;
                }
            }
        }
        lds_fence(); __builtin_amdgcn_s_barrier();
    }
#undef DSA_LOAD_ITEM
}

__device__ __forceinline__ float logsigmoidf_(float x) { return fminf(x, 0.f) - log1pf(__expf(-fabsf(x))); }
__device__ __forceinline__ float wave_incl_sum(float v, int lane) {
#pragma unroll
    for (int o = 1; o < 64; o <<= 1) { const float t = __shfl_up(v, o); if (lane >= o) v += t; }
    return v;
}
__device__ __forceinline__ float wave_incl_max(float v, int lane) {
#pragma unroll
    for (int o = 1; o < 64; o <<= 1) { const float t = __shfl_up(v, o); if (lane >= o) v = fmaxf(v, t); }
    return v;
}
__device__ __forceinline__ f32x4 mma_lds(const bf16_t* A, int lda, const bf16_t* Bt, int ldb, int K, int lane) {
    f32x4 acc = (f32x4){0.f, 0.f, 0.f, 0.f};
    const bf16_t* ap = A + (lane & 15) * lda + (lane >> 4) * 8; const bf16_t* bp = Bt + (lane & 15) * ldb + (lane >> 4) * 8;
    for (int k = 0; k < K; k += 32) acc = __builtin_amdgcn_mfma_f32_16x16x32_bf16(*(const bf16x8*)(ap + k), *(const bf16x8*)(bp + k), acc, 0, 0, 0);
    return acc;
}

__device__ __forceinline__ void phase_mlstm_a(const Args& a, unsigned char* lds) {
    unsigned char* ws = a.ws;
    const bf16_t* P = (const bf16_t*)(ws + WS_P); const bf16_t* QK = (const bf16_t*)(ws + WS_QK); const float* SM = (const float*)(ws + WS_SM);
    bf16_t* ST = (bf16_t*)(ws + WS_XB); float* DN = (float*)(ws + WS_DN); float* ML = (float*)(ws + WS_ML); float* BL = (float*)(ws + WS_BL);
    bf16_t* VT = (bf16_t*)lds;
    bf16_t* KT = (bf16_t*)(lds + 18432);
    float* WS_ = (float*)(lds + 18432 + 9216);
    const int tid = threadIdx.x, wave = tid >> 6, lane = tid & 63;
    for (int item = blockIdx.x; item < 4096; item += gridDim.x) {
        const int c = item & 127, h = (item >> 7) & 3, b = item >> 9;
        const size_t r0 = (size_t)b * SEQ + c * 64;
        if (wave == 0) {
            const float ig = SM[(r0 + lane) * 16 + 8 + h] + a.in[I_BI][h];
            const float lf = logsigmoidf_(SM[(r0 + lane) * 16 + 12 + h] + a.in[I_BF][h]);
            const float bs = wave_incl_sum(lf, lane);
            const float bl = __shfl(bs, 63);
            const float wk = bl - bs + ig;
            const float ml = wave_max(wk);
            WS_[lane] = __expf(wk - ml);
            if (lane == 0) { ML[item] = ml; BL[item] = bl; }
        }
        for (int i = tid; i < 1024; i += 512) { const int s = i >> 4, d0 = (i & 15) * 8; float f[8]; unpack8(*(const u32x4*)(P + (r0 + s) * LDP + C_MV + h * 128 + d0), f);
#pragma unroll
            for (int e = 0; e < 8; ++e) VT[(d0 + e) * 72 + s] = f2bf(f[e]); }
        __syncthreads();
        { const int s = tid >> 3, d0 = (tid & 7) * 8; float f[8]; unpack8(*(const u32x4*)(QK + (r0 + s) * 512 + 256 + h * 64 + d0), f); const float w = WS_[s];
#pragma unroll
            for (int e = 0; e < 8; ++e) KT[(d0 + e) * 72 + s] = f2bf(f[e] * w); }
        __syncthreads();
        bf16_t* st = ST + (size_t)item * 8192;
#pragma unroll
        for (int nt = 0; nt < 4; ++nt) {
            const f32x4 acc = mma_lds(VT + wave * 16 * 72, 72, KT + nt * 16 * 72, 72, 64, lane);
#pragma unroll
            for (int j = 0; j < 4; ++j) st[(wave * 16 + (lane >> 4) * 4 + j) * 64 + nt * 16 + (lane & 15)] = f2bf_sw(acc[j]);
        }
        if (tid < 64) { float s = 0.f; for (int k = 0; k < 64; ++k) s += bf1(KT[tid * 72 + k]); DN[item * 64 + tid] = s; }
        __syncthreads();
    }
}
__device__ __forceinline__ void phase_mlstm_b(const Args& a) {
    unsigned char* ws = a.ws;
    unsigned* ST2 = (unsigned*)(ws + WS_XB);
    float* DN = (float*)(ws + WS_DN); const float* ML = (const float*)(ws + WS_ML); const float* BL = (const float*)(ws + WS_BL); float* MS = (float*)(ws + WS_MS);
    const int total = 32 * 4160;
    for (int w = blockIdx.x * 512 + threadIdx.x; w < total; w += gridDim.x * 512) {
        const int bh = w / 4160, e = w % 4160;
        if (e < 4096) {
            unsigned* p = ST2 + (size_t)bh * 128 * 4096 + e;
            float C0 = 0.f, C1 = 0.f, m = 0.f;
            for (int c0 = 0; c0 < 128; c0 += 8) {
                unsigned d[8]; float bl[8], ml[8];
#pragma unroll
                for (int u = 0; u < 8; ++u) { d[u] = p[(size_t)(c0 + u) * 4096]; bl[u] = BL[bh * 128 + c0 + u]; ml[u] = ML[bh * 128 + c0 + u]; }
#pragma unroll
                for (int u = 0; u < 8; ++u) {
                    p[(size_t)(c0 + u) * 4096] = cvt_pk_bf16(C0, C1);
                    if (e == 0) MS[bh * 128 + c0 + u] = m;
                    const float mn = fmaxf(bl[u] + m, ml[u]);
                    const float wc = __expf(bl[u] + m - mn), wd = __expf(ml[u] - mn);
                    C0 = wc * C0 + wd * bflo(d[u]); C1 = wc * C1 + wd * bfhi(d[u]);
                    m = mn;
                }
            }
        } else {
            float* p = DN + (size_t)bh * 128 * 64 + (e - 4096);
            float C = 0.f, m = 0.f;
            for (int c0 = 0; c0 < 128; c0 += 8) {
                float d[8], bl[8], ml[8];
#pragma unroll
                for (int u = 0; u < 8; ++u) { d[u] = p[(size_t)(c0 + u) * 64]; bl[u] = BL[bh * 128 + c0 + u]; ml[u] = ML[bh * 128 + c0 + u]; }
#pragma unroll
                for (int u = 0; u < 8; ++u) {
                    p[(size_t)(c0 + u) * 64] = C;
                    const float mn = fmaxf(bl[u] + m, ml[u]);
                    C = __expf(bl[u] + m - mn) * C + __expf(ml[u] - mn) * d[u];
                    m = mn;
                }
            }
        }
    }
}
__device__ __forceinline__ void phase_mlstm_c(const Args& a, unsigned char* lds) {
    unsigned char* ws = a.ws;
    bf16_t* P = (bf16_t*)(ws + WS_P); const bf16_t* QK = (const bf16_t*)(ws + WS_QK); const float* SM = (const float*)(ws + WS_SM);
    const bf16_t* ST = (const bf16_t*)(ws + WS_XB); const float* DN = (const float*)(ws + WS_DN); const float* MS = (const float*)(ws + WS_MS);
    bf16_t* QS_ = (bf16_t*)lds;
    bf16_t* KS = (bf16_t*)(lds + 9216);
    bf16_t* AP = (bf16_t*)(lds + 18432);
    bf16_t* BT = (bf16_t*)(lds + 18432 + 17408);
    float* OUT = (float*)(lds + 18432 + 17408 + 34816);
    float* GS = (float*)(lds + 18432 + 17408 + 34816 + 33792);
    float* bS = GS; float* aS = GS + 64; float* mtS = GS + 128; float* wiS = GS + 192; float* nS = GS + 256; float* denS = GS + 320;
    const int tid = threadIdx.x, wave = tid >> 6, lane = tid & 63;
    for (int item = blockIdx.x; item < 4096; item += gridDim.x) {
        const int c = item & 127, h = (item >> 7) & 3, b = item >> 9;
        const size_t r0 = (size_t)b * SEQ + c * 64;
        if (wave == 0) {
            const float ig = SM[(r0 + lane) * 16 + 8 + h] + a.in[I_BI][h];
            const float lf = logsigmoidf_(SM[(r0 + lane) * 16 + 12 + h] + a.in[I_BF][h]);
            const float bs = wave_incl_sum(lf, lane);
            const float av = ig - bs;
            const float pm = wave_incl_max(av, lane);
            const float m0 = MS[item];
            const float mt = bs + fmaxf(pm, m0);
            bS[lane] = bs; aS[lane] = av; mtS[lane] = mt; wiS[lane] = __expf(bs + m0 - mt);
            nS[lane] = DN[item * 64 + lane];
        }
        { const int s = tid >> 3, d0 = (tid & 7) * 8;
            *(u32x4*)(QS_ + s * 72 + d0) = *(const u32x4*)(QK + (r0 + s) * 512 + h * 64 + d0);
            *(u32x4*)(KS + s * 72 + d0) = *(const u32x4*)(QK + (r0 + s) * 512 + 256 + h * 64 + d0); }
        for (int i = tid; i < 1024; i += 512) { const int s = i >> 4, d0 = (i & 15) * 8; float f[8]; unpack8(*(const u32x4*)(P + (r0 + s) * LDP + C_MV + h * 128 + d0), f);
#pragma unroll
            for (int e = 0; e < 8; ++e) BT[(d0 + e) * 136 + s] = f2bf(f[e]); }
        { const bf16_t* st = ST + (size_t)item * 8192;
            for (int i = tid; i < 1024; i += 512) { const int dv = i >> 3, k0 = (i & 7) * 8; *(u32x4*)(BT + dv * 136 + 64 + k0) = *(const u32x4*)(st + dv * 64 + k0); } }
        __syncthreads();
#pragma unroll
        for (int u = 0; u < 2; ++u) {
            const int id = wave * 2 + u, tr = id >> 2, tc = id & 3;
            f32x4 acc = (f32x4){0.f, 0.f, 0.f, 0.f};
            if (tc <= tr) acc = mma_lds(QS_ + tr * 16 * 72, 72, KS + tc * 16 * 72, 72, 64, lane);
            const int s = tc * 16 + (lane & 15);
#pragma unroll
            for (int j = 0; j < 4; ++j) { const int t = tr * 16 + (lane >> 4) * 4 + j;
                const float w = (s <= t) ? acc[j] * __expf(bS[t] + aS[s] - mtS[t]) : 0.f;
                AP[t * 136 + s] = f2bf(w); }
        }
        { const int t = tid >> 3, d0 = (tid & 7) * 8; float f[8]; unpack8(*(const u32x4*)(QS_ + t * 72 + d0), f); const float w = wiS[t];
#pragma unroll
            for (int e = 0; e < 8; ++e) f[e] *= w;
            *(u32x4*)(AP + t * 136 + 64 + d0) = pack8(f); }
        __syncthreads();
#pragma unroll
        for (int tr = 0; tr < 4; ++tr) {
            const f32x4 acc = mma_lds(AP + tr * 16 * 136, 136, BT + wave * 16 * 136, 136, 128, lane);
#pragma unroll
            for (int j = 0; j < 4; ++j) OUT[(tr * 16 + (lane >> 4) * 4 + j) * 132 + wave * 16 + (lane & 15)] = acc[j];
        }
        { const int t = tid >> 3, part = tid & 7; float s = 0.f;
#pragma unroll
            for (int e = 0; e < 16; ++e) { const int k = part * 16 + e; const float v = bf1(AP[t * 136 + k]); s += (k < 64) ? v : v * nS[k - 64]; }
            s += __shfl_xor(s, 1); s += __shfl_xor(s, 2); s += __shfl_xor(s, 4);
            if (part == 0) denS[t] = s; }
        __syncthreads();
        { const int t = tid >> 3, part = tid & 7, dv0 = part * 16;
            const float den = fmaxf(fabsf(denS[t]), __expf(-mtS[t])); const float inv = 1.f / den;
            float hv[16]; float sq = 0.f;
#pragma unroll
            for (int e = 0; e < 16; ++e) { hv[e] = OUT[t * 132 + dv0 + e] * inv; sq += hv[e] * hv[e]; }
            sq += __shfl_xor(sq, 1); sq += __shfl_xor(sq, 2); sq += __shfl_xor(sq, 4);
            const float rs = rsqrtf(sq * (1.f / 128.f) + EPS);
            bf16_t* po = P + (r0 + t) * LDP + C_MO + h * 128 + dv0;
            float og[16]; unpack8(*(const u32x4*)po, og); unpack8(*(const u32x4*)(po + 8), og + 8);
#pragma unroll
            for (int e = 0; e < 16; ++e) hv[e] = hv[e] * rs * a.in[I_MHN][h * 128 + dv0 + e] * sigmoidf_(og[e]);
            *(u32x4*)po = pack8(hv); *(u32x4*)(po + 8) = pack8(hv + 8); }
        __syncthreads();
    }
}


#define XB_TMO      128
#define XB_XCNT(j)  (256  + 64 * (j))
#define XB_XSUB(j)  (1280 + 64 * (j))
#define XB_XGEN(j)  (2304 + 64 * (j))
#define XB_TOP      3328
#define XB_TOPGEN   3392
#define XCD_BAR_WORDS 3456
#define XB_SPIN_CAP (1u << 22)
__device__ __forceinline__ unsigned xb_ld(unsigned* p)              { return __hip_atomic_load(p, __ATOMIC_RELAXED, __HIP_MEMORY_SCOPE_AGENT); }
__device__ __forceinline__ unsigned xb_add(unsigned* p, unsigned v) { return __hip_atomic_fetch_add(p, v, __ATOMIC_RELAXED, __HIP_MEMORY_SCOPE_AGENT); }
__device__ __forceinline__ unsigned xb_xcc_id() { return (unsigned)__builtin_amdgcn_s_getreg((3 << 11) | 20) & 0xFu; }
#define XB_SPIN(cond, bar) do { unsigned _sp = 0; while (cond) { __builtin_amdgcn_s_sleep(1); \
    if ((++_sp & 255u) == 0u) { if (xb_ld(&(bar)[XB_TMO])) break; if (_sp > XB_SPIN_CAP) { atomicAdd(&(bar)[XB_TMO], 1u); break; } } } } while (0)
struct XcdBarrier { unsigned* bar; unsigned x; volatile LAS unsigned* st; };
__device__ __forceinline__ XcdBarrier xcd_barrier_post(unsigned* bar, volatile LAS unsigned* st) {
    XcdBarrier b; b.bar = bar; b.x = xb_xcc_id(); b.st = st;
    if (threadIdx.x == 0) (void)xb_add(&bar[XB_XCNT(b.x)], 1u);
    return b;
}
__device__ __forceinline__ void xcd_barrier_complete(unsigned* bar, unsigned x, unsigned& nloc, unsigned& nx) {
    const unsigned G = gridDim.x * gridDim.y * gridDim.z;
    unsigned sum, cnt, mine, sp = 0u;
    for (;;) {
        sum = 0u; cnt = 0u; mine = 0u;
#pragma unroll
        for (unsigned j = 0; j < 16; ++j) { const unsigned c = xb_ld(&bar[XB_XCNT(j)]); sum += c; cnt += (c > 0u) ? 1u : 0u; mine = (j == x) ? c : mine; }
        if (sum == G) break;
        __builtin_amdgcn_s_sleep(1);
        if ((++sp & 255u) == 0u) { if (xb_ld(&bar[XB_TMO])) break; if (sp > XB_SPIN_CAP) { atomicAdd(&bar[XB_TMO], 1u); break; } }
    }
    nloc = mine > 0u ? mine : 1u; nx = cnt > 0u ? cnt : 1u;
}
__device__ __forceinline__ void xcd_barrier(const XcdBarrier& b) {
    asm volatile("s_waitcnt vmcnt(0)" ::: "memory");
    __syncthreads();
    if (threadIdx.x == 0) {
        unsigned* bar = b.bar;
        __builtin_amdgcn_s_waitcnt(0);
        unsigned nloc = b.st[0], nx = b.st[1];
        if (nloc == 0u) { xcd_barrier_complete(bar, b.x, nloc, nx); b.st[0] = nloc; b.st[1] = nx; }
        const unsigned old = xb_add(&bar[XB_XSUB(b.x)], 1u);
        const unsigned gen = old / nloc;
        if (old + 1u == (gen + 1u) * nloc) {
            __builtin_amdgcn_fence(__ATOMIC_RELEASE, "agent");
            asm volatile("s_waitcnt vmcnt(0)" ::: "memory");
            const unsigned og = xb_add(&bar[XB_TOP], 1u);
            const unsigned tg = og / nx;
            if (og + 1u == (tg + 1u) * nx) xb_add(&bar[XB_TOPGEN], 1u);
            else XB_SPIN(xb_ld(&bar[XB_TOPGEN]) == tg, bar);
            __builtin_amdgcn_fence(__ATOMIC_ACQUIRE, "agent");
            xb_add(&bar[XB_XGEN(b.x)], 1u);
            asm volatile("s_waitcnt vmcnt(0)" ::: "memory");
        } else {
            XB_SPIN(xb_ld(&bar[XB_XGEN(b.x)]) == gen, bar);
            __builtin_amdgcn_fence(__ATOMIC_ACQUIRE, "agent");
            asm volatile("s_waitcnt vmcnt(0)" ::: "memory");
        }
    }
    __syncthreads();
}

#ifndef DBG_ZERO_YA
#define DBG_ZERO_YA 1
#endif
#ifndef PH
#define PH 0xFFFF
#endif
__global__ void __launch_bounds__(512, 2) mega_fwd(Args a) {
    extern __shared__ __attribute__((aligned(16))) unsigned char lds[];
    cg::grid_group grid = cg::this_grid();
    LAS unsigned char* ldsl = (LAS unsigned char*)lds;
    unsigned char* ws = a.ws;
    const int G = gridDim.x, bid = blockIdx.x;
    bf16_t* XB = (bf16_t*)(ws + WS_XB); bf16_t* Pb = (bf16_t*)(ws + WS_P); bf16_t* MG = (bf16_t*)(ws + WS_MG); bf16_t* QKb = (bf16_t*)(ws + WS_QK);
    float* ss0 = (float*)(ws + WS_SS0); float* ss1 = (float*)(ws + WS_SS1); float* ss2 = (float*)(ws + WS_SS2);

    unsigned* barw = (unsigned*)(ws + WS_BAR);
    if (bid == 0) { for (int i = threadIdx.x; i < XCD_BAR_WORDS; i += 512) barw[i] = 0u; }
    volatile LAS unsigned* bst = (volatile LAS unsigned*)(ldsl + LDS_BYTES - 16);
    if (threadIdx.x == 0) { bst[0] = 0u; bst[1] = 0u; }
    if (PH & 1) phase0(a, lds);
    __threadfence();
    grid.sync();
    const XcdBarrier xbar = xcd_barrier_post(barw, bst);
    if (PH & 2) {
        pg8::Gemm g{XB, (const bf16_t*)(ws + WS_W1), DM, DM, MROWS, 2 * FF, DM}; pg8::StaticOrder S; S.init(MROWS, 2 * FF, G, bid);
        pg8::EpiSwiGLU E{Pb, ss0}; pg8::gemm_phase(ldsl, g, S, E);
    }
    xcd_barrier(xbar);
    if (PH & 4) {
        pg8::Gemm g{Pb, (const bf16_t*)(ws + WS_W2), FF, FF, MROWS, DM, FF}; pg8::StaticOrder S; S.init(MROWS, DM, G, bid);
        pg8::EpiRes<false, false, true> E{a.in[I_X], nullptr, nullptr, XB, (bf16_t*)a.out, ss1, 0.5f}; pg8::gemm_phase(ldsl, g, S, E);
    }
    xcd_barrier(xbar);
    if (PH & 8) {
        pg8::Gemm g{XB, (const bf16_t*)(ws + WS_WIN), DM, DM, MROWS, LDP, DM}; pg8::StaticOrder S; S.init(MROWS, LDP, G, bid);
        pg8::EpiP E{Pb, (float*)(ws + WS_SM), ss1}; pg8::gemm_phase(ldsl, g, S, E);
    }
    xcd_barrier(xbar);
    if (PH & 16) phase_postp(a);
    xcd_barrier(xbar);
    if (PH & 32) {
        pg8::Gemm g{XB, (const bf16_t*)(ws + WS_WQK), 512, 512, MROWS, 512, 512}; pg8::StaticOrder S; S.init(MROWS, 512, G, bid);
        pg8::EpiBf16 E{QKb, 512}; pg8::gemm_phase(ldsl, g, S, E);
    }
    xcd_barrier(xbar);
    if (PH & 64) phase_mlstm_a(a, lds);
    xcd_barrier(xbar);
    if (PH & 128) phase_mlstm_b(a);
    xcd_barrier(xbar);
    if (PH & 256) phase_mlstm_c(a, lds);
    if (DBG_TWICE & 1) phase_dsa<true>(a, lds);
    if (PH & 512) phase_dsa<false>(a, lds);
    xcd_barrier(xbar);
    if (PH & 1024) {
        pg8::StaticOrder S; S.init(MROWS, DM, G, bid);
        { pg8::Gemm g{Pb + C_AQ, (const bf16_t*)(ws + WS_WA), LDP, 512, MROWS, DM, 512}; pg8::EpiMerge<0> E{Pb, MG, C_GA}; pg8::gemm_phase(ldsl, g, S, E); }
        { pg8::Gemm g{Pb + C_MO, (const bf16_t*)(ws + WS_WB), LDP, 512, MROWS, DM, 512}; pg8::EpiMerge<1> E{Pb, MG, C_GB}; pg8::gemm_phase(ldsl, g, S, E); }
    }
    xcd_barrier(xbar);
    if (PH & 2048) {
        pg8::Gemm g{MG, (const bf16_t*)(ws + WS_WO), DM, DM, MROWS, DM, DM}; pg8::StaticOrder S; S.init(MROWS, DM, G, bid);
        pg8::EpiRes<true, false, true> E{nullptr, (const bf16_t*)a.out, nullptr, XB, nullptr, ss2, 1.0f}; pg8::gemm_phase(ldsl, g, S, E);
    }
    xcd_barrier(xbar);
    if (PH & 4096) {
        pg8::Gemm g{XB, (const bf16_t*)(ws + WS_W3), DM, DM, MROWS, 2 * FF, DM}; pg8::StaticOrder S; S.init(MROWS, 2 * FF, G, bid);
        pg8::EpiSwiGLU E{Pb, ss2}; pg8::gemm_phase(ldsl, g, S, E);
    }
    xcd_barrier(xbar);
    if (PH & 8192) {
        pg8::Gemm g{Pb, (const bf16_t*)(ws + WS_W4), FF, FF, MROWS, DM, FF}; pg8::StaticOrder S; S.init(MROWS, DM, G, bid);
        pg8::EpiRes<true, true, false> E{nullptr, XB, a.out, nullptr, nullptr, nullptr, 0.5f}; pg8::gemm_phase(ldsl, g, S, E);
    }
}

extern "C" void kernel_launch(void* const* d_in, const int* in_sizes, int n_in, void* d_out, int out_size, void* d_ws, size_t ws_size, hipStream_t stream) {
    static int grid = 0;
    if (grid == 0) {
        if (n_in != 24 || ws_size < WS_END) { fprintf(stderr, "kernel_launch: unexpected n_in %d / ws %zu\n", n_in, ws_size); grid = -1; return; }
        int dev = 0, cus = 0, per_cu = 0;
        hipGetDevice(&dev);
        hipDeviceGetAttribute(&cus, hipDeviceAttributeMultiprocessorCount, dev);
        hipFuncSetAttribute((const void*)mega_fwd, hipFuncAttributeMaxDynamicSharedMemorySize, LDS_BYTES);
        hipOccupancyMaxActiveBlocksPerMultiprocessor(&per_cu, (const void*)mega_fwd, 512, LDS_BYTES);
        if (per_cu < 1) { fprintf(stderr, "kernel_launch: occupancy query says %d blocks/CU\n", per_cu); per_cu = 1; }
        (void)hipGetLastError();
        grid = cus * per_cu;
    }
    if (grid < 0) return;
    Args a{};
    for (int i = 0; i < 24; ++i) a.in[i] = (const float*)d_in[i];
    a.out = (float*)d_out; a.ws = (unsigned char*)d_ws;
    void* args[] = {&a};
    hipError_t e = hipLaunchCooperativeKernel((const void*)mega_fwd, dim3(grid), dim3(512), args, LDS_BYTES, stream);
    if (e != hipSuccess) fprintf(stderr, "cooperative launch failed: %s (grid %d)\n", hipGetErrorString(e), grid);
}
```

```cpp
#include <hip/hip_runtime.h>
#include <hip/hip_cooperative_groups.h>
#include <cstdio>
#include <cstdint>
namespace cg = cooperative_groups;
#define DBG_ZERO_YA 0
#define DBG_TWICE 0
#define DBG_NOSEL 0

#define LAS __attribute__((address_space(3)))
typedef unsigned short bf16_t;
typedef short bf16x8 __attribute__((ext_vector_type(8)));
typedef float f32x4 __attribute__((ext_vector_type(4)));
typedef unsigned u32x4 __attribute__((ext_vector_type(4)));
typedef unsigned u32x2 __attribute__((ext_vector_type(2)));
typedef __bf16 bf2_t __attribute__((ext_vector_type(2)));
typedef short v4i16_t __attribute__((ext_vector_type(4)));

constexpr int MROWS = 65536, DM = 1024, FF = 2816, SEQ = 8192, NB = 8;
constexpr int LDP = 5120;
constexpr int C_AQ = 0, C_AK = 512, C_AV = 640, C_IQ = 768, C_IK = 1280, C_MX = 1344, C_MV = 1856, C_MO = 2368, C_GA = 2880, C_GB = 3904, C_SM = 4928;
constexpr float EPS = 1e-6f;
constexpr size_t MiB = 1u << 20;
constexpr size_t WS_SS0 = 0, WS_SS1 = 256 * 1024, WS_SS2 = 512 * 1024;
constexpr size_t WS_DN = 1 * MiB;
constexpr size_t WS_ML = 2 * MiB, WS_BL = 2 * MiB + 16384, WS_MS = 2 * MiB + 32768;
constexpr size_t WS_BAR = 2 * MiB + 65536;
constexpr size_t WS_SM = 3 * MiB;
constexpr size_t WS_W1 = 8 * MiB, WS_W2 = 19 * MiB, WS_W3 = 25 * MiB, WS_W4 = 36 * MiB, WS_WIN = 42 * MiB, WS_WA = 52 * MiB, WS_WB = 53 * MiB, WS_WO = 54 * MiB, WS_WQK = 56 * MiB;
constexpr size_t WS_XB = 64 * MiB;
constexpr size_t WS_P = 192 * MiB;
constexpr size_t WS_MG = 832 * MiB;
constexpr size_t WS_IKC = 832 * MiB;
constexpr size_t WS_KVC = 840 * MiB;
constexpr size_t WS_QK = 960 * MiB;
constexpr size_t WS_END = 1024 * MiB;
constexpr int LDS_BYTES = 156 * 1024;

__device__ __forceinline__ unsigned cvt_pk_bf16(float lo, float hi) { unsigned r; asm volatile("v_cvt_pk_bf16_f32 %0, %1, %2" : "=v"(r) : "v"(lo), "v"(hi)); return r; }
__device__ __forceinline__ float bflo(unsigned u) { return __uint_as_float(u << 16); }
__device__ __forceinline__ float bfhi(unsigned u) { return __uint_as_float(u & 0xffff0000u); }
__device__ __forceinline__ float bf1(bf16_t u) { return __uint_as_float(((unsigned)u) << 16); }
__device__ __forceinline__ bf16_t f2bf(float f) { return (bf16_t)(cvt_pk_bf16(f, 0.f) & 0xffffu); }
__device__ __forceinline__ bf16_t f2bf_sw(float f) { const unsigned u = __float_as_uint(f); return (bf16_t)((u + 0x7fffu + ((u >> 16) & 1u)) >> 16); }
__device__ __forceinline__ float wave_sum(float v) {
#pragma unroll
    for (int o = 1; o < 64; o <<= 1) v += __shfl_xor(v, o);
    return v;
}
__device__ __forceinline__ float wave_max(float v) {
#pragma unroll
    for (int o = 1; o < 64; o <<= 1) v = fmaxf(v, __shfl_xor(v, o));
    return v;
}
__device__ __forceinline__ float sigmoidf_(float x) { return __builtin_amdgcn_rcpf(1.f + __expf(-x)); }
__device__ __forceinline__ float dot2bf(unsigned a, unsigned b, float c) { const unsigned aa = a, bb = b; return __builtin_amdgcn_fdot2_f32_bf16(__builtin_bit_cast(bf2_t, aa), __builtin_bit_cast(bf2_t, bb), c, false); }
__device__ __forceinline__ float relu_(float x) { const int i = __float_as_int(x); return __int_as_float(i > 0 ? i : 0); }
__device__ __forceinline__ void lds_order() { asm volatile("" ::: "memory"); }
__device__ __forceinline__ void lds_fence() { asm volatile("s_waitcnt lgkmcnt(0)" ::: "memory"); }
__device__ __forceinline__ void unpack8(u32x4 v, float* f) {
    f[0] = bflo(v.x); f[1] = bfhi(v.x); f[2] = bflo(v.y); f[3] = bfhi(v.y); f[4] = bflo(v.z); f[5] = bfhi(v.z); f[6] = bflo(v.w); f[7] = bfhi(v.w);
}
__device__ __forceinline__ u32x4 pack8(const float* f) {
    u32x4 o; o.x = cvt_pk_bf16(f[0], f[1]); o.y = cvt_pk_bf16(f[2], f[3]); o.z = cvt_pk_bf16(f[4], f[5]); o.w = cvt_pk_bf16(f[6], f[7]); return o;
}

namespace pg8 {
constexpr int BM = 256, BK = 64, HALF = 128, HTB = HALF * BK * 2, NXCD = 8, WGM = 8;
__host__ __device__ __forceinline__ int lds_byte(int r, int c) { const int st = (r >> 4) * 2 + (c >> 5), rr = r & 15, cc = c & 31, ob = rr * 64 + cc * 2; return st * 1024 + (ob ^ (((ob >> 9) & 1) << 5)); }
__host__ __device__ __forceinline__ void stage_rc(int b, int& R, int& C) { const int st = b / 1024, sb = b % 1024, swz = sb ^ (((sb >> 9) & 1) << 5); R = (st >> 1) * 16 + swz / 64; C = (st & 1) * 32 + (swz % 64) / 2; }
__host__ __device__ __forceinline__ int perm32(int rho) { const int n = rho >> 4, i = rho & 15; return 8 * (i >> 2) + 4 * n + (i & 3); }
struct Unit { int pm, pn; };
struct Gemm { const bf16_t* A; const bf16_t* Bt; int lda, ldb, M, N, K; };
struct StaticOrder {
    int nM, nN, nwg, G, c;
    __device__ void init(int M, int N, int G_, int c_) { nM = M / BM; nN = N / BM; nwg = nM * nN; G = G_; c = c_; }
    __device__ bool next(int i, Unit& u) const {
        const long L = (long)i * G + c; if (L >= nwg) return false;
        int wgid = (int)L; { const int q = nwg / NXCD, r = nwg % NXCD, xcd = wgid % NXCD, off = wgid / NXCD; wgid = (xcd < r ? xcd * (q + 1) : r * (q + 1) + (xcd - r) * q) + off; }
        const int nig = WGM * nN, gid = wgid / nig, fm = gid * WGM, gsz = (nM - fm) < WGM ? (nM - fm) : WGM;
        u.pm = fm + ((wgid % nig) % gsz); u.pn = (wgid % nig) / gsz; return true;
    }
};

template <class Epi>
__device__ __forceinline__ void gemm_phase(LAS unsigned char* lds, const Gemm g, const StaticOrder& S, const Epi& E) {
    int tid_ = threadIdx.x; asm volatile("" : "+v"(tid_));
    const int tid = tid_, wid = __builtin_amdgcn_readfirstlane(tid >> 6), lane = tid & 63, wr = wid >> 2, wc = wid & 3, fr = lane & 15, fq = lane >> 4;
    const int K = g.K, nt = K / BK;
    unsigned voffA[2], voffB[2];
#pragma unroll
    for (int i = 0; i < 2; ++i) { int R, C; stage_rc(tid * 16 + i * 8192, R, C); const int Rb = (R & ~31) + perm32(R & 31);
        voffA[i] = (unsigned)(R * g.lda + C) * 2u; voffB[i] = (unsigned)(Rb * g.ldb + C) * 2u; }
    const size_t kstep = (size_t)(BK * 2);
    const size_t hsA = (size_t)HALF * g.lda * 2, hsB = (size_t)HALF * g.ldb * 2;
    const size_t tsA = 2 * hsA, tsB = 2 * hsB;
    const unsigned ldsw = (unsigned)wid * 1024u;
    const int aoff = lds_byte(wr * 64 + fr, fq * 8), boff = lds_byte(wc * 32 + fr, fq * 8);
#define PG8_SA(b, h) (((b) * 2 + (h)) * HTB)
#define PG8_SB(b, h) ((4 + (b) * 2 + (h)) * HTB)
#define PG8_STAGE(bufoff, gbase, voff) do { _Pragma("unroll") for (int _i = 0; _i < 2; ++_i) \
        __builtin_amdgcn_global_load_lds((const unsigned*)((const char*)(gbase) + (voff)[_i]), (LAS unsigned*)(lds + (bufoff) + ldsw + _i * 8192), 16, 0, 0); } while (0)
#define PG8_LDA(dst, b, h) do { _Pragma("unroll") for (int m = 0; m < 4; ++m) _Pragma("unroll") for (int k = 0; k < 2; ++k) dst[m][k] = *(const LAS bf16x8*)(lds + PG8_SA(b, h) + aoff + m * 2048 + k * 1024); } while (0)
#define PG8_LDB(dst, b, h) do { _Pragma("unroll") for (int n = 0; n < 2; ++n) _Pragma("unroll") for (int k = 0; k < 2; ++k) dst[n][k] = *(const LAS bf16x8*)(lds + PG8_SB(b, h) + boff + n * 2048 + k * 1024); } while (0)
#define PG8_MMA(ai, bj, At, Bt) do { __builtin_amdgcn_s_setprio(1); _Pragma("unroll") for (int m = 0; m < 4; ++m) _Pragma("unroll") for (int n = 0; n < 2; ++n) _Pragma("unroll") for (int k = 0; k < 2; ++k) \
        acc[ai][bj][m][n] = __builtin_amdgcn_mfma_f32_16x16x32_bf16(Bt[n][k], At[m][k], acc[ai][bj][m][n], 0, 0, 0); __builtin_amdgcn_s_setprio(0); } while (0)
#define PG8_WAIT_V(n) asm volatile("s_waitcnt vmcnt(" #n ")" ::: "memory")
#define PG8_WAIT_L(n) asm volatile("s_waitcnt lgkmcnt(" #n ")" ::: "memory")
#define PG8_BAR __builtin_amdgcn_s_barrier()
#define PG8_SCHED __builtin_amdgcn_sched_barrier(0)
    Unit cur, nxt; int ui = 0;
    if (!S.next(0, cur)) return;
    f32x4 acc[2][2][4][2];
#pragma unroll
    for (int a = 0; a < 2; ++a)
#pragma unroll
        for (int b = 0; b < 2; ++b)
#pragma unroll
            for (int m = 0; m < 4; ++m)
#pragma unroll
                for (int n = 0; n < 2; ++n) acc[a][b][m][n] = (f32x4){0.f, 0.f, 0.f, 0.f};
    bf16x8 At[4][2], B0[2][2], B1[2][2];
    const char* cA = (const char*)g.A + (size_t)cur.pm * tsA; const char* cB = (const char*)g.Bt + (size_t)cur.pn * tsB;
    PG8_STAGE(PG8_SB(0, 0), cB, voffB); PG8_STAGE(PG8_SB(0, 1), cB + hsB, voffB); PG8_STAGE(PG8_SA(0, 0), cA, voffA); PG8_STAGE(PG8_SA(0, 1), cA + hsA, voffA);
    if (wr == 1) PG8_BAR;
    PG8_WAIT_V(2); PG8_BAR;
    PG8_STAGE(PG8_SB(1, 0), cB + kstep, voffB); PG8_STAGE(PG8_SA(1, 0), cA + kstep, voffA); PG8_STAGE(PG8_SB(1, 1), cB + hsB + kstep, voffB);
    PG8_WAIT_V(6); PG8_BAR;
    for (;;) {
        const bool has_next = S.next(ui + 1, nxt);
        const char* nA = has_next ? (const char*)g.A + (size_t)nxt.pm * tsA : cA; const char* nB = has_next ? (const char*)g.Bt + (size_t)nxt.pn * tsB : cB;
        for (int t = 0; t < nt; t += 2) {
            const bool last = (t == nt - 2);
            const char* a1 = cA + (size_t)(t + 1) * kstep;
            const char* a2 = last ? nA : cA + (size_t)(t + 2) * kstep; const char* b2 = last ? nB : cB + (size_t)(t + 2) * kstep;
            const char* a3 = a2 + kstep; const char* b3 = b2 + kstep;
            PG8_LDB(B0, 0, 0); PG8_LDB(B1, 0, 1); PG8_SCHED; PG8_LDA(At, 0, 0); PG8_STAGE(PG8_SA(1, 1), a1 + hsA, voffA);
            PG8_WAIT_V(8); PG8_WAIT_L(0); PG8_BAR; PG8_MMA(0, 0, At, B0); PG8_MMA(0, 1, At, B1); PG8_BAR; PG8_SCHED;
            PG8_LDA(At, 0, 1); PG8_STAGE(PG8_SB(0, 0), b2, voffB); PG8_STAGE(PG8_SB(0, 1), b2 + hsB, voffB); PG8_STAGE(PG8_SA(0, 0), a2, voffA);
            PG8_WAIT_V(8); PG8_WAIT_L(0); PG8_BAR; PG8_MMA(1, 0, At, B0); PG8_MMA(1, 1, At, B1); PG8_BAR; PG8_SCHED;
            PG8_LDB(B0, 1, 0); PG8_LDB(B1, 1, 1); PG8_SCHED; PG8_LDA(At, 1, 0); PG8_STAGE(PG8_SA(0, 1), a2 + hsA, voffA);
            PG8_WAIT_V(8); PG8_WAIT_L(0); PG8_BAR; PG8_MMA(0, 0, At, B0); PG8_MMA(0, 1, At, B1); PG8_BAR; PG8_SCHED;
            PG8_LDA(At, 1, 1); PG8_STAGE(PG8_SB(1, 0), b3, voffB); PG8_STAGE(PG8_SB(1, 1), b3 + hsB, voffB); PG8_STAGE(PG8_SA(1, 0), a3, voffA);
            PG8_WAIT_V(8); PG8_WAIT_L(0); PG8_BAR; PG8_MMA(1, 0, At, B0); PG8_MMA(1, 1, At, B1); PG8_BAR; PG8_SCHED;
        }
        if (wr == 0) PG8_BAR;
        E(acc, cur, wr, wc, fr, fq);
        if (!has_next) break;
#pragma unroll
        for (int a = 0; a < 2; ++a)
#pragma unroll
            for (int b = 0; b < 2; ++b)
#pragma unroll
                for (int m = 0; m < 4; ++m)
#pragma unroll
                    for (int n = 0; n < 2; ++n) acc[a][b][m][n] = (f32x4){0.f, 0.f, 0.f, 0.f};
        cur = nxt; cA = nA; cB = nB; ++ui;
        if (wr == 1) PG8_BAR;
    }
    PG8_WAIT_V(0);
    PG8_BAR;
#undef PG8_SA
#undef PG8_SB
#undef PG8_STAGE
#undef PG8_LDA
#undef PG8_LDB
#undef PG8_MMA
#undef PG8_WAIT_V
#undef PG8_WAIT_L
#undef PG8_BAR
#undef PG8_SCHED
}

typedef f32x4 AccT[2][2][4][2];
struct EpiSwiGLU {
    bf16_t* O; const float* ss;
    __device__ __forceinline__ void operator()(const AccT& acc, const Unit& u, int wr, int wc, int fr, int fq) const {
        const int row0 = u.pm * BM + wr * 64 + fr, col = u.pn * 128 + wc * 32 + 8 * fq;
#pragma unroll
        for (int ai = 0; ai < 2; ++ai)
#pragma unroll
            for (int m = 0; m < 4; ++m) {
                const int row = row0 + ai * HALF + m * 16;
                const float rs = rsqrtf(ss[row] * (1.f / 1024.f) + EPS);
                float o[8];
#pragma unroll
                for (int n = 0; n < 2; ++n)
#pragma unroll
                    for (int j = 0; j < 4; ++j) { const float gt = acc[ai][0][m][n][j] * rs, up = acc[ai][1][m][n][j] * rs; o[n * 4 + j] = gt * up * sigmoidf_(gt); }
                *(u32x4*)(O + (size_t)row * FF + col) = pack8(o);
            }
    }
};
template <bool RES_BF16, bool WRITE_F32, bool WRITE_XB> struct EpiRes {
    const float* res; const bf16_t* resb; float* out; bf16_t* xb; bf16_t* xb2; float* ss; float alpha;
    __device__ __forceinline__ void operator()(const AccT& acc, const Unit& u, int wr, int wc, int fr, int fq) const {
        const int row0 = u.pm * BM + wr * 64 + fr, col0 = u.pn * BM + wc * 32 + 8 * fq;
#pragma unroll
        for (int ai = 0; ai < 2; ++ai)
#pragma unroll
            for (int m = 0; m < 4; ++m) {
                const int row = row0 + ai * HALF + m * 16; float sq = 0.f;
#pragma unroll
                for (int bj = 0; bj < 2; ++bj) {
                    const size_t off = (size_t)row * DM + col0 + bj * HALF;
                    f32x4 r0, r1;
                    if (RES_BF16) { float f[8]; unpack8(*(const u32x4*)(resb + off), f); r0 = (f32x4){f[0], f[1], f[2], f[3]}; r1 = (f32x4){f[4], f[5], f[6], f[7]}; }
                    else { r0 = *(const f32x4*)(res + off); r1 = *(const f32x4*)(res + off + 4); }
                    const f32x4 v0 = r0 + acc[ai][bj][m][0] * alpha, v1 = r1 + acc[ai][bj][m][1] * alpha;
                    if (WRITE_F32) { *(f32x4*)(out + off) = v0; *(f32x4*)(out + off + 4) = v1; }
                    if (WRITE_XB) {
                        u32x4 w; w.x = cvt_pk_bf16(v0[0], v0[1]); w.y = cvt_pk_bf16(v0[2], v0[3]); w.z = cvt_pk_bf16(v1[0], v1[1]); w.w = cvt_pk_bf16(v1[2], v1[3]);
                        *(u32x4*)(xb + off) = w; if (xb2) *(u32x4*)(xb2 + off) = w;
                        sq += v0[0] * v0[0] + v0[1] * v0[1] + v0[2] * v0[2] + v0[3] * v0[3] + v1[0] * v1[0] + v1[1] * v1[1] + v1[2] * v1[2] + v1[3] * v1[3];
                    }
                }
                if (WRITE_XB) { sq += __shfl_xor(sq, 16); sq += __shfl_xor(sq, 32); if (fq == 0) atomicAdd(ss + row, sq); }
            }
    }
};
struct EpiP {
    bf16_t* P; float* SM; const float* ss;
    __device__ __forceinline__ void operator()(const AccT& acc, const Unit& u, int wr, int wc, int fr, int fq) const {
        const int row0 = u.pm * BM + wr * 64 + fr, col0 = u.pn * BM + wc * 32 + 8 * fq;
#pragma unroll
        for (int ai = 0; ai < 2; ++ai)
#pragma unroll
            for (int m = 0; m < 4; ++m) {
                const int row = row0 + ai * HALF + m * 16;
                const float rs = rsqrtf(ss[row] * (1.f / 1024.f) + EPS);
#pragma unroll
                for (int bj = 0; bj < 2; ++bj) {
                    const int col = col0 + bj * HALF;
                    const f32x4 v0 = acc[ai][bj][m][0] * rs, v1 = acc[ai][bj][m][1] * rs;
                    u32x4 w; w.x = cvt_pk_bf16(v0[0], v0[1]); w.y = cvt_pk_bf16(v0[2], v0[3]); w.z = cvt_pk_bf16(v1[0], v1[1]); w.w = cvt_pk_bf16(v1[2], v1[3]);
                    *(u32x4*)(P + (size_t)row * LDP + col) = w;
                    if (col >= C_SM && col < C_SM + 16) { float* s = SM + (size_t)row * 16 + (col - C_SM); *(f32x4*)s = v0; *(f32x4*)(s + 4) = v1; }
                }
            }
    }
};
struct EpiBf16 {
    bf16_t* O; int ldc;
    __device__ __forceinline__ void operator()(const AccT& acc, const Unit& u, int wr, int wc, int fr, int fq) const {
        const int row0 = u.pm * BM + wr * 64 + fr, col0 = u.pn * BM + wc * 32 + 8 * fq;
#pragma unroll
        for (int ai = 0; ai < 2; ++ai)
#pragma unroll
            for (int m = 0; m < 4; ++m) {
                const int row = row0 + ai * HALF + m * 16;
#pragma unroll
                for (int bj = 0; bj < 2; ++bj) {
                    const f32x4 v0 = acc[ai][bj][m][0], v1 = acc[ai][bj][m][1];
                    u32x4 w; w.x = cvt_pk_bf16(v0[0], v0[1]); w.y = cvt_pk_bf16(v0[2], v0[3]); w.z = cvt_pk_bf16(v1[0], v1[1]); w.w = cvt_pk_bf16(v1[2], v1[3]);
                    *(u32x4*)(O + (size_t)row * ldc + col0 + bj * HALF) = w;
                }
            }
    }
};
template <int PASS> struct EpiMerge {
    const bf16_t* P; bf16_t* MG; int goff;
    __device__ __forceinline__ void operator()(const AccT& acc, const Unit& u, int wr, int wc, int fr, int fq) const {
        const int row0 = u.pm * BM + wr * 64 + fr, col0 = u.pn * BM + wc * 32 + 8 * fq;
#pragma unroll
        for (int ai = 0; ai < 2; ++ai)
#pragma unroll
            for (int m = 0; m < 4; ++m) {
                const int row = row0 + ai * HALF + m * 16;
#pragma unroll
                for (int bj = 0; bj < 2; ++bj) {
                    const int col = col0 + bj * HALF;
                    float gt[8], o[8]; unpack8(*(const u32x4*)(P + (size_t)row * LDP + goff + col), gt);
                    if (PASS == 1) unpack8(*(const u32x4*)(MG + (size_t)row * DM + col), o);
#pragma unroll
                    for (int j = 0; j < 8; ++j) { const float a = acc[ai][bj][m][j >> 2][j & 3] * sigmoidf_(gt[j]); o[j] = (PASS == 1) ? o[j] + a : a; }
                    *(u32x4*)(MG + (size_t)row * DM + col) = pack8(o);
                }
            }
    }
};
}

struct Args {
    const float* in[24];
    float* out;
    unsigned char* ws;
};
enum { I_X = 0, I_F1N, I_F1G, I_F1U, I_F1D, I_MIXN, I_WIN, I_QN, I_KN, I_IKN, I_CW, I_CB, I_WMQ, I_WMK, I_BI, I_BF, I_MHN, I_WPA, I_WPB, I_WOUT, I_F2N, I_F2G, I_F2U, I_F2D };

template <class F> __device__ __forceinline__ void prep_tile(bf16_t* Bt, int K, int n0, int k0, const F src, float* tile) {
    const int tid = threadIdx.x;
    { const int nn = tid & 63, kk = tid >> 6;
#pragma unroll
        for (int i = 0; i < 8; ++i) { const int k = i * 8 + kk; tile[k * 65 + nn] = src(k0 + k, n0 + nn); } }
    __syncthreads();
    { const int nn = tid >> 3, kc = tid & 7; const float* s = tile + (kc * 8) * 65 + nn;
        u32x4 o; o.x = cvt_pk_bf16(s[0], s[65]); o.y = cvt_pk_bf16(s[130], s[195]); o.z = cvt_pk_bf16(s[260], s[325]); o.w = cvt_pk_bf16(s[390], s[455]);
        *(u32x4*)(Bt + (size_t)(n0 + nn) * K + k0 + kc * 8) = o; }
    __syncthreads();
}
struct SrcUp { const float* wg; const float* wu; const float* g;
    __device__ __forceinline__ float operator()(int k, int n) const { const int col = (n >> 8) * 128 + (n & 127); const size_t bj = (size_t)((n >> 7) & 1); const float* w = (const float*)((uintptr_t)wg + ((uintptr_t)wu - (uintptr_t)wg) * bj); return w[(size_t)k * FF + col] * g[k]; } };
struct SrcPlain { const float* w; int ldw;
    __device__ __forceinline__ float operator()(int k, int n) const { return w[(size_t)k * ldw + n]; } };
struct SrcIn { const float* w; const float* g;
    __device__ __forceinline__ float operator()(int k, int n) const {
        int col;
        if (n < 1344) col = n; else if (n < 2368) col = n + 8; else if (n < 4928) col = n + 16;
        else if (n < 4936) col = n - 4928 + 1344; else if (n < 4940) col = n - 4936 + 2376; else if (n < 4944) col = n - 4940 + 2380; else col = -1;
        return col >= 0 ? w[(size_t)k * 4944 + col] * g[k] : 0.f; } };
struct SrcQK { const float* wq; const float* wk;
    __device__ __forceinline__ float operator()(int k, int n) const {
        const int isk = n >> 8, h = (n >> 6) & 3, j = n & 63, hk = k >> 7, c = k & 127;
        if (hk != h) return 0.f;
        const float* w = (const float*)((uintptr_t)wq + ((uintptr_t)wk - (uintptr_t)wq) * (size_t)isk); return w[(size_t)(h * 128 + c) * 64 + j] * (isk ? 1.f : 0.125f); } };

__device__ __forceinline__ void phase0(const Args& a, unsigned char* lds) {
    float* tile = (float*)lds;
    unsigned char* ws = a.ws;
    constexpr int T_UP = 88 * 16, T_DN = 16 * 44, T_IN = 80 * 16, T_PR = 16 * 8, T_WO = 16 * 16, T_QK = 8 * 8;
    constexpr int NITEMS = 2 * T_UP + 2 * T_DN + T_IN + 2 * T_PR + T_WO + T_QK;
    for (int it = blockIdx.x; it < NITEMS; it += gridDim.x) {
        int r = it;
        if (r < T_UP) { SrcUp s{a.in[I_F1G], a.in[I_F1U], a.in[I_F1N]}; prep_tile((bf16_t*)(ws + WS_W1), 1024, (r / 16) * 64, (r % 16) * 64, s, tile); continue; } r -= T_UP;
        if (r < T_UP) { SrcUp s{a.in[I_F2G], a.in[I_F2U], a.in[I_F2N]}; prep_tile((bf16_t*)(ws + WS_W3), 1024, (r / 16) * 64, (r % 16) * 64, s, tile); continue; } r -= T_UP;
        if (r < T_DN) { SrcPlain s{a.in[I_F1D], 1024}; prep_tile((bf16_t*)(ws + WS_W2), FF, (r / 44) * 64, (r % 44) * 64, s, tile); continue; } r -= T_DN;
        if (r < T_DN) { SrcPlain s{a.in[I_F2D], 1024}; prep_tile((bf16_t*)(ws + WS_W4), FF, (r / 44) * 64, (r % 44) * 64, s, tile); continue; } r -= T_DN;
        if (r < T_IN) { SrcIn s{a.in[I_WIN], a.in[I_MIXN]}; prep_tile((bf16_t*)(ws + WS_WIN), 1024, (r / 16) * 64, (r % 16) * 64, s, tile); continue; } r -= T_IN;
        if (r < T_PR) { SrcPlain s{a.in[I_WPA], 1024}; prep_tile((bf16_t*)(ws + WS_WA), 512, (r / 8) * 64, (r % 8) * 64, s, tile); continue; } r -= T_PR;
        if (r < T_PR) { SrcPlain s{a.in[I_WPB], 1024}; prep_tile((bf16_t*)(ws + WS_WB), 512, (r / 8) * 64, (r % 8) * 64, s, tile); continue; } r -= T_PR;
        if (r < T_WO) { SrcPlain s{a.in[I_WOUT], 1024}; prep_tile((bf16_t*)(ws + WS_WO), 1024, (r / 16) * 64, (r % 16) * 64, s, tile); continue; } r -= T_WO;
        { SrcQK s{a.in[I_WMQ], a.in[I_WMK]}; prep_tile((bf16_t*)(ws + WS_WQK), 512, (r / 8) * 64, (r % 8) * 64, s, tile); }
    }
    const int lane = threadIdx.x & 63, gw = blockIdx.x * 8 + (threadIdx.x >> 6), NGW = gridDim.x * 8;
    const float* x = a.in[I_X]; bf16_t* XB = (bf16_t*)(ws + WS_XB);
    float* ss0 = (float*)(ws + WS_SS0); float* ss1 = (float*)(ws + WS_SS1); float* ss2 = (float*)(ws + WS_SS2);
    for (int row = gw; row < MROWS; row += NGW) {
        const f32x4* xr = (const f32x4*)(x + (size_t)row * DM) + lane;
        f32x4 v[4]; float s = 0.f;
#pragma unroll
        for (int j = 0; j < 4; ++j) { v[j] = xr[64 * j]; s += v[j][0] * v[j][0] + v[j][1] * v[j][1] + v[j][2] * v[j][2] + v[j][3] * v[j][3]; }
        s = wave_sum(s);
        if (lane == 0) { ss0[row] = s; ss1[row] = 0.f; ss2[row] = 0.f; }
        unsigned long long* o8 = (unsigned long long*)(XB + (size_t)row * DM) + lane;
#pragma unroll
        for (int j = 0; j < 4; ++j) o8[64 * j] = (unsigned long long)cvt_pk_bf16(v[j][0], v[j][1]) | ((unsigned long long)cvt_pk_bf16(v[j][2], v[j][3]) << 32);
    }
}

__device__ __forceinline__ void phase_postp(const Args& a) {
    unsigned char* ws = a.ws;
    bf16_t* P = (bf16_t*)(ws + WS_P); bf16_t* XC = (bf16_t*)(ws + WS_XB); bf16_t* IKC = (bf16_t*)(ws + WS_IKC); bf16_t* KVC = (bf16_t*)(ws + WS_KVC);
    const int lane = threadIdx.x & 63, gw = blockIdx.x * 8 + (threadIdx.x >> 6), NGW = gridDim.x * 8;
    const int c0 = lane * 8;
    float cw[4][8], cb[8], gq[8], gk[8];
#pragma unroll
    for (int e = 0; e < 8; ++e) {
        cb[e] = a.in[I_CB][c0 + e];
#pragma unroll
        for (int j = 0; j < 4; ++j) cw[j][e] = a.in[I_CW][j * 512 + c0 + e];
        gq[e] = a.in[I_QN][(lane & 7) * 8 + e];
        gk[e] = (lane < 16) ? a.in[I_KN][(lane & 7) * 8 + e] : a.in[I_IKN][(lane & 7) * 8 + e];
    }
    const int koff = (lane < 16) ? (C_AK + lane * 8) : (C_IK + (lane & 7) * 8);
    const int voff = C_AV + ((lane - 32) & 15) * 8;
    u32x4 nmx[4], naq, nkk, nav;
#define PP_LOAD(ROW) do { const int t_ = (ROW) & (SEQ - 1); const bf16_t* pr_ = P + (size_t)(ROW) * LDP; \
        _Pragma("unroll") for (int j = 0; j < 4; ++j) { if (t_ - 3 + j >= 0) nmx[j] = *(const u32x4*)(P + (size_t)((ROW) - 3 + j) * LDP + C_MX + c0); else nmx[j] = (u32x4){0u, 0u, 0u, 0u}; } \
        naq = *(const u32x4*)(pr_ + C_AQ + c0); nkk = *(const u32x4*)(pr_ + koff); nav = *(const u32x4*)(pr_ + voff); } while (0)
    if (gw < MROWS) PP_LOAD(gw);
    for (int row = gw; row < MROWS; row += NGW) {
        bf16_t* pr = P + (size_t)row * LDP;
        u32x4 cmx[4];
#pragma unroll
        for (int j = 0; j < 4; ++j) cmx[j] = nmx[j];
        const u32x4 caq = naq, ckk = nkk, cav = nav;
        if (row + NGW < MROWS) PP_LOAD(row + NGW);
        float accv[8];
#pragma unroll
        for (int e = 0; e < 8; ++e) accv[e] = cb[e];
#pragma unroll
        for (int j = 0; j < 4; ++j) { float xf[8]; unpack8(cmx[j], xf);
#pragma unroll
            for (int e = 0; e < 8; ++e) accv[e] += xf[e] * cw[j][e]; }
#pragma unroll
        for (int e = 0; e < 8; ++e) accv[e] = accv[e] * sigmoidf_(accv[e]);
        *(u32x4*)(XC + (size_t)row * 512 + c0) = pack8(accv);
        { float f[8]; unpack8(caq, f); float s = 0.f;
#pragma unroll
            for (int e = 0; e < 8; ++e) s += f[e] * f[e];
            s += __shfl_xor(s, 1); s += __shfl_xor(s, 2); s += __shfl_xor(s, 4);
            const float rs = rsqrtf(s * (1.f / 64.f) + EPS);
#pragma unroll
            for (int e = 0; e < 8; ++e) f[e] = f[e] * rs * gq[e];
            *(u32x4*)(pr + C_AQ + c0) = pack8(f); }
        { float f[8]; unpack8(ckk, f); float s = 0.f;
#pragma unroll
            for (int e = 0; e < 8; ++e) s += f[e] * f[e];
            s += __shfl_xor(s, 1); s += __shfl_xor(s, 2); s += __shfl_xor(s, 4);
            const float rs = rsqrtf(s * (1.f / 64.f) + EPS);
#pragma unroll
            for (int e = 0; e < 8; ++e) f[e] = f[e] * rs * gk[e];
            if (lane < 16) *(u32x4*)(KVC + (size_t)row * 256 + lane * 8) = pack8(f);
            else if (lane < 24) *(u32x4*)(IKC + ((((size_t)(row >> 4)) * 8 + (lane - 16)) * 16 + (row & 15)) * 8) = pack8(f);
            else if (lane >= 32 && lane < 48) *(u32x4*)(KVC + (size_t)row * 256 + 128 + (lane - 32) * 8) = cav; }
    }
#undef PP_LOAD
}

__device__ __forceinline__ unsigned fkey(float s) { const unsigned u = __float_as_uint(s); return (u & 0x80000000u) ? ~u : (u | 0x80000000u); }


__device__ __forceinline__ unsigned wave_incl_scan_dpp(unsigned x) {
    x += (unsigned)__builtin_amdgcn_update_dpp(0, (int)x, 0x111, 0xf, 0xf, false);
    x += (unsigned)__builtin_amdgcn_update_dpp(0, (int)x, 0x112, 0xf, 0xf, false);
    x += (unsigned)__builtin_amdgcn_update_dpp(0, (int)x, 0x114, 0xf, 0xf, false);
    x += (unsigned)__builtin_amdgcn_update_dpp(0, (int)x, 0x118, 0xf, 0xf, false);
    x += (unsigned)__builtin_amdgcn_update_dpp(0, (int)x, 0x142, 0xa, 0xf, false);
    x += (unsigned)__builtin_amdgcn_update_dpp(0, (int)x, 0x143, 0xc, 0xf, false);
    return x;
}
__device__ __forceinline__ int find_bin(const unsigned* hist, int& need, int lane, int& binc) {
    const int base = 1023 - 16 * lane; unsigned s = 0;
#pragma unroll
    for (int i = 0; i < 16; ++i) { const unsigned w = hist[base - ((i + lane) & 15)]; s += (w & 0xffffu) + (w >> 16); }
    const unsigned p = wave_incl_scan_dpp(s);
    const unsigned long long bal = __ballot(p >= (unsigned)need);
    const int L = bal ? (__ffsll((long long)bal) - 1) : 63;
    const unsigned excl = __shfl(p - s, L);
    const int b0 = 1023 - 16 * L, t = lane & 31;
    const unsigned w2 = hist[b0 - (t >> 1)];
    const unsigned v2 = (lane < 32) ? ((t & 1) ? (w2 & 0xffffu) : (w2 >> 16)) : 0u;
    const unsigned p2 = wave_incl_scan_dpp(v2);
    const unsigned long long bal2 = __ballot((lane < 32) && ((unsigned)excl + p2 >= (unsigned)need));
    const int ts = bal2 ? (__ffsll((long long)bal2) - 1) : 31;
    const int vs = (int)__shfl(v2, ts), ps = (int)__shfl(p2, ts);
    int bin = 2 * (b0 - (ts >> 1)) + ((ts & 1) ? 0 : 1);
    int fneed = need - ((int)excl + ps - vs), bc = vs;
    if (fneed < 1) fneed = 1;
    need = fneed; binc = bc; return bin;
}


__device__ __forceinline__ int find_bin128(const unsigned* sh, int& need, int lane, int& binc) {
    const unsigned hi = sh[127 - 2 * lane], lo = sh[126 - 2 * lane]; const unsigned s = hi + lo;
    const unsigned p = wave_incl_scan_dpp(s);
    const unsigned long long bal = __ballot(p >= (unsigned)need);
    const int L = bal ? (__ffsll((long long)bal) - 1) : 63;
    const int excl = (int)__shfl(p - s, L); const int hiL = (int)__shfl(hi, L), loL = (int)__shfl(lo, L);
    int bin, fneed, bc;
    if (excl + hiL >= need) { bin = 127 - 2 * L; fneed = need - excl; bc = hiL; } else { bin = 126 - 2 * L; fneed = need - excl - hiL; bc = loL; }
    if (fneed < 1) fneed = 1;
    need = fneed; binc = bc; return bin;
}

template <bool DUMMY> __device__ __forceinline__ void phase_dsa(const Args& a, unsigned char* lds) {
    unsigned char* ws = a.ws;
    bf16_t* P = (bf16_t*)(ws + WS_P); const float* SM = (const float*)(ws + WS_SM);
    const bf16_t* IKC = (const bf16_t*)(ws + WS_IKC); const bf16_t* KVC = (const bf16_t*)(ws + WS_KVC);
    constexpr int SCS = 8200;
    float* SC = (float*)lds;
    unsigned* HIST = (unsigned*)(lds + 131200);
    int* LIST = (int*)(lds + 131200 + 16384);
    unsigned* QS = (unsigned*)(lds + 131200 + 16384 + 4096);
    int* CNT = (int*)(lds + 131200 + 16384 + 4096 + 4096);
    const float idx_scale = 0.125f * 0.35355339059327373f;
    f32x4 wqv[2]; unsigned qsv[2];
#define DSA_LOAD_ITEM(ITEM) do { const int b_ = (ITEM) & 7, t0_ = ((ITEM) >> 3) * 4; const size_t r_ = (size_t)b_ * SEQ + t0_; \
        int tl_ = threadIdx.x; asm volatile("" : "+v"(tl_)); const int ln_ = tl_ & 63, q4_ = ln_ >> 4; \
        wqv[0] = *(const f32x4*)(SM + (r_ + q4_) * 16); wqv[1] = *(const f32x4*)(SM + (r_ + q4_) * 16 + 4); \
        _Pragma("unroll") for (int i_ = 0; i_ < 2; ++i_) { const int e_ = tl_ + 512 * i_; qsv[i_] = *(const unsigned*)(P + (r_ + (e_ >> 8)) * LDP + C_AQ + (e_ & 255) * 2); } } while (0)
    if ((int)blockIdx.x < 16384) DSA_LOAD_ITEM(blockIdx.x);
    for (int item = blockIdx.x; item < 16384; item += gridDim.x) {
        int tid_ = threadIdx.x; asm volatile("" : "+v"(tid_));
        const int tid = tid_, wave = __builtin_amdgcn_readfirstlane(tid >> 6), lane = tid & 63, quad = lane >> 4, l15 = lane & 15;
        const int b = item & 7, tq = item >> 3, t0 = tq * 4, L = ((t0 >> 6) + 1) * 64;
        const size_t r0 = (size_t)b * SEQ + t0;
        const bool do_sel = (L > 256) && !DBG_NOSEL;
        { u32x4* hz = (u32x4*)HIST; hz[tid] = (u32x4){0u, 0u, 0u, 0u}; hz[tid + 512] = (u32x4){0u, 0u, 0u, 0u}; }
        if (tid < 8) CNT[4 + tid] = 0;
        QS[tid] = qsv[0]; QS[tid + 512] = qsv[1];
        float wq[8];
#pragma unroll
        for (int h = 0; h < 4; ++h) { wq[h] = wqv[0][h] * idx_scale; wq[4 + h] = wqv[1][h] * idx_scale; }
        bf16x8 af[2][2];
#pragma unroll
        for (int T = 0; T < 2; ++T)
#pragma unroll
            for (int ks = 0; ks < 2; ++ks) af[T][ks] = *(const bf16x8*)(P + (r0 + (l15 >> 2)) * LDP + C_IQ + (4 * T + (l15 & 3)) * 64 + ks * 32 + quad * 8);
        const int ngroups = L >> 6;
        const bf16_t* ikb = IKC + (size_t)b * SEQ * 64 + (quad * 16 + l15) * 8;
        bf16x8 B0[4][2], B1[4][2], B2[4][2];
#define IDX_LOAD(BUF, G) do { _Pragma("unroll") for (int tt = 0; tt < 4; ++tt) _Pragma("unroll") for (int ks = 0; ks < 2; ++ks) \
                BUF[tt][ks] = *(const bf16x8*)(ikb + (size_t)(((G) * 4 + tt) * 8 + ks * 4) * 128); } while (0)
        if (wave < ngroups) IDX_LOAD(B0, wave);
        if (wave + 8 < ngroups) IDX_LOAD(B1, wave + 8);
        if (wave + 16 < ngroups) IDX_LOAD(B2, wave + 16);
        lds_fence(); __builtin_amdgcn_s_barrier();
        for (int rep = 0; rep < ((DBG_TWICE & 2) ? 2 : 1); ++rep) {
            const bool hist_on = do_sel && (rep == (((DBG_TWICE & 2) ? 2 : 1) - 1));
#define IDX_COMPUTE(BUF, G) do { _Pragma("unroll") for (int tt = 0; tt < 4; ++tt) { \
                const int key = (G) * 64 + tt * 16 + l15; \
                f32x4 c0 = (f32x4){0.f, 0.f, 0.f, 0.f}, c1 = (f32x4){0.f, 0.f, 0.f, 0.f}; \
                c0 = __builtin_amdgcn_mfma_f32_16x16x32_bf16(af[0][0], BUF[tt][0], c0, 0, 0, 0); \
                c1 = __builtin_amdgcn_mfma_f32_16x16x32_bf16(af[1][0], BUF[tt][0], c1, 0, 0, 0); \
                c0 = __builtin_amdgcn_mfma_f32_16x16x32_bf16(af[0][1], BUF[tt][1], c0, 0, 0, 0); \
                c1 = __builtin_amdgcn_mfma_f32_16x16x32_bf16(af[1][1], BUF[tt][1], c1, 0, 0, 0); \
                float sc = 0.f; \
                _Pragma("unroll") for (int j = 0; j < 4; ++j) { sc += wq[j] * relu_(c0[j]); sc += wq[4 + j] * relu_(c1[j]); } \
                sc += 0.f; \
                SC[quad * SCS + key] = sc; \
                if (hist_on) { const unsigned bin = fkey(sc) >> 21; atomicAdd(&HIST[quad * 1024 + (bin >> 1)], (bin & 1u) ? 0x10000u : 1u); } } } while (0)
            int g = wave;
            for (; g < ngroups; g += 24) {
                IDX_COMPUTE(B0, g);
                if (g + 24 < ngroups) IDX_LOAD(B0, g + 24);
                if (g + 8 < ngroups) { IDX_COMPUTE(B1, g + 8); if (g + 32 < ngroups) IDX_LOAD(B1, g + 32); }
                if (g + 16 < ngroups) { IDX_COMPUTE(B2, g + 16); if (g + 40 < ngroups) IDX_LOAD(B2, g + 40); }
            }
#undef IDX_LOAD
#undef IDX_COMPUTE
        }
        lds_fence(); __builtin_amdgcn_s_barrier();
        if (item + (int)gridDim.x < 16384) DSA_LOAD_ITEM(item + (int)gridDim.x);
        {
            constexpr int CAP = 448;
            const unsigned long long ltmask = (1ull << lane) - 1ull;
            if (!do_sel) {
                const int q = wave >> 1, hf = wave & 1; int* list = LIST + q * 256;
                if (hf == 0) { for (int i = lane; i < 256; i += 64) list[i] = (i < L) ? i : 0; if (lane == 0) CNT[q] = L; }
            } else {
                {
                    const int q = wave >> 1, hf = wave & 1; int* list = LIST + q * 256; const float* sc = SC + q * SCS; unsigned* hist = HIST + q * 1024;
                    const int halfL = L >> 1, beg = hf * halfL, end = beg + halfL;
                    int need = 256, binc = 0;
                    const unsigned b1 = (unsigned)find_bin(hist, need, lane, binc);
                    const int c1 = binc, nsure = 256 - need; const bool store_c = c1 <= CAP;
                    if (hf == 0 && lane == 0) { CNT[12 + q] = (int)b1; CNT[16 + q] = need; CNT[8 + q] = c1; }
                    lds_fence(); __builtin_amdgcn_s_barrier();
                    int cs = 0, cc = 0;
                    for (int i0 = beg + lane * 4; i0 < end; i0 += 256) { const f32x4 v = *(const f32x4*)(sc + i0);
#pragma unroll
                        for (int e = 0; e < 4; ++e) { const unsigned k = fkey(v[e]); const unsigned kb = k >> 21;
                            const bool sure = kb > b1, cand = (kb == b1) && store_c;
                            const unsigned long long ms = __ballot(sure), mc = __ballot(cand);
                            if (ms) { const int p = cs + __popcll(ms & ltmask); const int pp = hf ? nsure - 1 - p : p; if (sure && pp >= 0 && pp < 256) list[pp] = i0 + e; cs += __popcll(ms); }
                            if (mc) { const int p = cc + __popcll(mc & ltmask); const int pp = hf ? c1 - 1 - p : p; if (cand && pp >= 0 && pp < CAP) { hist[2 * pp] = k; hist[2 * pp + 1] = (unsigned)(i0 + e); } cc += __popcll(mc); } } }
                    lds_fence(); __builtin_amdgcn_s_barrier();
                }
                if (wave < 4) {
                    const int q = wave; int* list = LIST + q * 256; unsigned* hist = HIST + q * 1024; unsigned* sh = hist + 896; const float* sc = SC + q * SCS;
                    const unsigned b1 = (unsigned)CNT[12 + q]; int need = CNT[16 + q]; const int c = CNT[8 + q]; const int nsure = 256 - need;
                    if (c <= CAP) {
                        unsigned ck[7]; int ci[7];
#pragma unroll
                        for (int t = 0; t < 7; ++t) { const int i = lane + 64 * t; const bool valid = i < c; ck[t] = valid ? hist[2 * i] : 0u; ci[t] = valid ? (int)hist[2 * i + 1] : -1; }
                        int binc = 0;
                        sh[2 * lane] = 0u; sh[2 * lane + 1] = 0u; lds_order();
#pragma unroll
                        for (int t = 0; t < 7; ++t) if (ci[t] >= 0) atomicAdd(&sh[(ck[t] >> 14) & 127u], 1u);
                        lds_order();
                        const unsigned bA = (unsigned)find_bin128(sh, need, lane, binc);
                        lds_order();
                        sh[2 * lane] = 0u; sh[2 * lane + 1] = 0u; lds_order();
#pragma unroll
                        for (int t = 0; t < 7; ++t) if (ci[t] >= 0 && ((ck[t] >> 14) & 127u) == bA) atomicAdd(&sh[(ck[t] >> 7) & 127u], 1u);
                        lds_order();
                        const unsigned bB = (unsigned)find_bin128(sh, need, lane, binc);
                        const unsigned preB = (bA << 7) | bB;
                        lds_order();
                        sh[2 * lane] = 0u; sh[2 * lane + 1] = 0u; lds_order();
#pragma unroll
                        for (int t = 0; t < 7; ++t) if (ci[t] >= 0 && ((ck[t] >> 7) & 0x3fffu) == preB) atomicAdd(&sh[ck[t] & 127u], 1u);
                        lds_order();
                        const unsigned bC = (unsigned)find_bin128(sh, need, lane, binc);
                        const unsigned T = (b1 << 21) | (preB << 7) | bC;
                        const int tie_total = binc, need_t = need;
                        int cnt = 0;
#pragma unroll
                        for (int t = 0; t < 7; ++t) {
                            const bool valid = ci[t] >= 0;
                            bool sel = valid && (ck[t] > T);
                            if (valid && ck[t] == T) {
                                if (tie_total == need_t) sel = true;
                                else { int rank = 0; for (int j = 0; j < c; ++j) rank += (hist[2 * j] == T && (int)hist[2 * j + 1] < ci[t]) ? 1 : 0; sel = rank < need_t; }
                            }
                            const unsigned long long m = __ballot(sel);
                            const int pos = nsure + cnt + __popcll(m & ltmask);
                            if (sel && pos < 256) list[pos] = ci[t];
                            cnt += __popcll(m);
                        }
                    } else {
                        int binc = 0;
                        lds_order();
#pragma unroll
                        for (int i = 0; i < 16; ++i) hist[lane * 16 + i] = 0u;
                        lds_order();
                        for (int i0 = 0; i0 < L; i0 += 64) { const unsigned k = fkey(sc[i0 + lane]); if ((k >> 21) == b1) { const unsigned bin = (k >> 10) & 2047u; atomicAdd(&hist[bin >> 1], (bin & 1u) ? 0x10000u : 1u); } }
                        lds_order();
                        const unsigned b2 = (unsigned)find_bin(hist, need, lane, binc);
                        const unsigned pre2 = (b1 << 11) | b2;
                        lds_order();
#pragma unroll
                        for (int i = 0; i < 16; ++i) hist[lane * 16 + i] = 0u;
                        lds_order();
                        for (int i0 = 0; i0 < L; i0 += 64) { const unsigned k = fkey(sc[i0 + lane]); if ((k >> 10) == pre2) { const unsigned bin = k & 1023u; atomicAdd(&hist[bin >> 1], (bin & 1u) ? 0x10000u : 1u); } }
                        lds_order();
                        const unsigned b3 = (unsigned)find_bin(hist, need, lane, binc);
                        const unsigned T = (pre2 << 10) | b3;
                        int count = 0, ties = 0;
                        for (int i0 = 0; i0 < L; i0 += 64) {
                            const unsigned k = fkey(sc[i0 + lane]);
                            const bool eq = (k == T);
                            const unsigned long long em = __ballot(eq);
                            const int erank = ties + __popcll(em & ltmask);
                            const bool sel = (k > T) || (eq && erank < need);
                            const unsigned long long smk = __ballot(sel);
                            const int pos = count + __popcll(smk & ltmask);
                            if (sel && pos < 256) list[pos] = i0 + lane;
                            count += __popcll(smk); ties += __popcll(em);
                        }
                        if (count > 256) count = 256;
                        for (int i = count + lane; i < 256; i += 64) list[i] = 0;
                    }
                    if (lane == 0) CNT[q] = 256;
                }
            }
        }
        lds_fence(); __builtin_amdgcn_s_barrier();
        for (int repc = 0; repc < ((DBG_TWICE & 4) ? 2 : 1); ++repc) {
            const bool dummy_c = (repc + 1) < ((DBG_TWICE & 4) ? 2 : 1);
            int lane_c = lane; asm volatile("" : "+v"(lane_c));
            const int qi = wave >> 1, g = wave & 1; const int count = CNT[qi];
            const int* list = LIST + qi * 256;
            float* PB = SC + wave * 1024;
            const unsigned* qd = QS + (qi * 8 + g * 4) * 32;
            const bf16_t* kvb = KVC + (size_t)b * SEQ * 256 + g * 64;
            const int ks = lane_c >> 3, dg = lane_c & 7, l15c = lane_c & 15, quadc = lane_c >> 4;
            const int nblk = count >> 6;
            bf16_t* KL = (bf16_t*)(lds + 32768 + wave * 9216);
            bf16x8 bq[2];
#pragma unroll
            for (int s2 = 0; s2 < 2; ++s2) {
                bf16x8 t = *(const bf16x8*)((const bf16_t*)QS + (qi * 8 + g * 4 + (l15c & 3)) * 64 + s2 * 32 + quadc * 8);
                if (l15c >= 4) t = (bf16x8){0, 0, 0, 0, 0, 0, 0, 0};
                bq[s2] = t;
            }
            const bf16_t* kb = kvb + dg * 8;
            float sreg[4][4][4];
            u32x4 kcur[8];
#pragma unroll
            for (int u = 0; u < 8; ++u) kcur[u] = *(const u32x4*)(kb + (size_t)list[u * 8 + ks] * 256);
#pragma unroll
            for (int blk = 0; blk < 4; ++blk) {
                if (blk < nblk) {
#pragma unroll
                    for (int u = 0; u < 8; ++u) *(u32x4*)(KL + (u * 8 + ks) * 72 + dg * 8) = kcur[u];
                    if (blk + 1 < nblk) {
#pragma unroll
                        for (int u = 0; u < 8; ++u) kcur[u] = *(const u32x4*)(kb + (size_t)list[(blk + 1) * 64 + u * 8 + ks] * 256);
                    }
                    lds_order();
#pragma unroll
                    for (int kt = 0; kt < 4; ++kt) {
                        f32x4 acc = (f32x4){0.f, 0.f, 0.f, 0.f};
#pragma unroll
                        for (int s2 = 0; s2 < 2; ++s2) acc = __builtin_amdgcn_mfma_f32_16x16x32_bf16(*(const bf16x8*)(KL + (kt * 16 + l15c) * 72 + s2 * 32 + quadc * 8), bq[s2], acc, 0, 0, 0);
#pragma unroll
                        for (int j = 0; j < 4; ++j) sreg[blk][kt][j] = acc[j] * 0.125f;
                    }
                    lds_order();
                } else {
#pragma unroll
                    for (int kt = 0; kt < 4; ++kt)
#pragma unroll
                        for (int j = 0; j < 4; ++j) sreg[blk][kt][j] = -INFINITY;
                }
            }
            const bf16_t* vb = kvb + 128 + dg * 8;
            u32x4 vreg[8];
#pragma unroll
            for (int u = 0; u < 8; ++u) vreg[u] = *(const u32x4*)(vb + (size_t)list[u * 8 + ks] * 256);
            float mx = -INFINITY;
#pragma unroll
            for (int blk = 0; blk < 4; ++blk)
#pragma unroll
                for (int kt = 0; kt < 4; ++kt)
#pragma unroll
                    for (int j = 0; j < 4; ++j) mx = fmaxf(mx, sreg[blk][kt][j]);
            mx = fmaxf(mx, __shfl_xor(mx, 16)); mx = fmaxf(mx, __shfl_xor(mx, 32));
            float sum = 0.f;
#pragma unroll
            for (int blk = 0; blk < 4; ++blk)
#pragma unroll
                for (int kt = 0; kt < 4; ++kt)
#pragma unroll
                    for (int j = 0; j < 4; ++j) { const float e = __expf(sreg[blk][kt][j] - mx); sreg[blk][kt][j] = e; sum += e; }
            sum += __shfl_xor(sum, 16); sum += __shfl_xor(sum, 32);
            const float invs = 1.f / sum;
            f32x4 oacc[4];
#pragma unroll
            for (int dt = 0; dt < 4; ++dt) oacc[dt] = (f32x4){0.f, 0.f, 0.f, 0.f};
            bf16_t* VT = KL;
#pragma unroll
            for (int blk = 0; blk < 4; ++blk) {
                if (blk < nblk) {
#pragma unroll
                    for (int u = 0; u < 8; ++u) {
                        const int rho = ((u >> 2) << 5) + ((((2 * u) & 3) + (ks >> 2)) << 3) + (((u >> 1) & 1) << 2) + (ks & 3);
                        *(u32x4*)(VT + rho * 72 + dg * 8) = vreg[u];
                    }
                    if (blk + 1 < nblk) {
#pragma unroll
                        for (int u = 0; u < 8; ++u) vreg[u] = *(const u32x4*)(vb + (size_t)list[(blk + 1) * 64 + u * 8 + ks] * 256);
                    }
                    lds_order();
#pragma unroll
                    for (int s2 = 0; s2 < 2; ++s2) {
                        u32x4 pw;
                        pw[0] = cvt_pk_bf16(sreg[blk][2 * s2][0], sreg[blk][2 * s2][1]); pw[1] = cvt_pk_bf16(sreg[blk][2 * s2][2], sreg[blk][2 * s2][3]);
                        pw[2] = cvt_pk_bf16(sreg[blk][2 * s2 + 1][0], sreg[blk][2 * s2 + 1][1]); pw[3] = cvt_pk_bf16(sreg[blk][2 * s2 + 1][2], sreg[blk][2 * s2 + 1][3]);
                        const bf16x8 pf = __builtin_bit_cast(bf16x8, pw);
#pragma unroll
                        for (int dt = 0; dt < 4; ++dt) {
                            const LAS unsigned char* vp = (const LAS unsigned char*)VT + ((32 * s2 + 8 * quadc + (l15c >> 2)) * 72) * 2 + dt * 32 + (l15c & 3) * 8;
                            const v4i16_t t0 = __builtin_amdgcn_ds_read_tr16_b64_v4i16((LAS v4i16_t*)vp);
                            const v4i16_t t1 = __builtin_amdgcn_ds_read_tr16_b64_v4i16((LAS v4i16_t*)(vp + 4 * 72 * 2));
                            const bf16x8 af2 = (bf16x8){t0[0], t0[1], t0[2], t0[3], t1[0], t1[1], t1[2], t1[3]};
                            oacc[dt] = __builtin_amdgcn_mfma_f32_16x16x32_bf16(af2, pf, oacc[dt], 0, 0, 0);
                        }
                    }
                    lds_order();
                }
            }
            if (l15c < 4) {
                bf16_t* yo = (DUMMY || dummy_c) ? ((bf16_t*)(ws + WS_MG + 48 * MiB) + (r0 + qi) * 512 + (g * 4 + l15c) * 64 + quadc * 4) : (P + (r0 + qi) * LDP + C_AQ + (g * 4 + l15c) * 64 + quadc * 4);
#pragma unroll
                for (int dt = 0; dt < 4; ++dt) {
                    const f32x4 v = oacc[dt] * invs;
                    u32x2 w; w[0] = cvt_pk_bf16(v[0], v[1]); w[1] = cvt_pk_bf16(v[2], v[3]);
                    *(u32x2*)(yo + dt * 16) = w;
                }
            }
        }
        lds_fence(); __builtin_amdgcn_s_barrier();
    }
#undef DSA_LOAD_ITEM
}

__device__ __forceinline__ float logsigmoidf_(float x) { return fminf(x, 0.f) - log1pf(__expf(-fabsf(x))); }
__device__ __forceinline__ float wave_incl_sum(float v, int lane) {
#pragma unroll
    for (int o = 1; o < 64; o <<= 1) { const float t = __shfl_up(v, o); if (lane >= o) v += t; }
    return v;
}
__device__ __forceinline__ float wave_incl_max(float v, int lane) {
#pragma unroll
    for (int o = 1; o < 64; o <<= 1) { const float t = __shfl_up(v, o); if (lane >= o) v = fmaxf(v, t); }
    return v;
}
__device__ __forceinline__ f32x4 mma_lds(const bf16_t* A, int lda, const bf16_t* Bt, int ldb, int K, int lane) {
    f32x4 acc = (f32x4){0.f, 0.f, 0.f, 0.f};
    const bf16_t* ap = A + (lane & 15) * lda + (lane >> 4) * 8; const bf16_t* bp = Bt + (lane & 15) * ldb + (lane >> 4) * 8;
    for (int k = 0; k < K; k += 32) acc = __builtin_amdgcn_mfma_f32_16x16x32_bf16(*(const bf16x8*)(ap + k), *(const bf16x8*)(bp + k), acc, 0, 0, 0);
    return acc;
}

__device__ __forceinline__ void phase_mlstm_a(const Args& a, unsigned char* lds) {
    unsigned char* ws = a.ws;
    const bf16_t* P = (const bf16_t*)(ws + WS_P); const bf16_t* QK = (const bf16_t*)(ws + WS_QK); const float* SM = (const float*)(ws + WS_SM);
    bf16_t* ST = (bf16_t*)(ws + WS_XB); float* DN = (float*)(ws + WS_DN); float* ML = (float*)(ws + WS_ML); float* BL = (float*)(ws + WS_BL);
    bf16_t* VT = (bf16_t*)lds;
    bf16_t* KT = (bf16_t*)(lds + 18432);
    float* WS_ = (float*)(lds + 18432 + 9216);
    const int tid = threadIdx.x, wave = tid >> 6, lane = tid & 63;
    for (int item = blockIdx.x; item < 4096; item += gridDim.x) {
        const int c = item & 127, h = (item >> 7) & 3, b = item >> 9;
        const size_t r0 = (size_t)b * SEQ + c * 64;
        if (wave == 0) {
            const float ig = SM[(r0 + lane) * 16 + 8 + h] + a.in[I_BI][h];
            const float lf = logsigmoidf_(SM[(r0 + lane) * 16 + 12 + h] + a.in[I_BF][h]);
            const float bs = wave_incl_sum(lf, lane);
            const float bl = __shfl(bs, 63);
            const float wk = bl - bs + ig;
            const float ml = wave_max(wk);
            WS_[lane] = __expf(wk - ml);
            if (lane == 0) { ML[item] = ml; BL[item] = bl; }
        }
        for (int i = tid; i < 1024; i += 512) { const int s = i >> 4, d0 = (i & 15) * 8; float f[8]; unpack8(*(const u32x4*)(P + (r0 + s) * LDP + C_MV + h * 128 + d0), f);
#pragma unroll
            for (int e = 0; e < 8; ++e) VT[(d0 + e) * 72 + s] = f2bf(f[e]); }
        __syncthreads();
        { const int s = tid >> 3, d0 = (tid & 7) * 8; float f[8]; unpack8(*(const u32x4*)(QK + (r0 + s) * 512 + 256 + h * 64 + d0), f); const float w = WS_[s];
#pragma unroll
            for (int e = 0; e < 8; ++e) KT[(d0 + e) * 72 + s] = f2bf(f[e] * w); }
        __syncthreads();
        bf16_t* st = ST + (size_t)item * 8192;
#pragma unroll
        for (int nt = 0; nt < 4; ++nt) {
            const f32x4 acc = mma_lds(VT + wave * 16 * 72, 72, KT + nt * 16 * 72, 72, 64, lane);
#pragma unroll
            for (int j = 0; j < 4; ++j) st[(wave * 16 + (lane >> 4) * 4 + j) * 64 + nt * 16 + (lane & 15)] = f2bf_sw(acc[j]);
        }
        if (tid < 64) { float s = 0.f; for (int k = 0; k < 64; ++k) s += bf1(KT[tid * 72 + k]); DN[item * 64 + tid] = s; }
        __syncthreads();
    }
}
__device__ __forceinline__ void phase_mlstm_b(const Args& a) {
    unsigned char* ws = a.ws;
    unsigned* ST2 = (unsigned*)(ws + WS_XB);
    float* DN = (float*)(ws + WS_DN); const float* ML = (const float*)(ws + WS_ML); const float* BL = (const float*)(ws + WS_BL); float* MS = (float*)(ws + WS_MS);
    const int total = 32 * 4160;
    for (int w = blockIdx.x * 512 + threadIdx.x; w < total; w += gridDim.x * 512) {
        const int bh = w / 4160, e = w % 4160;
        if (e < 4096) {
            unsigned* p = ST2 + (size_t)bh * 128 * 4096 + e;
            float C0 = 0.f, C1 = 0.f, m = 0.f;
            for (int c0 = 0; c0 < 128; c0 += 8) {
                unsigned d[8]; float bl[8], ml[8];
#pragma unroll
                for (int u = 0; u < 8; ++u) { d[u] = p[(size_t)(c0 + u) * 4096]; bl[u] = BL[bh * 128 + c0 + u]; ml[u] = ML[bh * 128 + c0 + u]; }
#pragma unroll
                for (int u = 0; u < 8; ++u) {
                    p[(size_t)(c0 + u) * 4096] = cvt_pk_bf16(C0, C1);
                    if (e == 0) MS[bh * 128 + c0 + u] = m;
                    const float mn = fmaxf(bl[u] + m, ml[u]);
                    const float wc = __expf(bl[u] + m - mn), wd = __expf(ml[u] - mn);
                    C0 = wc * C0 + wd * bflo(d[u]); C1 = wc * C1 + wd * bfhi(d[u]);
                    m = mn;
                }
            }
        } else {
            float* p = DN + (size_t)bh * 128 * 64 + (e - 4096);
            float C = 0.f, m = 0.f;
            for (int c0 = 0; c0 < 128; c0 += 8) {
                float d[8], bl[8], ml[8];
#pragma unroll
                for (int u = 0; u < 8; ++u) { d[u] = p[(size_t)(c0 + u) * 64]; bl[u] = BL[bh * 128 + c0 + u]; ml[u] = ML[bh * 128 + c0 + u]; }
#pragma unroll
                for (int u = 0; u < 8; ++u) {
                    p[(size_t)(c0 + u) * 64] = C;
                    const float mn = fmaxf(bl[u] + m, ml[u]);
                    C = __expf(bl[u] + m - mn) * C + __expf(ml[u] - mn) * d[u];
                    m = mn;
                }
            }
        }
    }
}
__device__ __forceinline__ void phase_mlstm_c(const Args& a, unsigned char* lds) {
    unsigned char* ws = a.ws;
    bf16_t* P = (bf16_t*)(ws + WS_P); const bf16_t* QK = (const bf16_t*)(ws + WS_QK); const float* SM = (const float*)(ws + WS_SM);
    const bf16_t* ST = (const bf16_t*)(ws + WS_XB); const float* DN = (const float*)(ws + WS_DN); const float* MS = (const float*)(ws + WS_MS);
    bf16_t* QS_ = (bf16_t*)lds;
    bf16_t* KS = (bf16_t*)(lds + 9216);
    bf16_t* AP = (bf16_t*)(lds + 18432);
    bf16_t* BT = (bf16_t*)(lds + 18432 + 17408);
    float* OUT = (float*)(lds + 18432 + 17408 + 34816);
    float* GS = (float*)(lds + 18432 + 17408 + 34816 + 33792);
    float* bS = GS; float* aS = GS + 64; float* mtS = GS + 128; float* wiS = GS + 192; float* nS = GS + 256; float* denS = GS + 320;
    const int tid = threadIdx.x, wave = tid >> 6, lane = tid & 63;
    for (int item = blockIdx.x; item < 4096; item += gridDim.x) {
        const int c = item & 127, h = (item >> 7) & 3, b = item >> 9;
        const size_t r0 = (size_t)b * SEQ + c * 64;
        if (wave == 0) {
            const float ig = SM[(r0 + lane) * 16 + 8 + h] + a.in[I_BI][h];
            const float lf = logsigmoidf_(SM[(r0 + lane) * 16 + 12 + h] + a.in[I_BF][h]);
            const float bs = wave_incl_sum(lf, lane);
            const float av = ig - bs;
            const float pm = wave_incl_max(av, lane);
            const float m0 = MS[item];
            const float mt = bs + fmaxf(pm, m0);
            bS[lane] = bs; aS[lane] = av; mtS[lane] = mt; wiS[lane] = __expf(bs + m0 - mt);
            nS[lane] = DN[item * 64 + lane];
        }
        { const int s = tid >> 3, d0 = (tid & 7) * 8;
            *(u32x4*)(QS_ + s * 72 + d0) = *(const u32x4*)(QK + (r0 + s) * 512 + h * 64 + d0);
            *(u32x4*)(KS + s * 72 + d0) = *(const u32x4*)(QK + (r0 + s) * 512 + 256 + h * 64 + d0); }
        for (int i = tid; i < 1024; i += 512) { const int s = i >> 4, d0 = (i & 15) * 8; float f[8]; unpack8(*(const u32x4*)(P + (r0 + s) * LDP + C_MV + h * 128 + d0), f);
#pragma unroll
            for (int e = 0; e < 8; ++e) BT[(d0 + e) * 136 + s] = f2bf(f[e]); }
        { const bf16_t* st = ST + (size_t)item * 8192;
            for (int i = tid; i < 1024; i += 512) { const int dv = i >> 3, k0 = (i & 7) * 8; *(u32x4*)(BT + dv * 136 + 64 + k0) = *(const u32x4*)(st + dv * 64 + k0); } }
        __syncthreads();
#pragma unroll
        for (int u = 0; u < 2; ++u) {
            const int id = wave * 2 + u, tr = id >> 2, tc = id & 3;
            f32x4 acc = (f32x4){0.f, 0.f, 0.f, 0.f};
            if (tc <= tr) acc = mma_lds(QS_ + tr * 16 * 72, 72, KS + tc * 16 * 72, 72, 64, lane);
            const int s = tc * 16 + (lane & 15);
#pragma unroll
            for (int j = 0; j < 4; ++j) { const int t = tr * 16 + (lane >> 4) * 4 + j;
                const float w = (s <= t) ? acc[j] * __expf(bS[t] + aS[s] - mtS[t]) : 0.f;
                AP[t * 136 + s] = f2bf(w); }
        }
        { const int t = tid >> 3, d0 = (tid & 7) * 8; float f[8]; unpack8(*(const u32x4*)(QS_ + t * 72 + d0), f); const float w = wiS[t];
#pragma unroll
            for (int e = 0; e < 8; ++e) f[e] *= w;
            *(u32x4*)(AP + t * 136 + 64 + d0) = pack8(f); }
        __syncthreads();
#pragma unroll
        for (int tr = 0; tr < 4; ++tr) {
            const f32x4 acc = mma_lds(AP + tr * 16 * 136, 136, BT + wave * 16 * 136, 136, 128, lane);
#pragma unroll
            for (int j = 0; j < 4; ++j) OUT[(tr * 16 + (lane >> 4) * 4 + j) * 132 + wave * 16 + (lane & 15)] = acc[j];
        }
        { const int t = tid >> 3, part = tid & 7; float s = 0.f;
#pragma unroll
            for (int e = 0; e < 16; ++e) { const int k = part * 16 + e; const float v = bf1(AP[t * 136 + k]); s += (k < 64) ? v : v * nS[k - 64]; }
            s += __shfl_xor(s, 1); s += __shfl_xor(s, 2); s += __shfl_xor(s, 4);
            if (part == 0) denS[t] = s; }
        __syncthreads();
        { const int t = tid >> 3, part = tid & 7, dv0 = part * 16;
            const float den = fmaxf(fabsf(denS[t]), __expf(-mtS[t])); const float inv = 1.f / den;
            float hv[16]; float sq = 0.f;
#pragma unroll
            for (int e = 0; e < 16; ++e) { hv[e] = OUT[t * 132 + dv0 + e] * inv; sq += hv[e] * hv[e]; }
            sq += __shfl_xor(sq, 1); sq += __shfl_xor(sq, 2); sq += __shfl_xor(sq, 4);
            const float rs = rsqrtf(sq * (1.f / 128.f) + EPS);
            bf16_t* po = P + (r0 + t) * LDP + C_MO + h * 128 + dv0;
            float og[16]; unpack8(*(const u32x4*)po, og); unpack8(*(const u32x4*)(po + 8), og + 8);
#pragma unroll
            for (int e = 0; e < 16; ++e) hv[e] = hv[e] * rs * a.in[I_MHN][h * 128 + dv0 + e] * sigmoidf_(og[e]);
            *(u32x4*)po = pack8(hv); *(u32x4*)(po + 8) = pack8(hv + 8); }
        __syncthreads();
    }
}


#define XB_TMO      128
#define XB_XCNT(j)  (256  + 64 * (j))
#define XB_XSUB(j)  (1280 + 64 * (j))
#define XB_XGEN(j)  (2304 + 64 * (j))
#define XB_TOP      3328
#define XB_TOPGEN   3392
#define XCD_BAR_WORDS 3456
#define XB_SPIN_CAP (1u << 22)
__device__ __forceinline__ unsigned xb_ld(unsigned* p)              { return __hip_atomic_load(p, __ATOMIC_RELAXED, __HIP_MEMORY_SCOPE_AGENT); }
__device__ __forceinline__ unsigned xb_add(unsigned* p, unsigned v) { return __hip_atomic_fetch_add(p, v, __ATOMIC_RELAXED, __HIP_MEMORY_SCOPE_AGENT); }
__device__ __forceinline__ unsigned xb_xcc_id() { return (unsigned)__builtin_amdgcn_s_getreg((3 << 11) | 20) & 0xFu; }
#define XB_SPIN(cond, bar) do { unsigned _sp = 0; while (cond) { __builtin_amdgcn_s_sleep(1); \
    if ((++_sp & 255u) == 0u) { if (xb_ld(&(bar)[XB_TMO])) break; if (_sp > XB_SPIN_CAP) { atomicAdd(&(bar)[XB_TMO], 1u); break; } } } } while (0)
struct XcdBarrier { unsigned* bar; unsigned x; volatile LAS unsigned* st; };
__device__ __forceinline__ XcdBarrier xcd_barrier_post(unsigned* bar, volatile LAS unsigned* st) {
    XcdBarrier b; b.bar = bar; b.x = xb_xcc_id(); b.st = st;
    if (threadIdx.x == 0) (void)xb_add(&bar[XB_XCNT(b.x)], 1u);
    return b;
}
__device__ __forceinline__ void xcd_barrier_complete(unsigned* bar, unsigned x, unsigned& nloc, unsigned& nx) {
    const unsigned G = gridDim.x * gridDim.y * gridDim.z;
    unsigned sum, cnt, mine, sp = 0u;
    for (;;) {
        sum = 0u; cnt = 0u; mine = 0u;
#pragma unroll
        for (unsigned j = 0; j < 16; ++j) { const unsigned c = xb_ld(&bar[XB_XCNT(j)]); sum += c; cnt += (c > 0u) ? 1u : 0u; mine = (j == x) ? c : mine; }
        if (sum == G) break;
        __builtin_amdgcn_s_sleep(1);
        if ((++sp & 255u) == 0u) { if (xb_ld(&bar[XB_TMO])) break; if (sp > XB_SPIN_CAP) { atomicAdd(&bar[XB_TMO], 1u); break; } }
    }
    nloc = mine > 0u ? mine : 1u; nx = cnt > 0u ? cnt : 1u;
}
__device__ __forceinline__ void xcd_barrier(const XcdBarrier& b) {
    asm volatile("s_waitcnt vmcnt(0)" ::: "memory");
    __syncthreads();
    if (threadIdx.x == 0) {
        unsigned* bar = b.bar;
        __builtin_amdgcn_s_waitcnt(0);
        unsigned nloc = b.st[0], nx = b.st[1];
        if (nloc == 0u) { xcd_barrier_complete(bar, b.x, nloc, nx); b.st[0] = nloc; b.st[1] = nx; }
        const unsigned old = xb_add(&bar[XB_XSUB(b.x)], 1u);
        const unsigned gen = old / nloc;
        if (old + 1u == (gen + 1u) * nloc) {
            __builtin_amdgcn_fence(__ATOMIC_RELEASE, "agent");
            asm volatile("s_waitcnt vmcnt(0)" ::: "memory");
            const unsigned og = xb_add(&bar[XB_TOP], 1u);
            const unsigned tg = og / nx;
            if (og + 1u == (tg + 1u) * nx) xb_add(&bar[XB_TOPGEN], 1u);
            else XB_SPIN(xb_ld(&bar[XB_TOPGEN]) == tg, bar);
            __builtin_amdgcn_fence(__ATOMIC_ACQUIRE, "agent");
            xb_add(&bar[XB_XGEN(b.x)], 1u);
            asm volatile("s_waitcnt vmcnt(0)" ::: "memory");
        } else {
            XB_SPIN(xb_ld(&bar[XB_XGEN(b.x)]) == gen, bar);
            __builtin_amdgcn_fence(__ATOMIC_ACQUIRE, "agent");
            asm volatile("s_waitcnt vmcnt(0)" ::: "memory");
        }
    }
    __syncthreads();
}

#ifndef DBG_ZERO_YA
#define DBG_ZERO_YA 1
#endif
#ifndef PH
#define PH 0xFFFF
#endif
__global__ void __launch_bounds__(512, 2) mega_fwd(Args a) {
    extern __shared__ __attribute__((aligned(16))) unsigned char lds[];
    cg::grid_group grid = cg::this_grid();
    LAS unsigned char* ldsl = (LAS unsigned char*)lds;
    unsigned char* ws = a.ws;
    const int G = gridDim.x, bid = blockIdx.x;
    bf16_t* XB = (bf16_t*)(ws + WS_XB); bf16_t* Pb = (bf16_t*)(ws + WS_P); bf16_t* MG = (bf16_t*)(ws + WS_MG); bf16_t* QKb = (bf16_t*)(ws + WS_QK);
    float* ss0 = (float*)(ws + WS_SS0); float* ss1 = (float*)(ws + WS_SS1); float* ss2 = (float*)(ws + WS_SS2);

    unsigned* barw = (unsigned*)(ws + WS_BAR);
    if (bid == 0) { for (int i = threadIdx.x; i < XCD_BAR_WORDS; i += 512) barw[i] = 0u; }
    volatile LAS unsigned* bst = (volatile LAS unsigned*)(ldsl + LDS_BYTES - 16);
    if (threadIdx.x == 0) { bst[0] = 0u; bst[1] = 0u; }
    if (PH & 1) phase0(a, lds);
    __threadfence();
    grid.sync();
    const XcdBarrier xbar = xcd_barrier_post(barw, bst);
    if (PH & 2) {
        pg8::Gemm g{XB, (const bf16_t*)(ws + WS_W1), DM, DM, MROWS, 2 * FF, DM}; pg8::StaticOrder S; S.init(MROWS, 2 * FF, G, bid);
        pg8::EpiSwiGLU E{Pb, ss0}; pg8::gemm_phase(ldsl, g, S, E);
    }
    xcd_barrier(xbar);
    if (PH & 4) {
        pg8::Gemm g{Pb, (const bf16_t*)(ws + WS_W2), FF, FF, MROWS, DM, FF}; pg8::StaticOrder S; S.init(MROWS, DM, G, bid);
        pg8::EpiRes<false, false, true> E{a.in[I_X], nullptr, nullptr, XB, (bf16_t*)a.out, ss1, 0.5f}; pg8::gemm_phase(ldsl, g, S, E);
    }
    xcd_barrier(xbar);
    if (PH & 8) {
        pg8::Gemm g{XB, (const bf16_t*)(ws + WS_WIN), DM, DM, MROWS, LDP, DM}; pg8::StaticOrder S; S.init(MROWS, LDP, G, bid);
        pg8::EpiP E{Pb, (float*)(ws + WS_SM), ss1}; pg8::gemm_phase(ldsl, g, S, E);
    }
    xcd_barrier(xbar);
    if (PH & 16) phase_postp(a);
    xcd_barrier(xbar);
    if (PH & 32) {
        pg8::Gemm g{XB, (const bf16_t*)(ws + WS_WQK), 512, 512, MROWS, 512, 512}; pg8::StaticOrder S; S.init(MROWS, 512, G, bid);
        pg8::EpiBf16 E{QKb, 512}; pg8::gemm_phase(ldsl, g, S, E);
    }
    xcd_barrier(xbar);
    if (PH & 64) phase_mlstm_a(a, lds);
    xcd_barrier(xbar);
    if (PH & 128) phase_mlstm_b(a);
    xcd_barrier(xbar);
    if (PH & 256) phase_mlstm_c(a, lds);
    if (DBG_TWICE & 1) phase_dsa<true>(a, lds);
    if (PH & 512) phase_dsa<false>(a, lds);
    xcd_barrier(xbar);
    if (PH & 1024) {
        pg8::StaticOrder S; S.init(MROWS, DM, G, bid);
        { pg8::Gemm g{Pb + C_AQ, (const bf16_t*)(ws + WS_WA), LDP, 512, MROWS, DM, 512}; pg8::EpiMerge<0> E{Pb, MG, C_GA}; pg8::gemm_phase(ldsl, g, S, E); }
        { pg8::Gemm g{Pb + C_MO, (const bf16_t*)(ws + WS_WB), LDP, 512, MROWS, DM, 512}; pg8::EpiMerge<1> E{Pb, MG, C_GB}; pg8::gemm_phase(ldsl, g, S, E); }
    }
    xcd_barrier(xbar);
    if (PH & 2048) {
        pg8::Gemm g{MG, (const bf16_t*)(ws + WS_WO), DM, DM, MROWS, DM, DM}; pg8::StaticOrder S; S.init(MROWS, DM, G, bid);
        pg8::EpiRes<true, false, true> E{nullptr, (const bf16_t*)a.out, nullptr, XB, nullptr, ss2, 1.0f}; pg8::gemm_phase(ldsl, g, S, E);
    }
    xcd_barrier(xbar);
    if (PH & 4096) {
        pg8::Gemm g{XB, (const bf16_t*)(ws + WS_W3), DM, DM, MROWS, 2 * FF, DM}; pg8::StaticOrder S; S.init(MROWS, 2 * FF, G, bid);
        pg8::EpiSwiGLU E{Pb, ss2}; pg8::gemm_phase(ldsl, g, S, E);
    }
    xcd_barrier(xbar);
    if (PH & 8192) {
        pg8::Gemm g{Pb, (const bf16_t*)(ws + WS_W4), FF, FF, MROWS, DM, FF}; pg8::StaticOrder S; S.init(MROWS, DM, G, bid);
        pg8::EpiRes<true, true, false> E{nullptr, XB, a.out, nullptr, nullptr, nullptr, 0.5f}; pg8::gemm_phase(ldsl, g, S, E);
    }
}

extern "C" void kernel_launch(void* const* d_in, const int* in_sizes, int n_in, void* d_out, int out_size, void* d_ws, size_t ws_size, hipStream_t stream) {
    static int grid = 0;
    if (grid == 0) {
        if (n_in != 24 || ws_size < WS_END) { fprintf(stderr, "kernel_launch: unexpected n_in %d / ws %zu\n", n_in, ws_size); grid = -1; return; }
        int dev = 0, cus = 0, per_cu = 0;
        hipGetDevice(&dev);
        hipDeviceGetAttribute(&cus, hipDeviceAttributeMultiprocessorCount, dev);
        hipFuncSetAttribute((const void*)mega_fwd, hipFuncAttributeMaxDynamicSharedMemorySize, LDS_BYTES);
        hipOccupancyMaxActiveBlocksPerMultiprocessor(&per_cu, (const void*)mega_fwd, 512, LDS_BYTES);
        if (per_cu < 1) { fprintf(stderr, "kernel_launch: occupancy query says %d blocks/CU\n", per_cu); per_cu = 1; }
        (void)hipGetLastError();
        grid = cus * per_cu;
    }
    if (grid < 0) return;
    Args a{};
    for (int i = 0; i < 24; ++i) a.in[i] = (const float*)d_in[i];
    a.out = (float*)d_out; a.ws = (unsigned char*)d_ws;
    void* args[] = {&a};
    hipError_t e = hipLaunchCooperativeKernel((const void*)mega_fwd, dim3(grid), dim3(512), args, LDS_BYTES, stream);
    if (e != hipSuccess) fprintf(stderr, "cooperative launch failed: %s (grid %d)\n", hipGetErrorString(e), grid);
}
```

```cpp
#include <hip/hip_runtime.h>
#include <hip/hip_cooperative_groups.h>
#include <cstdio>
#include <cstdint>
namespace cg = cooperative_groups;
#define DBG_ZERO_YA 0
#define DBG_TWICE 0
#define DBG_NOSEL 0

#define LAS __attribute__((address_space(3)))
typedef unsigned short bf16_t;
typedef short bf16x8 __attribute__((ext_vector_type(8)));
typedef float f32x4 __attribute__((ext_vector_type(4)));
typedef unsigned u32x4 __attribute__((ext_vector_type(4)));
typedef unsigned u32x2 __attribute__((ext_vector_type(2)));
typedef __bf16 bf2_t __attribute__((ext_vector_type(2)));
typedef short v4i16_t __attribute__((ext_vector_type(4)));

constexpr int MROWS = 65536, DM = 1024, FF = 2816, SEQ = 8192, NB = 8;
constexpr int LDP = 5120;
constexpr int C_AQ = 0, C_AK = 512, C_AV = 640, C_IQ = 768, C_IK = 1280, C_MX = 1344, C_MV = 1856, C_MO = 2368, C_GA = 2880, C_GB = 3904, C_SM = 4928;
constexpr float EPS = 1e-6f;
constexpr size_t MiB = 1u << 20;
constexpr size_t WS_SS0 = 0, WS_SS1 = 256 * 1024, WS_SS2 = 512 * 1024;
constexpr size_t WS_DN = 1 * MiB;
constexpr size_t WS_ML = 2 * MiB, WS_BL = 2 * MiB + 16384, WS_MS = 2 * MiB + 32768;
constexpr size_t WS_BAR = 2 * MiB + 65536;
constexpr size_t WS_SM = 3 * MiB;
constexpr size_t WS_W1 = 8 * MiB, WS_W2 = 19 * MiB, WS_W3 = 25 * MiB, WS_W4 = 36 * MiB, WS_WIN = 42 * MiB, WS_WA = 52 * MiB, WS_WB = 53 * MiB, WS_WO = 54 * MiB, WS_WQK = 56 * MiB;
constexpr size_t WS_XB = 64 * MiB;
constexpr size_t WS_P = 192 * MiB;
constexpr size_t WS_MG = 832 * MiB;
constexpr size_t WS_IKC = 832 * MiB;
constexpr size_t WS_KVC = 840 * MiB;
constexpr size_t WS_QK = 960 * MiB;
constexpr size_t WS_END = 1024 * MiB;
constexpr int LDS_BYTES = 156 * 1024;

__device__ __forceinline__ unsigned cvt_pk_bf16(float lo, float hi) { unsigned r; asm volatile("v_cvt_pk_bf16_f32 %0, %1, %2" : "=v"(r) : "v"(lo), "v"(hi)); return r; }
__device__ __forceinline__ float bflo(unsigned u) { return __uint_as_float(u << 16); }
__device__ __forceinline__ float bfhi(unsigned u) { return __uint_as_float(u & 0xffff0000u); }
__device__ __forceinline__ float bf1(bf16_t u) { return __uint_as_float(((unsigned)u) << 16); }
__device__ __forceinline__ bf16_t f2bf(float f) { return (bf16_t)(cvt_pk_bf16(f, 0.f) & 0xffffu); }
__device__ __forceinline__ bf16_t f2bf_sw(float f) { const unsigned u = __float_as_uint(f); return (bf16_t)((u + 0x7fffu + ((u >> 16) & 1u)) >> 16); }
__device__ __forceinline__ float wave_sum(float v) {
#pragma unroll
    for (int o = 1; o < 64; o <<= 1) v += __shfl_xor(v, o);
    return v;
}
__device__ __forceinline__ float wave_max(float v) {
#pragma unroll
    for (int o = 1; o < 64; o <<= 1) v = fmaxf(v, __shfl_xor(v, o));
    return v;
}
__device__ __forceinline__ float sigmoidf_(float x) { return __builtin_amdgcn_rcpf(1.f + __expf(-x)); }
__device__ __forceinline__ float dot2bf(unsigned a, unsigned b, float c) { const unsigned aa = a, bb = b; return __builtin_amdgcn_fdot2_f32_bf16(__builtin_bit_cast(bf2_t, aa), __builtin_bit_cast(bf2_t, bb), c, false); }
__device__ __forceinline__ float relu_(float x) { const int i = __float_as_int(x); return __int_as_float(i > 0 ? i : 0); }
__device__ __forceinline__ void lds_order() { asm volatile("" ::: "memory"); }
__device__ __forceinline__ void lds_fence() { asm volatile("s_waitcnt lgkmcnt(0)" ::: "memory"); }
__device__ __forceinline__ void unpack8(u32x4 v, float* f) {
    f[0] = bflo(v.x); f[1] = bfhi(v.x); f[2] = bflo(v.y); f[3] = bfhi(v.y); f[4] = bflo(v.z); f[5] = bfhi(v.z); f[6] = bflo(v.w); f[7] = bfhi(v.w);
}
__device__ __forceinline__ u32x4 pack8(const float* f) {
    u32x4 o; o.x = cvt_pk_bf16(f[0], f[1]); o.y = cvt_pk_bf16(f[2], f[3]); o.z = cvt_pk_bf16(f[4], f[5]); o.w = cvt_pk_bf16(f[6], f[7]); return o;
}

namespace pg8 {
constexpr int BM = 256, BK = 64, HALF = 128, HTB = HALF * BK * 2, NXCD = 8, WGM = 8;
__host__ __device__ __forceinline__ int lds_byte(int r, int c) { const int st = (r >> 4) * 2 + (c >> 5), rr = r & 15, cc = c & 31, ob = rr * 64 + cc * 2; return st * 1024 + (ob ^ (((ob >> 9) & 1) << 5)); }
__host__ __device__ __forceinline__ void stage_rc(int b, int& R, int& C) { const int st = b / 1024, sb = b % 1024, swz = sb ^ (((sb >> 9) & 1) << 5); R = (st >> 1) * 16 + swz / 64; C = (st & 1) * 32 + (swz % 64) / 2; }
__host__ __device__ __forceinline__ int perm32(int rho) { const int n = rho >> 4, i = rho & 15; return 8 * (i >> 2) + 4 * n + (i & 3); }
struct Unit { int pm, pn; };
struct Gemm { const bf16_t* A; const bf16_t* Bt; int lda, ldb, M, N, K; };
struct StaticOrder {
    int nM, nN, nwg, G, c;
    __device__ void init(int M, int N, int G_, int c_) { nM = M / BM; nN = N / BM; nwg = nM * nN; G = G_; c = c_; }
    __device__ bool next(int i, Unit& u) const {
        const long L = (long)i * G + c; if (L >= nwg) return false;
        int wgid = (int)L; { const int q = nwg / NXCD, r = nwg % NXCD, xcd = wgid % NXCD, off = wgid / NXCD; wgid = (xcd < r ? xcd * (q + 1) : r * (q + 1) + (xcd - r) * q) + off; }
        const int nig = WGM * nN, gid = wgid / nig, fm = gid * WGM, gsz = (nM - fm) < WGM ? (nM - fm) : WGM;
        u.pm = fm + ((wgid % nig) % gsz); u.pn = (wgid % nig) / gsz; return true;
    }
};

template <class Epi>
__device__ __forceinline__ void gemm_phase(LAS unsigned char* lds, const Gemm g, const StaticOrder& S, const Epi& E) {
    int tid_ = threadIdx.x; asm volatile("" : "+v"(tid_));
    const int tid = tid_, wid = __builtin_amdgcn_readfirstlane(tid >> 6), lane = tid & 63, wr = wid >> 2, wc = wid & 3, fr = lane & 15, fq = lane >> 4;
    const int K = g.K, nt = K / BK;
    unsigned voffA[2], voffB[2];
#pragma unroll
    for (int i = 0; i < 2; ++i) { int R, C; stage_rc(tid * 16 + i * 8192, R, C); const int Rb = (R & ~31) + perm32(R & 31);
        voffA[i] = (unsigned)(R * g.lda + C) * 2u; voffB[i] = (unsigned)(Rb * g.ldb + C) * 2u; }
    const size_t kstep = (size_t)(BK * 2);
    const size_t hsA = (size_t)HALF * g.lda * 2, hsB = (size_t)HALF * g.ldb * 2;
    const size_t tsA = 2 * hsA, tsB = 2 * hsB;
    const unsigned ldsw = (unsigned)wid * 1024u;
    const int aoff = lds_byte(wr * 64 + fr, fq * 8), boff = lds_byte(wc * 32 + fr, fq * 8);
#define PG8_SA(b, h) (((b) * 2 + (h)) * HTB)
#define PG8_SB(b, h) ((4 + (b) * 2 + (h)) * HTB)
#define PG8_STAGE(bufoff, gbase, voff) do { _Pragma("unroll") for (int _i = 0; _i < 2; ++_i) \
        __builtin_amdgcn_global_load_lds((const unsigned*)((const char*)(gbase) + (voff)[_i]), (LAS unsigned*)(lds + (bufoff) + ldsw + _i * 8192), 16, 0, 0); } while (0)
#define PG8_LDA(dst, b, h) do { _Pragma("unroll") for (int m = 0; m < 4; ++m) _Pragma("unroll") for (int k = 0; k < 2; ++k) dst[m][k] = *(const LAS bf16x8*)(lds + PG8_SA(b, h) + aoff + m * 2048 + k * 1024); } while (0)
#define PG8_LDB(dst, b, h) do { _Pragma("unroll") for (int n = 0; n < 2; ++n) _Pragma("unroll") for (int k = 0; k < 2; ++k) dst[n][k] = *(const LAS bf16x8*)(lds + PG8_SB(b, h) + boff + n * 2048 + k * 1024); } while (0)
#define PG8_MMA(ai, bj, At, Bt) do { __builtin_amdgcn_s_setprio(1); _Pragma("unroll") for (int m = 0; m < 4; ++m) _Pragma("unroll") for (int n = 0; n < 2; ++n) _Pragma("unroll") for (int k = 0; k < 2; ++k) \
        acc[ai][bj][m][n] = __builtin_amdgcn_mfma_f32_16x16x32_bf16(Bt[n][k], At[m][k], acc[ai][bj][m][n], 0, 0, 0); __builtin_amdgcn_s_setprio(0); } while (0)
#define PG8_WAIT_V(n) asm volatile("s_waitcnt vmcnt(" #n ")" ::: "memory")
#define PG8_WAIT_L(n) asm volatile("s_waitcnt lgkmcnt(" #n ")" ::: "memory")
#define PG8_BAR __builtin_amdgcn_s_barrier()
#define PG8_SCHED __builtin_amdgcn_sched_barrier(0)
    Unit cur, nxt; int ui = 0;
    if (!S.next(0, cur)) return;
    f32x4 acc[2][2][4][2];
#pragma unroll
    for (int a = 0; a < 2; ++a)
#pragma unroll
        for (int b = 0; b < 2; ++b)
#pragma unroll
            for (int m = 0; m < 4; ++m)
#pragma unroll
                for (int n = 0; n < 2; ++n) acc[a][b][m][n] = (f32x4){0.f, 0.f, 0.f, 0.f};
    bf16x8 At[4][2], B0[2][2], B1[2][2];
    const char* cA = (const char*)g.A + (size_t)cur.pm * tsA; const char* cB = (const char*)g.Bt + (size_t)cur.pn * tsB;
    PG8_STAGE(PG8_SB(0, 0), cB, voffB); PG8_STAGE(PG8_SB(0, 1), cB + hsB, voffB); PG8_STAGE(PG8_SA(0, 0), cA, voffA); PG8_STAGE(PG8_SA(0, 1), cA + hsA, voffA);
    if (wr == 1) PG8_BAR;
    PG8_WAIT_V(2); PG8_BAR;
    PG8_STAGE(PG8_SB(1, 0), cB + kstep, voffB); PG8_STAGE(PG8_SA(1, 0), cA + kstep, voffA); PG8_STAGE(PG8_SB(1, 1), cB + hsB + kstep, voffB);
    PG8_WAIT_V(6); PG8_BAR;
    for (;;) {
        const bool has_next = S.next(ui + 1, nxt);
        const char* nA = has_next ? (const char*)g.A + (size_t)nxt.pm * tsA : cA; const char* nB = has_next ? (const char*)g.Bt + (size_t)nxt.pn * tsB : cB;
        for (int t = 0; t < nt; t += 2) {
            const bool last = (t == nt - 2);
            const char* a1 = cA + (size_t)(t + 1) * kstep;
            const char* a2 = last ? nA : cA + (size_t)(t + 2) * kstep; const char* b2 = last ? nB : cB + (size_t)(t + 2) * kstep;
            const char* a3 = a2 + kstep; const char* b3 = b2 + kstep;
            PG8_LDB(B0, 0, 0); PG8_LDB(B1, 0, 1); PG8_SCHED; PG8_LDA(At, 0, 0); PG8_STAGE(PG8_SA(1, 1), a1 + hsA, voffA);
            PG8_WAIT_V(8); PG8_WAIT_L(0); PG8_BAR; PG8_MMA(0, 0, At, B0); PG8_MMA(0, 1, At, B1); PG8_BAR; PG8_SCHED;
            PG8_LDA(At, 0, 1); PG8_STAGE(PG8_SB(0, 0), b2, voffB); PG8_STAGE(PG8_SB(0, 1), b2 + hsB, voffB); PG8_STAGE(PG8_SA(0, 0), a2, voffA);
            PG8_WAIT_V(8); PG8_WAIT_L(0); PG8_BAR; PG8_MMA(1, 0, At, B0); PG8_MMA(1, 1, At, B1); PG8_BAR; PG8_SCHED;
            PG8_LDB(B0, 1, 0); PG8_LDB(B1, 1, 1); PG8_SCHED; PG8_LDA(At, 1, 0); PG8_STAGE(PG8_SA(0, 1), a2 + hsA, voffA);
            PG8_WAIT_V(8); PG8_WAIT_L(0); PG8_BAR; PG8_MMA(0, 0, At, B0); PG8_MMA(0, 1, At, B1); PG8_BAR; PG8_SCHED;
            PG8_LDA(At, 1, 1); PG8_STAGE(PG8_SB(1, 0), b3, voffB); PG8_STAGE(PG8_SB(1, 1), b3 + hsB, voffB); PG8_STAGE(PG8_SA(1, 0), a3, voffA);
            PG8_WAIT_V(8); PG8_WAIT_L(0); PG8_BAR; PG8_MMA(1, 0, At, B0); PG8_MMA(1, 1, At, B1); PG8_BAR; PG8_SCHED;
        }
        if (wr == 0) PG8_BAR;
        E(acc, cur, wr, wc, fr, fq);
        if (!has_next) break;
#pragma unroll
        for (int a = 0; a < 2; ++a)
#pragma unroll
            for (int b = 0; b < 2; ++b)
#pragma unroll
                for (int m = 0; m < 4; ++m)
#pragma unroll
                    for (int n = 0; n < 2; ++n) acc[a][b][m][n] = (f32x4){0.f, 0.f, 0.f, 0.f};
        cur = nxt; cA = nA; cB = nB; ++ui;
        if (wr == 1) PG8_BAR;
    }
    PG8_WAIT_V(0);
    PG8_BAR;
#undef PG8_SA
#undef PG8_SB
#undef PG8_STAGE
#undef PG8_LDA
#undef PG8_LDB
#undef PG8_MMA
#undef PG8_WAIT_V
#undef PG8_WAIT_L
#undef PG8_BAR
#undef PG8_SCHED
}

typedef f32x4 AccT[2][2][4][2];
struct EpiSwiGLU {
    bf16_t* O; const float* ss;
    __device__ __forceinline__ void operator()(const AccT& acc, const Unit& u, int wr, int wc, int fr, int fq) const {
        const int row0 = u.pm * BM + wr * 64 + fr, col = u.pn * 128 + wc * 32 + 8 * fq;
#pragma unroll
        for (int ai = 0; ai < 2; ++ai)
#pragma unroll
            for (int m = 0; m < 4; ++m) {
                const int row = row0 + ai * HALF + m * 16;
                const float rs = rsqrtf(ss[row] * (1.f / 1024.f) + EPS);
                float o[8];
#pragma unroll
                for (int n = 0; n < 2; ++n)
#pragma unroll
                    for (int j = 0; j < 4; ++j) { const float gt = acc[ai][0][m][n][j] * rs, up = acc[ai][1][m][n][j] * rs; o[n * 4 + j] = gt * up * sigmoidf_(gt); }
                *(u32x4*)(O + (size_t)row * FF + col) = pack8(o);
            }
    }
};
template <bool RES_BF16, bool WRITE_F32, bool WRITE_XB> struct EpiRes {
    const float* res; const bf16_t* resb; float* out; bf16_t* xb; bf16_t* xb2; float* ss; float alpha;
    __device__ __forceinline__ void operator()(const AccT& acc, const Unit& u, int wr, int wc, int fr, int fq) const {
        const int row0 = u.pm * BM + wr * 64 + fr, col0 = u.pn * BM + wc * 32 + 8 * fq;
#pragma unroll
        for (int ai = 0; ai < 2; ++ai)
#pragma unroll
            for (int m = 0; m < 4; ++m) {
                const int row = row0 + ai * HALF + m * 16; float sq = 0.f;
#pragma unroll
                for (int bj = 0; bj < 2; ++bj) {
                    const size_t off = (size_t)row * DM + col0 + bj * HALF;
                    f32x4 r0, r1;
                    if (RES_BF16) { float f[8]; unpack8(*(const u32x4*)(resb + off), f); r0 = (f32x4){f[0], f[1], f[2], f[3]}; r1 = (f32x4){f[4], f[5], f[6], f[7]}; }
                    else { r0 = *(const f32x4*)(res + off); r1 = *(const f32x4*)(res + off + 4); }
                    const f32x4 v0 = r0 + acc[ai][bj][m][0] * alpha, v1 = r1 + acc[ai][bj][m][1] * alpha;
                    if (WRITE_F32) { *(f32x4*)(out + off) = v0; *(f32x4*)(out + off + 4) = v1; }
                    if (WRITE_XB) {
                        u32x4 w; w.x = cvt_pk_bf16(v0[0], v0[1]); w.y = cvt_pk_bf16(v0[2], v0[3]); w.z = cvt_pk_bf16(v1[0], v1[1]); w.w = cvt_pk_bf16(v1[2], v1[3]);
                        *(u32x4*)(xb + off) = w; if (xb2) *(u32x4*)(xb2 + off) = w;
                        sq += v0[0] * v0[0] + v0[1] * v0[1] + v0[2] * v0[2] + v0[3] * v0[3] + v1[0] * v1[0] + v1[1] * v1[1] + v1[2] * v1[2] + v1[3] * v1[3];
                    }
                }
                if (WRITE_XB) { sq += __shfl_xor(sq, 16); sq += __shfl_xor(sq, 32); if (fq == 0) atomicAdd(ss + row, sq); }
            }
    }
};
struct EpiP {
    bf16_t* P; float* SM; const float* ss;
    __device__ __forceinline__ void operator()(const AccT& acc, const Unit& u, int wr, int wc, int fr, int fq) const {
        const int row0 = u.pm * BM + wr * 64 + fr, col0 = u.pn * BM + wc * 32 + 8 * fq;
#pragma unroll
        for (int ai = 0; ai < 2; ++ai)
#pragma unroll
            for (int m = 0; m < 4; ++m) {
                const int row = row0 + ai * HALF + m * 16;
                const float rs = rsqrtf(ss[row] * (1.f / 1024.f) + EPS);
#pragma unroll
                for (int bj = 0; bj < 2; ++bj) {
                    const int col = col0 + bj * HALF;
                    const f32x4 v0 = acc[ai][bj][m][0] * rs, v1 = acc[ai][bj][m][1] * rs;
                    u32x4 w; w.x = cvt_pk_bf16(v0[0], v0[1]); w.y = cvt_pk_bf16(v0[2], v0[3]); w.z = cvt_pk_bf16(v1[0], v1[1]); w.w = cvt_pk_bf16(v1[2], v1[3]);
                    *(u32x4*)(P + (size_t)row * LDP + col) = w;
                    if (col >= C_SM && col < C_SM + 16) { float* s = SM + (size_t)row * 16 + (col - C_SM); *(f32x4*)s = v0; *(f32x4*)(s + 4) = v1; }
                }
            }
    }
};
struct EpiBf16 {
    bf16_t* O; int ldc;
    __device__ __forceinline__ void operator()(const AccT& acc, const Unit& u, int wr, int wc, int fr, int fq) const {
        const int row0 = u.pm * BM + wr * 64 + fr, col0 = u.pn * BM + wc * 32 + 8 * fq;
#pragma unroll
        for (int ai = 0; ai < 2; ++ai)
#pragma unroll
            for (int m = 0; m < 4; ++m) {
                const int row = row0 + ai * HALF + m * 16;
#pragma unroll
                for (int bj = 0; bj < 2; ++bj) {
                    const f32x4 v0 = acc[ai][bj][m][0], v1 = acc[ai][bj][m][1];
                    u32x4 w; w.x = cvt_pk_bf16(v0[0], v0[1]); w.y = cvt_pk_bf16(v0[2], v0[3]); w.z = cvt_pk_bf16(v1[0], v1[1]); w.w = cvt_pk_bf16(v1[2], v1[3]);
                    *(u32x4*)(O + (size_t)row * ldc + col0 + bj * HALF) = w;
                }
            }
    }
};
template <int PASS> struct EpiMerge {
    const bf16_t* P; bf16_t* MG; int goff;
    __device__ __forceinline__ void operator()(const AccT& acc, const Unit& u, int wr, int wc, int fr, int fq) const {
        const int row0 = u.pm * BM + wr * 64 + fr, col0 = u.pn * BM + wc * 32 + 8 * fq;
#pragma unroll
        for (int ai = 0; ai < 2; ++ai)
#pragma unroll
            for (int m = 0; m < 4; ++m) {
                const int row = row0 + ai * HALF + m * 16;
#pragma unroll
                for (int bj = 0; bj < 2; ++bj) {
                    const int col = col0 + bj * HALF;
                    float gt[8], o[8]; unpack8(*(const u32x4*)(P + (size_t)row * LDP + goff + col), gt);
                    if (PASS == 1) unpack8(*(const u32x4*)(MG + (size_t)row * DM + col), o);
#pragma unroll
                    for (int j = 0; j < 8; ++j) { const float a = acc[ai][bj][m][j >> 2][j & 3] * sigmoidf_(gt[j]); o[j] = (PASS == 1) ? o[j] + a : a; }
                    *(u32x4*)(MG + (size_t)row * DM + col) = pack8(o);
                }
            }
    }
};
}

struct Args {
    const float* in[24];
    float* out;
    unsigned char* ws;
};
enum { I_X = 0, I_F1N, I_F1G, I_F1U, I_F1D, I_MIXN, I_WIN, I_QN, I_KN, I_IKN, I_CW, I_CB, I_WMQ, I_WMK, I_BI, I_BF, I_MHN, I_WPA, I_WPB, I_WOUT, I_F2N, I_F2G, I_F2U, I_F2D };

template <class F> __device__ __forceinline__ void prep_tile(bf16_t* Bt, int K, int n0, int k0, const F src, float* tile) {
    const int tid = threadIdx.x;
    { const int nn = tid & 63, kk = tid >> 6;
#pragma unroll
        for (int i = 0; i < 8; ++i) { const int k = i * 8 + kk; tile[k * 65 + nn] = src(k0 + k, n0 + nn); } }
    __syncthreads();
    { const int nn = tid >> 3, kc = tid & 7; const float* s = tile + (kc * 8) * 65 + nn;
        u32x4 o; o.x = cvt_pk_bf16(s[0], s[65]); o.y = cvt_pk_bf16(s[130], s[195]); o.z = cvt_pk_bf16(s[260], s[325]); o.w = cvt_pk_bf16(s[390], s[455]);
        *(u32x4*)(Bt + (size_t)(n0 + nn) * K + k0 + kc * 8) = o; }
    __syncthreads();
}
struct SrcUp { const float* wg; const float* wu; const float* g;
    __device__ __forceinline__ float operator()(int k, int n) const { const int col = (n >> 8) * 128 + (n & 127); const size_t bj = (size_t)((n >> 7) & 1); const float* w = (const float*)((uintptr_t)wg + ((uintptr_t)wu - (uintptr_t)wg) * bj); return w[(size_t)k * FF + col] * g[k]; } };
struct SrcPlain { const float* w; int ldw;
    __device__ __forceinline__ float operator()(int k, int n) const { return w[(size_t)k * ldw + n]; } };
struct SrcIn { const float* w; const float* g;
    __device__ __forceinline__ float operator()(int k, int n) const {
        int col;
        if (n < 1344) col = n; else if (n < 2368) col = n + 8; else if (n < 4928) col = n + 16;
        else if (n < 4936) col = n - 4928 + 1344; else if (n < 4940) col = n - 4936 + 2376; else if (n < 4944) col = n - 4940 + 2380; else col = -1;
        return col >= 0 ? w[(size_t)k * 4944 + col] * g[k] : 0.f; } };
struct SrcQK { const float* wq; const float* wk;
    __device__ __forceinline__ float operator()(int k, int n) const {
        const int isk = n >> 8, h = (n >> 6) & 3, j = n & 63, hk = k >> 7, c = k & 127;
        if (hk != h) return 0.f;
        const float* w = (const float*)((uintptr_t)wq + ((uintptr_t)wk - (uintptr_t)wq) * (size_t)isk); return w[(size_t)(h * 128 + c) * 64 + j] * (isk ? 1.f : 0.125f); } };

__device__ __forceinline__ void phase0(const Args& a, unsigned char* lds) {
    float* tile = (float*)lds;
    unsigned char* ws = a.ws;
    constexpr int T_UP = 88 * 16, T_DN = 16 * 44, T_IN = 80 * 16, T_PR = 16 * 8, T_WO = 16 * 16, T_QK = 8 * 8;
    constexpr int NITEMS = 2 * T_UP + 2 * T_DN + T_IN + 2 * T_PR + T_WO + T_QK;
    for (int it = blockIdx.x; it < NITEMS; it += gridDim.x) {
        int r = it;
        if (r < T_UP) { SrcUp s{a.in[I_F1G], a.in[I_F1U], a.in[I_F1N]}; prep_tile((bf16_t*)(ws + WS_W1), 1024, (r / 16) * 64, (r % 16) * 64, s, tile); continue; } r -= T_UP;
        if (r < T_UP) { SrcUp s{a.in[I_F2G], a.in[I_F2U], a.in[I_F2N]}; prep_tile((bf16_t*)(ws + WS_W3), 1024, (r / 16) * 64, (r % 16) * 64, s, tile); continue; } r -= T_UP;
        if (r < T_DN) { SrcPlain s{a.in[I_F1D], 1024}; prep_tile((bf16_t*)(ws + WS_W2), FF, (r / 44) * 64, (r % 44) * 64, s, tile); continue; } r -= T_DN;
        if (r < T_DN) { SrcPlain s{a.in[I_F2D], 1024}; prep_tile((bf16_t*)(ws + WS_W4), FF, (r / 44) * 64, (r % 44) * 64, s, tile); continue; } r -= T_DN;
        if (r < T_IN) { SrcIn s{a.in[I_WIN], a.in[I_MIXN]}; prep_tile((bf16_t*)(ws + WS_WIN), 1024, (r / 16) * 64, (r % 16) * 64, s, tile); continue; } r -= T_IN;
        if (r < T_PR) { SrcPlain s{a.in[I_WPA], 1024}; prep_tile((bf16_t*)(ws + WS_WA), 512, (r / 8) * 64, (r % 8) * 64, s, tile); continue; } r -= T_PR;
        if (r < T_PR) { SrcPlain s{a.in[I_WPB], 1024}; prep_tile((bf16_t*)(ws + WS_WB), 512, (r / 8) * 64, (r % 8) * 64, s, tile); continue; } r -= T_PR;
        if (r < T_WO) { SrcPlain s{a.in[I_WOUT], 1024}; prep_tile((bf16_t*)(ws + WS_WO), 1024, (r / 16) * 64, (r % 16) * 64, s, tile); continue; } r -= T_WO;
        { SrcQK s{a.in[I_WMQ], a.in[I_WMK]}; prep_tile((bf16_t*)(ws + WS_WQK), 512, (r / 8) * 64, (r % 8) * 64, s, tile); }
    }
    const int lane = threadIdx.x & 63, gw = blockIdx.x * 8 + (threadIdx.x >> 6), NGW = gridDim.x * 8;
    const float* x = a.in[I_X]; bf16_t* XB = (bf16_t*)(ws + WS_XB);
    float* ss0 = (float*)(ws + WS_SS0); float* ss1 = (float*)(ws + WS_SS1); float* ss2 = (float*)(ws + WS_SS2);
    for (int row = gw; row < MROWS; row += NGW) {
        const f32x4* xr = (const f32x4*)(x + (size_t)row * DM) + lane;
        f32x4 v[4]; float s = 0.f;
#pragma unroll
        for (int j = 0; j < 4; ++j) { v[j] = xr[64 * j]; s += v[j][0] * v[j][0] + v[j][1] * v[j][1] + v[j][2] * v[j][2] + v[j][3] * v[j][3]; }
        s = wave_sum(s);
        if (lane == 0) { ss0[row] = s; ss1[row] = 0.f; ss2[row] = 0.f; }
        unsigned long long* o8 = (unsigned long long*)(XB + (size_t)row * DM) + lane;
#pragma unroll
        for (int j = 0; j < 4; ++j) o8[64 * j] = (unsigned long long)cvt_pk_bf16(v[j][0], v[j][1]) | ((unsigned long long)cvt_pk_bf16(v[j][2], v[j][3]) << 32);
    }
}

__device__ __forceinline__ void phase_postp(const Args& a) {
    unsigned char* ws = a.ws;
    bf16_t* P = (bf16_t*)(ws + WS_P); bf16_t* XC = (bf16_t*)(ws + WS_XB); bf16_t* IKC = (bf16_t*)(ws + WS_IKC); bf16_t* KVC = (bf16_t*)(ws + WS_KVC);
    const int lane = threadIdx.x & 63, gw = blockIdx.x * 8 + (threadIdx.x >> 6), NGW = gridDim.x * 8;
    const int c0 = lane * 8;
    float cw[4][8], cb[8], gq[8], gk[8];
#pragma unroll
    for (int e = 0; e < 8; ++e) {
        cb[e] = a.in[I_CB][c0 + e];
#pragma unroll
        for (int j = 0; j < 4; ++j) cw[j][e] = a.in[I_CW][j * 512 + c0 + e];
        gq[e] = a.in[I_QN][(lane & 7) * 8 + e];
        gk[e] = (lane < 16) ? a.in[I_KN][(lane & 7) * 8 + e] : a.in[I_IKN][(lane & 7) * 8 + e];
    }
    const int koff = (lane < 16) ? (C_AK + lane * 8) : (C_IK + (lane & 7) * 8);
    const int voff = C_AV + ((lane - 32) & 15) * 8;
    u32x4 nmx[4], naq, nkk, nav;
#define PP_LOAD(ROW) do { const int t_ = (ROW) & (SEQ - 1); const bf16_t* pr_ = P + (size_t)(ROW) * LDP; \
        _Pragma("unroll") for (int j = 0; j < 4; ++j) { if (t_ - 3 + j >= 0) nmx[j] = *(const u32x4*)(P + (size_t)((ROW) - 3 + j) * LDP + C_MX + c0); else nmx[j] = (u32x4){0u, 0u, 0u, 0u}; } \
        naq = *(const u32x4*)(pr_ + C_AQ + c0); nkk = *(const u32x4*)(pr_ + koff); nav = *(const u32x4*)(pr_ + voff); } while (0)
    if (gw < MROWS) PP_LOAD(gw);
    for (int row = gw; row < MROWS; row += NGW) {
        bf16_t* pr = P + (size_t)row * LDP;
        u32x4 cmx[4];
#pragma unroll
        for (int j = 0; j < 4; ++j) cmx[j] = nmx[j];
        const u32x4 caq = naq, ckk = nkk, cav = nav;
        if (row + NGW < MROWS) PP_LOAD(row + NGW);
        float accv[8];
#pragma unroll
        for (int e = 0; e < 8; ++e) accv[e] = cb[e];
#pragma unroll
        for (int j = 0; j < 4; ++j) { float xf[8]; unpack8(cmx[j], xf);
#pragma unroll
            for (int e = 0; e < 8; ++e) accv[e] += xf[e] * cw[j][e]; }
#pragma unroll
        for (int e = 0; e < 8; ++e) accv[e] = accv[e] * sigmoidf_(accv[e]);
        *(u32x4*)(XC + (size_t)row * 512 + c0) = pack8(accv);
        { float f[8]; unpack8(caq, f); float s = 0.f;
#pragma unroll
            for (int e = 0; e < 8; ++e) s += f[e] * f[e];
            s += __shfl_xor(s, 1); s += __shfl_xor(s, 2); s += __shfl_xor(s, 4);
            const float rs = rsqrtf(s * (1.f / 64.f) + EPS);
#pragma unroll
            for (int e = 0; e < 8; ++e) f[e] = f[e] * rs * gq[e];
            *(u32x4*)(pr + C_AQ + c0) = pack8(f); }
        { float f[8]; unpack8(ckk, f); float s = 0.f;
#pragma unroll
            for (int e = 0; e < 8; ++e) s += f[e] * f[e];
            s += __shfl_xor(s, 1); s += __shfl_xor(s, 2); s += __shfl_xor(s, 4);
            const float rs = rsqrtf(s * (1.f / 64.f) + EPS);
#pragma unroll
            for (int e = 0; e < 8; ++e) f[e] = f[e] * rs * gk[e];
            if (lane < 16) *(u32x4*)(KVC + (size_t)row * 256 + lane * 8) = pack8(f);
            else if (lane < 24) *(u32x4*)(IKC + ((((size_t)(row >> 4)) * 8 + (lane - 16)) * 16 + (row & 15)) * 8) = pack8(f);
            else if (lane >= 32 && lane < 48) *(u32x4*)(KVC + (size_t)row * 256 + 128 + (lane - 32) * 8) = cav; }
    }
#undef PP_LOAD
}

__device__ __forceinline__ unsigned fkey(float s) { const unsigned u = __float_as_uint(s); return (u & 0x80000000u) ? ~u : (u | 0x80000000u); }


__device__ __forceinline__ unsigned wave_incl_scan_dpp(unsigned x) {
    x += (unsigned)__builtin_amdgcn_update_dpp(0, (int)x, 0x111, 0xf, 0xf, false);
    x += (unsigned)__builtin_amdgcn_update_dpp(0, (int)x, 0x112, 0xf, 0xf, false);
    x += (unsigned)__builtin_amdgcn_update_dpp(0, (int)x, 0x114, 0xf, 0xf, false);
    x += (unsigned)__builtin_amdgcn_update_dpp(0, (int)x, 0x118, 0xf, 0xf, false);
    x += (unsigned)__builtin_amdgcn_update_dpp(0, (int)x, 0x142, 0xa, 0xf, false);
    x += (unsigned)__builtin_amdgcn_update_dpp(0, (int)x, 0x143, 0xc, 0xf, false);
    return x;
}
__device__ __forceinline__ int find_bin(const unsigned* hist, int& need, int lane, int& binc) {
    const int base = 1023 - 16 * lane; unsigned s = 0;
#pragma unroll
    for (int i = 0; i < 16; ++i) { const unsigned w = hist[base - ((i + lane) & 15)]; s += (w & 0xffffu) + (w >> 16); }
    const unsigned p = wave_incl_scan_dpp(s);
    const unsigned long long bal = __ballot(p >= (unsigned)need);
    const int L = bal ? (__ffsll((long long)bal) - 1) : 63;
    const unsigned excl = __shfl(p - s, L);
    const int b0 = 1023 - 16 * L, t = lane & 31;
    const unsigned w2 = hist[b0 - (t >> 1)];
    const unsigned v2 = (lane < 32) ? ((t & 1) ? (w2 & 0xffffu) : (w2 >> 16)) : 0u;
    const unsigned p2 = wave_incl_scan_dpp(v2);
    const unsigned long long bal2 = __ballot((lane < 32) && ((unsigned)excl + p2 >= (unsigned)need));
    const int ts = bal2 ? (__ffsll((long long)bal2) - 1) : 31;
    const int vs = (int)__shfl(v2, ts), ps = (int)__shfl(p2, ts);
    int bin = 2 * (b0 - (ts >> 1)) + ((ts & 1) ? 0 : 1);
    int fneed = need - ((int)excl + ps - vs), bc = vs;
    if (fneed < 1) fneed = 1;
    need = fneed; binc = bc; return bin;
}


__device__ __forceinline__ int find_bin128(const unsigned* sh, int& need, int lane, int& binc) {
    const unsigned hi = sh[127 - 2 * lane], lo = sh[126 - 2 * lane]; const unsigned s = hi + lo;
    const unsigned p = wave_incl_scan_dpp(s);
    const unsigned long long bal = __ballot(p >= (unsigned)need);
    const int L = bal ? (__ffsll((long long)bal) - 1) : 63;
    const int excl = (int)__shfl(p - s, L); const int hiL = (int)__shfl(hi, L), loL = (int)__shfl(lo, L);
    int bin, fneed, bc;
    if (excl + hiL >= need) { bin = 127 - 2 * L; fneed = need - excl; bc = hiL; } else { bin = 126 - 2 * L; fneed = need - excl - hiL; bc = loL; }
    if (fneed < 1) fneed = 1;
    need = fneed; binc = bc; return bin;
}

template <bool DUMMY> __device__ __forceinline__ void phase_dsa(const Args& a, unsigned char* lds) {
    unsigned char* ws = a.ws;
    bf16_t* P = (bf16_t*)(ws + WS_P); const float* SM = (const float*)(ws + WS_SM);
    const bf16_t* IKC = (const bf16_t*)(ws + WS_IKC); const bf16_t* KVC = (const bf16_t*)(ws + WS_KVC);
    constexpr int SCS = 8200;
    float* SC = (float*)lds;
    unsigned* HIST = (unsigned*)(lds + 131200);
    int* LIST = (int*)(lds + 131200 + 16384);
    unsigned* QS = (unsigned*)(lds + 131200 + 16384 + 4096);
    int* CNT = (int*)(lds + 131200 + 16384 + 4096 + 4096);
    const float idx_scale = 0.125f * 0.35355339059327373f;
    f32x4 wqv[2]; unsigned qsv[2];
#define DSA_LOAD_ITEM(ITEM) do { const int b_ = (ITEM) & 7, t0_ = ((ITEM) >> 3) * 4; const size_t r_ = (size_t)b_ * SEQ + t0_; \
        int tl_ = threadIdx.x; asm volatile("" : "+v"(tl_)); const int ln_ = tl_ & 63, q4_ = ln_ >> 4; \
        wqv[0] = *(const f32x4*)(SM + (r_ + q4_) * 16); wqv[1] = *(const f32x4*)(SM + (r_ + q4_) * 16 + 4); \
        _Pragma("unroll") for (int i_ = 0; i_ < 2; ++i_) { const int e_ = tl_ + 512 * i_; qsv[i_] = *(const unsigned*)(P + (r_ + (e_ >> 8)) * LDP + C_AQ + (e_ & 255) * 2); } } while (0)
    if ((int)blockIdx.x < 16384) DSA_LOAD_ITEM(blockIdx.x);
    for (int item = blockIdx.x; item < 16384; item += gridDim.x) {
        int tid_ = threadIdx.x; asm volatile("" : "+v"(tid_));
        const int tid = tid_, wave = __builtin_amdgcn_readfirstlane(tid >> 6), lane = tid & 63, quad = lane >> 4, l15 = lane & 15;
        const int b = item & 7, tq = item >> 3, t0 = tq * 4, L = ((t0 >> 6) + 1) * 64;
        const size_t r0 = (size_t)b * SEQ + t0;
        const bool do_sel = (L > 256) && !DBG_NOSEL;
        { u32x4* hz = (u32x4*)HIST; hz[tid] = (u32x4){0u, 0u, 0u, 0u}; hz[tid + 512] = (u32x4){0u, 0u, 0u, 0u}; }
        if (tid < 8) CNT[4 + tid] = 0;
        QS[tid] = qsv[0]; QS[tid + 512] = qsv[1];
        float wq[8];
#pragma unroll
        for (int h = 0; h < 4; ++h) { wq[h] = wqv[0][h] * idx_scale; wq[4 + h] = wqv[1][h] * idx_scale; }
        bf16x8 af[2][2];
#pragma unroll
        for (int T = 0; T < 2; ++T)
#pragma unroll
            for (int ks = 0; ks < 2; ++ks) af[T][ks] = *(const bf16x8*)(P + (r0 + (l15 >> 2)) * LDP + C_IQ + (4 * T + (l15 & 3)) * 64 + ks * 32 + quad * 8);
        const int ngroups = L >> 6;
        const bf16_t* ikb = IKC + (size_t)b * SEQ * 64 + (quad * 16 + l15) * 8;
        bf16x8 B0[4][2], B1[4][2], B2[4][2];
#define IDX_LOAD(BUF, G) do { _Pragma("unroll") for (int tt = 0; tt < 4; ++tt) _Pragma("unroll") for (int ks = 0; ks < 2; ++ks) \
                BUF[tt][ks] = *(const bf16x8*)(ikb + (size_t)(((G) * 4 + tt) * 8 + ks * 4) * 128); } while (0)
        if (wave < ngroups) IDX_LOAD(B0, wave);
        if (wave + 8 < ngroups) IDX_LOAD(B1, wave + 8);
        if (wave + 16 < ngroups) IDX_LOAD(B2, wave + 16);
        lds_fence(); __builtin_amdgcn_s_barrier();
        for (int rep = 0; rep < ((DBG_TWICE & 2) ? 2 : 1); ++rep) {
            const bool hist_on = do_sel && (rep == (((DBG_TWICE & 2) ? 2 : 1) - 1));
#define IDX_COMPUTE(BUF, G) do { _Pragma("unroll") for (int tt = 0; tt < 4; ++tt) { \
                const int key = (G) * 64 + tt * 16 + l15; \
                f32x4 c0 = (f32x4){0.f, 0.f, 0.f, 0.f}, c1 = (f32x4){0.f, 0.f, 0.f, 0.f}; \
                c0 = __builtin_amdgcn_mfma_f32_16x16x32_bf16(af[0][0], BUF[tt][0], c0, 0, 0, 0); \
                c1 = __builtin_amdgcn_mfma_f32_16x16x32_bf16(af[1][0], BUF[tt][0], c1, 0, 0, 0); \
                c0 = __builtin_amdgcn_mfma_f32_16x16x32_bf16(af[0][1], BUF[tt][1], c0, 0, 0, 0); \
                c1 = __builtin_amdgcn_mfma_f32_16x16x32_bf16(af[1][1], BUF[tt][1], c1, 0, 0, 0); \
                float sc = 0.f; \
                _Pragma("unroll") for (int j = 0; j < 4; ++j) { sc += wq[j] * relu_(c0[j]); sc += wq[4 + j] * relu_(c1[j]); } \
                sc += 0.f; \
                SC[quad * SCS + key] = sc; \
                if (hist_on) { const unsigned bin = fkey(sc) >> 21; atomicAdd(&HIST[quad * 1024 + (bin >> 1)], (bin & 1u) ? 0x10000u : 1u); } } } while (0)
            int g = wave;
            for (; g < ngroups; g += 24) {
                IDX_COMPUTE(B0, g);
                if (g + 24 < ngroups) IDX_LOAD(B0, g + 24);
                if (g + 8 < ngroups) { IDX_COMPUTE(B1, g + 8); if (g + 32 < ngroups) IDX_LOAD(B1, g + 32); }
                if (g + 16 < ngroups) { IDX_COMPUTE(B2, g + 16); if (g + 40 < ngroups) IDX_LOAD(B2, g + 40); }
            }
#undef IDX_LOAD
#undef IDX_COMPUTE
        }
        lds_fence(); __builtin_amdgcn_s_barrier();
        if (item + (int)gridDim.x < 16384) DSA_LOAD_ITEM(item + (int)gridDim.x);
        {
            constexpr int CAP = 448;
            const unsigned long long ltmask = (1ull << lane) - 1ull;
            if (!do_sel) {
                const int q = wave >> 1, hf = wave & 1; int* list = LIST + q * 256;
                if (hf == 0) { for (int i = lane; i < 256; i += 64) list[i] = (i < L) ? i : 0; if (lane == 0) CNT[q] = L; }
            } else {
                {
                    const int q = wave >> 1, hf = wave & 1; int* list = LIST + q * 256; const float* sc = SC + q * SCS; unsigned* hist = HIST + q * 1024;
                    const int halfL = L >> 1, beg = hf * halfL, end = beg + halfL;
                    int need = 256, binc = 0;
                    const unsigned b1 = (unsigned)find_bin(hist, need, lane, binc);
                    const int c1 = binc, nsure = 256 - need; const bool store_c = c1 <= CAP;
                    if (hf == 0 && lane == 0) { CNT[12 + q] = (int)b1; CNT[16 + q] = need; CNT[8 + q] = c1; }
                    lds_fence(); __builtin_amdgcn_s_barrier();
                    int cs = 0, cc = 0;
                    for (int i0 = beg + lane * 4; i0 < end; i0 += 256) { const f32x4 v = *(const f32x4*)(sc + i0);
#pragma unroll
                        for (int e = 0; e < 4; ++e) { const unsigned k = fkey(v[e]); const unsigned kb = k >> 21;
                            const bool sure = kb > b1, cand = (kb == b1) && store_c;
                            const unsigned long long ms = __ballot(sure), mc = __ballot(cand);
                            if (ms) { const int p = cs + __popcll(ms & ltmask); const int pp = hf ? nsure - 1 - p : p; if (sure && pp >= 0 && pp < 256) list[pp] = i0 + e; cs += __popcll(ms); }
                            if (mc) { const int p = cc + __popcll(mc & ltmask); const int pp = hf ? c1 - 1 - p : p; if (cand && pp >= 0 && pp < CAP) { hist[2 * pp] = k; hist[2 * pp + 1] = (unsigned)(i0 + e); } cc += __popcll(mc); } } }
                    lds_fence(); __builtin_amdgcn_s_barrier();
                }
                if (wave < 4) {
                    const int q = wave; int* list = LIST + q * 256; unsigned* hist = HIST + q * 1024; unsigned* sh = hist + 896; const float* sc = SC + q * SCS;
                    const unsigned b1 = (unsigned)CNT[12 + q]; int need = CNT[16 + q]; const int c = CNT[8 + q]; const int nsure = 256 - need;
                    if (c <= CAP) {
                        unsigned ck[7]; int ci[7];
#pragma unroll
                        for (int t = 0; t < 7; ++t) { const int i = lane + 64 * t; const bool valid = i < c; ck[t] = valid ? hist[2 * i] : 0u; ci[t] = valid ? (int)hist[2 * i + 1] : -1; }
                        int binc = 0;
                        sh[2 * lane] = 0u; sh[2 * lane + 1] = 0u; lds_order();
#pragma unroll
                        for (int t = 0; t < 7; ++t) if (ci[t] >= 0) atomicAdd(&sh[(ck[t] >> 14) & 127u], 1u);
                        lds_order();
                        const unsigned bA = (unsigned)find_bin128(sh, need, lane, binc);
                        lds_order();
                        sh[2 * lane] = 0u; sh[2 * lane + 1] = 0u; lds_order();
#pragma unroll
                        for (int t = 0; t < 7; ++t) if (ci[t] >= 0 && ((ck[t] >> 14) & 127u) == bA) atomicAdd(&sh[(ck[t] >> 7) & 127u], 1u);
                        lds_order();
                        const unsigned bB = (unsigned)find_bin128(sh, need, lane, binc);
                        const unsigned preB = (bA << 7) | bB;
                        lds_order();
                        sh[2 * lane] = 0u; sh[2 * lane + 1] = 0u; lds_order();
#pragma unroll
                        for (int t = 0; t < 7; ++t) if (ci[t] >= 0 && ((ck[t] >> 7) & 0x3fffu) == preB) atomicAdd(&sh[ck[t] & 127u], 1u);
                        lds_order();
                        const unsigned bC = (unsigned)find_bin128(sh, need, lane, binc);
                        const unsigned T = (b1 << 21) | (preB << 7) | bC;
                        const int tie_total = binc, need_t = need;
                        int cnt = 0;
#pragma unroll
                        for (int t = 0; t < 7; ++t) {
                            const bool valid = ci[t] >= 0;
                            bool sel = valid && (ck[t] > T);
                            if (valid && ck[t] == T) {
                                if (tie_total == need_t) sel = true;
                                else { int rank = 0; for (int j = 0; j < c; ++j) rank += (hist[2 * j] == T && (int)hist[2 * j + 1] < ci[t]) ? 1 : 0; sel = rank < need_t; }
                            }
                            const unsigned long long m = __ballot(sel);
                            const int pos = nsure + cnt + __popcll(m & ltmask);
                            if (sel && pos < 256) list[pos] = ci[t];
                            cnt += __popcll(m);
                        }
                    } else {
                        int binc = 0;
                        lds_order();
#pragma unroll
                        for (int i = 0; i < 16; ++i) hist[lane * 16 + i] = 0u;
                        lds_order();
                        for (int i0 = 0; i0 < L; i0 += 64) { const unsigned k = fkey(sc[i0 + lane]); if ((k >> 21) == b1) { const unsigned bin = (k >> 10) & 2047u; atomicAdd(&hist[bin >> 1], (bin & 1u) ? 0x10000u : 1u); } }
                        lds_order();
                        const unsigned b2 = (unsigned)find_bin(hist, need, lane, binc);
                        const unsigned pre2 = (b1 << 11) | b2;
                        lds_order();
#pragma unroll
                        for (int i = 0; i < 16; ++i) hist[lane * 16 + i] = 0u;
                        lds_order();
                        for (int i0 = 0; i0 < L; i0 += 64) { const unsigned k = fkey(sc[i0 + lane]); if ((k >> 10) == pre2) { const unsigned bin = k & 1023u; atomicAdd(&hist[bin >> 1], (bin & 1u) ? 0x10000u : 1u); } }
                        lds_order();
                        const unsigned b3 = (unsigned)find_bin(hist, need, lane, binc);
                        const unsigned T = (pre2 << 10) | b3;
                        int count = 0, ties = 0;
                        for (int i0 = 0; i0 < L; i0 += 64) {
                            const unsigned k = fkey(sc[i0 + lane]);
                            const bool eq = (k == T);
                            const unsigned long long em = __ballot(eq);
                            const int erank = ties + __popcll(em & ltmask);
                            const bool sel = (k > T) || (eq && erank < need);
                            const unsigned long long smk = __ballot(sel);
                            const int pos = count + __popcll(smk & ltmask);
                            if (sel && pos < 256) list[pos] = i0 + lane;
                            count += __popcll(smk); ties += __popcll(em);
                        }
                        if (count > 256) count = 256;
                        for (int i = count + lane; i < 256; i += 64) list[i] = 0;
                    }
                    if (lane == 0) CNT[q] = 256;
                }
            }
        }
        lds_fence(); __builtin_amdgcn_s_barrier();
        for (int repc = 0; repc < ((DBG_TWICE & 4) ? 2 : 1); ++repc) {
            const bool dummy_c = (repc + 1) < ((DBG_TWICE & 4) ? 2 : 1);
            int lane_c = lane; asm volatile("" : "+v"(lane_c));
            const int qi = wave >> 1, g = wave & 1; const int count = CNT[qi];
            const int* list = LIST + qi * 256;
            float* PB = SC + wave * 1024;
            const unsigned* qd = QS + (qi * 8 + g * 4) * 32;
            const bf16_t* kvb = KVC + (size_t)b * SEQ * 256 + g * 64;
            const int ks = lane_c >> 3, dg = lane_c & 7, l15c = lane_c & 15, quadc = lane_c >> 4;
            const int nblk = count >> 6;
            bf16_t* KL = (bf16_t*)(lds + 32768 + wave * 9216);
            bf16x8 bq[2];
#pragma unroll
            for (int s2 = 0; s2 < 2; ++s2) {
                bf16x8 t = *(const bf16x8*)((const bf16_t*)QS + (qi * 8 + g * 4 + (l15c & 3)) * 64 + s2 * 32 + quadc * 8);
                if (l15c >= 4) t = (bf16x8){0, 0, 0, 0, 0, 0, 0, 0};
                bq[s2] = t;
            }
            const bf16_t* kb = kvb + dg * 8;
            float sreg[4][4][4];
            u32x4 kcur[8];
#pragma unroll
            for (int u = 0; u < 8; ++u) kcur[u] = *(const u32x4*)(kb + (size_t)list[u * 8 + ks] * 256);
#pragma unroll
            for (int blk = 0; blk < 4; ++blk) {
                if (blk < nblk) {
#pragma unroll
                    for (int u = 0; u < 8; ++u) *(u32x4*)(KL + (u * 8 + ks) * 72 + dg * 8) = kcur[u];
                    if (blk + 1 < nblk) {
#pragma unroll
                        for (int u = 0; u < 8; ++u) kcur[u] = *(const u32x4*)(kb + (size_t)list[(blk + 1) * 64 + u * 8 + ks] * 256);
                    }
                    lds_order();
#pragma unroll
                    for (int kt = 0; kt < 4; ++kt) {
                        f32x4 acc = (f32x4){0.f, 0.f, 0.f, 0.f};
#pragma unroll
                        for (int s2 = 0; s2 < 2; ++s2) acc = __builtin_amdgcn_mfma_f32_16x16x32_bf16(*(const bf16x8*)(KL + (kt * 16 + l15c) * 72 + s2 * 32 + quadc * 8), bq[s2], acc, 0, 0, 0);
#pragma unroll
                        for (int j = 0; j < 4; ++j) sreg[blk][kt][j] = acc[j] * 0.125f;
                    }
                    lds_order();
                } else {
#pragma unroll
                    for (int kt = 0; kt < 4; ++kt)
#pragma unroll
                        for (int j = 0; j < 4; ++j) sreg[blk][kt][j] = -INFINITY;
                }
            }
            const bf16_t* vb = kvb + 128 + dg * 8;
            u32x4 vreg[8];
#pragma unroll
            for (int u = 0; u < 8; ++u) vreg[u] = *(const u32x4*)(vb + (size_t)list[u * 8 + ks] * 256);
            float mx = -INFINITY;
#pragma unroll
            for (int blk = 0; blk < 4; ++blk)
#pragma unroll
                for (int kt = 0; kt < 4; ++kt)
#pragma unroll
                    for (int j = 0; j < 4; ++j) mx = fmaxf(mx, sreg[blk][kt][j]);
            mx = fmaxf(mx, __shfl_xor(mx, 16)); mx = fmaxf(mx, __shfl_xor(mx, 32));
            float sum = 0.f;
#pragma unroll
            for (int blk = 0; blk < 4; ++blk)
#pragma unroll
                for (int kt = 0; kt < 4; ++kt)
#pragma unroll
                    for (int j = 0; j < 4; ++j) { const float e = __expf(sreg[blk][kt][j] - mx); sreg[blk][kt][j] = e; sum += e; }
            sum += __shfl_xor(sum, 16); sum += __shfl_xor(sum, 32);
            const float invs = 1.f / sum;
            f32x4 oacc[4];
#pragma unroll
            for (int dt = 0; dt < 4; ++dt) oacc[dt] = (f32x4){0.f, 0.f, 0.f, 0.f};
            bf16_t* VT = KL;
#pragma unroll
            for (int blk = 0; blk < 4; ++blk) {
                if (blk < nblk) {
#pragma unroll
                    for (int u = 0; u < 8; ++u) {
                        const int rho = ((u >> 2) << 5) + ((((2 * u) & 3) + (ks >> 2)) << 3) + (((u >> 1) & 1) << 2) + (ks & 3);
                        *(u32x4*)(VT + rho * 72 + dg * 8) = vreg[u];
                    }
                    if (blk + 1 < nblk) {
#pragma unroll
                        for (int u = 0; u < 8; ++u) vreg[u] = *(const u32x4*)(vb + (size_t)list[(blk + 1) * 64 + u * 8 + ks] * 256);
                    }
                    lds_order();
#pragma unroll
                    for (int s2 = 0; s2 < 2; ++s2) {
                        u32x4 pw;
                        pw[0] = cvt_pk_bf16(sreg[blk][2 * s2][0], sreg[blk][2 * s2][1]); pw[1] = cvt_pk_bf16(sreg[blk][2 * s2][2], sreg[blk][2 * s2][3]);
                        pw[2] = cvt_pk_bf16(sreg[blk][2 * s2 + 1][0], sreg[blk][2 * s2 + 1][1]); pw[3] = cvt_pk_bf16(sreg[blk][2 * s2 + 1][2], sreg[blk][2 * s2 + 1][3]);
                        const bf16x8 pf = __builtin_bit_cast(bf16x8, pw);
#pragma unroll
                        for (int dt = 0; dt < 4; ++dt) {
                            const LAS unsigned char* vp = (const LAS unsigned char*)VT + ((32 * s2 + 8 * quadc + (l15c >> 2)) * 72) * 2 + dt * 32 + (l15c & 3) * 8;
                            const v4i16_t t0 = __builtin_amdgcn_ds_read_tr16_b64_v4i16((LAS v4i16_t*)vp);
                            const v4i16_t t1 = __builtin_amdgcn_ds_read_tr16_b64_v4i16((LAS v4i16_t*)(vp + 4 * 72 * 2));
                            const bf16x8 af2 = (bf16x8){t0[0], t0[1], t0[2], t0[3], t1[0], t1[1], t1[2], t1[3]};
                            oacc[dt] = __builtin_amdgcn_mfma_f32_16x16x32_bf16(af2, pf, oacc[dt], 0, 0, 0);
                        }
                    }
                    lds_order();
                }
            }
            if (l15c < 4) {
                bf16_t* yo = (DUMMY || dummy_c) ? ((bf16_t*)(ws + WS_MG + 48 * MiB) + (r0 + qi) * 512 + (g * 4 + l15c) * 64 + quadc * 4) : (P + (r0 + qi) * LDP + C_AQ + (g * 4 + l15c) * 64 + quadc * 4);
#pragma unroll
                for (int dt = 0; dt < 4; ++dt) {
                    const f32x4 v = oacc[dt] * invs;
                    u32x2 w; w[0] = cvt_pk_bf16(v[0], v[1]); w[1] = cvt_pk_bf16(v[2], v[3]);
                    *(u32x2*)(yo + dt * 16) = w;
                }
            }
        }
        lds_fence(); __builtin_amdgcn_s_barrier();
    }
#undef DSA_LOAD_ITEM
}

__device__ __forceinline__ float logsigmoidf_(float x) { return fminf(x, 0.f) - log1pf(__expf(-fabsf(x))); }
#define DPP_F(x, ident, ctrl, rmask) __int_as_float(__builtin_amdgcn_update_dpp(__float_as_int(ident), __float_as_int(x), ctrl, rmask, 0xf, false))
__device__ __forceinline__ float wave_incl_sum(float v, int lane) {
    (void)lane;
    v += DPP_F(v, 0.f, 0x111, 0xf); v += DPP_F(v, 0.f, 0x112, 0xf); v += DPP_F(v, 0.f, 0x114, 0xf); v += DPP_F(v, 0.f, 0x118, 0xf);
    v += DPP_F(v, 0.f, 0x142, 0xa); v += DPP_F(v, 0.f, 0x143, 0xc);
    return v;
}
__device__ __forceinline__ float wave_incl_max(float v, int lane) {
    (void)lane;
    const float ninf = -INFINITY;
    v = fmaxf(v, DPP_F(v, ninf, 0x111, 0xf)); v = fmaxf(v, DPP_F(v, ninf, 0x112, 0xf)); v = fmaxf(v, DPP_F(v, ninf, 0x114, 0xf)); v = fmaxf(v, DPP_F(v, ninf, 0x118, 0xf));
    v = fmaxf(v, DPP_F(v, ninf, 0x142, 0xa)); v = fmaxf(v, DPP_F(v, ninf, 0x143, 0xc));
    return v;
}
__device__ __forceinline__ f32x4 mma_lds(const bf16_t* A, int lda, const bf16_t* Bt, int ldb, int K, int lane) {
    f32x4 acc = (f32x4){0.f, 0.f, 0.f, 0.f};
    const bf16_t* ap = A + (lane & 15) * lda + (lane >> 4) * 8; const bf16_t* bp = Bt + (lane & 15) * ldb + (lane >> 4) * 8;
    for (int k = 0; k < K; k += 32) acc = __builtin_amdgcn_mfma_f32_16x16x32_bf16(*(const bf16x8*)(ap + k), *(const bf16x8*)(bp + k), acc, 0, 0, 0);
    return acc;
}

__device__ __forceinline__ void phase_mlstm_a(const Args& a, unsigned char* lds) {
    unsigned char* ws = a.ws;
    const bf16_t* P = (const bf16_t*)(ws + WS_P); const bf16_t* QK = (const bf16_t*)(ws + WS_QK); const float* SM = (const float*)(ws + WS_SM);
    bf16_t* ST = (bf16_t*)(ws + WS_XB); float* DN = (float*)(ws + WS_DN); float* ML = (float*)(ws + WS_ML); float* BL = (float*)(ws + WS_BL);
    bf16_t* VT = (bf16_t*)lds;
    bf16_t* KT = (bf16_t*)(lds + 18432);
    float* WS_ = (float*)(lds + 18432 + 9216);
    const int tid = threadIdx.x, wave = tid >> 6, lane = tid & 63;
    for (int item = blockIdx.x; item < 4096; item += gridDim.x) {
        const int c = item & 127, h = (item >> 7) & 3, b = item >> 9;
        const size_t r0 = (size_t)b * SEQ + c * 64;
        if (wave == 0) {
            const float ig = SM[(r0 + lane) * 16 + 8 + h] + a.in[I_BI][h];
            const float lf = logsigmoidf_(SM[(r0 + lane) * 16 + 12 + h] + a.in[I_BF][h]);
            const float bs = wave_incl_sum(lf, lane);
            const float bl = __shfl(bs, 63);
            const float wk = bl - bs + ig;
            const float ml = wave_max(wk);
            WS_[lane] = __expf(wk - ml);
            if (lane == 0) { ML[item] = ml; BL[item] = bl; }
        }
        for (int i = tid; i < 1024; i += 512) { const int s = i >> 4, d0 = (i & 15) * 8; float f[8]; unpack8(*(const u32x4*)(P + (r0 + s) * LDP + C_MV + h * 128 + d0), f);
#pragma unroll
            for (int e = 0; e < 8; ++e) VT[(d0 + e) * 72 + s] = f2bf(f[e]); }
        __syncthreads();
        { const int s = tid >> 3, d0 = (tid & 7) * 8; float f[8]; unpack8(*(const u32x4*)(QK + (r0 + s) * 512 + 256 + h * 64 + d0), f); const float w = WS_[s];
#pragma unroll
            for (int e = 0; e < 8; ++e) KT[(d0 + e) * 72 + s] = f2bf(f[e] * w); }
        __syncthreads();
        bf16_t* st = ST + (size_t)item * 8192;
#pragma unroll
        for (int nt = 0; nt < 4; ++nt) {
            const f32x4 acc = mma_lds(VT + wave * 16 * 72, 72, KT + nt * 16 * 72, 72, 64, lane);
#pragma unroll
            for (int j = 0; j < 4; ++j) st[(wave * 16 + (lane >> 4) * 4 + j) * 64 + nt * 16 + (lane & 15)] = f2bf_sw(acc[j]);
        }
        if (tid < 64) { float s = 0.f; for (int k = 0; k < 64; ++k) s += bf1(KT[tid * 72 + k]); DN[item * 64 + tid] = s; }
        __syncthreads();
    }
}
__device__ __forceinline__ void phase_mlstm_b(const Args& a) {
    unsigned char* ws = a.ws;
    unsigned* ST2 = (unsigned*)(ws + WS_XB);
    float* DN = (float*)(ws + WS_DN); const float* ML = (const float*)(ws + WS_ML); const float* BL = (const float*)(ws + WS_BL); float* MS = (float*)(ws + WS_MS);
    const int total = 32 * 4160;
    for (int w = blockIdx.x * 512 + threadIdx.x; w < total; w += gridDim.x * 512) {
        const int bh = w / 4160, e = w % 4160;
        if (e < 4096) {
            unsigned* p = ST2 + (size_t)bh * 128 * 4096 + e;
            float C0 = 0.f, C1 = 0.f, m = 0.f;
            for (int c0 = 0; c0 < 128; c0 += 8) {
                unsigned d[8]; float bl[8], ml[8];
#pragma unroll
                for (int u = 0; u < 8; ++u) { d[u] = p[(size_t)(c0 + u) * 4096]; bl[u] = BL[bh * 128 + c0 + u]; ml[u] = ML[bh * 128 + c0 + u]; }
#pragma unroll
                for (int u = 0; u < 8; ++u) {
                    p[(size_t)(c0 + u) * 4096] = cvt_pk_bf16(C0, C1);
                    if (e == 0) MS[bh * 128 + c0 + u] = m;
                    const float mn = fmaxf(bl[u] + m, ml[u]);
                    const float wc = __expf(bl[u] + m - mn), wd = __expf(ml[u] - mn);
                    C0 = wc * C0 + wd * bflo(d[u]); C1 = wc * C1 + wd * bfhi(d[u]);
                    m = mn;
                }
            }
        } else {
            float* p = DN + (size_t)bh * 128 * 64 + (e - 4096);
            float C = 0.f, m = 0.f;
            for (int c0 = 0; c0 < 128; c0 += 8) {
                float d[8], bl[8], ml[8];
#pragma unroll
                for (int u = 0; u < 8; ++u) { d[u] = p[(size_t)(c0 + u) * 64]; bl[u] = BL[bh * 128 + c0 + u]; ml[u] = ML[bh * 128 + c0 + u]; }
#pragma unroll
                for (int u = 0; u < 8; ++u) {
                    p[(size_t)(c0 + u) * 64] = C;
                    const float mn = fmaxf(bl[u] + m, ml[u]);
                    C = __expf(bl[u] + m - mn) * C + __expf(ml[u] - mn) * d[u];
                    m = mn;
                }
            }
        }
    }
}
__device__ __forceinline__ void phase_mlstm_c(const Args& a, unsigned char* lds) {
    unsigned char* ws = a.ws;
    bf16_t* P = (bf16_t*)(ws + WS_P); const bf16_t* QK = (const bf16_t*)(ws + WS_QK); const float* SM = (const float*)(ws + WS_SM);
    const bf16_t* ST = (const bf16_t*)(ws + WS_XB); const float* DN = (const float*)(ws + WS_DN); const float* MS = (const float*)(ws + WS_MS);
    bf16_t* QS_ = (bf16_t*)lds;
    bf16_t* KS = (bf16_t*)(lds + 9216);
    bf16_t* AP = (bf16_t*)(lds + 18432);
    bf16_t* BT = (bf16_t*)(lds + 18432 + 17408);
    float* OUT = (float*)(lds + 18432 + 17408 + 34816);
    float* GS = (float*)(lds + 18432 + 17408 + 34816 + 33792);
    float* bS = GS; float* aS = GS + 64; float* mtS = GS + 128; float* wiS = GS + 192; float* nS = GS + 256; float* denS = GS + 320;
    const int tid = threadIdx.x, wave = tid >> 6, lane = tid & 63;
    for (int item = blockIdx.x; item < 4096; item += gridDim.x) {
        const int c = item & 127, h = (item >> 7) & 3, b = item >> 9;
        const size_t r0 = (size_t)b * SEQ + c * 64;
        if (wave == 0) {
            const float ig = SM[(r0 + lane) * 16 + 8 + h] + a.in[I_BI][h];
            const float lf = logsigmoidf_(SM[(r0 + lane) * 16 + 12 + h] + a.in[I_BF][h]);
            const float bs = wave_incl_sum(lf, lane);
            const float av = ig - bs;
            const float pm = wave_incl_max(av, lane);
            const float m0 = MS[item];
            const float mt = bs + fmaxf(pm, m0);
            bS[lane] = bs; aS[lane] = av; mtS[lane] = mt; wiS[lane] = __expf(bs + m0 - mt);
            nS[lane] = DN[item * 64 + lane];
        }
        { const int s = tid >> 3, d0 = (tid & 7) * 8;
            *(u32x4*)(QS_ + s * 72 + d0) = *(const u32x4*)(QK + (r0 + s) * 512 + h * 64 + d0);
            *(u32x4*)(KS + s * 72 + d0) = *(const u32x4*)(QK + (r0 + s) * 512 + 256 + h * 64 + d0); }
        for (int i = tid; i < 1024; i += 512) { const int s = i >> 4, d0 = (i & 15) * 8; float f[8]; unpack8(*(const u32x4*)(P + (r0 + s) * LDP + C_MV + h * 128 + d0), f);
#pragma unroll
            for (int e = 0; e < 8; ++e) BT[(d0 + e) * 136 + s] = f2bf(f[e]); }
        { const bf16_t* st = ST + (size_t)item * 8192;
            for (int i = tid; i < 1024; i += 512) { const int dv = i >> 3, k0 = (i & 7) * 8; *(u32x4*)(BT + dv * 136 + 64 + k0) = *(const u32x4*)(st + dv * 64 + k0); } }
        __syncthreads();
#pragma unroll
        for (int u = 0; u < 2; ++u) {
            const int id = wave * 2 + u, tr = id >> 2, tc = id & 3;
            f32x4 acc = (f32x4){0.f, 0.f, 0.f, 0.f};
            if (tc <= tr) acc = mma_lds(QS_ + tr * 16 * 72, 72, KS + tc * 16 * 72, 72, 64, lane);
            const int s = tc * 16 + (lane & 15);
#pragma unroll
            for (int j = 0; j < 4; ++j) { const int t = tr * 16 + (lane >> 4) * 4 + j;
                const float w = (s <= t) ? acc[j] * __expf(bS[t] + aS[s] - mtS[t]) : 0.f;
                AP[t * 136 + s] = f2bf(w); }
        }
        { const int t = tid >> 3, d0 = (tid & 7) * 8; float f[8]; unpack8(*(const u32x4*)(QS_ + t * 72 + d0), f); const float w = wiS[t];
#pragma unroll
            for (int e = 0; e < 8; ++e) f[e] *= w;
            *(u32x4*)(AP + t * 136 + 64 + d0) = pack8(f); }
        __syncthreads();
#pragma unroll
        for (int tr = 0; tr < 4; ++tr) {
            const f32x4 acc = mma_lds(AP + tr * 16 * 136, 136, BT + wave * 16 * 136, 136, 128, lane);
#pragma unroll
            for (int j = 0; j < 4; ++j) OUT[(tr * 16 + (lane >> 4) * 4 + j) * 132 + wave * 16 + (lane & 15)] = acc[j];
        }
        { const int t = tid >> 3, part = tid & 7; float s = 0.f;
#pragma unroll
            for (int e = 0; e < 16; ++e) { const int k = part * 16 + e; const float v = bf1(AP[t * 136 + k]); s += (k < 64) ? v : v * nS[k - 64]; }
            s += __shfl_xor(s, 1); s += __shfl_xor(s, 2); s += __shfl_xor(s, 4);
            if (part == 0) denS[t] = s; }
        __syncthreads();
        { const int t = tid >> 3, part = tid & 7, dv0 = part * 16;
            const float den = fmaxf(fabsf(denS[t]), __expf(-mtS[t])); const float inv = 1.f / den;
            float hv[16]; float sq = 0.f;
#pragma unroll
            for (int e = 0; e < 16; ++e) { hv[e] = OUT[t * 132 + dv0 + e] * inv; sq += hv[e] * hv[e]; }
            sq += __shfl_xor(sq, 1); sq += __shfl_xor(sq, 2); sq += __shfl_xor(sq, 4);
            const float rs = rsqrtf(sq * (1.f / 128.f) + EPS);
            bf16_t* po = P + (r0 + t) * LDP + C_MO + h * 128 + dv0;
            float og[16]; unpack8(*(const u32x4*)po, og); unpack8(*(const u32x4*)(po + 8), og + 8);
#pragma unroll
            for (int e = 0; e < 16; ++e) hv[e] = hv[e] * rs * a.in[I_MHN][h * 128 + dv0 + e] * sigmoidf_(og[e]);
            *(u32x4*)po = pack8(hv); *(u32x4*)(po + 8) = pack8(hv + 8); }
        __syncthreads();
    }
}


#define XB_TMO      128
#define XB_XCNT(j)  (256  + 64 * (j))
#define XB_XSUB(j)  (1280 + 64 * (j))
#define XB_XGEN(j)  (2304 + 64 * (j))
#define XB_TOP      3328
#define XB_TOPGEN   3392
#define XCD_BAR_WORDS 3456
#define XB_SPIN_CAP (1u << 22)
__device__ __forceinline__ unsigned xb_ld(unsigned* p)              { return __hip_atomic_load(p, __ATOMIC_RELAXED, __HIP_MEMORY_SCOPE_AGENT); }
__device__ __forceinline__ unsigned xb_add(unsigned* p, unsigned v) { return __hip_atomic_fetch_add(p, v, __ATOMIC_RELAXED, __HIP_MEMORY_SCOPE_AGENT); }
__device__ __forceinline__ unsigned xb_xcc_id() { return (unsigned)__builtin_amdgcn_s_getreg((3 << 11) | 20) & 0xFu; }
#define XB_SPIN(cond, bar) do { unsigned _sp = 0; while (cond) { __builtin_amdgcn_s_sleep(1); \
    if ((++_sp & 255u) == 0u) { if (xb_ld(&(bar)[XB_TMO])) break; if (_sp > XB_SPIN_CAP) { atomicAdd(&(bar)[XB_TMO], 1u); break; } } } } while (0)
struct XcdBarrier { unsigned* bar; unsigned x; volatile LAS unsigned* st; };
__device__ __forceinline__ XcdBarrier xcd_barrier_post(unsigned* bar, volatile LAS unsigned* st) {
    XcdBarrier b; b.bar = bar; b.x = xb_xcc_id(); b.st = st;
    if (threadIdx.x == 0) (void)xb_add(&bar[XB_XCNT(b.x)], 1u);
    return b;
}
__device__ __forceinline__ void xcd_barrier_complete(unsigned* bar, unsigned x, unsigned& nloc, unsigned& nx) {
    const unsigned G = gridDim.x * gridDim.y * gridDim.z;
    unsigned sum, cnt, mine, sp = 0u;
    for (;;) {
        sum = 0u; cnt = 0u; mine = 0u;
#pragma unroll
        for (unsigned j = 0; j < 16; ++j) { const unsigned c = xb_ld(&bar[XB_XCNT(j)]); sum += c; cnt += (c > 0u) ? 1u : 0u; mine = (j == x) ? c : mine; }
        if (sum == G) break;
        __builtin_amdgcn_s_sleep(1);
        if ((++sp & 255u) == 0u) { if (xb_ld(&bar[XB_TMO])) break; if (sp > XB_SPIN_CAP) { atomicAdd(&bar[XB_TMO], 1u); break; } }
    }
    nloc = mine > 0u ? mine : 1u; nx = cnt > 0u ? cnt : 1u;
}
__device__ __forceinline__ void xcd_barrier(const XcdBarrier& b) {
    asm volatile("s_waitcnt vmcnt(0)" ::: "memory");
    __syncthreads();
    if (threadIdx.x == 0) {
        unsigned* bar = b.bar;
        __builtin_amdgcn_s_waitcnt(0);
        unsigned nloc = b.st[0], nx = b.st[1];
        if (nloc == 0u) { xcd_barrier_complete(bar, b.x, nloc, nx); b.st[0] = nloc; b.st[1] = nx; }
        const unsigned old = xb_add(&bar[XB_XSUB(b.x)], 1u);
        const unsigned gen = old / nloc;
        if (old + 1u == (gen + 1u) * nloc) {
            __builtin_amdgcn_fence(__ATOMIC_RELEASE, "agent");
            asm volatile("s_waitcnt vmcnt(0)" ::: "memory");
            const unsigned og = xb_add(&bar[XB_TOP], 1u);
            const unsigned tg = og / nx;
            if (og + 1u == (tg + 1u) * nx) xb_add(&bar[XB_TOPGEN], 1u);
            else XB_SPIN(xb_ld(&bar[XB_TOPGEN]) == tg, bar);
            __builtin_amdgcn_fence(__ATOMIC_ACQUIRE, "agent");
            xb_add(&bar[XB_XGEN(b.x)], 1u);
            asm volatile("s_waitcnt vmcnt(0)" ::: "memory");
        } else {
            XB_SPIN(xb_ld(&bar[XB_XGEN(b.x)]) == gen, bar);
            __builtin_amdgcn_fence(__ATOMIC_ACQUIRE, "agent");
            asm volatile("s_waitcnt vmcnt(0)" ::: "memory");
        }
    }
    __syncthreads();
}

#ifndef DBG_ZERO_YA
#define DBG_ZERO_YA 1
#endif
#ifndef PH
#define PH 0xFFFF
#endif
__global__ void __launch_bounds__(512, 2) mega_fwd(Args a) {
    extern __shared__ __attribute__((aligned(16))) unsigned char lds[];
    cg::grid_group grid = cg::this_grid();
    LAS unsigned char* ldsl = (LAS unsigned char*)lds;
    unsigned char* ws = a.ws;
    const int G = gridDim.x, bid = blockIdx.x;
    bf16_t* XB = (bf16_t*)(ws + WS_XB); bf16_t* Pb = (bf16_t*)(ws + WS_P); bf16_t* MG = (bf16_t*)(ws + WS_MG); bf16_t* QKb = (bf16_t*)(ws + WS_QK);
    float* ss0 = (float*)(ws + WS_SS0); float* ss1 = (float*)(ws + WS_SS1); float* ss2 = (float*)(ws + WS_SS2);

    unsigned* barw = (unsigned*)(ws + WS_BAR);
    if (bid == 0) { for (int i = threadIdx.x; i < XCD_BAR_WORDS; i += 512) barw[i] = 0u; }
    volatile LAS unsigned* bst = (volatile LAS unsigned*)(ldsl + LDS_BYTES - 16);
    if (threadIdx.x == 0) { bst[0] = 0u; bst[1] = 0u; }
    if (PH & 1) phase0(a, lds);
    __threadfence();
    grid.sync();
    const XcdBarrier xbar = xcd_barrier_post(barw, bst);
    if (PH & 2) {
        pg8::Gemm g{XB, (const bf16_t*)(ws + WS_W1), DM, DM, MROWS, 2 * FF, DM}; pg8::StaticOrder S; S.init(MROWS, 2 * FF, G, bid);
        pg8::EpiSwiGLU E{Pb, ss0}; pg8::gemm_phase(ldsl, g, S, E);
    }
    xcd_barrier(xbar);
    if (PH & 4) {
        pg8::Gemm g{Pb, (const bf16_t*)(ws + WS_W2), FF, FF, MROWS, DM, FF}; pg8::StaticOrder S; S.init(MROWS, DM, G, bid);
        pg8::EpiRes<false, false, true> E{a.in[I_X], nullptr, nullptr, XB, (bf16_t*)a.out, ss1, 0.5f}; pg8::gemm_phase(ldsl, g, S, E);
    }
    xcd_barrier(xbar);
    if (PH & 8) {
        pg8::Gemm g{XB, (const bf16_t*)(ws + WS_WIN), DM, DM, MROWS, LDP, DM}; pg8::StaticOrder S; S.init(MROWS, LDP, G, bid);
        pg8::EpiP E{Pb, (float*)(ws + WS_SM), ss1}; pg8::gemm_phase(ldsl, g, S, E);
    }
    xcd_barrier(xbar);
    if (PH & 16) phase_postp(a);
    xcd_barrier(xbar);
    if (PH & 32) {
        pg8::Gemm g{XB, (const bf16_t*)(ws + WS_WQK), 512, 512, MROWS, 512, 512}; pg8::StaticOrder S; S.init(MROWS, 512, G, bid);
        pg8::EpiBf16 E{QKb, 512}; pg8::gemm_phase(ldsl, g, S, E);
    }
    xcd_barrier(xbar);
    if (PH & 64) phase_mlstm_a(a, lds);
    xcd_barrier(xbar);
    if (PH & 128) phase_mlstm_b(a);
    xcd_barrier(xbar);
    if (PH & 256) phase_mlstm_c(a, lds);
    if (DBG_TWICE & 1) phase_dsa<true>(a, lds);
    if (PH & 512) phase_dsa<false>(a, lds);
    xcd_barrier(xbar);
    if (PH & 1024) {
        pg8::StaticOrder S; S.init(MROWS, DM, G, bid);
        { pg8::Gemm g{Pb + C_AQ, (const bf16_t*)(ws + WS_WA), LDP, 512, MROWS, DM, 512}; pg8::EpiMerge<0> E{Pb, MG, C_GA}; pg8::gemm_phase(ldsl, g, S, E); }
        { pg8::Gemm g{Pb + C_MO, (const bf16_t*)(ws + WS_WB), LDP, 512, MROWS, DM, 512}; pg8::EpiMerge<1> E{Pb, MG, C_GB}; pg8::gemm_phase(ldsl, g, S, E); }
    }
    xcd_barrier(xbar);
    if (PH & 2048) {
        pg8::Gemm g{MG, (const bf16_t*)(ws + WS_WO), DM, DM, MROWS, DM, DM}; pg8::StaticOrder S; S.init(MROWS, DM, G, bid);
        pg8::EpiRes<true, false, true> E{nullptr, (const bf16_t*)a.out, nullptr, XB, nullptr, ss2, 1.0f}; pg8::gemm_phase(ldsl, g, S, E);
    }
    xcd_barrier(xbar);
    if (PH & 4096) {
        pg8::Gemm g{XB, (const bf16_t*)(ws + WS_W3), DM, DM, MROWS, 2 * FF, DM}; pg8::StaticOrder S; S.init(MROWS, 2 * FF, G, bid);
        pg8::EpiSwiGLU E{Pb, ss2}; pg8::gemm_phase(ldsl, g, S, E);
    }
    xcd_barrier(xbar);
    if (PH & 8192) {
        pg8::Gemm g{Pb, (const bf16_t*)(ws + WS_W4), FF, FF, MROWS, DM, FF}; pg8::StaticOrder S; S.init(MROWS, DM, G, bid);
        pg8::EpiRes<true, true, false> E{nullptr, XB, a.out, nullptr, nullptr, nullptr, 0.5f}; pg8::gemm_phase(ldsl, g, S, E);
    }
}

extern "C" void kernel_launch(void* const* d_in, const int* in_sizes, int n_in, void* d_out, int out_size, void* d_ws, size_t ws_size, hipStream_t stream) {
    static int grid = 0;
    if (grid == 0) {
        if (n_in != 24 || ws_size < WS_END) { fprintf(stderr, "kernel_launch: unexpected n_in %d / ws %zu\n", n_in, ws_size); grid = -1; return; }
        int dev = 0, cus = 0, per_cu = 0;
        hipGetDevice(&dev);
        hipDeviceGetAttribute(&cus, hipDeviceAttributeMultiprocessorCount, dev);
        hipFuncSetAttribute((const void*)mega_fwd, hipFuncAttributeMaxDynamicSharedMemorySize, LDS_BYTES);
        hipOccupancyMaxActiveBlocksPerMultiprocessor(&per_cu, (const void*)mega_fwd, 512, LDS_BYTES);
        if (per_cu < 1) { fprintf(stderr, "kernel_launch: occupancy query says %d blocks/CU\n", per_cu); per_cu = 1; }
        (void)hipGetLastError();
        grid = cus * per_cu;
    }
    if (grid < 0) return;
    Args a{};
    for (int i = 0; i < 24; ++i) a.in[i] = (const float*)d_in[i];
    a.out = (float*)d_out; a.ws = (unsigned char*)d_ws;
    void* args[] = {&a};
    hipError_t e = hipLaunchCooperativeKernel((const void*)mega_fwd, dim3(grid), dim3(512), args, LDS_BYTES, stream);
    if (e != hipSuccess) fprintf(stderr, "cooperative launch failed: %s (grid %d)\n", hipGetErrorString(e), grid);
}
```

```cpp
#include <hip/hip_runtime.h>
#include <hip/hip_cooperative_groups.h>
#include <cstdio>
#include <cstdint>
namespace cg = cooperative_groups;
#define DBG_ZERO_YA 0
#define DBG_TWICE 0
#define DBG_NOSEL 0

#define LAS __attribute__((address_space(3)))
typedef unsigned short bf16_t;
typedef short bf16x8 __attribute__((ext_vector_type(8)));
typedef float f32x4 __attribute__((ext_vector_type(4)));
typedef unsigned u32x4 __attribute__((ext_vector_type(4)));
typedef unsigned u32x2 __attribute__((ext_vector_type(2)));
typedef __bf16 bf2_t __attribute__((ext_vector_type(2)));
typedef short v4i16_t __attribute__((ext_vector_type(4)));

constexpr int MROWS = 65536, DM = 1024, FF = 2816, SEQ = 8192, NB = 8;
constexpr int LDP = 5120;
constexpr int C_AQ = 0, C_AK = 512, C_AV = 640, C_IQ = 768, C_IK = 1280, C_MX = 1344, C_MV = 1856, C_MO = 2368, C_GA = 2880, C_GB = 3904, C_SM = 4928;
constexpr float EPS = 1e-6f;
constexpr size_t MiB = 1u << 20;
constexpr size_t WS_SS0 = 0, WS_SS1 = 256 * 1024, WS_SS2 = 512 * 1024;
constexpr size_t WS_DN = 1 * MiB;
constexpr size_t WS_ML = 2 * MiB, WS_BL = 2 * MiB + 16384, WS_MS = 2 * MiB + 32768;
constexpr size_t WS_BAR = 2 * MiB + 65536;
constexpr size_t WS_SM = 3 * MiB;
constexpr size_t WS_W1 = 8 * MiB, WS_W2 = 19 * MiB, WS_W3 = 25 * MiB, WS_W4 = 36 * MiB, WS_WIN = 42 * MiB, WS_WA = 52 * MiB, WS_WB = 53 * MiB, WS_WO = 54 * MiB, WS_WQK = 56 * MiB;
constexpr size_t WS_XB = 64 * MiB;
constexpr size_t WS_P = 192 * MiB;
constexpr size_t WS_MG = 832 * MiB;
constexpr size_t WS_IKC = 832 * MiB;
constexpr size_t WS_KVC = 840 * MiB;
constexpr size_t WS_QK = 960 * MiB;
constexpr size_t WS_END = 1024 * MiB;
constexpr int LDS_BYTES = 156 * 1024;

__device__ __forceinline__ unsigned cvt_pk_bf16(float lo, float hi) { unsigned r; asm volatile("v_cvt_pk_bf16_f32 %0, %1, %2" : "=v"(r) : "v"(lo), "v"(hi)); return r; }
__device__ __forceinline__ float bflo(unsigned u) { return __uint_as_float(u << 16); }
__device__ __forceinline__ float bfhi(unsigned u) { return __uint_as_float(u & 0xffff0000u); }
__device__ __forceinline__ float bf1(bf16_t u) { return __uint_as_float(((unsigned)u) << 16); }
__device__ __forceinline__ bf16_t f2bf(float f) { return (bf16_t)(cvt_pk_bf16(f, 0.f) & 0xffffu); }
__device__ __forceinline__ bf16_t f2bf_sw(float f) { const unsigned u = __float_as_uint(f); return (bf16_t)((u + 0x7fffu + ((u >> 16) & 1u)) >> 16); }
__device__ __forceinline__ float wave_sum(float v) {
#pragma unroll
    for (int o = 1; o < 64; o <<= 1) v += __shfl_xor(v, o);
    return v;
}
__device__ __forceinline__ float wave_max(float v) {
#pragma unroll
    for (int o = 1; o < 64; o <<= 1) v = fmaxf(v, __shfl_xor(v, o));
    return v;
}
__device__ __forceinline__ float sigmoidf_(float x) { return __builtin_amdgcn_rcpf(1.f + __expf(-x)); }
__device__ __forceinline__ float dot2bf(unsigned a, unsigned b, float c) { const unsigned aa = a, bb = b; return __builtin_amdgcn_fdot2_f32_bf16(__builtin_bit_cast(bf2_t, aa), __builtin_bit_cast(bf2_t, bb), c, false); }
__device__ __forceinline__ float relu_(float x) { const int i = __float_as_int(x); return __int_as_float(i > 0 ? i : 0); }
__device__ __forceinline__ void lds_order() { asm volatile("" ::: "memory"); }
__device__ __forceinline__ void lds_fence() { asm volatile("s_waitcnt lgkmcnt(0)" ::: "memory"); }
__device__ __forceinline__ void unpack8(u32x4 v, float* f) {
    f[0] = bflo(v.x); f[1] = bfhi(v.x); f[2] = bflo(v.y); f[3] = bfhi(v.y); f[4] = bflo(v.z); f[5] = bfhi(v.z); f[6] = bflo(v.w); f[7] = bfhi(v.w);
}
__device__ __forceinline__ u32x4 pack8(const float* f) {
    u32x4 o; o.x = cvt_pk_bf16(f[0], f[1]); o.y = cvt_pk_bf16(f[2], f[3]); o.z = cvt_pk_bf16(f[4], f[5]); o.w = cvt_pk_bf16(f[6], f[7]); return o;
}

namespace pg8 {
constexpr int BM = 256, BK = 64, HALF = 128, HTB = HALF * BK * 2, NXCD = 8, WGM = 8;
__host__ __device__ __forceinline__ int lds_byte(int r, int c) { const int st = (r >> 4) * 2 + (c >> 5), rr = r & 15, cc = c & 31, ob = rr * 64 + cc * 2; return st * 1024 + (ob ^ (((ob >> 9) & 1) << 5)); }
__host__ __device__ __forceinline__ void stage_rc(int b, int& R, int& C) { const int st = b / 1024, sb = b % 1024, swz = sb ^ (((sb >> 9) & 1) << 5); R = (st >> 1) * 16 + swz / 64; C = (st & 1) * 32 + (swz % 64) / 2; }
__host__ __device__ __forceinline__ int perm32(int rho) { const int n = rho >> 4, i = rho & 15; return 8 * (i >> 2) + 4 * n + (i & 3); }
struct Unit { int pm, pn; };
struct Gemm { const bf16_t* A; const bf16_t* Bt; int lda, ldb, M, N, K; };
struct StaticOrder {
    int nM, nN, nwg, G, c;
    __device__ void init(int M, int N, int G_, int c_) { nM = M / BM; nN = N / BM; nwg = nM * nN; G = G_; c = c_; }
    __device__ bool next(int i, Unit& u) const {
        const long L = (long)i * G + c; if (L >= nwg) return false;
        int wgid = (int)L; { const int q = nwg / NXCD, r = nwg % NXCD, xcd = wgid % NXCD, off = wgid / NXCD; wgid = (xcd < r ? xcd * (q + 1) : r * (q + 1) + (xcd - r) * q) + off; }
        const int nig = WGM * nN, gid = wgid / nig, fm = gid * WGM, gsz = (nM - fm) < WGM ? (nM - fm) : WGM;
        u.pm = fm + ((wgid % nig) % gsz); u.pn = (wgid % nig) / gsz; return true;
    }
};

template <class Epi>
__device__ __forceinline__ void gemm_phase(LAS unsigned char* lds, const Gemm g, const StaticOrder& S, const Epi& E) {
    int tid_ = threadIdx.x; asm volatile("" : "+v"(tid_));
    const int tid = tid_, wid = __builtin_amdgcn_readfirstlane(tid >> 6), lane = tid & 63, wr = wid >> 2, wc = wid & 3, fr = lane & 15, fq = lane >> 4;
    const int K = g.K, nt = K / BK;
    unsigned voffA[2], voffB[2];
#pragma unroll
    for (int i = 0; i < 2; ++i) { int R, C; stage_rc(tid * 16 + i * 8192, R, C); const int Rb = (R & ~31) + perm32(R & 31);
        voffA[i] = (unsigned)(R * g.lda + C) * 2u; voffB[i] = (unsigned)(Rb * g.ldb + C) * 2u; }
    const size_t kstep = (size_t)(BK * 2);
    const size_t hsA = (size_t)HALF * g.lda * 2, hsB = (size_t)HALF * g.ldb * 2;
    const size_t tsA = 2 * hsA, tsB = 2 * hsB;
    const unsigned ldsw = (unsigned)wid * 1024u;
    const int aoff = lds_byte(wr * 64 + fr, fq * 8), boff = lds_byte(wc * 32 + fr, fq * 8);
#define PG8_SA(b, h) (((b) * 2 + (h)) * HTB)
#define PG8_SB(b, h) ((4 + (b) * 2 + (h)) * HTB)
#define PG8_STAGE(bufoff, gbase, voff) do { _Pragma("unroll") for (int _i = 0; _i < 2; ++_i) \
        __builtin_amdgcn_global_load_lds((const unsigned*)((const char*)(gbase) + (voff)[_i]), (LAS unsigned*)(lds + (bufoff) + ldsw + _i * 8192), 16, 0, 0); } while (0)
#define PG8_LDA(dst, b, h) do { _Pragma("unroll") for (int m = 0; m < 4; ++m) _Pragma("unroll") for (int k = 0; k < 2; ++k) dst[m][k] = *(const LAS bf16x8*)(lds + PG8_SA(b, h) + aoff + m * 2048 + k * 1024); } while (0)
#define PG8_LDB(dst, b, h) do { _Pragma("unroll") for (int n = 0; n < 2; ++n) _Pragma("unroll") for (int k = 0; k < 2; ++k) dst[n][k] = *(const LAS bf16x8*)(lds + PG8_SB(b, h) + boff + n * 2048 + k * 1024); } while (0)
#define PG8_MMA(ai, bj, At, Bt) do { __builtin_amdgcn_s_setprio(1); _Pragma("unroll") for (int m = 0; m < 4; ++m) _Pragma("unroll") for (int n = 0; n < 2; ++n) _Pragma("unroll") for (int k = 0; k < 2; ++k) \
        acc[ai][bj][m][n] = __builtin_amdgcn_mfma_f32_16x16x32_bf16(Bt[n][k], At[m][k], acc[ai][bj][m][n], 0, 0, 0); __builtin_amdgcn_s_setprio(0); } while (0)
#define PG8_WAIT_V(n) asm volatile("s_waitcnt vmcnt(" #n ")" ::: "memory")
#define PG8_WAIT_L(n) asm volatile("s_waitcnt lgkmcnt(" #n ")" ::: "memory")
#define PG8_BAR __builtin_amdgcn_s_barrier()
#define PG8_SCHED __builtin_amdgcn_sched_barrier(0)
    Unit cur, nxt; int ui = 0;
    if (!S.next(0, cur)) return;
    f32x4 acc[2][2][4][2];
#pragma unroll
    for (int a = 0; a < 2; ++a)
#pragma unroll
        for (int b = 0; b < 2; ++b)
#pragma unroll
            for (int m = 0; m < 4; ++m)
#pragma unroll
                for (int n = 0; n < 2; ++n) acc[a][b][m][n] = (f32x4){0.f, 0.f, 0.f, 0.f};
    bf16x8 At[4][2], B0[2][2], B1[2][2];
    const char* cA = (const char*)g.A + (size_t)cur.pm * tsA; const char* cB = (const char*)g.Bt + (size_t)cur.pn * tsB;
    PG8_STAGE(PG8_SB(0, 0), cB, voffB); PG8_STAGE(PG8_SB(0, 1), cB + hsB, voffB); PG8_STAGE(PG8_SA(0, 0), cA, voffA); PG8_STAGE(PG8_SA(0, 1), cA + hsA, voffA);
    if (wr == 1) PG8_BAR;
    PG8_WAIT_V(2); PG8_BAR;
    PG8_STAGE(PG8_SB(1, 0), cB + kstep, voffB); PG8_STAGE(PG8_SA(1, 0), cA + kstep, voffA); PG8_STAGE(PG8_SB(1, 1), cB + hsB + kstep, voffB);
    PG8_WAIT_V(6); PG8_BAR;
    for (;;) {
        const bool has_next = S.next(ui + 1, nxt);
        const char* nA = has_next ? (const char*)g.A + (size_t)nxt.pm * tsA : cA; const char* nB = has_next ? (const char*)g.Bt + (size_t)nxt.pn * tsB : cB;
        for (int t = 0; t < nt; t += 2) {
            const bool last = (t == nt - 2);
            const char* a1 = cA + (size_t)(t + 1) * kstep;
            const char* a2 = last ? nA : cA + (size_t)(t + 2) * kstep; const char* b2 = last ? nB : cB + (size_t)(t + 2) * kstep;
            const char* a3 = a2 + kstep; const char* b3 = b2 + kstep;
            PG8_LDB(B0, 0, 0); PG8_LDB(B1, 0, 1); PG8_SCHED; PG8_LDA(At, 0, 0); PG8_STAGE(PG8_SA(1, 1), a1 + hsA, voffA);
            PG8_WAIT_V(8); PG8_WAIT_L(0); PG8_BAR; PG8_MMA(0, 0, At, B0); PG8_MMA(0, 1, At, B1); PG8_BAR; PG8_SCHED;
            PG8_LDA(At, 0, 1); PG8_STAGE(PG8_SB(0, 0), b2, voffB); PG8_STAGE(PG8_SB(0, 1), b2 + hsB, voffB); PG8_STAGE(PG8_SA(0, 0), a2, voffA);
            PG8_WAIT_V(8); PG8_WAIT_L(0); PG8_BAR; PG8_MMA(1, 0, At, B0); PG8_MMA(1, 1, At, B1); PG8_BAR; PG8_SCHED;
            PG8_LDB(B0, 1, 0); PG8_LDB(B1, 1, 1); PG8_SCHED; PG8_LDA(At, 1, 0); PG8_STAGE(PG8_SA(0, 1), a2 + hsA, voffA);
            PG8_WAIT_V(8); PG8_WAIT_L(0); PG8_BAR; PG8_MMA(0, 0, At, B0); PG8_MMA(0, 1, At, B1); PG8_BAR; PG8_SCHED;
            PG8_LDA(At, 1, 1); PG8_STAGE(PG8_SB(1, 0), b3, voffB); PG8_STAGE(PG8_SB(1, 1), b3 + hsB, voffB); PG8_STAGE(PG8_SA(1, 0), a3, voffA);
            PG8_WAIT_V(8); PG8_WAIT_L(0); PG8_BAR; PG8_MMA(1, 0, At, B0); PG8_MMA(1, 1, At, B1); PG8_BAR; PG8_SCHED;
        }
        if (wr == 0) PG8_BAR;
        E(acc, cur, wr, wc, fr, fq);
        if (!has_next) break;
#pragma unroll
        for (int a = 0; a < 2; ++a)
#pragma unroll
            for (int b = 0; b < 2; ++b)
#pragma unroll
                for (int m = 0; m < 4; ++m)
#pragma unroll
                    for (int n = 0; n < 2; ++n) acc[a][b][m][n] = (f32x4){0.f, 0.f, 0.f, 0.f};
        cur = nxt; cA = nA; cB = nB; ++ui;
        if (wr == 1) PG8_BAR;
    }
    PG8_WAIT_V(0);
    PG8_BAR;
#undef PG8_SA
#undef PG8_SB
#undef PG8_STAGE
#undef PG8_LDA
#undef PG8_LDB
#undef PG8_MMA
#undef PG8_WAIT_V
#undef PG8_WAIT_L
#undef PG8_BAR
#undef PG8_SCHED
}

typedef f32x4 AccT[2][2][4][2];
struct EpiSwiGLU {
    bf16_t* O; const float* ss;
    __device__ __forceinline__ void operator()(const AccT& acc, const Unit& u, int wr, int wc, int fr, int fq) const {
        const int row0 = u.pm * BM + wr * 64 + fr, col = u.pn * 128 + wc * 32 + 8 * fq;
#pragma unroll
        for (int ai = 0; ai < 2; ++ai)
#pragma unroll
            for (int m = 0; m < 4; ++m) {
                const int row = row0 + ai * HALF + m * 16;
                const float rs = rsqrtf(ss[row] * (1.f / 1024.f) + EPS);
                float o[8];
#pragma unroll
                for (int n = 0; n < 2; ++n)
#pragma unroll
                    for (int j = 0; j < 4; ++j) { const float gt = acc[ai][0][m][n][j] * rs, up = acc[ai][1][m][n][j] * rs; o[n * 4 + j] = gt * up * sigmoidf_(gt); }
                *(u32x4*)(O + (size_t)row * FF + col) = pack8(o);
            }
    }
};
template <bool RES_BF16, bool WRITE_F32, bool WRITE_XB> struct EpiRes {
    const float* res; const bf16_t* resb; float* out; bf16_t* xb; bf16_t* xb2; float* ss; float alpha;
    __device__ __forceinline__ void operator()(const AccT& acc, const Unit& u, int wr, int wc, int fr, int fq) const {
        const int row0 = u.pm * BM + wr * 64 + fr, col0 = u.pn * BM + wc * 32 + 8 * fq;
#pragma unroll
        for (int ai = 0; ai < 2; ++ai)
#pragma unroll
            for (int m = 0; m < 4; ++m) {
                const int row = row0 + ai * HALF + m * 16; float sq = 0.f;
#pragma unroll
                for (int bj = 0; bj < 2; ++bj) {
                    const size_t off = (size_t)row * DM + col0 + bj * HALF;
                    f32x4 r0, r1;
                    if (RES_BF16) { float f[8]; unpack8(*(const u32x4*)(resb + off), f); r0 = (f32x4){f[0], f[1], f[2], f[3]}; r1 = (f32x4){f[4], f[5], f[6], f[7]}; }
                    else { r0 = *(const f32x4*)(res + off); r1 = *(const f32x4*)(res + off + 4); }
                    const f32x4 v0 = r0 + acc[ai][bj][m][0] * alpha, v1 = r1 + acc[ai][bj][m][1] * alpha;
                    if (WRITE_F32) { *(f32x4*)(out + off) = v0; *(f32x4*)(out + off + 4) = v1; }
                    if (WRITE_XB) {
                        u32x4 w; w.x = cvt_pk_bf16(v0[0], v0[1]); w.y = cvt_pk_bf16(v0[2], v0[3]); w.z = cvt_pk_bf16(v1[0], v1[1]); w.w = cvt_pk_bf16(v1[2], v1[3]);
                        *(u32x4*)(xb + off) = w; if (xb2) *(u32x4*)(xb2 + off) = w;
                        sq += v0[0] * v0[0] + v0[1] * v0[1] + v0[2] * v0[2] + v0[3] * v0[3] + v1[0] * v1[0] + v1[1] * v1[1] + v1[2] * v1[2] + v1[3] * v1[3];
                    }
                }
                if (WRITE_XB) { sq += __shfl_xor(sq, 16); sq += __shfl_xor(sq, 32); if (fq == 0) atomicAdd(ss + row, sq); }
            }
    }
};
struct EpiP {
    bf16_t* P; float* SM; const float* ss;
    __device__ __forceinline__ void operator()(const AccT& acc, const Unit& u, int wr, int wc, int fr, int fq) const {
        const int row0 = u.pm * BM + wr * 64 + fr, col0 = u.pn * BM + wc * 32 + 8 * fq;
#pragma unroll
        for (int ai = 0; ai < 2; ++ai)
#pragma unroll
            for (int m = 0; m < 4; ++m) {
                const int row = row0 + ai * HALF + m * 16;
                const float rs = rsqrtf(ss[row] * (1.f / 1024.f) + EPS);
#pragma unroll
                for (int bj = 0; bj < 2; ++bj) {
                    const int col = col0 + bj * HALF;
                    const f32x4 v0 = acc[ai][bj][m][0] * rs, v1 = acc[ai][bj][m][1] * rs;
                    u32x4 w; w.x = cvt_pk_bf16(v0[0], v0[1]); w.y = cvt_pk_bf16(v0[2], v0[3]); w.z = cvt_pk_bf16(v1[0], v1[1]); w.w = cvt_pk_bf16(v1[2], v1[3]);
                    *(u32x4*)(P + (size_t)row * LDP + col) = w;
                    if (col >= C_SM && col < C_SM + 16) { float* s = SM + (size_t)row * 16 + (col - C_SM); *(f32x4*)s = v0; *(f32x4*)(s + 4) = v1; }
                }
            }
    }
};
struct EpiBf16 {
    bf16_t* O; int ldc;
    __device__ __forceinline__ void operator()(const AccT& acc, const Unit& u, int wr, int wc, int fr, int fq) const {
        const int row0 = u.pm * BM + wr * 64 + fr, col0 = u.pn * BM + wc * 32 + 8 * fq;
#pragma unroll
        for (int ai = 0; ai < 2; ++ai)
#pragma unroll
            for (int m = 0; m < 4; ++m) {
                const int row = row0 + ai * HALF + m * 16;
#pragma unroll
                for (int bj = 0; bj < 2; ++bj) {
                    const f32x4 v0 = acc[ai][bj][m][0], v1 = acc[ai][bj][m][1];
                    u32x4 w; w.x = cvt_pk_bf16(v0[0], v0[1]); w.y = cvt_pk_bf16(v0[2], v0[3]); w.z = cvt_pk_bf16(v1[0], v1[1]); w.w = cvt_pk_bf16(v1[2], v1[3]);
                    *(u32x4*)(O + (size_t)row * ldc + col0 + bj * HALF) = w;
                }
            }
    }
};
template <int PASS> struct EpiMerge {
    const bf16_t* P; bf16_t* MG; int goff;
    __device__ __forceinline__ void operator()(const AccT& acc, const Unit& u, int wr, int wc, int fr, int fq) const {
        const int row0 = u.pm * BM + wr * 64 + fr, col0 = u.pn * BM + wc * 32 + 8 * fq;
#pragma unroll
        for (int ai = 0; ai < 2; ++ai)
#pragma unroll
            for (int m = 0; m < 4; ++m) {
                const int row = row0 + ai * HALF + m * 16;
#pragma unroll
                for (int bj = 0; bj < 2; ++bj) {
                    const int col = col0 + bj * HALF;
                    float gt[8], o[8]; unpack8(*(const u32x4*)(P + (size_t)row * LDP + goff + col), gt);
                    if (PASS == 1) unpack8(*(const u32x4*)(MG + (size_t)row * DM + col), o);
#pragma unroll
                    for (int j = 0; j < 8; ++j) { const float a = acc[ai][bj][m][j >> 2][j & 3] * sigmoidf_(gt[j]); o[j] = (PASS == 1) ? o[j] + a : a; }
                    *(u32x4*)(MG + (size_t)row * DM + col) = pack8(o);
                }
            }
    }
};
}

struct Args {
    const float* in[24];
    float* out;
    unsigned char* ws;
};
enum { I_X = 0, I_F1N, I_F1G, I_F1U, I_F1D, I_MIXN, I_WIN, I_QN, I_KN, I_IKN, I_CW, I_CB, I_WMQ, I_WMK, I_BI, I_BF, I_MHN, I_WPA, I_WPB, I_WOUT, I_F2N, I_F2G, I_F2U, I_F2D };

template <class F> __device__ __forceinline__ void prep_load(int n0, int k0, const F src, float (&v)[8]) {
    const int tid = threadIdx.x, nn = tid & 63, kk = tid >> 6;
#pragma unroll
    for (int i = 0; i < 8; ++i) v[i] = src(k0 + i * 8 + kk, n0 + nn);
}
__device__ __forceinline__ void prep_store(bf16_t* Bt, int K, int n0, int k0, const float (&v)[8], float* tile) {
    const int tid = threadIdx.x;
    { const int nn = tid & 63, kk = tid >> 6;
#pragma unroll
        for (int i = 0; i < 8; ++i) tile[(i * 8 + kk) * 65 + nn] = v[i]; }
    __syncthreads();
    { const int nn = tid >> 3, kc = tid & 7; const float* s = tile + (kc * 8) * 65 + nn;
        u32x4 o; o.x = cvt_pk_bf16(s[0], s[65]); o.y = cvt_pk_bf16(s[130], s[195]); o.z = cvt_pk_bf16(s[260], s[325]); o.w = cvt_pk_bf16(s[390], s[455]);
        *(u32x4*)(Bt + (size_t)(n0 + nn) * K + k0 + kc * 8) = o; }
    __syncthreads();
}
struct SrcUp { const float* wg; const float* wu; const float* g;
    __device__ __forceinline__ float operator()(int k, int n) const { const int col = (n >> 8) * 128 + (n & 127); const size_t bj = (size_t)((n >> 7) & 1); const float* w = (const float*)((uintptr_t)wg + ((uintptr_t)wu - (uintptr_t)wg) * bj); return w[(size_t)k * FF + col] * g[k]; } };
struct SrcPlain { const float* w; int ldw;
    __device__ __forceinline__ float operator()(int k, int n) const { return w[(size_t)k * ldw + n]; } };
struct SrcIn { const float* w; const float* g;
    __device__ __forceinline__ float operator()(int k, int n) const {
        int col;
        if (n < 1344) col = n; else if (n < 2368) col = n + 8; else if (n < 4928) col = n + 16;
        else if (n < 4936) col = n - 4928 + 1344; else if (n < 4940) col = n - 4936 + 2376; else if (n < 4944) col = n - 4940 + 2380; else col = -1;
        return col >= 0 ? w[(size_t)k * 4944 + col] * g[k] : 0.f; } };
struct SrcQK { const float* wq; const float* wk;
    __device__ __forceinline__ float operator()(int k, int n) const {
        const int isk = n >> 8, h = (n >> 6) & 3, j = n & 63, hk = k >> 7, c = k & 127;
        if (hk != h) return 0.f;
        const float* w = (const float*)((uintptr_t)wq + ((uintptr_t)wk - (uintptr_t)wq) * (size_t)isk); return w[(size_t)(h * 128 + c) * 64 + j] * (isk ? 1.f : 0.125f); } };

__device__ __forceinline__ void phase0(const Args& a, unsigned char* lds) {
    float* tile = (float*)lds;
    unsigned char* ws = a.ws;
    constexpr int T_UP = 88 * 16, T_DN = 16 * 44, T_IN = 80 * 16, T_PR = 16 * 8, T_WO = 16 * 16, T_QK = 8 * 8;
    constexpr int NITEMS = 2 * T_UP + 2 * T_DN + T_IN + 2 * T_PR + T_WO + T_QK;
#define P0_LOAD(IT, V, BOFF, KK, N0, K0) do { int r = (IT); \
        if (r < T_UP) { SrcUp s_{a.in[I_F1G], a.in[I_F1U], a.in[I_F1N]}; BOFF = WS_W1; KK = 1024; N0 = (r / 16) * 64; K0 = (r % 16) * 64; prep_load(N0, K0, s_, V); break; } r -= T_UP; \
        if (r < T_UP) { SrcUp s_{a.in[I_F2G], a.in[I_F2U], a.in[I_F2N]}; BOFF = WS_W3; KK = 1024; N0 = (r / 16) * 64; K0 = (r % 16) * 64; prep_load(N0, K0, s_, V); break; } r -= T_UP; \
        if (r < T_DN) { SrcPlain s_{a.in[I_F1D], 1024}; BOFF = WS_W2; KK = FF; N0 = (r / 44) * 64; K0 = (r % 44) * 64; prep_load(N0, K0, s_, V); break; } r -= T_DN; \
        if (r < T_DN) { SrcPlain s_{a.in[I_F2D], 1024}; BOFF = WS_W4; KK = FF; N0 = (r / 44) * 64; K0 = (r % 44) * 64; prep_load(N0, K0, s_, V); break; } r -= T_DN; \
        if (r < T_IN) { SrcIn s_{a.in[I_WIN], a.in[I_MIXN]}; BOFF = WS_WIN; KK = 1024; N0 = (r / 16) * 64; K0 = (r % 16) * 64; prep_load(N0, K0, s_, V); break; } r -= T_IN; \
        if (r < T_PR) { SrcPlain s_{a.in[I_WPA], 1024}; BOFF = WS_WA; KK = 512; N0 = (r / 8) * 64; K0 = (r % 8) * 64; prep_load(N0, K0, s_, V); break; } r -= T_PR; \
        if (r < T_PR) { SrcPlain s_{a.in[I_WPB], 1024}; BOFF = WS_WB; KK = 512; N0 = (r / 8) * 64; K0 = (r % 8) * 64; prep_load(N0, K0, s_, V); break; } r -= T_PR; \
        if (r < T_WO) { SrcPlain s_{a.in[I_WOUT], 1024}; BOFF = WS_WO; KK = 1024; N0 = (r / 16) * 64; K0 = (r % 16) * 64; prep_load(N0, K0, s_, V); break; } r -= T_WO; \
        { SrcQK s_{a.in[I_WMQ], a.in[I_WMK]}; BOFF = WS_WQK; KK = 512; N0 = (r / 8) * 64; K0 = (r % 8) * 64; prep_load(N0, K0, s_, V); } } while (0)
    {
        float v[8], vn[8]; size_t boff = 0, boffn = 0; int kk_ = 0, n0_ = 0, k0_ = 0, kkn = 0, n0n = 0, k0n = 0;
        int it = blockIdx.x;
        if (it < NITEMS) P0_LOAD(it, v, boff, kk_, n0_, k0_);
        for (; it < NITEMS; it += gridDim.x) {
            const int itn = it + (int)gridDim.x;
            if (itn < NITEMS) P0_LOAD(itn, vn, boffn, kkn, n0n, k0n);
            prep_store((bf16_t*)(ws + boff), kk_, n0_, k0_, v, tile);
#pragma unroll
            for (int i = 0; i < 8; ++i) v[i] = vn[i];
            boff = boffn; kk_ = kkn; n0_ = n0n; k0_ = k0n;
        }
    }
#undef P0_LOAD
    const int lane = threadIdx.x & 63, gw = blockIdx.x * 8 + (threadIdx.x >> 6), NGW = gridDim.x * 8;
    const float* x = a.in[I_X]; bf16_t* XB = (bf16_t*)(ws + WS_XB);
    float* ss0 = (float*)(ws + WS_SS0); float* ss1 = (float*)(ws + WS_SS1); float* ss2 = (float*)(ws + WS_SS2);
    for (int row = gw; row < MROWS; row += NGW) {
        const f32x4* xr = (const f32x4*)(x + (size_t)row * DM) + lane;
        f32x4 v[4]; float s = 0.f;
#pragma unroll
        for (int j = 0; j < 4; ++j) { v[j] = xr[64 * j]; s += v[j][0] * v[j][0] + v[j][1] * v[j][1] + v[j][2] * v[j][2] + v[j][3] * v[j][3]; }
        s = wave_sum(s);
        if (lane == 0) { ss0[row] = s; ss1[row] = 0.f; ss2[row] = 0.f; }
        unsigned long long* o8 = (unsigned long long*)(XB + (size_t)row * DM) + lane;
#pragma unroll
        for (int j = 0; j < 4; ++j) o8[64 * j] = (unsigned long long)cvt_pk_bf16(v[j][0], v[j][1]) | ((unsigned long long)cvt_pk_bf16(v[j][2], v[j][3]) << 32);
    }
}

__device__ __forceinline__ void phase_postp(const Args& a) {
    unsigned char* ws = a.ws;
    bf16_t* P = (bf16_t*)(ws + WS_P); bf16_t* XC = (bf16_t*)(ws + WS_XB); bf16_t* IKC = (bf16_t*)(ws + WS_IKC); bf16_t* KVC = (bf16_t*)(ws + WS_KVC);
    const int lane = threadIdx.x & 63, gw = blockIdx.x * 8 + (threadIdx.x >> 6), NGW = gridDim.x * 8;
    const int c0 = lane * 8;
    float cw[4][8], cb[8], gq[8], gk[8];
#pragma unroll
    for (int e = 0; e < 8; ++e) {
        cb[e] = a.in[I_CB][c0 + e];
#pragma unroll
        for (int j = 0; j < 4; ++j) cw[j][e] = a.in[I_CW][j * 512 + c0 + e];
        gq[e] = a.in[I_QN][(lane & 7) * 8 + e];
        gk[e] = (lane < 16) ? a.in[I_KN][(lane & 7) * 8 + e] : a.in[I_IKN][(lane & 7) * 8 + e];
    }
    const int koff = (lane < 16) ? (C_AK + lane * 8) : (C_IK + (lane & 7) * 8);
    const int voff = C_AV + ((lane - 32) & 15) * 8;
    u32x4 nmx[4], naq, nkk, nav;
#define PP_LOAD(ROW) do { const int t_ = (ROW) & (SEQ - 1); const bf16_t* pr_ = P + (size_t)(ROW) * LDP; \
        _Pragma("unroll") for (int j = 0; j < 4; ++j) { if (t_ - 3 + j >= 0) nmx[j] = *(const u32x4*)(P + (size_t)((ROW) - 3 + j) * LDP + C_MX + c0); else nmx[j] = (u32x4){0u, 0u, 0u, 0u}; } \
        naq = *(const u32x4*)(pr_ + C_AQ + c0); nkk = *(const u32x4*)(pr_ + koff); nav = *(const u32x4*)(pr_ + voff); } while (0)
    if (gw < MROWS) PP_LOAD(gw);
    for (int row = gw; row < MROWS; row += NGW) {
        bf16_t* pr = P + (size_t)row * LDP;
        u32x4 cmx[4];
#pragma unroll
        for (int j = 0; j < 4; ++j) cmx[j] = nmx[j];
        const u32x4 caq = naq, ckk = nkk, cav = nav;
        if (row + NGW < MROWS) PP_LOAD(row + NGW);
        float accv[8];
#pragma unroll
        for (int e = 0; e < 8; ++e) accv[e] = cb[e];
#pragma unroll
        for (int j = 0; j < 4; ++j) { float xf[8]; unpack8(cmx[j], xf);
#pragma unroll
            for (int e = 0; e < 8; ++e) accv[e] += xf[e] * cw[j][e]; }
#pragma unroll
        for (int e = 0; e < 8; ++e) accv[e] = accv[e] * sigmoidf_(accv[e]);
        *(u32x4*)(XC + (size_t)row * 512 + c0) = pack8(accv);
        { float f[8]; unpack8(caq, f); float s = 0.f;
#pragma unroll
            for (int e = 0; e < 8; ++e) s += f[e] * f[e];
            s += __shfl_xor(s, 1); s += __shfl_xor(s, 2); s += __shfl_xor(s, 4);
            const float rs = rsqrtf(s * (1.f / 64.f) + EPS);
#pragma unroll
            for (int e = 0; e < 8; ++e) f[e] = f[e] * rs * gq[e];
            *(u32x4*)(pr + C_AQ + c0) = pack8(f); }
        { float f[8]; unpack8(ckk, f); float s = 0.f;
#pragma unroll
            for (int e = 0; e < 8; ++e) s += f[e] * f[e];
            s += __shfl_xor(s, 1); s += __shfl_xor(s, 2); s += __shfl_xor(s, 4);
            const float rs = rsqrtf(s * (1.f / 64.f) + EPS);
#pragma unroll
            for (int e = 0; e < 8; ++e) f[e] = f[e] * rs * gk[e];
            if (lane < 16) *(u32x4*)(KVC + (size_t)row * 256 + lane * 8) = pack8(f);
            else if (lane < 24) *(u32x4*)(IKC + ((((size_t)(row >> 4)) * 8 + (lane - 16)) * 16 + (row & 15)) * 8) = pack8(f);
            else if (lane >= 32 && lane < 48) *(u32x4*)(KVC + (size_t)row * 256 + 128 + (lane - 32) * 8) = cav; }
    }
#undef PP_LOAD
}

__device__ __forceinline__ unsigned fkey(float s) { const unsigned u = __float_as_uint(s); return (u & 0x80000000u) ? ~u : (u | 0x80000000u); }


__device__ __forceinline__ unsigned wave_incl_scan_dpp(unsigned x) {
    x += (unsigned)__builtin_amdgcn_update_dpp(0, (int)x, 0x111, 0xf, 0xf, false);
    x += (unsigned)__builtin_amdgcn_update_dpp(0, (int)x, 0x112, 0xf, 0xf, false);
    x += (unsigned)__builtin_amdgcn_update_dpp(0, (int)x, 0x114, 0xf, 0xf, false);
    x += (unsigned)__builtin_amdgcn_update_dpp(0, (int)x, 0x118, 0xf, 0xf, false);
    x += (unsigned)__builtin_amdgcn_update_dpp(0, (int)x, 0x142, 0xa, 0xf, false);
    x += (unsigned)__builtin_amdgcn_update_dpp(0, (int)x, 0x143, 0xc, 0xf, false);
    return x;
}
__device__ __forceinline__ int find_bin(const unsigned* hist, int& need, int lane, int& binc) {
    const int base = 1023 - 16 * lane; unsigned s = 0;
#pragma unroll
    for (int i = 0; i < 16; ++i) { const unsigned w = hist[base - ((i + lane) & 15)]; s += (w & 0xffffu) + (w >> 16); }
    const unsigned p = wave_incl_scan_dpp(s);
    const unsigned long long bal = __ballot(p >= (unsigned)need);
    const int L = bal ? (__ffsll((long long)bal) - 1) : 63;
    const unsigned excl = __shfl(p - s, L);
    const int b0 = 1023 - 16 * L, t = lane & 31;
    const unsigned w2 = hist[b0 - (t >> 1)];
    const unsigned v2 = (lane < 32) ? ((t & 1) ? (w2 & 0xffffu) : (w2 >> 16)) : 0u;
    const unsigned p2 = wave_incl_scan_dpp(v2);
    const unsigned long long bal2 = __ballot((lane < 32) && ((unsigned)excl + p2 >= (unsigned)need));
    const int ts = bal2 ? (__ffsll((long long)bal2) - 1) : 31;
    const int vs = (int)__shfl(v2, ts), ps = (int)__shfl(p2, ts);
    int bin = 2 * (b0 - (ts >> 1)) + ((ts & 1) ? 0 : 1);
    int fneed = need - ((int)excl + ps - vs), bc = vs;
    if (fneed < 1) fneed = 1;
    need = fneed; binc = bc; return bin;
}


__device__ __forceinline__ int find_bin128(const unsigned* sh, int& need, int lane, int& binc) {
    const unsigned hi = sh[127 - 2 * lane], lo = sh[126 - 2 * lane]; const unsigned s = hi + lo;
    const unsigned p = wave_incl_scan_dpp(s);
    const unsigned long long bal = __ballot(p >= (unsigned)need);
    const int L = bal ? (__ffsll((long long)bal) - 1) : 63;
    const int excl = (int)__shfl(p - s, L); const int hiL = (int)__shfl(hi, L), loL = (int)__shfl(lo, L);
    int bin, fneed, bc;
    if (excl + hiL >= need) { bin = 127 - 2 * L; fneed = need - excl; bc = hiL; } else { bin = 126 - 2 * L; fneed = need - excl - hiL; bc = loL; }
    if (fneed < 1) fneed = 1;
    need = fneed; binc = bc; return bin;
}

template <bool DUMMY> __device__ __forceinline__ void phase_dsa(const Args& a, unsigned char* lds) {
    unsigned char* ws = a.ws;
    bf16_t* P = (bf16_t*)(ws + WS_P); const float* SM = (const float*)(ws + WS_SM);
    const bf16_t* IKC = (const bf16_t*)(ws + WS_IKC); const bf16_t* KVC = (const bf16_t*)(ws + WS_KVC);
    constexpr int SCS = 8200;
    float* SC = (float*)lds;
    unsigned* HIST = (unsigned*)(lds + 131200);
    int* LIST = (int*)(lds + 131200 + 16384);
    unsigned* QS = (unsigned*)(lds + 131200 + 16384 + 4096);
    int* CNT = (int*)(lds + 131200 + 16384 + 4096 + 4096);
    const float idx_scale = 0.125f * 0.35355339059327373f;
    f32x4 wqv[2]; unsigned qsv[2];
#define DSA_LOAD_ITEM(ITEM) do { const int b_ = (ITEM) & 7, t0_ = ((ITEM) >> 3) * 4; const size_t r_ = (size_t)b_ * SEQ + t0_; \
        int tl_ = threadIdx.x; asm volatile("" : "+v"(tl_)); const int ln_ = tl_ & 63, q4_ = ln_ >> 4; \
        wqv[0] = *(const f32x4*)(SM + (r_ + q4_) * 16); wqv[1] = *(const f32x4*)(SM + (r_ + q4_) * 16 + 4); \
        _Pragma("unroll") for (int i_ = 0; i_ < 2; ++i_) { const int e_ = tl_ + 512 * i_; qsv[i_] = *(const unsigned*)(P + (r_ + (e_ >> 8)) * LDP + C_AQ + (e_ & 255) * 2); } } while (0)
    if ((int)blockIdx.x < 16384) DSA_LOAD_ITEM(blockIdx.x);
    for (int item = blockIdx.x; item < 16384; item += gridDim.x) {
        int tid_ = threadIdx.x; asm volatile("" : "+v"(tid_));
        const int tid = tid_, wave = __builtin_amdgcn_readfirstlane(tid >> 6), lane = tid & 63, quad = lane >> 4, l15 = lane & 15;
        const int b = item & 7, tq = item >> 3, t0 = tq * 4, L = ((t0 >> 6) + 1) * 64;
        const size_t r0 = (size_t)b * SEQ + t0;
        const bool do_sel = (L > 256) && !DBG_NOSEL;
        { u32x4* hz = (u32x4*)HIST; hz[tid] = (u32x4){0u, 0u, 0u, 0u}; hz[tid + 512] = (u32x4){0u, 0u, 0u, 0u}; }
        if (tid < 8) CNT[4 + tid] = 0;
        QS[tid] = qsv[0]; QS[tid + 512] = qsv[1];
        float wq[8];
#pragma unroll
        for (int h = 0; h < 4; ++h) { wq[h] = wqv[0][h] * idx_scale; wq[4 + h] = wqv[1][h] * idx_scale; }
        bf16x8 af[2][2];
#pragma unroll
        for (int T = 0; T < 2; ++T)
#pragma unroll
            for (int ks = 0; ks < 2; ++ks) af[T][ks] = *(const bf16x8*)(P + (r0 + (l15 >> 2)) * LDP + C_IQ + (4 * T + (l15 & 3)) * 64 + ks * 32 + quad * 8);
        const int ngroups = L >> 6;
        const bf16_t* ikb = IKC + (size_t)b * SEQ * 64 + (quad * 16 + l15) * 8;
        bf16x8 B0[4][2], B1[4][2], B2[4][2];
#define IDX_LOAD(BUF, G) do { _Pragma("unroll") for (int tt = 0; tt < 4; ++tt) _Pragma("unroll") for (int ks = 0; ks < 2; ++ks) \
                BUF[tt][ks] = *(const bf16x8*)(ikb + (size_t)(((G) * 4 + tt) * 8 + ks * 4) * 128); } while (0)
        if (wave < ngroups) IDX_LOAD(B0, wave);
        if (wave + 8 < ngroups) IDX_LOAD(B1, wave + 8);
        if (wave + 16 < ngroups) IDX_LOAD(B2, wave + 16);
        lds_fence(); __builtin_amdgcn_s_barrier();
        for (int rep = 0; rep < ((DBG_TWICE & 2) ? 2 : 1); ++rep) {
            const bool hist_on = do_sel && (rep == (((DBG_TWICE & 2) ? 2 : 1) - 1));
#define IDX_COMPUTE(BUF, G) do { _Pragma("unroll") for (int tt = 0; tt < 4; ++tt) { \
                const int key = (G) * 64 + tt * 16 + l15; \
                f32x4 c0 = (f32x4){0.f, 0.f, 0.f, 0.f}, c1 = (f32x4){0.f, 0.f, 0.f, 0.f}; \
                c0 = __builtin_amdgcn_mfma_f32_16x16x32_bf16(af[0][0], BUF[tt][0], c0, 0, 0, 0); \
                c1 = __builtin_amdgcn_mfma_f32_16x16x32_bf16(af[1][0], BUF[tt][0], c1, 0, 0, 0); \
                c0 = __builtin_amdgcn_mfma_f32_16x16x32_bf16(af[0][1], BUF[tt][1], c0, 0, 0, 0); \
                c1 = __builtin_amdgcn_mfma_f32_16x16x32_bf16(af[1][1], BUF[tt][1], c1, 0, 0, 0); \
                float sc = 0.f; \
                _Pragma("unroll") for (int j = 0; j < 4; ++j) { sc += wq[j] * relu_(c0[j]); sc += wq[4 + j] * relu_(c1[j]); } \
                sc += 0.f; \
                SC[quad * SCS + key] = sc; \
                if (hist_on) { const unsigned bin = fkey(sc) >> 21; atomicAdd(&HIST[quad * 1024 + (bin >> 1)], (bin & 1u) ? 0x10000u : 1u); } } } while (0)
            int g = wave;
            for (; g < ngroups; g += 24) {
                IDX_COMPUTE(B0, g);
                if (g + 24 < ngroups) IDX_LOAD(B0, g + 24);
                if (g + 8 < ngroups) { IDX_COMPUTE(B1, g + 8); if (g + 32 < ngroups) IDX_LOAD(B1, g + 32); }
                if (g + 16 < ngroups) { IDX_COMPUTE(B2, g + 16); if (g + 40 < ngroups) IDX_LOAD(B2, g + 40); }
            }
#undef IDX_LOAD
#undef IDX_COMPUTE
        }
        lds_fence(); __builtin_amdgcn_s_barrier();
        if (item + (int)gridDim.x < 16384) DSA_LOAD_ITEM(item + (int)gridDim.x);
        {
            constexpr int CAP = 448;
            const unsigned long long ltmask = (1ull << lane) - 1ull;
            if (!do_sel) {
                const int q = wave >> 1, hf = wave & 1; int* list = LIST + q * 256;
                if (hf == 0) { for (int i = lane; i < 256; i += 64) list[i] = (i < L) ? i : 0; if (lane == 0) CNT[q] = L; }
            } else {
                {
                    const int q = wave >> 1, hf = wave & 1; int* list = LIST + q * 256; const float* sc = SC + q * SCS; unsigned* hist = HIST + q * 1024;
                    const int halfL = L >> 1, beg = hf * halfL, end = beg + halfL;
                    int need = 256, binc = 0;
                    const unsigned b1 = (unsigned)find_bin(hist, need, lane, binc);
                    const int c1 = binc, nsure = 256 - need; const bool store_c = c1 <= CAP;
                    if (hf == 0 && lane == 0) { CNT[12 + q] = (int)b1; CNT[16 + q] = need; CNT[8 + q] = c1; }
                    lds_fence(); __builtin_amdgcn_s_barrier();
                    int cs = 0, cc = 0;
                    for (int i0 = beg + lane * 4; i0 < end; i0 += 256) { const f32x4 v = *(const f32x4*)(sc + i0);
#pragma unroll
                        for (int e = 0; e < 4; ++e) { const unsigned k = fkey(v[e]); const unsigned kb = k >> 21;
                            const bool sure = kb > b1, cand = (kb == b1) && store_c;
                            const unsigned long long ms = __ballot(sure), mc = __ballot(cand);
                            if (ms) { const int p = cs + __popcll(ms & ltmask); const int pp = hf ? nsure - 1 - p : p; if (sure && pp >= 0 && pp < 256) list[pp] = i0 + e; cs += __popcll(ms); }
                            if (mc) { const int p = cc + __popcll(mc & ltmask); const int pp = hf ? c1 - 1 - p : p; if (cand && pp >= 0 && pp < CAP) { hist[2 * pp] = k; hist[2 * pp + 1] = (unsigned)(i0 + e); } cc += __popcll(mc); } } }
                    lds_fence(); __builtin_amdgcn_s_barrier();
                }
                if (wave < 4) {
                    const int q = wave; int* list = LIST + q * 256; unsigned* hist = HIST + q * 1024; unsigned* sh = hist + 896; const float* sc = SC + q * SCS;
                    const unsigned b1 = (unsigned)CNT[12 + q]; int need = CNT[16 + q]; const int c = CNT[8 + q]; const int nsure = 256 - need;
                    if (c <= CAP) {
                        unsigned ck[7]; int ci[7];
#pragma unroll
                        for (int t = 0; t < 7; ++t) { const int i = lane + 64 * t; const bool valid = i < c; ck[t] = valid ? hist[2 * i] : 0u; ci[t] = valid ? (int)hist[2 * i + 1] : -1; }
                        int binc = 0;
                        sh[2 * lane] = 0u; sh[2 * lane + 1] = 0u; lds_order();
#pragma unroll
                        for (int t = 0; t < 7; ++t) if (ci[t] >= 0) atomicAdd(&sh[(ck[t] >> 14) & 127u], 1u);
                        lds_order();
                        const unsigned bA = (unsigned)find_bin128(sh, need, lane, binc);
                        lds_order();
                        sh[2 * lane] = 0u; sh[2 * lane + 1] = 0u; lds_order();
#pragma unroll
                        for (int t = 0; t < 7; ++t) if (ci[t] >= 0 && ((ck[t] >> 14) & 127u) == bA) atomicAdd(&sh[(ck[t] >> 7) & 127u], 1u);
                        lds_order();
                        const unsigned bB = (unsigned)find_bin128(sh, need, lane, binc);
                        const unsigned preB = (bA << 7) | bB;
                        lds_order();
                        sh[2 * lane] = 0u; sh[2 * lane + 1] = 0u; lds_order();
#pragma unroll
                        for (int t = 0; t < 7; ++t) if (ci[t] >= 0 && ((ck[t] >> 7) & 0x3fffu) == preB) atomicAdd(&sh[ck[t] & 127u], 1u);
                        lds_order();
                        const unsigned bC = (unsigned)find_bin128(sh, need, lane, binc);
                        const unsigned T = (b1 << 21) | (preB << 7) | bC;
                        const int tie_total = binc, need_t = need;
                        int cnt = 0;
#pragma unroll
                        for (int t = 0; t < 7; ++t) {
                            const bool valid = ci[t] >= 0;
                            bool sel = valid && (ck[t] > T);
                            if (valid && ck[t] == T) {
                                if (tie_total == need_t) sel = true;
                                else { int rank = 0; for (int j = 0; j < c; ++j) rank += (hist[2 * j] == T && (int)hist[2 * j + 1] < ci[t]) ? 1 : 0; sel = rank < need_t; }
                            }
                            const unsigned long long m = __ballot(sel);
                            const int pos = nsure + cnt + __popcll(m & ltmask);
                            if (sel && pos < 256) list[pos] = ci[t];
                            cnt += __popcll(m);
                        }
                    } else {
                        int binc = 0;
                        lds_order();
#pragma unroll
                        for (int i = 0; i < 16; ++i) hist[lane * 16 + i] = 0u;
                        lds_order();
                        for (int i0 = 0; i0 < L; i0 += 64) { const unsigned k = fkey(sc[i0 + lane]); if ((k >> 21) == b1) { const unsigned bin = (k >> 10) & 2047u; atomicAdd(&hist[bin >> 1], (bin & 1u) ? 0x10000u : 1u); } }
                        lds_order();
                        const unsigned b2 = (unsigned)find_bin(hist, need, lane, binc);
                        const unsigned pre2 = (b1 << 11) | b2;
                        lds_order();
#pragma unroll
                        for (int i = 0; i < 16; ++i) hist[lane * 16 + i] = 0u;
                        lds_order();
                        for (int i0 = 0; i0 < L; i0 += 64) { const unsigned k = fkey(sc[i0 + lane]); if ((k >> 10) == pre2) { const unsigned bin = k & 1023u; atomicAdd(&hist[bin >> 1], (bin & 1u) ? 0x10000u : 1u); } }
                        lds_order();
                        const unsigned b3 = (unsigned)find_bin(hist, need, lane, binc);
                        const unsigned T = (pre2 << 10) | b3;
                        int count = 0, ties = 0;
                        for (int i0 = 0; i0 < L; i0 += 64) {
                            const unsigned k = fkey(sc[i0 + lane]);
                            const bool eq = (k == T);
                            const unsigned long long em = __ballot(eq);
                            const int erank = ties + __popcll(em & ltmask);
                            const bool sel = (k > T) || (eq && erank < need);
                            const unsigned long long smk = __ballot(sel);
                            const int pos = count + __popcll(smk & ltmask);
                            if (sel && pos < 256) list[pos] = i0 + lane;
                            count += __popcll(smk); ties += __popcll(em);
                        }
                        if (count > 256) count = 256;
                        for (int i = count + lane; i < 256; i += 64) list[i] = 0;
                    }
                    if (lane == 0) CNT[q] = 256;
                }
            }
        }
        lds_fence(); __builtin_amdgcn_s_barrier();
        for (int repc = 0; repc < ((DBG_TWICE & 4) ? 2 : 1); ++repc) {
            const bool dummy_c = (repc + 1) < ((DBG_TWICE & 4) ? 2 : 1);
            int lane_c = lane; asm volatile("" : "+v"(lane_c));
            const int qi = wave >> 1, g = wave & 1; const int count = CNT[qi];
            const int* list = LIST + qi * 256;
            float* PB = SC + wave * 1024;
            const unsigned* qd = QS + (qi * 8 + g * 4) * 32;
            const bf16_t* kvb = KVC + (size_t)b * SEQ * 256 + g * 64;
            const int ks = lane_c >> 3, dg = lane_c & 7, l15c = lane_c & 15, quadc = lane_c >> 4;
            const int nblk = count >> 6;
            bf16_t* KL = (bf16_t*)(lds + 32768 + wave * 9216);
            bf16x8 bq[2];
#pragma unroll
            for (int s2 = 0; s2 < 2; ++s2) {
                bf16x8 t = *(const bf16x8*)((const bf16_t*)QS + (qi * 8 + g * 4 + (l15c & 3)) * 64 + s2 * 32 + quadc * 8);
                if (l15c >= 4) t = (bf16x8){0, 0, 0, 0, 0, 0, 0, 0};
                bq[s2] = t;
            }
            const bf16_t* kb = kvb + dg * 8;
            float sreg[4][4][4];
            u32x4 kcur[8];
#pragma unroll
            for (int u = 0; u < 8; ++u) kcur[u] = *(const u32x4*)(kb + (size_t)list[u * 8 + ks] * 256);
#pragma unroll
            for (int blk = 0; blk < 4; ++blk) {
                if (blk < nblk) {
#pragma unroll
                    for (int u = 0; u < 8; ++u) *(u32x4*)(KL + (u * 8 + ks) * 72 + dg * 8) = kcur[u];
                    if (blk + 1 < nblk) {
#pragma unroll
                        for (int u = 0; u < 8; ++u) kcur[u] = *(const u32x4*)(kb + (size_t)list[(blk + 1) * 64 + u * 8 + ks] * 256);
                    }
                    lds_order();
#pragma unroll
                    for (int kt = 0; kt < 4; ++kt) {
                        f32x4 acc = (f32x4){0.f, 0.f, 0.f, 0.f};
#pragma unroll
                        for (int s2 = 0; s2 < 2; ++s2) acc = __builtin_amdgcn_mfma_f32_16x16x32_bf16(*(const bf16x8*)(KL + (kt * 16 + l15c) * 72 + s2 * 32 + quadc * 8), bq[s2], acc, 0, 0, 0);
#pragma unroll
                        for (int j = 0; j < 4; ++j) sreg[blk][kt][j] = acc[j] * 0.125f;
                    }
                    lds_order();
                } else {
#pragma unroll
                    for (int kt = 0; kt < 4; ++kt)
#pragma unroll
                        for (int j = 0; j < 4; ++j) sreg[blk][kt][j] = -INFINITY;
                }
            }
            const bf16_t* vb = kvb + 128 + dg * 8;
            u32x4 vreg[8];
#pragma unroll
            for (int u = 0; u < 8; ++u) vreg[u] = *(const u32x4*)(vb + (size_t)list[u * 8 + ks] * 256);
            float mx = -INFINITY;
#pragma unroll
            for (int blk = 0; blk < 4; ++blk)
#pragma unroll
                for (int kt = 0; kt < 4; ++kt)
#pragma unroll
                    for (int j = 0; j < 4; ++j) mx = fmaxf(mx, sreg[blk][kt][j]);
            mx = fmaxf(mx, __shfl_xor(mx, 16)); mx = fmaxf(mx, __shfl_xor(mx, 32));
            float sum = 0.f;
#pragma unroll
            for (int blk = 0; blk < 4; ++blk)
#pragma unroll
                for (int kt = 0; kt < 4; ++kt)
#pragma unroll
                    for (int j = 0; j < 4; ++j) { const float e = __expf(sreg[blk][kt][j] - mx); sreg[blk][kt][j] = e; sum += e; }
            sum += __shfl_xor(sum, 16); sum += __shfl_xor(sum, 32);
            const float invs = 1.f / sum;
            f32x4 oacc[4];
#pragma unroll
            for (int dt = 0; dt < 4; ++dt) oacc[dt] = (f32x4){0.f, 0.f, 0.f, 0.f};
            bf16_t* VT = KL;
#pragma unroll
            for (int blk = 0; blk < 4; ++blk) {
                if (blk < nblk) {
#pragma unroll
                    for (int u = 0; u < 8; ++u) {
                        const int rho = ((u >> 2) << 5) + ((((2 * u) & 3) + (ks >> 2)) << 3) + (((u >> 1) & 1) << 2) + (ks & 3);
                        *(u32x4*)(VT + rho * 72 + dg * 8) = vreg[u];
                    }
                    if (blk + 1 < nblk) {
#pragma unroll
                        for (int u = 0; u < 8; ++u) vreg[u] = *(const u32x4*)(vb + (size_t)list[(blk + 1) * 64 + u * 8 + ks] * 256);
                    }
                    lds_order();
#pragma unroll
                    for (int s2 = 0; s2 < 2; ++s2) {
                        u32x4 pw;
                        pw[0] = cvt_pk_bf16(sreg[blk][2 * s2][0], sreg[blk][2 * s2][1]); pw[1] = cvt_pk_bf16(sreg[blk][2 * s2][2], sreg[blk][2 * s2][3]);
                        pw[2] = cvt_pk_bf16(sreg[blk][2 * s2 + 1][0], sreg[blk][2 * s2 + 1][1]); pw[3] = cvt_pk_bf16(sreg[blk][2 * s2 + 1][2], sreg[blk][2 * s2 + 1][3]);
                        const bf16x8 pf = __builtin_bit_cast(bf16x8, pw);
#pragma unroll
                        for (int dt = 0; dt < 4; ++dt) {
                            const LAS unsigned char* vp = (const LAS unsigned char*)VT + ((32 * s2 + 8 * quadc + (l15c >> 2)) * 72) * 2 + dt * 32 + (l15c & 3) * 8;
                            const v4i16_t t0 = __builtin_amdgcn_ds_read_tr16_b64_v4i16((LAS v4i16_t*)vp);
                            const v4i16_t t1 = __builtin_amdgcn_ds_read_tr16_b64_v4i16((LAS v4i16_t*)(vp + 4 * 72 * 2));
                            const bf16x8 af2 = (bf16x8){t0[0], t0[1], t0[2], t0[3], t1[0], t1[1], t1[2], t1[3]};
                            oacc[dt] = __builtin_amdgcn_mfma_f32_16x16x32_bf16(af2, pf, oacc[dt], 0, 0, 0);
                        }
                    }
                    lds_order();
                }
            }
            if (l15c < 4) {
                bf16_t* yo = (DUMMY || dummy_c) ? ((bf16_t*)(ws + WS_MG + 48 * MiB) + (r0 + qi) * 512 + (g * 4 + l15c) * 64 + quadc * 4) : (P + (r0 + qi) * LDP + C_AQ + (g * 4 + l15c) * 64 + quadc * 4);
#pragma unroll
                for (int dt = 0; dt < 4; ++dt) {
                    const f32x4 v = oacc[dt] * invs;
                    u32x2 w; w[0] = cvt_pk_bf16(v[0], v[1]); w[1] = cvt_pk_bf16(v[2], v[3]);
                    *(u32x2*)(yo + dt * 16) = w;
                }
            }
        }
        lds_fence(); __builtin_amdgcn_s_barrier();
    }
#undef DSA_LOAD_ITEM
}

__device__ __forceinline__ float logsigmoidf_(float x) { return fminf(x, 0.f) - log1pf(__expf(-fabsf(x))); }
#define DPP_F(x, ident, ctrl, rmask) __int_as_float(__builtin_amdgcn_update_dpp(__float_as_int(ident), __float_as_int(x), ctrl, rmask, 0xf, false))
__device__ __forceinline__ float wave_incl_sum(float v, int lane) {
    (void)lane;
    v += DPP_F(v, 0.f, 0x111, 0xf); v += DPP_F(v, 0.f, 0x112, 0xf); v += DPP_F(v, 0.f, 0x114, 0xf); v += DPP_F(v, 0.f, 0x118, 0xf);
    v += DPP_F(v, 0.f, 0x142, 0xa); v += DPP_F(v, 0.f, 0x143, 0xc);
    return v;
}
__device__ __forceinline__ float wave_incl_max(float v, int lane) {
    (void)lane;
    const float ninf = -INFINITY;
    v = fmaxf(v, DPP_F(v, ninf, 0x111, 0xf)); v = fmaxf(v, DPP_F(v, ninf, 0x112, 0xf)); v = fmaxf(v, DPP_F(v, ninf, 0x114, 0xf)); v = fmaxf(v, DPP_F(v, ninf, 0x118, 0xf));
    v = fmaxf(v, DPP_F(v, ninf, 0x142, 0xa)); v = fmaxf(v, DPP_F(v, ninf, 0x143, 0xc));
    return v;
}
__device__ __forceinline__ f32x4 mma_lds(const bf16_t* A, int lda, const bf16_t* Bt, int ldb, int K, int lane) {
    f32x4 acc = (f32x4){0.f, 0.f, 0.f, 0.f};
    const bf16_t* ap = A + (lane & 15) * lda + (lane >> 4) * 8; const bf16_t* bp = Bt + (lane & 15) * ldb + (lane >> 4) * 8;
    for (int k = 0; k < K; k += 32) acc = __builtin_amdgcn_mfma_f32_16x16x32_bf16(*(const bf16x8*)(ap + k), *(const bf16x8*)(bp + k), acc, 0, 0, 0);
    return acc;
}

__device__ __forceinline__ void phase_mlstm_a(const Args& a, unsigned char* lds) {
    unsigned char* ws = a.ws;
    const bf16_t* P = (const bf16_t*)(ws + WS_P); const bf16_t* QK = (const bf16_t*)(ws + WS_QK); const float* SM = (const float*)(ws + WS_SM);
    bf16_t* ST = (bf16_t*)(ws + WS_XB); float* DN = (float*)(ws + WS_DN); float* ML = (float*)(ws + WS_ML); float* BL = (float*)(ws + WS_BL);
    bf16_t* VT = (bf16_t*)lds;
    bf16_t* KT = (bf16_t*)(lds + 18432);
    float* WS_ = (float*)(lds + 18432 + 9216);
    const int tid = threadIdx.x, wave = tid >> 6, lane = tid & 63;
    for (int item = blockIdx.x; item < 4096; item += gridDim.x) {
        const int c = item & 127, h = (item >> 7) & 3, b = item >> 9;
        const size_t r0 = (size_t)b * SEQ + c * 64;
        if (wave == 0) {
            const float ig = SM[(r0 + lane) * 16 + 8 + h] + a.in[I_BI][h];
            const float lf = logsigmoidf_(SM[(r0 + lane) * 16 + 12 + h] + a.in[I_BF][h]);
            const float bs = wave_incl_sum(lf, lane);
            const float bl = __shfl(bs, 63);
            const float wk = bl - bs + ig;
            const float ml = wave_max(wk);
            WS_[lane] = __expf(wk - ml);
            if (lane == 0) { ML[item] = ml; BL[item] = bl; }
        }
        for (int i = tid; i < 1024; i += 512) { const int s = i >> 4, d0 = (i & 15) * 8; float f[8]; unpack8(*(const u32x4*)(P + (r0 + s) * LDP + C_MV + h * 128 + d0), f);
#pragma unroll
            for (int e = 0; e < 8; ++e) VT[(d0 + e) * 72 + s] = f2bf(f[e]); }
        __syncthreads();
        { const int s = tid >> 3, d0 = (tid & 7) * 8; float f[8]; unpack8(*(const u32x4*)(QK + (r0 + s) * 512 + 256 + h * 64 + d0), f); const float w = WS_[s];
#pragma unroll
            for (int e = 0; e < 8; ++e) KT[(d0 + e) * 72 + s] = f2bf(f[e] * w); }
        __syncthreads();
        bf16_t* st = ST + (size_t)item * 8192;
#pragma unroll
        for (int nt = 0; nt < 4; ++nt) {
            const f32x4 acc = mma_lds(VT + wave * 16 * 72, 72, KT + nt * 16 * 72, 72, 64, lane);
#pragma unroll
            for (int j = 0; j < 4; ++j) st[(wave * 16 + (lane >> 4) * 4 + j) * 64 + nt * 16 + (lane & 15)] = f2bf_sw(acc[j]);
        }
        if (tid < 64) { float s = 0.f; for (int k = 0; k < 64; ++k) s += bf1(KT[tid * 72 + k]); DN[item * 64 + tid] = s; }
        __syncthreads();
    }
}
__device__ __forceinline__ void phase_mlstm_b(const Args& a) {
    unsigned char* ws = a.ws;
    unsigned* ST2 = (unsigned*)(ws + WS_XB);
    float* DN = (float*)(ws + WS_DN); const float* ML = (const float*)(ws + WS_ML); const float* BL = (const float*)(ws + WS_BL); float* MS = (float*)(ws + WS_MS);
    const int total = 32 * 4160;
    for (int w = blockIdx.x * 512 + threadIdx.x; w < total; w += gridDim.x * 512) {
        const int bh = w / 4160, e = w % 4160;
        if (e < 4096) {
            unsigned* p = ST2 + (size_t)bh * 128 * 4096 + e;
            float C0 = 0.f, C1 = 0.f, m = 0.f;
            for (int c0 = 0; c0 < 128; c0 += 8) {
                unsigned d[8]; float bl[8], ml[8];
#pragma unroll
                for (int u = 0; u < 8; ++u) { d[u] = p[(size_t)(c0 + u) * 4096]; bl[u] = BL[bh * 128 + c0 + u]; ml[u] = ML[bh * 128 + c0 + u]; }
#pragma unroll
                for (int u = 0; u < 8; ++u) {
                    p[(size_t)(c0 + u) * 4096] = cvt_pk_bf16(C0, C1);
                    if (e == 0) MS[bh * 128 + c0 + u] = m;
                    const float mn = fmaxf(bl[u] + m, ml[u]);
                    const float wc = __expf(bl[u] + m - mn), wd = __expf(ml[u] - mn);
                    C0 = wc * C0 + wd * bflo(d[u]); C1 = wc * C1 + wd * bfhi(d[u]);
                    m = mn;
                }
            }
        } else {
            float* p = DN + (size_t)bh * 128 * 64 + (e - 4096);
            float C = 0.f, m = 0.f;
            for (int c0 = 0; c0 < 128; c0 += 8) {
                float d[8], bl[8], ml[8];
#pragma unroll
                for (int u = 0; u < 8; ++u) { d[u] = p[(size_t)(c0 + u) * 64]; bl[u] = BL[bh * 128 + c0 + u]; ml[u] = ML[bh * 128 + c0 + u]; }
#pragma unroll
                for (int u = 0; u < 8; ++u) {
                    p[(size_t)(c0 + u) * 64] = C;
                    const float mn = fmaxf(bl[u] + m, ml[u]);
                    C = __expf(bl[u] + m - mn) * C + __expf(ml[u] - mn) * d[u];
                    m = mn;
                }
            }
        }
    }
}
__device__ __forceinline__ void phase_mlstm_c(const Args& a, unsigned char* lds) {
    unsigned char* ws = a.ws;
    bf16_t* P = (bf16_t*)(ws + WS_P); const bf16_t* QK = (const bf16_t*)(ws + WS_QK); const float* SM = (const float*)(ws + WS_SM);
    const bf16_t* ST = (const bf16_t*)(ws + WS_XB); const float* DN = (const float*)(ws + WS_DN); const float* MS = (const float*)(ws + WS_MS);
    bf16_t* QS_ = (bf16_t*)lds;
    bf16_t* KS = (bf16_t*)(lds + 9216);
    bf16_t* AP = (bf16_t*)(lds + 18432);
    bf16_t* BT = (bf16_t*)(lds + 18432 + 17408);
    float* OUT = (float*)(lds + 18432 + 17408 + 34816);
    float* GS = (float*)(lds + 18432 + 17408 + 34816 + 33792);
    float* bS = GS; float* aS = GS + 64; float* mtS = GS + 128; float* wiS = GS + 192; float* nS = GS + 256; float* denS = GS + 320;
    const int tid = threadIdx.x, wave = tid >> 6, lane = tid & 63;
    for (int item = blockIdx.x; item < 4096; item += gridDim.x) {
        const int c = item & 127, h = (item >> 7) & 3, b = item >> 9;
        const size_t r0 = (size_t)b * SEQ + c * 64;
        if (wave == 0) {
            const float ig = SM[(r0 + lane) * 16 + 8 + h] + a.in[I_BI][h];
            const float lf = logsigmoidf_(SM[(r0 + lane) * 16 + 12 + h] + a.in[I_BF][h]);
            const float bs = wave_incl_sum(lf, lane);
            const float av = ig - bs;
            const float pm = wave_incl_max(av, lane);
            const float m0 = MS[item];
            const float mt = bs + fmaxf(pm, m0);
            bS[lane] = bs; aS[lane] = av; mtS[lane] = mt; wiS[lane] = __expf(bs + m0 - mt);
            nS[lane] = DN[item * 64 + lane];
        }
        { const int s = tid >> 3, d0 = (tid & 7) * 8;
            *(u32x4*)(QS_ + s * 72 + d0) = *(const u32x4*)(QK + (r0 + s) * 512 + h * 64 + d0);
            *(u32x4*)(KS + s * 72 + d0) = *(const u32x4*)(QK + (r0 + s) * 512 + 256 + h * 64 + d0); }
        for (int i = tid; i < 1024; i += 512) { const int s = i >> 4, d0 = (i & 15) * 8; float f[8]; unpack8(*(const u32x4*)(P + (r0 + s) * LDP + C_MV + h * 128 + d0), f);
#pragma unroll
            for (int e = 0; e < 8; ++e) BT[(d0 + e) * 136 + s] = f2bf(f[e]); }
        { const bf16_t* st = ST + (size_t)item * 8192;
            for (int i = tid; i < 1024; i += 512) { const int dv = i >> 3, k0 = (i & 7) * 8; *(u32x4*)(BT + dv * 136 + 64 + k0) = *(const u32x4*)(st + dv * 64 + k0); } }
        __syncthreads();
#pragma unroll
        for (int u = 0; u < 2; ++u) {
            const int id = wave * 2 + u, tr = id >> 2, tc = id & 3;
            f32x4 acc = (f32x4){0.f, 0.f, 0.f, 0.f};
            if (tc <= tr) acc = mma_lds(QS_ + tr * 16 * 72, 72, KS + tc * 16 * 72, 72, 64, lane);
            const int s = tc * 16 + (lane & 15);
#pragma unroll
            for (int j = 0; j < 4; ++j) { const int t = tr * 16 + (lane >> 4) * 4 + j;
                const float w = (s <= t) ? acc[j] * __expf(bS[t] + aS[s] - mtS[t]) : 0.f;
                AP[t * 136 + s] = f2bf(w); }
        }
        { const int t = tid >> 3, d0 = (tid & 7) * 8; float f[8]; unpack8(*(const u32x4*)(QS_ + t * 72 + d0), f); const float w = wiS[t];
#pragma unroll
            for (int e = 0; e < 8; ++e) f[e] *= w;
            *(u32x4*)(AP + t * 136 + 64 + d0) = pack8(f); }
        __syncthreads();
#pragma unroll
        for (int tr = 0; tr < 4; ++tr) {
            const f32x4 acc = mma_lds(AP + tr * 16 * 136, 136, BT + wave * 16 * 136, 136, 128, lane);
#pragma unroll
            for (int j = 0; j < 4; ++j) OUT[(tr * 16 + (lane >> 4) * 4 + j) * 132 + wave * 16 + (lane & 15)] = acc[j];
        }
        { const int t = tid >> 3, part = tid & 7; float s = 0.f;
#pragma unroll
            for (int e = 0; e < 16; ++e) { const int k = part * 16 + e; const float v = bf1(AP[t * 136 + k]); s += (k < 64) ? v : v * nS[k - 64]; }
            s += __shfl_xor(s, 1); s += __shfl_xor(s, 2); s += __shfl_xor(s, 4);
            if (part == 0) denS[t] = s; }
        __syncthreads();
        { const int t = tid >> 3, part = tid & 7, dv0 = part * 16;
            const float den = fmaxf(fabsf(denS[t]), __expf(-mtS[t])); const float inv = 1.f / den;
            float hv[16]; float sq = 0.f;
#pragma unroll
            for (int e = 0; e < 16; ++e) { hv[e] = OUT[t * 132 + dv0 + e] * inv; sq += hv[e] * hv[e]; }
            sq += __shfl_xor(sq, 1); sq += __shfl_xor(sq, 2); sq += __shfl_xor(sq, 4);
            const float rs = rsqrtf(sq * (1.f / 128.f) + EPS);
            bf16_t* po = P + (r0 + t) * LDP + C_MO + h * 128 + dv0;
            float og[16]; unpack8(*(const u32x4*)po, og); unpack8(*(const u32x4*)(po + 8), og + 8);
#pragma unroll
            for (int e = 0; e < 16; ++e) hv[e] = hv[e] * rs * a.in[I_MHN][h * 128 + dv0 + e] * sigmoidf_(og[e]);
            *(u32x4*)po = pack8(hv); *(u32x4*)(po + 8) = pack8(hv + 8); }
        __syncthreads();
    }
}


#define XB_TMO      128
#define XB_XCNT(j)  (256  + 64 * (j))
#define XB_XSUB(j)  (1280 + 64 * (j))
#define XB_XGEN(j)  (2304 + 64 * (j))
#define XB_TOP      3328
#define XB_TOPGEN   3392
#define XCD_BAR_WORDS 3456
#define XB_SPIN_CAP (1u << 22)
__device__ __forceinline__ unsigned xb_ld(unsigned* p)              { return __hip_atomic_load(p, __ATOMIC_RELAXED, __HIP_MEMORY_SCOPE_AGENT); }
__device__ __forceinline__ unsigned xb_add(unsigned* p, unsigned v) { return __hip_atomic_fetch_add(p, v, __ATOMIC_RELAXED, __HIP_MEMORY_SCOPE_AGENT); }
__device__ __forceinline__ unsigned xb_xcc_id() { return (unsigned)__builtin_amdgcn_s_getreg((3 << 11) | 20) & 0xFu; }
#define XB_SPIN(cond, bar) do { unsigned _sp = 0; while (cond) { __builtin_amdgcn_s_sleep(1); \
    if ((++_sp & 255u) == 0u) { if (xb_ld(&(bar)[XB_TMO])) break; if (_sp > XB_SPIN_CAP) { atomicAdd(&(bar)[XB_TMO], 1u); break; } } } } while (0)
struct XcdBarrier { unsigned* bar; unsigned x; volatile LAS unsigned* st; };
__device__ __forceinline__ XcdBarrier xcd_barrier_post(unsigned* bar, volatile LAS unsigned* st) {
    XcdBarrier b; b.bar = bar; b.x = xb_xcc_id(); b.st = st;
    if (threadIdx.x == 0) (void)xb_add(&bar[XB_XCNT(b.x)], 1u);
    return b;
}
__device__ __forceinline__ void xcd_barrier_complete(unsigned* bar, unsigned x, unsigned& nloc, unsigned& nx) {
    const unsigned G = gridDim.x * gridDim.y * gridDim.z;
    unsigned sum, cnt, mine, sp = 0u;
    for (;;) {
        sum = 0u; cnt = 0u; mine = 0u;
#pragma unroll
        for (unsigned j = 0; j < 16; ++j) { const unsigned c = xb_ld(&bar[XB_XCNT(j)]); sum += c; cnt += (c > 0u) ? 1u : 0u; mine = (j == x) ? c : mine; }
        if (sum == G) break;
        __builtin_amdgcn_s_sleep(1);
        if ((++sp & 255u) == 0u) { if (xb_ld(&bar[XB_TMO])) break; if (sp > XB_SPIN_CAP) { atomicAdd(&bar[XB_TMO], 1u); break; } }
    }
    nloc = mine > 0u ? mine : 1u; nx = cnt > 0u ? cnt : 1u;
}
__device__ __forceinline__ void xcd_barrier(const XcdBarrier& b) {
    asm volatile("s_waitcnt vmcnt(0)" ::: "memory");
    __syncthreads();
    if (threadIdx.x == 0) {
        unsigned* bar = b.bar;
        __builtin_amdgcn_s_waitcnt(0);
        unsigned nloc = b.st[0], nx = b.st[1];
        if (nloc == 0u) { xcd_barrier_complete(bar, b.x, nloc, nx); b.st[0] = nloc; b.st[1] = nx; }
        const unsigned old = xb_add(&bar[XB_XSUB(b.x)], 1u);
        const unsigned gen = old / nloc;
        if (old + 1u == (gen + 1u) * nloc) {
            __builtin_amdgcn_fence(__ATOMIC_RELEASE, "agent");
            asm volatile("s_waitcnt vmcnt(0)" ::: "memory");
            const unsigned og = xb_add(&bar[XB_TOP], 1u);
            const unsigned tg = og / nx;
            if (og + 1u == (tg + 1u) * nx) xb_add(&bar[XB_TOPGEN], 1u);
            else XB_SPIN(xb_ld(&bar[XB_TOPGEN]) == tg, bar);
            __builtin_amdgcn_fence(__ATOMIC_ACQUIRE, "agent");
            xb_add(&bar[XB_XGEN(b.x)], 1u);
            asm volatile("s_waitcnt vmcnt(0)" ::: "memory");
        } else {
            XB_SPIN(xb_ld(&bar[XB_XGEN(b.x)]) == gen, bar);
            __builtin_amdgcn_fence(__ATOMIC_ACQUIRE, "agent");
            asm volatile("s_waitcnt vmcnt(0)" ::: "memory");
        }
    }
    __syncthreads();
}

#ifndef DBG_ZERO_YA
#define DBG_ZERO_YA 1
#endif
#ifndef PH
#define PH 0xFFFF
#endif
__global__ void __launch_bounds__(512, 2) mega_fwd(Args a) {
    extern __shared__ __attribute__((aligned(16))) unsigned char lds[];
    cg::grid_group grid = cg::this_grid();
    LAS unsigned char* ldsl = (LAS unsigned char*)lds;
    unsigned char* ws = a.ws;
    const int G = gridDim.x, bid = blockIdx.x;
    bf16_t* XB = (bf16_t*)(ws + WS_XB); bf16_t* Pb = (bf16_t*)(ws + WS_P); bf16_t* MG = (bf16_t*)(ws + WS_MG); bf16_t* QKb = (bf16_t*)(ws + WS_QK);
    float* ss0 = (float*)(ws + WS_SS0); float* ss1 = (float*)(ws + WS_SS1); float* ss2 = (float*)(ws + WS_SS2);

    unsigned* barw = (unsigned*)(ws + WS_BAR);
    if (bid == 0) { for (int i = threadIdx.x; i < XCD_BAR_WORDS; i += 512) barw[i] = 0u; }
    volatile LAS unsigned* bst = (volatile LAS unsigned*)(ldsl + LDS_BYTES - 16);
    if (threadIdx.x == 0) { bst[0] = 0u; bst[1] = 0u; }
    if (PH & 1) phase0(a, lds);
    __threadfence();
    grid.sync();
    const XcdBarrier xbar = xcd_barrier_post(barw, bst);
    if (PH & 2) {
        pg8::Gemm g{XB, (const bf16_t*)(ws + WS_W1), DM, DM, MROWS, 2 * FF, DM}; pg8::StaticOrder S; S.init(MROWS, 2 * FF, G, bid);
        pg8::EpiSwiGLU E{Pb, ss0}; pg8::gemm_phase(ldsl, g, S, E);
    }
    xcd_barrier(xbar);
    if (PH & 4) {
        pg8::Gemm g{Pb, (const bf16_t*)(ws + WS_W2), FF, FF, MROWS, DM, FF}; pg8::StaticOrder S; S.init(MROWS, DM, G, bid);
        pg8::EpiRes<false, false, true> E{a.in[I_X], nullptr, nullptr, XB, (bf16_t*)a.out, ss1, 0.5f}; pg8::gemm_phase(ldsl, g, S, E);
    }
    xcd_barrier(xbar);
    if (PH & 8) {
        pg8::Gemm g{XB, (const bf16_t*)(ws + WS_WIN), DM, DM, MROWS, LDP, DM}; pg8::StaticOrder S; S.init(MROWS, LDP, G, bid);
        pg8::EpiP E{Pb, (float*)(ws + WS_SM), ss1}; pg8::gemm_phase(ldsl, g, S, E);
    }
    xcd_barrier(xbar);
    if (PH & 16) phase_postp(a);
    xcd_barrier(xbar);
    if (PH & 32) {
        pg8::Gemm g{XB, (const bf16_t*)(ws + WS_WQK), 512, 512, MROWS, 512, 512}; pg8::StaticOrder S; S.init(MROWS, 512, G, bid);
        pg8::EpiBf16 E{QKb, 512}; pg8::gemm_phase(ldsl, g, S, E);
    }
    xcd_barrier(xbar);
    if (PH & 64) phase_mlstm_a(a, lds);
    xcd_barrier(xbar);
    if (PH & 128) phase_mlstm_b(a);
    xcd_barrier(xbar);
    if (PH & 256) phase_mlstm_c(a, lds);
    if (DBG_TWICE & 1) phase_dsa<true>(a, lds);
    if (PH & 512) phase_dsa<false>(a, lds);
    xcd_barrier(xbar);
    if (PH & 1024) {
        pg8::StaticOrder S; S.init(MROWS, DM, G, bid);
        { pg8::Gemm g{Pb + C_AQ, (const bf16_t*)(ws + WS_WA), LDP, 512, MROWS, DM, 512}; pg8::EpiMerge<0> E{Pb, MG, C_GA}; pg8::gemm_phase(ldsl, g, S, E); }
        { pg8::Gemm g{Pb + C_MO, (const bf16_t*)(ws + WS_WB), LDP, 512, MROWS, DM, 512}; pg8::EpiMerge<1> E{Pb, MG, C_GB}; pg8::gemm_phase(ldsl, g, S, E); }
    }
    xcd_barrier(xbar);
    if (PH & 2048) {
        pg8::Gemm g{MG, (const bf16_t*)(ws + WS_WO), DM, DM, MROWS, DM, DM}; pg8::StaticOrder S; S.init(MROWS, DM, G, bid);
        pg8::EpiRes<true, false, true> E{nullptr, (const bf16_t*)a.out, nullptr, XB, nullptr, ss2, 1.0f}; pg8::gemm_phase(ldsl, g, S, E);
    }
    xcd_barrier(xbar);
    if (PH & 4096) {
        pg8::Gemm g{XB, (const bf16_t*)(ws + WS_W3), DM, DM, MROWS, 2 * FF, DM}; pg8::StaticOrder S; S.init(MROWS, 2 * FF, G, bid);
        pg8::EpiSwiGLU E{Pb, ss2}; pg8::gemm_phase(ldsl, g, S, E);
    }
    xcd_barrier(xbar);
    if (PH & 8192) {
        pg8::Gemm g{Pb, (const bf16_t*)(ws + WS_W4), FF, FF, MROWS, DM, FF}; pg8::StaticOrder S; S.init(MROWS, DM, G, bid);
        pg8::EpiRes<true, true, false> E{nullptr, XB, a.out, nullptr, nullptr, nullptr, 0.5f}; pg8::gemm_phase(ldsl, g, S, E);
    }
}

extern "C" void kernel_launch(void* const* d_in, const int* in_sizes, int n_in, void* d_out, int out_size, void* d_ws, size_t ws_size, hipStream_t stream) {
    static int grid = 0;
    if (grid == 0) {
        if (n_in != 24 || ws_size < WS_END) { fprintf(stderr, "kernel_launch: unexpected n_in %d / ws %zu\n", n_in, ws_size); grid = -1; return; }
        int dev = 0, cus = 0, per_cu = 0;
        hipGetDevice(&dev);
        hipDeviceGetAttribute(&cus, hipDeviceAttributeMultiprocessorCount, dev);
        hipFuncSetAttribute((const void*)mega_fwd, hipFuncAttributeMaxDynamicSharedMemorySize, LDS_BYTES);
        hipOccupancyMaxActiveBlocksPerMultiprocessor(&per_cu, (const void*)mega_fwd, 512, LDS_BYTES);
        if (per_cu < 1) { fprintf(stderr, "kernel_launch: occupancy query says %d blocks/CU\n", per_cu); per_cu = 1; }
        (void)hipGetLastError();
        grid = cus * per_cu;
    }
    if (grid < 0) return;
    Args a{};
    for (int i = 0; i < 24; ++i) a.in[i] = (const float*)d_in[i];
    a.out = (float*)d_out; a.ws = (unsigned char*)d_ws;
    void* args[] = {&a};
    hipError_t e = hipLaunchCooperativeKernel((const void*)mega_fwd, dim3(grid), dim3(512), args, LDS_BYTES, stream);
    if (e != hipSuccess) fprintf(stderr, "cooperative launch failed: %s (grid %d)\n", hipGetErrorString(e), grid);
}
```

```cpp
#include <hip/hip_runtime.h>
#include <hip/hip_cooperative_groups.h>
#include <cstdio>
#include <cstdint>
namespace cg = cooperative_groups;
#define DBG_ZERO_YA 0
#define DBG_TWICE 0
#define DBG_NOSEL 0

#define LAS __attribute__((address_space(3)))
typedef unsigned short bf16_t;
typedef short bf16x8 __attribute__((ext_vector_type(8)));
typedef float f32x4 __attribute__((ext_vector_type(4)));
typedef unsigned u32x4 __attribute__((ext_vector_type(4)));
typedef unsigned u32x2 __attribute__((ext_vector_type(2)));
typedef __bf16 bf2_t __attribute__((ext_vector_type(2)));
typedef short v4i16_t __attribute__((ext_vector_type(4)));

constexpr int MROWS = 65536, DM = 1024, FF = 2816, SEQ = 8192, NB = 8;
constexpr int LDP = 5120;
constexpr int C_AQ = 0, C_AK = 512, C_AV = 640, C_IQ = 768, C_IK = 1280, C_MX = 1344, C_MV = 1856, C_MO = 2368, C_GA = 2880, C_GB = 3904, C_SM = 4928;
constexpr float EPS = 1e-6f;
constexpr size_t MiB = 1u << 20;
constexpr size_t WS_SS0 = 0, WS_SS1 = 256 * 1024, WS_SS2 = 512 * 1024;
constexpr size_t WS_DN = 1 * MiB;
constexpr size_t WS_ML = 2 * MiB, WS_BL = 2 * MiB + 16384, WS_MS = 2 * MiB + 32768;
constexpr size_t WS_BAR = 2 * MiB + 65536;
constexpr size_t WS_SM = 3 * MiB;
constexpr size_t WS_W1 = 8 * MiB, WS_W2 = 19 * MiB, WS_W3 = 25 * MiB, WS_W4 = 36 * MiB, WS_WIN = 42 * MiB, WS_WA = 52 * MiB, WS_WB = 53 * MiB, WS_WO = 54 * MiB, WS_WQK = 56 * MiB;
constexpr size_t WS_XB = 64 * MiB;
constexpr size_t WS_P = 192 * MiB;
constexpr size_t WS_MG = 832 * MiB;
constexpr size_t WS_IKC = 832 * MiB;
constexpr size_t WS_KVC = 840 * MiB;
constexpr size_t WS_QK = 960 * MiB;
constexpr size_t WS_END = 1024 * MiB;
constexpr int LDS_BYTES = 156 * 1024;

__device__ __forceinline__ unsigned cvt_pk_bf16(float lo, float hi) { unsigned r; asm volatile("v_cvt_pk_bf16_f32 %0, %1, %2" : "=v"(r) : "v"(lo), "v"(hi)); return r; }
__device__ __forceinline__ float bflo(unsigned u) { return __uint_as_float(u << 16); }
__device__ __forceinline__ float bfhi(unsigned u) { return __uint_as_float(u & 0xffff0000u); }
__device__ __forceinline__ float bf1(bf16_t u) { return __uint_as_float(((unsigned)u) << 16); }
__device__ __forceinline__ bf16_t f2bf(float f) { return (bf16_t)(cvt_pk_bf16(f, 0.f) & 0xffffu); }
__device__ __forceinline__ bf16_t f2bf_sw(float f) { const unsigned u = __float_as_uint(f); return (bf16_t)((u + 0x7fffu + ((u >> 16) & 1u)) >> 16); }
__device__ __forceinline__ float wave_sum(float v) {
#pragma unroll
    for (int o = 1; o < 64; o <<= 1) v += __shfl_xor(v, o);
    return v;
}
__device__ __forceinline__ float wave_max(float v) {
#pragma unroll
    for (int o = 1; o < 64; o <<= 1) v = fmaxf(v, __shfl_xor(v, o));
    return v;
}
__device__ __forceinline__ float sigmoidf_(float x) { return __builtin_amdgcn_rcpf(1.f + __expf(-x)); }
__device__ __forceinline__ float dot2bf(unsigned a, unsigned b, float c) { const unsigned aa = a, bb = b; return __builtin_amdgcn_fdot2_f32_bf16(__builtin_bit_cast(bf2_t, aa), __builtin_bit_cast(bf2_t, bb), c, false); }
__device__ __forceinline__ float relu_(float x) { const int i = __float_as_int(x); return __int_as_float(i > 0 ? i : 0); }
__device__ __forceinline__ void lds_order() { asm volatile("" ::: "memory"); }
__device__ __forceinline__ void lds_fence() { asm volatile("s_waitcnt lgkmcnt(0)" ::: "memory"); }
__device__ __forceinline__ void unpack8(u32x4 v, float* f) {
    f[0] = bflo(v.x); f[1] = bfhi(v.x); f[2] = bflo(v.y); f[3] = bfhi(v.y); f[4] = bflo(v.z); f[5] = bfhi(v.z); f[6] = bflo(v.w); f[7] = bfhi(v.w);
}
__device__ __forceinline__ u32x4 pack8(const float* f) {
    u32x4 o; o.x = cvt_pk_bf16(f[0], f[1]); o.y = cvt_pk_bf16(f[2], f[3]); o.z = cvt_pk_bf16(f[4], f[5]); o.w = cvt_pk_bf16(f[6], f[7]); return o;
}

namespace pg8 {
constexpr int BM = 256, BK = 64, HALF = 128, HTB = HALF * BK * 2, NXCD = 8, WGM = 8;
__host__ __device__ __forceinline__ int lds_byte(int r, int c) { const int st = (r >> 4) * 2 + (c >> 5), rr = r & 15, cc = c & 31, ob = rr * 64 + cc * 2; return st * 1024 + (ob ^ (((ob >> 9) & 1) << 5)); }
__host__ __device__ __forceinline__ void stage_rc(int b, int& R, int& C) { const int st = b / 1024, sb = b % 1024, swz = sb ^ (((sb >> 9) & 1) << 5); R = (st >> 1) * 16 + swz / 64; C = (st & 1) * 32 + (swz % 64) / 2; }
__host__ __device__ __forceinline__ int perm32(int rho) { const int n = rho >> 4, i = rho & 15; return 8 * (i >> 2) + 4 * n + (i & 3); }
struct Unit { int pm, pn; };
struct Gemm { const bf16_t* A; const bf16_t* Bt; int lda, ldb, M, N, K; };
struct StaticOrder {
    int nM, nN, nwg, G, c;
    __device__ void init(int M, int N, int G_, int c_) { nM = M / BM; nN = N / BM; nwg = nM * nN; G = G_; c = c_; }
    __device__ bool next(int i, Unit& u) const {
        const long L = (long)i * G + c; if (L >= nwg) return false;
        int wgid = (int)L; { const int q = nwg / NXCD, r = nwg % NXCD, xcd = wgid % NXCD, off = wgid / NXCD; wgid = (xcd < r ? xcd * (q + 1) : r * (q + 1) + (xcd - r) * q) + off; }
        const int nig = WGM * nN, gid = wgid / nig, fm = gid * WGM, gsz = (nM - fm) < WGM ? (nM - fm) : WGM;
        u.pm = fm + ((wgid % nig) % gsz); u.pn = (wgid % nig) / gsz; return true;
    }
};

template <class Epi>
__device__ __forceinline__ void gemm_phase(LAS unsigned char* lds, const Gemm g, const StaticOrder& S, const Epi& E) {
    int tid_ = threadIdx.x; asm volatile("" : "+v"(tid_));
    const int tid = tid_, wid = __builtin_amdgcn_readfirstlane(tid >> 6), lane = tid & 63, wr = wid >> 2, wc = wid & 3, fr = lane & 15, fq = lane >> 4;
    const int K = g.K, nt = K / BK;
    unsigned voffA[2], voffB[2];
#pragma unroll
    for (int i = 0; i < 2; ++i) { int R, C; stage_rc(tid * 16 + i * 8192, R, C); const int Rb = (R & ~31) + perm32(R & 31);
        voffA[i] = (unsigned)(R * g.lda + C) * 2u; voffB[i] = (unsigned)(Rb * g.ldb + C) * 2u; }
    const size_t kstep = (size_t)(BK * 2);
    const size_t hsA = (size_t)HALF * g.lda * 2, hsB = (size_t)HALF * g.ldb * 2;
    const size_t tsA = 2 * hsA, tsB = 2 * hsB;
    const unsigned ldsw = (unsigned)wid * 1024u;
    const int aoff = lds_byte(wr * 64 + fr, fq * 8), boff = lds_byte(wc * 32 + fr, fq * 8);
#define PG8_SA(b, h) (((b) * 2 + (h)) * HTB)
#define PG8_SB(b, h) ((4 + (b) * 2 + (h)) * HTB)
#define PG8_STAGE(bufoff, gbase, voff) do { _Pragma("unroll") for (int _i = 0; _i < 2; ++_i) \
        __builtin_amdgcn_global_load_lds((const unsigned*)((const char*)(gbase) + (voff)[_i]), (LAS unsigned*)(lds + (bufoff) + ldsw + _i * 8192), 16, 0, 0); } while (0)
#define PG8_LDA(dst, b, h) do { _Pragma("unroll") for (int m = 0; m < 4; ++m) _Pragma("unroll") for (int k = 0; k < 2; ++k) dst[m][k] = *(const LAS bf16x8*)(lds + PG8_SA(b, h) + aoff + m * 2048 + k * 1024); } while (0)
#define PG8_LDB(dst, b, h) do { _Pragma("unroll") for (int n = 0; n < 2; ++n) _Pragma("unroll") for (int k = 0; k < 2; ++k) dst[n][k] = *(const LAS bf16x8*)(lds + PG8_SB(b, h) + boff + n * 2048 + k * 1024); } while (0)
#define PG8_MMA(ai, bj, At, Bt) do { __builtin_amdgcn_s_setprio(1); _Pragma("unroll") for (int m = 0; m < 4; ++m) _Pragma("unroll") for (int n = 0; n < 2; ++n) _Pragma("unroll") for (int k = 0; k < 2; ++k) \
        acc[ai][bj][m][n] = __builtin_amdgcn_mfma_f32_16x16x32_bf16(Bt[n][k], At[m][k], acc[ai][bj][m][n], 0, 0, 0); __builtin_amdgcn_s_setprio(0); } while (0)
#define PG8_WAIT_V(n) asm volatile("s_waitcnt vmcnt(" #n ")" ::: "memory")
#define PG8_WAIT_L(n) asm volatile("s_waitcnt lgkmcnt(" #n ")" ::: "memory")
#define PG8_BAR __builtin_amdgcn_s_barrier()
#define PG8_SCHED __builtin_amdgcn_sched_barrier(0)
    Unit cur, nxt; int ui = 0;
    if (!S.next(0, cur)) return;
    f32x4 acc[2][2][4][2];
#pragma unroll
    for (int a = 0; a < 2; ++a)
#pragma unroll
        for (int b = 0; b < 2; ++b)
#pragma unroll
            for (int m = 0; m < 4; ++m)
#pragma unroll
                for (int n = 0; n < 2; ++n) acc[a][b][m][n] = (f32x4){0.f, 0.f, 0.f, 0.f};
    bf16x8 At[4][2], B0[2][2], B1[2][2];
    const char* cA = (const char*)g.A + (size_t)cur.pm * tsA; const char* cB = (const char*)g.Bt + (size_t)cur.pn * tsB;
    PG8_STAGE(PG8_SB(0, 0), cB, voffB); PG8_STAGE(PG8_SB(0, 1), cB + hsB, voffB); PG8_STAGE(PG8_SA(0, 0), cA, voffA); PG8_STAGE(PG8_SA(0, 1), cA + hsA, voffA);
    if (wr == 1) PG8_BAR;
    PG8_WAIT_V(2); PG8_BAR;
    PG8_STAGE(PG8_SB(1, 0), cB + kstep, voffB); PG8_STAGE(PG8_SA(1, 0), cA + kstep, voffA); PG8_STAGE(PG8_SB(1, 1), cB + hsB + kstep, voffB);
    PG8_WAIT_V(6); PG8_BAR;
    for (;;) {
        const bool has_next = S.next(ui + 1, nxt);
        const char* nA = has_next ? (const char*)g.A + (size_t)nxt.pm * tsA : cA; const char* nB = has_next ? (const char*)g.Bt + (size_t)nxt.pn * tsB : cB;
        for (int t = 0; t < nt; t += 2) {
            const bool last = (t == nt - 2);
            const char* a1 = cA + (size_t)(t + 1) * kstep;
            const char* a2 = last ? nA : cA + (size_t)(t + 2) * kstep; const char* b2 = last ? nB : cB + (size_t)(t + 2) * kstep;
            const char* a3 = a2 + kstep; const char* b3 = b2 + kstep;
            PG8_LDB(B0, 0, 0); PG8_LDB(B1, 0, 1); PG8_SCHED; PG8_LDA(At, 0, 0); PG8_STAGE(PG8_SA(1, 1), a1 + hsA, voffA);
            PG8_WAIT_V(8); PG8_WAIT_L(0); PG8_BAR; PG8_MMA(0, 0, At, B0); PG8_MMA(0, 1, At, B1); PG8_BAR; PG8_SCHED;
            PG8_LDA(At, 0, 1); PG8_STAGE(PG8_SB(0, 0), b2, voffB); PG8_STAGE(PG8_SB(0, 1), b2 + hsB, voffB); PG8_STAGE(PG8_SA(0, 0), a2, voffA);
            PG8_WAIT_V(8); PG8_WAIT_L(0); PG8_BAR; PG8_MMA(1, 0, At, B0); PG8_MMA(1, 1, At, B1); PG8_BAR; PG8_SCHED;
            PG8_LDB(B0, 1, 0); PG8_LDB(B1, 1, 1); PG8_SCHED; PG8_LDA(At, 1, 0); PG8_STAGE(PG8_SA(0, 1), a2 + hsA, voffA);
            PG8_WAIT_V(8); PG8_WAIT_L(0); PG8_BAR; PG8_MMA(0, 0, At, B0); PG8_MMA(0, 1, At, B1); PG8_BAR; PG8_SCHED;
            PG8_LDA(At, 1, 1); PG8_STAGE(PG8_SB(1, 0), b3, voffB); PG8_STAGE(PG8_SB(1, 1), b3 + hsB, voffB); PG8_STAGE(PG8_SA(1, 0), a3, voffA);
            PG8_WAIT_V(8); PG8_WAIT_L(0); PG8_BAR; PG8_MMA(1, 0, At, B0); PG8_MMA(1, 1, At, B1); PG8_BAR; PG8_SCHED;
        }
        if (wr == 0) PG8_BAR;
        E(acc, cur, wr, wc, fr, fq);
        if (!has_next) break;
#pragma unroll
        for (int a = 0; a < 2; ++a)
#pragma unroll
            for (int b = 0; b < 2; ++b)
#pragma unroll
                for (int m = 0; m < 4; ++m)
#pragma unroll
                    for (int n = 0; n < 2; ++n) acc[a][b][m][n] = (f32x4){0.f, 0.f, 0.f, 0.f};
        cur = nxt; cA = nA; cB = nB; ++ui;
        if (wr == 1) PG8_BAR;
    }
    PG8_WAIT_V(0);
    PG8_BAR;
#undef PG8_SA
#undef PG8_SB
#undef PG8_STAGE
#undef PG8_LDA
#undef PG8_LDB
#undef PG8_MMA
#undef PG8_WAIT_V
#undef PG8_WAIT_L
#undef PG8_BAR
#undef PG8_SCHED
}

typedef f32x4 AccT[2][2][4][2];
struct EpiSwiGLU {
    bf16_t* O; const float* ss;
    __device__ __forceinline__ void operator()(const AccT& acc, const Unit& u, int wr, int wc, int fr, int fq) const {
        const int row0 = u.pm * BM + wr * 64 + fr, col = u.pn * 128 + wc * 32 + 8 * fq;
#pragma unroll
        for (int ai = 0; ai < 2; ++ai)
#pragma unroll
            for (int m = 0; m < 4; ++m) {
                const int row = row0 + ai * HALF + m * 16;
                const float rs = rsqrtf(ss[row] * (1.f / 1024.f) + EPS);
                float o[8];
#pragma unroll
                for (int n = 0; n < 2; ++n)
#pragma unroll
                    for (int j = 0; j < 4; ++j) { const float gt = acc[ai][0][m][n][j] * rs, up = acc[ai][1][m][n][j] * rs; o[n * 4 + j] = gt * up * sigmoidf_(gt); }
                *(u32x4*)(O + (size_t)row * FF + col) = pack8(o);
            }
    }
};
template <bool RES_BF16, bool WRITE_F32, bool WRITE_XB> struct EpiRes {
    const float* res; const bf16_t* resb; float* out; bf16_t* xb; bf16_t* xb2; float* ss; float alpha;
    __device__ __forceinline__ void operator()(const AccT& acc, const Unit& u, int wr, int wc, int fr, int fq) const {
        const int row0 = u.pm * BM + wr * 64 + fr, col0 = u.pn * BM + wc * 32 + 8 * fq;
#pragma unroll
        for (int ai = 0; ai < 2; ++ai)
#pragma unroll
            for (int m = 0; m < 4; ++m) {
                const int row = row0 + ai * HALF + m * 16; float sq = 0.f;
#pragma unroll
                for (int bj = 0; bj < 2; ++bj) {
                    const size_t off = (size_t)row * DM + col0 + bj * HALF;
                    f32x4 r0, r1;
                    if (RES_BF16) { float f[8]; unpack8(*(const u32x4*)(resb + off), f); r0 = (f32x4){f[0], f[1], f[2], f[3]}; r1 = (f32x4){f[4], f[5], f[6], f[7]}; }
                    else { r0 = *(const f32x4*)(res + off); r1 = *(const f32x4*)(res + off + 4); }
                    const f32x4 v0 = r0 + acc[ai][bj][m][0] * alpha, v1 = r1 + acc[ai][bj][m][1] * alpha;
                    if (WRITE_F32) { *(f32x4*)(out + off) = v0; *(f32x4*)(out + off + 4) = v1; }
                    if (WRITE_XB) {
                        u32x4 w; w.x = cvt_pk_bf16(v0[0], v0[1]); w.y = cvt_pk_bf16(v0[2], v0[3]); w.z = cvt_pk_bf16(v1[0], v1[1]); w.w = cvt_pk_bf16(v1[2], v1[3]);
                        *(u32x4*)(xb + off) = w; if (xb2) *(u32x4*)(xb2 + off) = w;
                        sq += v0[0] * v0[0] + v0[1] * v0[1] + v0[2] * v0[2] + v0[3] * v0[3] + v1[0] * v1[0] + v1[1] * v1[1] + v1[2] * v1[2] + v1[3] * v1[3];
                    }
                }
                if (WRITE_XB) { sq += __shfl_xor(sq, 16); sq += __shfl_xor(sq, 32); if (fq == 0) atomicAdd(ss + row, sq); }
            }
    }
};
struct EpiP {
    bf16_t* P; float* SM; const float* ss;
    __device__ __forceinline__ void operator()(const AccT& acc, const Unit& u, int wr, int wc, int fr, int fq) const {
        const int row0 = u.pm * BM + wr * 64 + fr, col0 = u.pn * BM + wc * 32 + 8 * fq;
#pragma unroll
        for (int ai = 0; ai < 2; ++ai)
#pragma unroll
            for (int m = 0; m < 4; ++m) {
                const int row = row0 + ai * HALF + m * 16;
                const float rs = rsqrtf(ss[row] * (1.f / 1024.f) + EPS);
#pragma unroll
                for (int bj = 0; bj < 2; ++bj) {
                    const int col = col0 + bj * HALF;
                    const f32x4 v0 = acc[ai][bj][m][0] * rs, v1 = acc[ai][bj][m][1] * rs;
                    u32x4 w; w.x = cvt_pk_bf16(v0[0], v0[1]); w.y = cvt_pk_bf16(v0[2], v0[3]); w.z = cvt_pk_bf16(v1[0], v1[1]); w.w = cvt_pk_bf16(v1[2], v1[3]);
                    *(u32x4*)(P + (size_t)row * LDP + col) = w;
                    if (col >= C_SM && col < C_SM + 16) { float* s = SM + (size_t)row * 16 + (col - C_SM); *(f32x4*)s = v0; *(f32x4*)(s + 4) = v1; }
                }
            }
    }
};
struct EpiBf16 {
    bf16_t* O; int ldc;
    __device__ __forceinline__ void operator()(const AccT& acc, const Unit& u, int wr, int wc, int fr, int fq) const {
        const int row0 = u.pm * BM + wr * 64 + fr, col0 = u.pn * BM + wc * 32 + 8 * fq;
#pragma unroll
        for (int ai = 0; ai < 2; ++ai)
#pragma unroll
            for (int m = 0; m < 4; ++m) {
                const int row = row0 + ai * HALF + m * 16;
#pragma unroll
                for (int bj = 0; bj < 2; ++bj) {
                    const f32x4 v0 = acc[ai][bj][m][0], v1 = acc[ai][bj][m][1];
                    u32x4 w; w.x = cvt_pk_bf16(v0[0], v0[1]); w.y = cvt_pk_bf16(v0[2], v0[3]); w.z = cvt_pk_bf16(v1[0], v1[1]); w.w = cvt_pk_bf16(v1[2], v1[3]);
                    *(u32x4*)(O + (size_t)row * ldc + col0 + bj * HALF) = w;
                }
            }
    }
};
template <int PASS> struct EpiMerge {
    const bf16_t* P; bf16_t* MG; int goff;
    __device__ __forceinline__ void operator()(const AccT& acc, const Unit& u, int wr, int wc, int fr, int fq) const {
        const int row0 = u.pm * BM + wr * 64 + fr, col0 = u.pn * BM + wc * 32 + 8 * fq;
#pragma unroll
        for (int ai = 0; ai < 2; ++ai)
#pragma unroll
            for (int m = 0; m < 4; ++m) {
                const int row = row0 + ai * HALF + m * 16;
#pragma unroll
                for (int bj = 0; bj < 2; ++bj) {
                    const int col = col0 + bj * HALF;
                    float gt[8], o[8]; unpack8(*(const u32x4*)(P + (size_t)row * LDP + goff + col), gt);
                    if (PASS == 1) unpack8(*(const u32x4*)(MG + (size_t)row * DM + col), o);
#pragma unroll
                    for (int j = 0; j < 8; ++j) { const float a = acc[ai][bj][m][j >> 2][j & 3] * sigmoidf_(gt[j]); o[j] = (PASS == 1) ? o[j] + a : a; }
                    *(u32x4*)(MG + (size_t)row * DM + col) = pack8(o);
                }
            }
    }
};
}

struct Args {
    const float* in[24];
    float* out;
    unsigned char* ws;
};
enum { I_X = 0, I_F1N, I_F1G, I_F1U, I_F1D, I_MIXN, I_WIN, I_QN, I_KN, I_IKN, I_CW, I_CB, I_WMQ, I_WMK, I_BI, I_BF, I_MHN, I_WPA, I_WPB, I_WOUT, I_F2N, I_F2G, I_F2U, I_F2D };

template <class F> __device__ __forceinline__ void prep_load(int n0, int k0, const F src, float (&v)[8]) {
    const int tid = threadIdx.x, nn = tid & 63, kk = tid >> 6;
#pragma unroll
    for (int i = 0; i < 8; ++i) v[i] = src(k0 + i * 8 + kk, n0 + nn);
}
__device__ __forceinline__ void prep_store(bf16_t* Bt, int K, int n0, int k0, const float (&v)[8], float* tile) {
    const int tid = threadIdx.x;
    { const int nn = tid & 63, kk = tid >> 6;
#pragma unroll
        for (int i = 0; i < 8; ++i) tile[(i * 8 + kk) * 65 + nn] = v[i]; }
    __syncthreads();
    { const int nn = tid >> 3, kc = tid & 7; const float* s = tile + (kc * 8) * 65 + nn;
        u32x4 o; o.x = cvt_pk_bf16(s[0], s[65]); o.y = cvt_pk_bf16(s[130], s[195]); o.z = cvt_pk_bf16(s[260], s[325]); o.w = cvt_pk_bf16(s[390], s[455]);
        *(u32x4*)(Bt + (size_t)(n0 + nn) * K + k0 + kc * 8) = o; }
    __syncthreads();
}
struct SrcUp { const float* wg; const float* wu; const float* g;
    __device__ __forceinline__ float operator()(int k, int n) const { const int col = (n >> 8) * 128 + (n & 127); const size_t bj = (size_t)((n >> 7) & 1); const float* w = (const float*)((uintptr_t)wg + ((uintptr_t)wu - (uintptr_t)wg) * bj); return w[(size_t)k * FF + col] * g[k]; } };
struct SrcPlain { const float* w; int ldw;
    __device__ __forceinline__ float operator()(int k, int n) const { return w[(size_t)k * ldw + n]; } };
struct SrcIn { const float* w; const float* g;
    __device__ __forceinline__ float operator()(int k, int n) const {
        int col;
        if (n < 1344) col = n; else if (n < 2368) col = n + 8; else if (n < 4928) col = n + 16;
        else if (n < 4936) col = n - 4928 + 1344; else if (n < 4940) col = n - 4936 + 2376; else if (n < 4944) col = n - 4940 + 2380; else col = -1;
        return col >= 0 ? w[(size_t)k * 4944 + col] * g[k] : 0.f; } };
struct SrcQK { const float* wq; const float* wk;
    __device__ __forceinline__ float operator()(int k, int n) const {
        const int isk = n >> 8, h = (n >> 6) & 3, j = n & 63, hk = k >> 7, c = k & 127;
        if (hk != h) return 0.f;
        const float* w = (const float*)((uintptr_t)wq + ((uintptr_t)wk - (uintptr_t)wq) * (size_t)isk); return w[(size_t)(h * 128 + c) * 64 + j] * (isk ? 1.f : 0.125f); } };

__device__ __forceinline__ void phase0(const Args& a, unsigned char* lds) {
    float* tile = (float*)lds;
    unsigned char* ws = a.ws;
    constexpr int T_UP = 88 * 16, T_DN = 16 * 44, T_IN = 80 * 16, T_PR = 16 * 8, T_WO = 16 * 16, T_QK = 8 * 8;
    constexpr int NITEMS = 2 * T_UP + 2 * T_DN + T_IN + 2 * T_PR + T_WO + T_QK;
#define P0_LOAD(IT, V, BOFF, KK, N0, K0) do { int r = (IT); \
        if (r < T_UP) { SrcUp s_{a.in[I_F1G], a.in[I_F1U], a.in[I_F1N]}; BOFF = WS_W1; KK = 1024; N0 = (r / 16) * 64; K0 = (r % 16) * 64; prep_load(N0, K0, s_, V); break; } r -= T_UP; \
        if (r < T_UP) { SrcUp s_{a.in[I_F2G], a.in[I_F2U], a.in[I_F2N]}; BOFF = WS_W3; KK = 1024; N0 = (r / 16) * 64; K0 = (r % 16) * 64; prep_load(N0, K0, s_, V); break; } r -= T_UP; \
        if (r < T_DN) { SrcPlain s_{a.in[I_F1D], 1024}; BOFF = WS_W2; KK = FF; N0 = (r / 44) * 64; K0 = (r % 44) * 64; prep_load(N0, K0, s_, V); break; } r -= T_DN; \
        if (r < T_DN) { SrcPlain s_{a.in[I_F2D], 1024}; BOFF = WS_W4; KK = FF; N0 = (r / 44) * 64; K0 = (r % 44) * 64; prep_load(N0, K0, s_, V); break; } r -= T_DN; \
        if (r < T_IN) { SrcIn s_{a.in[I_WIN], a.in[I_MIXN]}; BOFF = WS_WIN; KK = 1024; N0 = (r / 16) * 64; K0 = (r % 16) * 64; prep_load(N0, K0, s_, V); break; } r -= T_IN; \
        if (r < T_PR) { SrcPlain s_{a.in[I_WPA], 1024}; BOFF = WS_WA; KK = 512; N0 = (r / 8) * 64; K0 = (r % 8) * 64; prep_load(N0, K0, s_, V); break; } r -= T_PR; \
        if (r < T_PR) { SrcPlain s_{a.in[I_WPB], 1024}; BOFF = WS_WB; KK = 512; N0 = (r / 8) * 64; K0 = (r % 8) * 64; prep_load(N0, K0, s_, V); break; } r -= T_PR; \
        if (r < T_WO) { SrcPlain s_{a.in[I_WOUT], 1024}; BOFF = WS_WO; KK = 1024; N0 = (r / 16) * 64; K0 = (r % 16) * 64; prep_load(N0, K0, s_, V); break; } r -= T_WO; \
        { SrcQK s_{a.in[I_WMQ], a.in[I_WMK]}; BOFF = WS_WQK; KK = 512; N0 = (r / 8) * 64; K0 = (r % 8) * 64; prep_load(N0, K0, s_, V); } } while (0)
    {
        float v[8], vn[8]; size_t boff = 0, boffn = 0; int kk_ = 0, n0_ = 0, k0_ = 0, kkn = 0, n0n = 0, k0n = 0;
        int it = blockIdx.x;
        if (it < NITEMS) P0_LOAD(it, v, boff, kk_, n0_, k0_);
        for (; it < NITEMS; it += gridDim.x) {
            const int itn = it + (int)gridDim.x;
            if (itn < NITEMS) P0_LOAD(itn, vn, boffn, kkn, n0n, k0n);
            prep_store((bf16_t*)(ws + boff), kk_, n0_, k0_, v, tile);
#pragma unroll
            for (int i = 0; i < 8; ++i) v[i] = vn[i];
            boff = boffn; kk_ = kkn; n0_ = n0n; k0_ = k0n;
        }
    }
#undef P0_LOAD
    const int lane = threadIdx.x & 63, gw = blockIdx.x * 8 + (threadIdx.x >> 6), NGW = gridDim.x * 8;
    const float* x = a.in[I_X]; bf16_t* XB = (bf16_t*)(ws + WS_XB);
    float* ss0 = (float*)(ws + WS_SS0); float* ss1 = (float*)(ws + WS_SS1); float* ss2 = (float*)(ws + WS_SS2);
    for (int row = gw; row < MROWS; row += NGW) {
        const f32x4* xr = (const f32x4*)(x + (size_t)row * DM) + lane;
        f32x4 v[4]; float s = 0.f;
#pragma unroll
        for (int j = 0; j < 4; ++j) { v[j] = xr[64 * j]; s += v[j][0] * v[j][0] + v[j][1] * v[j][1] + v[j][2] * v[j][2] + v[j][3] * v[j][3]; }
        s = wave_sum(s);
        if (lane == 0) { ss0[row] = s; ss1[row] = 0.f; ss2[row] = 0.f; }
        unsigned long long* o8 = (unsigned long long*)(XB + (size_t)row * DM) + lane;
#pragma unroll
        for (int j = 0; j < 4; ++j) o8[64 * j] = (unsigned long long)cvt_pk_bf16(v[j][0], v[j][1]) | ((unsigned long long)cvt_pk_bf16(v[j][2], v[j][3]) << 32);
    }
}

__device__ __forceinline__ void phase_postp(const Args& a) {
    unsigned char* ws = a.ws;
    bf16_t* P = (bf16_t*)(ws + WS_P); bf16_t* XC = (bf16_t*)(ws + WS_XB); bf16_t* IKC = (bf16_t*)(ws + WS_IKC); bf16_t* KVC = (bf16_t*)(ws + WS_KVC);
    const int lane = threadIdx.x & 63, gw = blockIdx.x * 8 + (threadIdx.x >> 6), NGW = gridDim.x * 8;
    const int c0 = lane * 8;
    float cw[4][8], cb[8], gq[8], gk[8];
#pragma unroll
    for (int e = 0; e < 8; ++e) {
        cb[e] = a.in[I_CB][c0 + e];
#pragma unroll
        for (int j = 0; j < 4; ++j) cw[j][e] = a.in[I_CW][j * 512 + c0 + e];
        gq[e] = a.in[I_QN][(lane & 7) * 8 + e];
        gk[e] = (lane < 16) ? a.in[I_KN][(lane & 7) * 8 + e] : a.in[I_IKN][(lane & 7) * 8 + e];
    }
    const int koff = (lane < 16) ? (C_AK + lane * 8) : (C_IK + (lane & 7) * 8);
    const int voff = C_AV + ((lane - 32) & 15) * 8;
    u32x4 nmx[4], naq, nkk, nav;
#define PP_LOAD(ROW) do { const int t_ = (ROW) & (SEQ - 1); const bf16_t* pr_ = P + (size_t)(ROW) * LDP; \
        _Pragma("unroll") for (int j = 0; j < 4; ++j) { if (t_ - 3 + j >= 0) nmx[j] = *(const u32x4*)(P + (size_t)((ROW) - 3 + j) * LDP + C_MX + c0); else nmx[j] = (u32x4){0u, 0u, 0u, 0u}; } \
        naq = *(const u32x4*)(pr_ + C_AQ + c0); nkk = *(const u32x4*)(pr_ + koff); nav = *(const u32x4*)(pr_ + voff); } while (0)
    if (gw < MROWS) PP_LOAD(gw);
    for (int row = gw; row < MROWS; row += NGW) {
        bf16_t* pr = P + (size_t)row * LDP;
        u32x4 cmx[4];
#pragma unroll
        for (int j = 0; j < 4; ++j) cmx[j] = nmx[j];
        const u32x4 caq = naq, ckk = nkk, cav = nav;
        if (row + NGW < MROWS) PP_LOAD(row + NGW);
        float accv[8];
#pragma unroll
        for (int e = 0; e < 8; ++e) accv[e] = cb[e];
#pragma unroll
        for (int j = 0; j < 4; ++j) { float xf[8]; unpack8(cmx[j], xf);
#pragma unroll
            for (int e = 0; e < 8; ++e) accv[e] += xf[e] * cw[j][e]; }
#pragma unroll
        for (int e = 0; e < 8; ++e) accv[e] = accv[e] * sigmoidf_(accv[e]);
        *(u32x4*)(XC + (size_t)row * 512 + c0) = pack8(accv);
        { float f[8]; unpack8(caq, f); float s = 0.f;
#pragma unroll
            for (int e = 0; e < 8; ++e) s += f[e] * f[e];
            s += __shfl_xor(s, 1); s += __shfl_xor(s, 2); s += __shfl_xor(s, 4);
            const float rs = rsqrtf(s * (1.f / 64.f) + EPS);
#pragma unroll
            for (int e = 0; e < 8; ++e) f[e] = f[e] * rs * gq[e];
            *(u32x4*)(pr + C_AQ + c0) = pack8(f); }
        { float f[8]; unpack8(ckk, f); float s = 0.f;
#pragma unroll
            for (int e = 0; e < 8; ++e) s += f[e] * f[e];
            s += __shfl_xor(s, 1); s += __shfl_xor(s, 2); s += __shfl_xor(s, 4);
            const float rs = rsqrtf(s * (1.f / 64.f) + EPS);
#pragma unroll
            for (int e = 0; e < 8; ++e) f[e] = f[e] * rs * gk[e];
            if (lane < 16) *(u32x4*)(KVC + (size_t)row * 256 + lane * 8) = pack8(f);
            else if (lane < 24) *(u32x4*)(IKC + ((((size_t)(row >> 4)) * 8 + (lane - 16)) * 16 + (row & 15)) * 8) = pack8(f);
            else if (lane >= 32 && lane < 48) *(u32x4*)(KVC + (size_t)row * 256 + 128 + (lane - 32) * 8) = cav; }
    }
#undef PP_LOAD
}

__device__ __forceinline__ unsigned fkey(float s) { const unsigned u = __float_as_uint(s); return (u & 0x80000000u) ? ~u : (u | 0x80000000u); }


__device__ __forceinline__ unsigned wave_incl_scan_dpp(unsigned x) {
    x += (unsigned)__builtin_amdgcn_update_dpp(0, (int)x, 0x111, 0xf, 0xf, false);
    x += (unsigned)__builtin_amdgcn_update_dpp(0, (int)x, 0x112, 0xf, 0xf, false);
    x += (unsigned)__builtin_amdgcn_update_dpp(0, (int)x, 0x114, 0xf, 0xf, false);
    x += (unsigned)__builtin_amdgcn_update_dpp(0, (int)x, 0x118, 0xf, 0xf, false);
    x += (unsigned)__builtin_amdgcn_update_dpp(0, (int)x, 0x142, 0xa, 0xf, false);
    x += (unsigned)__builtin_amdgcn_update_dpp(0, (int)x, 0x143, 0xc, 0xf, false);
    return x;
}
__device__ __forceinline__ int find_bin(const unsigned* hist, int& need, int lane, int& binc) {
    const int base = 1023 - 16 * lane; unsigned s = 0;
#pragma unroll
    for (int i = 0; i < 16; ++i) { const unsigned w = hist[base - ((i + lane) & 15)]; s += (w & 0xffffu) + (w >> 16); }
    const unsigned p = wave_incl_scan_dpp(s);
    const unsigned long long bal = __ballot(p >= (unsigned)need);
    const int L = bal ? (__ffsll((long long)bal) - 1) : 63;
    const unsigned excl = __shfl(p - s, L);
    const int b0 = 1023 - 16 * L, t = lane & 31;
    const unsigned w2 = hist[b0 - (t >> 1)];
    const unsigned v2 = (lane < 32) ? ((t & 1) ? (w2 & 0xffffu) : (w2 >> 16)) : 0u;
    const unsigned p2 = wave_incl_scan_dpp(v2);
    const unsigned long long bal2 = __ballot((lane < 32) && ((unsigned)excl + p2 >= (unsigned)need));
    const int ts = bal2 ? (__ffsll((long long)bal2) - 1) : 31;
    const int vs = (int)__shfl(v2, ts), ps = (int)__shfl(p2, ts);
    int bin = 2 * (b0 - (ts >> 1)) + ((ts & 1) ? 0 : 1);
    int fneed = need - ((int)excl + ps - vs), bc = vs;
    if (fneed < 1) fneed = 1;
    need = fneed; binc = bc; return bin;
}


__device__ __forceinline__ int find_bin128(const unsigned* sh, int& need, int lane, int& binc) {
    const unsigned hi = sh[127 - 2 * lane], lo = sh[126 - 2 * lane]; const unsigned s = hi + lo;
    const unsigned p = wave_incl_scan_dpp(s);
    const unsigned long long bal = __ballot(p >= (unsigned)need);
    const int L = bal ? (__ffsll((long long)bal) - 1) : 63;
    const int excl = (int)__shfl(p - s, L); const int hiL = (int)__shfl(hi, L), loL = (int)__shfl(lo, L);
    int bin, fneed, bc;
    if (excl + hiL >= need) { bin = 127 - 2 * L; fneed = need - excl; bc = hiL; } else { bin = 126 - 2 * L; fneed = need - excl - hiL; bc = loL; }
    if (fneed < 1) fneed = 1;
    need = fneed; binc = bc; return bin;
}

template <bool DUMMY> __device__ __forceinline__ void phase_dsa(const Args& a, unsigned char* lds) {
    unsigned char* ws = a.ws;
    bf16_t* P = (bf16_t*)(ws + WS_P); const float* SM = (const float*)(ws + WS_SM);
    const bf16_t* IKC = (const bf16_t*)(ws + WS_IKC); const bf16_t* KVC = (const bf16_t*)(ws + WS_KVC);
    constexpr int SCS = 8200;
    float* SC = (float*)lds;
    unsigned* HIST = (unsigned*)(lds + 131200);
    int* LIST = (int*)(lds + 131200 + 16384);
    unsigned* QS = (unsigned*)(lds + 131200 + 16384 + 4096);
    int* CNT = (int*)(lds + 131200 + 16384 + 4096 + 4096);
    const float idx_scale = 0.125f * 0.35355339059327373f;
    f32x4 wqv[2]; unsigned qsv[2];
#define DSA_LOAD_ITEM(ITEM) do { const int b_ = (ITEM) & 7, t0_ = ((ITEM) >> 3) * 4; const size_t r_ = (size_t)b_ * SEQ + t0_; \
        int tl_ = threadIdx.x; asm volatile("" : "+v"(tl_)); const int ln_ = tl_ & 63, q4_ = ln_ >> 4; \
        wqv[0] = *(const f32x4*)(SM + (r_ + q4_) * 16); wqv[1] = *(const f32x4*)(SM + (r_ + q4_) * 16 + 4); \
        _Pragma("unroll") for (int i_ = 0; i_ < 2; ++i_) { const int e_ = tl_ + 512 * i_; qsv[i_] = *(const unsigned*)(P + (r_ + (e_ >> 8)) * LDP + C_AQ + (e_ & 255) * 2); } } while (0)
    if ((int)blockIdx.x < 16384) DSA_LOAD_ITEM(blockIdx.x);
    for (int item = blockIdx.x; item < 16384; item += gridDim.x) {
        int tid_ = threadIdx.x; asm volatile("" : "+v"(tid_));
        const int tid = tid_, wave = __builtin_amdgcn_readfirstlane(tid >> 6), lane = tid & 63, quad = lane >> 4, l15 = lane & 15;
        const int b = item & 7, tq = item >> 3, t0 = tq * 4, L = ((t0 >> 6) + 1) * 64;
        const size_t r0 = (size_t)b * SEQ + t0;
        const bool do_sel = (L > 256) && !DBG_NOSEL;
        { u32x4* hz = (u32x4*)HIST; hz[tid] = (u32x4){0u, 0u, 0u, 0u}; hz[tid + 512] = (u32x4){0u, 0u, 0u, 0u}; }
        if (tid < 8) CNT[4 + tid] = 0;
        QS[tid] = qsv[0]; QS[tid + 512] = qsv[1];
        float wq[8];
#pragma unroll
        for (int h = 0; h < 4; ++h) { wq[h] = wqv[0][h] * idx_scale; wq[4 + h] = wqv[1][h] * idx_scale; }
        bf16x8 af[2][2];
#pragma unroll
        for (int T = 0; T < 2; ++T)
#pragma unroll
            for (int ks = 0; ks < 2; ++ks) af[T][ks] = *(const bf16x8*)(P + (r0 + (l15 >> 2)) * LDP + C_IQ + (4 * T + (l15 & 3)) * 64 + ks * 32 + quad * 8);
        const int ngroups = L >> 6;
        const bf16_t* ikb = IKC + (size_t)b * SEQ * 64 + (quad * 16 + l15) * 8;
        bf16x8 B0[4][2], B1[4][2], B2[4][2];
#define IDX_LOAD(BUF, G) do { _Pragma("unroll") for (int tt = 0; tt < 4; ++tt) _Pragma("unroll") for (int ks = 0; ks < 2; ++ks) \
                BUF[tt][ks] = *(const bf16x8*)(ikb + (size_t)(((G) * 4 + tt) * 8 + ks * 4) * 128); } while (0)
        if (wave < ngroups) IDX_LOAD(B0, wave);
        if (wave + 8 < ngroups) IDX_LOAD(B1, wave + 8);
        if (wave + 16 < ngroups) IDX_LOAD(B2, wave + 16);
        lds_fence(); __builtin_amdgcn_s_barrier();
        for (int rep = 0; rep < ((DBG_TWICE & 2) ? 2 : 1); ++rep) {
            const bool hist_on = do_sel && (rep == (((DBG_TWICE & 2) ? 2 : 1) - 1));
#define IDX_COMPUTE(BUF, G) do { _Pragma("unroll") for (int tt = 0; tt < 4; ++tt) { \
                const int key = (G) * 64 + tt * 16 + l15; \
                f32x4 c0 = (f32x4){0.f, 0.f, 0.f, 0.f}, c1 = (f32x4){0.f, 0.f, 0.f, 0.f}; \
                c0 = __builtin_amdgcn_mfma_f32_16x16x32_bf16(af[0][0], BUF[tt][0], c0, 0, 0, 0); \
                c1 = __builtin_amdgcn_mfma_f32_16x16x32_bf16(af[1][0], BUF[tt][0], c1, 0, 0, 0); \
                c0 = __builtin_amdgcn_mfma_f32_16x16x32_bf16(af[0][1], BUF[tt][1], c0, 0, 0, 0); \
                c1 = __builtin_amdgcn_mfma_f32_16x16x32_bf16(af[1][1], BUF[tt][1], c1, 0, 0, 0); \
                float sc = 0.f; \
                _Pragma("unroll") for (int j = 0; j < 4; ++j) { sc += wq[j] * relu_(c0[j]); sc += wq[4 + j] * relu_(c1[j]); } \
                sc += 0.f; \
                SC[quad * SCS + key] = sc; \
                if (hist_on) { const unsigned bin = fkey(sc) >> 21; atomicAdd(&HIST[quad * 1024 + (bin >> 1)], (bin & 1u) ? 0x10000u : 1u); } } } while (0)
            int g = wave;
            for (; g < ngroups; g += 24) {
                IDX_COMPUTE(B0, g);
                if (g + 24 < ngroups) IDX_LOAD(B0, g + 24);
                if (g + 8 < ngroups) { IDX_COMPUTE(B1, g + 8); if (g + 32 < ngroups) IDX_LOAD(B1, g + 32); }
                if (g + 16 < ngroups) { IDX_COMPUTE(B2, g + 16); if (g + 40 < ngroups) IDX_LOAD(B2, g + 40); }
            }
#undef IDX_LOAD
#undef IDX_COMPUTE
        }
        lds_fence(); __builtin_amdgcn_s_barrier();
        if (item + (int)gridDim.x < 16384) DSA_LOAD_ITEM(item + (int)gridDim.x);
        {
            constexpr int CAP = 448;
            const unsigned long long ltmask = (1ull << lane) - 1ull;
            if (!do_sel) {
                const int q = wave >> 1, hf = wave & 1; int* list = LIST + q * 256;
                if (hf == 0) { for (int i = lane; i < 256; i += 64) list[i] = (i < L) ? i : 0; if (lane == 0) CNT[q] = L; }
            } else {
                {
                    const int q = wave >> 1, hf = wave & 1; int* list = LIST + q * 256; const float* sc = SC + q * SCS; unsigned* hist = HIST + q * 1024;
                    const int halfL = L >> 1, beg = hf * halfL, end = beg + halfL;
                    int need = 256, binc = 0;
                    const unsigned b1 = (unsigned)find_bin(hist, need, lane, binc);
                    const int c1 = binc, nsure = 256 - need; const bool store_c = c1 <= CAP;
                    if (hf == 0 && lane == 0) { CNT[12 + q] = (int)b1; CNT[16 + q] = need; CNT[8 + q] = c1; }
                    lds_fence(); __builtin_amdgcn_s_barrier();
                    int cs = 0, cc = 0;
                    for (int i0 = beg + lane * 4; i0 < end; i0 += 256) { const f32x4 v = *(const f32x4*)(sc + i0);
#pragma unroll
                        for (int e = 0; e < 4; ++e) { const unsigned k = fkey(v[e]); const unsigned kb = k >> 21;
                            const bool sure = kb > b1, cand = (kb == b1) && store_c;
                            const unsigned long long ms = __ballot(sure), mc = __ballot(cand);
                            if (ms) { const int p = cs + __popcll(ms & ltmask); const int pp = hf ? nsure - 1 - p : p; if (sure && pp >= 0 && pp < 256) list[pp] = i0 + e; cs += __popcll(ms); }
                            if (mc) { const int p = cc + __popcll(mc & ltmask); const int pp = hf ? c1 - 1 - p : p; if (cand && pp >= 0 && pp < CAP) { hist[2 * pp] = k; hist[2 * pp + 1] = (unsigned)(i0 + e); } cc += __popcll(mc); } } }
                    lds_fence(); __builtin_amdgcn_s_barrier();
                }
                if (wave < 4) {
                    const int q = wave; int* list = LIST + q * 256; unsigned* hist = HIST + q * 1024; unsigned* sh = hist + 896; const float* sc = SC + q * SCS;
                    const unsigned b1 = (unsigned)CNT[12 + q]; int need = CNT[16 + q]; const int c = CNT[8 + q]; const int nsure = 256 - need;
                    if (c <= CAP) {
                        unsigned ck[7]; int ci[7];
#pragma unroll
                        for (int t = 0; t < 7; ++t) { const int i = lane + 64 * t; const bool valid = i < c; ck[t] = valid ? hist[2 * i] : 0u; ci[t] = valid ? (int)hist[2 * i + 1] : -1; }
                        int binc = 0;
                        sh[2 * lane] = 0u; sh[2 * lane + 1] = 0u; lds_order();
#pragma unroll
                        for (int t = 0; t < 7; ++t) if (ci[t] >= 0) atomicAdd(&sh[(ck[t] >> 14) & 127u], 1u);
                        lds_order();
                        const unsigned bA = (unsigned)find_bin128(sh, need, lane, binc);
                        lds_order();
                        sh[2 * lane] = 0u; sh[2 * lane + 1] = 0u; lds_order();
#pragma unroll
                        for (int t = 0; t < 7; ++t) if (ci[t] >= 0 && ((ck[t] >> 14) & 127u) == bA) atomicAdd(&sh[(ck[t] >> 7) & 127u], 1u);
                        lds_order();
                        const unsigned bB = (unsigned)find_bin128(sh, need, lane, binc);
                        const unsigned preB = (bA << 7) | bB;
                        lds_order();
                        sh[2 * lane] = 0u; sh[2 * lane + 1] = 0u; lds_order();
#pragma unroll
                        for (int t = 0; t < 7; ++t) if (ci[t] >= 0 && ((ck[t] >> 7) & 0x3fffu) == preB) atomicAdd(&sh[ck[t] & 127u], 1u);
                        lds_order();
                        const unsigned bC = (unsigned)find_bin128(sh, need, lane, binc);
                        const unsigned T = (b1 << 21) | (preB << 7) | bC;
                        const int tie_total = binc, need_t = need;
                        int cnt = 0;
#pragma unroll
                        for (int t = 0; t < 7; ++t) {
                            const bool valid = ci[t] >= 0;
                            bool sel = valid && (ck[t] > T);
                            if (valid && ck[t] == T) {
                                if (tie_total == need_t) sel = true;
                                else { int rank = 0; for (int j = 0; j < c; ++j) rank += (hist[2 * j] == T && (int)hist[2 * j + 1] < ci[t]) ? 1 : 0; sel = rank < need_t; }
                            }
                            const unsigned long long m = __ballot(sel);
                            const int pos = nsure + cnt + __popcll(m & ltmask);
                            if (sel && pos < 256) list[pos] = ci[t];
                            cnt += __popcll(m);
                        }
                    } else {
                        int binc = 0;
                        lds_order();
#pragma unroll
                        for (int i = 0; i < 16; ++i) hist[lane * 16 + i] = 0u;
                        lds_order();
                        for (int i0 = 0; i0 < L; i0 += 64) { const unsigned k = fkey(sc[i0 + lane]); if ((k >> 21) == b1) { const unsigned bin = (k >> 10) & 2047u; atomicAdd(&hist[bin >> 1], (bin & 1u) ? 0x10000u : 1u); } }
                        lds_order();
                        const unsigned b2 = (unsigned)find_bin(hist, need, lane, binc);
                        const unsigned pre2 = (b1 << 11) | b2;
                        lds_order();
#pragma unroll
                        for (int i = 0; i < 16; ++i) hist[lane * 16 + i] = 0u;
                        lds_order();
                        for (int i0 = 0; i0 < L; i0 += 64) { const unsigned k = fkey(sc[i0 + lane]); if ((k >> 10) == pre2) { const unsigned bin = k & 1023u; atomicAdd(&hist[bin >> 1], (bin & 1u) ? 0x10000u : 1u); } }
                        lds_order();
                        const unsigned b3 = (unsigned)find_bin(hist, need, lane, binc);
                        const unsigned T = (pre2 << 10) | b3;
                        int count = 0, ties = 0;
                        for (int i0 = 0; i0 < L; i0 += 64) {
                            const unsigned k = fkey(sc[i0 + lane]);
                            const bool eq = (k == T);
                            const unsigned long long em = __ballot(eq);
                            const int erank = ties + __popcll(em & ltmask);
                            const bool sel = (k > T) || (eq && erank < need);
                            const unsigned long long smk = __ballot(sel);
                            const int pos = count + __popcll(smk & ltmask);
                            if (sel && pos < 256) list[pos] = i0 + lane;
                            count += __popcll(smk); ties += __popcll(em);
                        }
                        if (count > 256) count = 256;
                        for (int i = count + lane; i < 256; i += 64) list[i] = 0;
                    }
                    if (lane == 0) CNT[q] = 256;
                }
            }
        }
        lds_fence(); __builtin_amdgcn_s_barrier();
        for (int repc = 0; repc < ((DBG_TWICE & 4) ? 2 : 1); ++repc) {
            const bool dummy_c = (repc + 1) < ((DBG_TWICE & 4) ? 2 : 1);
            int lane_c = lane; asm volatile("" : "+v"(lane_c));
            const int qi = wave >> 1, g = wave & 1; const int count = CNT[qi];
            const int* list = LIST + qi * 256;
            float* PB = SC + wave * 1024;
            const unsigned* qd = QS + (qi * 8 + g * 4) * 32;
            const bf16_t* kvb = KVC + (size_t)b * SEQ * 256 + g * 64;
            const int ks = lane_c >> 3, dg = lane_c & 7, l15c = lane_c & 15, quadc = lane_c >> 4;
            const int nblk = count >> 6;
            bf16_t* KL = (bf16_t*)(lds + 32768 + wave * 9216);
            bf16x8 bq[2];
#pragma unroll
            for (int s2 = 0; s2 < 2; ++s2) {
                bf16x8 t = *(const bf16x8*)((const bf16_t*)QS + (qi * 8 + g * 4 + (l15c & 3)) * 64 + s2 * 32 + quadc * 8);
                if (l15c >= 4) t = (bf16x8){0, 0, 0, 0, 0, 0, 0, 0};
                bq[s2] = t;
            }
            const bf16_t* kb = kvb + dg * 8;
            float sreg[4][4][4];
            u32x4 kcur[8];
#pragma unroll
            for (int u = 0; u < 8; ++u) kcur[u] = *(const u32x4*)(kb + (size_t)list[u * 8 + ks] * 256);
#pragma unroll
            for (int blk = 0; blk < 4; ++blk) {
                if (blk < nblk) {
#pragma unroll
                    for (int u = 0; u < 8; ++u) *(u32x4*)(KL + (u * 8 + ks) * 72 + dg * 8) = kcur[u];
                    if (blk + 1 < nblk) {
#pragma unroll
                        for (int u = 0; u < 8; ++u) kcur[u] = *(const u32x4*)(kb + (size_t)list[(blk + 1) * 64 + u * 8 + ks] * 256);
                    }
                    lds_order();
#pragma unroll
                    for (int kt = 0; kt < 4; ++kt) {
                        f32x4 acc = (f32x4){0.f, 0.f, 0.f, 0.f};
#pragma unroll
                        for (int s2 = 0; s2 < 2; ++s2) acc = __builtin_amdgcn_mfma_f32_16x16x32_bf16(*(const bf16x8*)(KL + (kt * 16 + l15c) * 72 + s2 * 32 + quadc * 8), bq[s2], acc, 0, 0, 0);
#pragma unroll
                        for (int j = 0; j < 4; ++j) sreg[blk][kt][j] = acc[j] * 0.125f;
                    }
                    lds_order();
                } else {
#pragma unroll
                    for (int kt = 0; kt < 4; ++kt)
#pragma unroll
                        for (int j = 0; j < 4; ++j) sreg[blk][kt][j] = -INFINITY;
                }
            }
            const bf16_t* vb = kvb + 128 + dg * 8;
            u32x4 vreg[8];
#pragma unroll
            for (int u = 0; u < 8; ++u) vreg[u] = *(const u32x4*)(vb + (size_t)list[u * 8 + ks] * 256);
            float mx = -INFINITY;
#pragma unroll
            for (int blk = 0; blk < 4; ++blk)
#pragma unroll
                for (int kt = 0; kt < 4; ++kt)
#pragma unroll
                    for (int j = 0; j < 4; ++j) mx = fmaxf(mx, sreg[blk][kt][j]);
            mx = fmaxf(mx, __shfl_xor(mx, 16)); mx = fmaxf(mx, __shfl_xor(mx, 32));
            float sum = 0.f;
#pragma unroll
            for (int blk = 0; blk < 4; ++blk)
#pragma unroll
                for (int kt = 0; kt < 4; ++kt)
#pragma unroll
                    for (int j = 0; j < 4; ++j) { const float e = __expf(sreg[blk][kt][j] - mx); sreg[blk][kt][j] = e; sum += e; }
            sum += __shfl_xor(sum, 16); sum += __shfl_xor(sum, 32);
            const float invs = 1.f / sum;
            f32x4 oacc[4];
#pragma unroll
            for (int dt = 0; dt < 4; ++dt) oacc[dt] = (f32x4){0.f, 0.f, 0.f, 0.f};
            bf16_t* VT = KL;
#pragma unroll
            for (int blk = 0; blk < 4; ++blk) {
                if (blk < nblk) {
#pragma unroll
                    for (int u = 0; u < 8; ++u) {
                        const int rho = ((u >> 2) << 5) + ((((2 * u) & 3) + (ks >> 2)) << 3) + (((u >> 1) & 1) << 2) + (ks & 3);
                        *(u32x4*)(VT + rho * 72 + dg * 8) = vreg[u];
                    }
                    if (blk + 1 < nblk) {
#pragma unroll
                        for (int u = 0; u < 8; ++u) vreg[u] = *(const u32x4*)(vb + (size_t)list[(blk + 1) * 64 + u * 8 + ks] * 256);
                    }
                    lds_order();
#pragma unroll
                    for (int s2 = 0; s2 < 2; ++s2) {
                        u32x4 pw;
                        pw[0] = cvt_pk_bf16(sreg[blk][2 * s2][0], sreg[blk][2 * s2][1]); pw[1] = cvt_pk_bf16(sreg[blk][2 * s2][2], sreg[blk][2 * s2][3]);
                        pw[2] = cvt_pk_bf16(sreg[blk][2 * s2 + 1][0], sreg[blk][2 * s2 + 1][1]); pw[3] = cvt_pk_bf16(sreg[blk][2 * s2 + 1][2], sreg[blk][2 * s2 + 1][3]);
                        const bf16x8 pf = __builtin_bit_cast(bf16x8, pw);
#pragma unroll
                        for (int dt = 0; dt < 4; ++dt) {
                            const LAS unsigned char* vp = (const LAS unsigned char*)VT + ((32 * s2 + 8 * quadc + (l15c >> 2)) * 72) * 2 + dt * 32 + (l15c & 3) * 8;
                            const v4i16_t t0 = __builtin_amdgcn_ds_read_tr16_b64_v4i16((LAS v4i16_t*)vp);
                            const v4i16_t t1 = __builtin_amdgcn_ds_read_tr16_b64_v4i16((LAS v4i16_t*)(vp + 4 * 72 * 2));
                            const bf16x8 af2 = (bf16x8){t0[0], t0[1], t0[2], t0[3], t1[0], t1[1], t1[2], t1[3]};
                            oacc[dt] = __builtin_amdgcn_mfma_f32_16x16x32_bf16(af2, pf, oacc[dt], 0, 0, 0);
                        }
                    }
                    lds_order();
                }
            }
            if (l15c < 4) {
                bf16_t* yo = (DUMMY || dummy_c) ? ((bf16_t*)(ws + WS_MG + 48 * MiB) + (r0 + qi) * 512 + (g * 4 + l15c) * 64 + quadc * 4) : (P + (r0 + qi) * LDP + C_AQ + (g * 4 + l15c) * 64 + quadc * 4);
#pragma unroll
                for (int dt = 0; dt < 4; ++dt) {
                    const f32x4 v = oacc[dt] * invs;
                    u32x2 w; w[0] = cvt_pk_bf16(v[0], v[1]); w[1] = cvt_pk_bf16(v[2], v[3]);
                    *(u32x2*)(yo + dt * 16) = w;
                }
            }
        }
        lds_fence(); __builtin_amdgcn_s_barrier();
    }
#undef DSA_LOAD_ITEM
}

__device__ __forceinline__ float logsigmoidf_(float x) { return fminf(x, 0.f) - log1pf(__expf(-fabsf(x))); }
#define DPP_F(x, ident, ctrl, rmask) __int_as_float(__builtin_amdgcn_update_dpp(__float_as_int(ident), __float_as_int(x), ctrl, rmask, 0xf, false))
__device__ __forceinline__ float wave_incl_sum(float v, int lane) {
    (void)lane;
    v += DPP_F(v, 0.f, 0x111, 0xf); v += DPP_F(v, 0.f, 0x112, 0xf); v += DPP_F(v, 0.f, 0x114, 0xf); v += DPP_F(v, 0.f, 0x118, 0xf);
    v += DPP_F(v, 0.f, 0x142, 0xa); v += DPP_F(v, 0.f, 0x143, 0xc);
    return v;
}
__device__ __forceinline__ float wave_incl_max(float v, int lane) {
    (void)lane;
    const float ninf = -INFINITY;
    v = fmaxf(v, DPP_F(v, ninf, 0x111, 0xf)); v = fmaxf(v, DPP_F(v, ninf, 0x112, 0xf)); v = fmaxf(v, DPP_F(v, ninf, 0x114, 0xf)); v = fmaxf(v, DPP_F(v, ninf, 0x118, 0xf));
    v = fmaxf(v, DPP_F(v, ninf, 0x142, 0xa)); v = fmaxf(v, DPP_F(v, ninf, 0x143, 0xc));
    return v;
}
__device__ __forceinline__ f32x4 mma_lds(const bf16_t* A, int lda, const bf16_t* Bt, int ldb, int K, int lane) {
    f32x4 acc = (f32x4){0.f, 0.f, 0.f, 0.f};
    const bf16_t* ap = A + (lane & 15) * lda + (lane >> 4) * 8; const bf16_t* bp = Bt + (lane & 15) * ldb + (lane >> 4) * 8;
    for (int k = 0; k < K; k += 32) acc = __builtin_amdgcn_mfma_f32_16x16x32_bf16(*(const bf16x8*)(ap + k), *(const bf16x8*)(bp + k), acc, 0, 0, 0);
    return acc;
}

__device__ __forceinline__ void phase_mlstm_a(const Args& a, unsigned char* lds) {
    unsigned char* ws = a.ws;
    const bf16_t* P = (const bf16_t*)(ws + WS_P); const bf16_t* QK = (const bf16_t*)(ws + WS_QK); const float* SM = (const float*)(ws + WS_SM);
    bf16_t* ST = (bf16_t*)(ws + WS_XB); float* DN = (float*)(ws + WS_DN); float* ML = (float*)(ws + WS_ML); float* BL = (float*)(ws + WS_BL);
    bf16_t* VT = (bf16_t*)lds;
    bf16_t* KT = (bf16_t*)(lds + 18432);
    float* WS_ = (float*)(lds + 18432 + 9216);
    const int tid = threadIdx.x, wave = tid >> 6, lane = tid & 63;
    for (int item = blockIdx.x; item < 4096; item += gridDim.x) {
        const int c = item & 127, h = (item >> 7) & 3, b = item >> 9;
        const size_t r0 = (size_t)b * SEQ + c * 64;
        if (wave == 0) {
            const float ig = SM[(r0 + lane) * 16 + 8 + h] + a.in[I_BI][h];
            const float lf = logsigmoidf_(SM[(r0 + lane) * 16 + 12 + h] + a.in[I_BF][h]);
            const float bs = wave_incl_sum(lf, lane);
            const float bl = __shfl(bs, 63);
            const float wk = bl - bs + ig;
            const float ml = wave_max(wk);
            WS_[lane] = __expf(wk - ml);
            if (lane == 0) { ML[item] = ml; BL[item] = bl; }
        }
        for (int i = tid; i < 1024; i += 512) { const int s = i >> 4, d0 = (i & 15) * 8; float f[8]; unpack8(*(const u32x4*)(P + (r0 + s) * LDP + C_MV + h * 128 + d0), f);
#pragma unroll
            for (int e = 0; e < 8; ++e) VT[(d0 + e) * 72 + s] = f2bf(f[e]); }
        __syncthreads();
        { const int s = tid >> 3, d0 = (tid & 7) * 8; float f[8]; unpack8(*(const u32x4*)(QK + (r0 + s) * 512 + 256 + h * 64 + d0), f); const float w = WS_[s];
#pragma unroll
            for (int e = 0; e < 8; ++e) KT[(d0 + e) * 72 + s] = f2bf(f[e] * w); }
        __syncthreads();
        bf16_t* st = ST + (size_t)item * 8192;
#pragma unroll
        for (int nt = 0; nt < 4; ++nt) {
            const f32x4 acc = mma_lds(VT + wave * 16 * 72, 72, KT + nt * 16 * 72, 72, 64, lane);
#pragma unroll
            for (int j = 0; j < 4; ++j) st[(wave * 16 + (lane >> 4) * 4 + j) * 64 + nt * 16 + (lane & 15)] = f2bf_sw(acc[j]);
        }
        if (tid < 64) { float s = 0.f; for (int k = 0; k < 64; ++k) s += bf1(KT[tid * 72 + k]); DN[item * 64 + tid] = s; }
        __syncthreads();
    }
}
__device__ __forceinline__ void phase_mlstm_b(const Args& a) {
    unsigned char* ws = a.ws;
    unsigned* ST2 = (unsigned*)(ws + WS_XB);
    float* DN = (float*)(ws + WS_DN); const float* ML = (const float*)(ws + WS_ML); const float* BL = (const float*)(ws + WS_BL); float* MS = (float*)(ws + WS_MS);
    const int total = 32 * 4160;
    for (int w = blockIdx.x * 512 + threadIdx.x; w < total; w += gridDim.x * 512) {
        const int bh = w / 4160, e = w % 4160;
        if (e < 4096) {
            unsigned* p = ST2 + (size_t)bh * 128 * 4096 + e;
            float C0 = 0.f, C1 = 0.f, m = 0.f;
            for (int c0 = 0; c0 < 128; c0 += 8) {
                unsigned d[8]; float bl[8], ml[8];
#pragma unroll
                for (int u = 0; u < 8; ++u) { d[u] = p[(size_t)(c0 + u) * 4096]; bl[u] = BL[bh * 128 + c0 + u]; ml[u] = ML[bh * 128 + c0 + u]; }
#pragma unroll
                for (int u = 0; u < 8; ++u) {
                    p[(size_t)(c0 + u) * 4096] = cvt_pk_bf16(C0, C1);
                    if (e == 0) MS[bh * 128 + c0 + u] = m;
                    const float mn = fmaxf(bl[u] + m, ml[u]);
                    const float wc = __expf(bl[u] + m - mn), wd = __expf(ml[u] - mn);
                    C0 = wc * C0 + wd * bflo(d[u]); C1 = wc * C1 + wd * bfhi(d[u]);
                    m = mn;
                }
            }
        } else {
            float* p = DN + (size_t)bh * 128 * 64 + (e - 4096);
            float C = 0.f, m = 0.f;
            for (int c0 = 0; c0 < 128; c0 += 8) {
                float d[8], bl[8], ml[8];
#pragma unroll
                for (int u = 0; u < 8; ++u) { d[u] = p[(size_t)(c0 + u) * 64]; bl[u] = BL[bh * 128 + c0 + u]; ml[u] = ML[bh * 128 + c0 + u]; }
#pragma unroll
                for (int u = 0; u < 8; ++u) {
                    p[(size_t)(c0 + u) * 64] = C;
                    const float mn = fmaxf(bl[u] + m, ml[u]);
                    C = __expf(bl[u] + m - mn) * C + __expf(ml[u] - mn) * d[u];
                    m = mn;
                }
            }
        }
    }
}
__device__ __forceinline__ void phase_mlstm_c(const Args& a, unsigned char* lds) {
    unsigned char* ws = a.ws;
    bf16_t* P = (bf16_t*)(ws + WS_P); const bf16_t* QK = (const bf16_t*)(ws + WS_QK); const float* SM = (const float*)(ws + WS_SM);
    const bf16_t* ST = (const bf16_t*)(ws + WS_XB); const float* DN = (const float*)(ws + WS_DN); const float* MS = (const float*)(ws + WS_MS);
    bf16_t* QS_ = (bf16_t*)lds;
    bf16_t* KS = (bf16_t*)(lds + 9216);
    bf16_t* AP = (bf16_t*)(lds + 18432);
    bf16_t* BT = (bf16_t*)(lds + 18432 + 17408);
    float* OUT = (float*)(lds + 18432 + 17408 + 34816);
    float* GS = (float*)(lds + 18432 + 17408 + 34816 + 33792);
    float* bS = GS; float* aS = GS + 64; float* mtS = GS + 128; float* wiS = GS + 192; float* nS = GS + 256; float* denS = GS + 320;
    const int tid = threadIdx.x, wave = tid >> 6, lane = tid & 63;
    for (int item = blockIdx.x; item < 4096; item += gridDim.x) {
        const int c = item & 127, h = (item >> 7) & 3, b = item >> 9;
        const size_t r0 = (size_t)b * SEQ + c * 64;
        if (wave == 0) {
            const float ig = SM[(r0 + lane) * 16 + 8 + h] + a.in[I_BI][h];
            const float lf = logsigmoidf_(SM[(r0 + lane) * 16 + 12 + h] + a.in[I_BF][h]);
            const float bs = wave_incl_sum(lf, lane);
            const float av = ig - bs;
            const float pm = wave_incl_max(av, lane);
            const float m0 = MS[item];
            const float mt = bs + fmaxf(pm, m0);
            bS[lane] = bs; aS[lane] = av; mtS[lane] = mt; wiS[lane] = __expf(bs + m0 - mt);
            nS[lane] = DN[item * 64 + lane];
        }
        { const int s = tid >> 3, d0 = (tid & 7) * 8;
            *(u32x4*)(QS_ + s * 72 + d0) = *(const u32x4*)(QK + (r0 + s) * 512 + h * 64 + d0);
            *(u32x4*)(KS + s * 72 + d0) = *(const u32x4*)(QK + (r0 + s) * 512 + 256 + h * 64 + d0); }
        for (int i = tid; i < 1024; i += 512) { const int s = i >> 4, d0 = (i & 15) * 8; float f[8]; unpack8(*(const u32x4*)(P + (r0 + s) * LDP + C_MV + h * 128 + d0), f);
#pragma unroll
            for (int e = 0; e < 8; ++e) BT[(d0 + e) * 136 + s] = f2bf(f[e]); }
        { const bf16_t* st = ST + (size_t)item * 8192;
            for (int i = tid; i < 1024; i += 512) { const int dv = i >> 3, k0 = (i & 7) * 8; *(u32x4*)(BT + dv * 136 + 64 + k0) = *(const u32x4*)(st + dv * 64 + k0); } }
        __syncthreads();
#pragma unroll
        for (int u = 0; u < 2; ++u) {
            const int id = wave * 2 + u, tr = id >> 2, tc = id & 3;
            f32x4 acc = (f32x4){0.f, 0.f, 0.f, 0.f};
            if (tc <= tr) acc = mma_lds(QS_ + tr * 16 * 72, 72, KS + tc * 16 * 72, 72, 64, lane);
            const int s = tc * 16 + (lane & 15);
#pragma unroll
            for (int j = 0; j < 4; ++j) { const int t = tr * 16 + (lane >> 4) * 4 + j;
                const float w = (s <= t) ? acc[j] * __expf(bS[t] + aS[s] - mtS[t]) : 0.f;
                AP[t * 136 + s] = f2bf(w); }
        }
        { const int t = tid >> 3, d0 = (tid & 7) * 8; float f[8]; unpack8(*(const u32x4*)(QS_ + t * 72 + d0), f); const float w = wiS[t];
#pragma unroll
            for (int e = 0; e < 8; ++e) f[e] *= w;
            *(u32x4*)(AP + t * 136 + 64 + d0) = pack8(f); }
        __syncthreads();
#pragma unroll
        for (int tr = 0; tr < 4; ++tr) {
            const f32x4 acc = mma_lds(AP + tr * 16 * 136, 136, BT + wave * 16 * 136, 136, 128, lane);
#pragma unroll
            for (int j = 0; j < 4; ++j) OUT[(tr * 16 + (lane >> 4) * 4 + j) * 132 + wave * 16 + (lane & 15)] = acc[j];
        }
        { const int t = tid >> 3, part = tid & 7; float s = 0.f;
#pragma unroll
            for (int e = 0; e < 16; ++e) { const int k = part * 16 + e; const float v = bf1(AP[t * 136 + k]); s += (k < 64) ? v : v * nS[k - 64]; }
            s += __shfl_xor(s, 1); s += __shfl_xor(s, 2); s += __shfl_xor(s, 4);
            if (part == 0) denS[t] = s; }
        __syncthreads();
        { const int t = tid >> 3, part = tid & 7, dv0 = part * 16;
            const float den = fmaxf(fabsf(denS[t]), __expf(-mtS[t])); const float inv = 1.f / den;
            float hv[16]; float sq = 0.f;
#pragma unroll
            for (int e = 0; e < 16; ++e) { hv[e] = OUT[t * 132 + dv0 + e] * inv; sq += hv[e] * hv[e]; }
            sq += __shfl_xor(sq, 1); sq += __shfl_xor(sq, 2); sq += __shfl_xor(sq, 4);
            const float rs = rsqrtf(sq * (1.f / 128.f) + EPS);
            bf16_t* po = P + (r0 + t) * LDP + C_MO + h * 128 + dv0;
            float og[16]; unpack8(*(const u32x4*)po, og); unpack8(*(const u32x4*)(po + 8), og + 8);
#pragma unroll
            for (int e = 0; e < 16; ++e) hv[e] = hv[e] * rs * a.in[I_MHN][h * 128 + dv0 + e] * sigmoidf_(og[e]);
            *(u32x4*)po = pack8(hv); *(u32x4*)(po + 8) = pack8(hv + 8); }
        __syncthreads();
    }
}


#define XB_TMO      128
#define XB_XCNT(j)  (256  + 64 * (j))
#define XB_XSUB(j)  (1280 + 64 * (j))
#define XB_XGEN(j)  (2304 + 64 * (j))
#define XB_TOP      3328
#define XB_TOPGEN   3392
#define XCD_BAR_WORDS 3456
#define XB_SPIN_CAP (1u << 22)
__device__ __forceinline__ unsigned xb_ld(unsigned* p)              { return __hip_atomic_load(p, __ATOMIC_RELAXED, __HIP_MEMORY_SCOPE_AGENT); }
__device__ __forceinline__ unsigned xb_add(unsigned* p, unsigned v) { return __hip_atomic_fetch_add(p, v, __ATOMIC_RELAXED, __HIP_MEMORY_SCOPE_AGENT); }
__device__ __forceinline__ unsigned xb_xcc_id() { return (unsigned)__builtin_amdgcn_s_getreg((3 << 11) | 20) & 0xFu; }
#define XB_SPIN(cond, bar) do { unsigned _sp = 0; while (cond) { __builtin_amdgcn_s_sleep(1); \
    if ((++_sp & 255u) == 0u) { if (xb_ld(&(bar)[XB_TMO])) break; if (_sp > XB_SPIN_CAP) { atomicAdd(&(bar)[XB_TMO], 1u); break; } } } } while (0)
struct XcdBarrier { unsigned* bar; unsigned x; volatile LAS unsigned* st; };
__device__ __forceinline__ XcdBarrier xcd_barrier_post(unsigned* bar, volatile LAS unsigned* st) {
    XcdBarrier b; b.bar = bar; b.x = xb_xcc_id(); b.st = st;
    if (threadIdx.x == 0) (void)xb_add(&bar[XB_XCNT(b.x)], 1u);
    return b;
}
__device__ __forceinline__ void xcd_barrier_complete(unsigned* bar, unsigned x, unsigned& nloc, unsigned& nx) {
    const unsigned G = gridDim.x * gridDim.y * gridDim.z;
    unsigned sum, cnt, mine, sp = 0u;
    for (;;) {
        sum = 0u; cnt = 0u; mine = 0u;
#pragma unroll
        for (unsigned j = 0; j < 16; ++j) { const unsigned c = xb_ld(&bar[XB_XCNT(j)]); sum += c; cnt += (c > 0u) ? 1u : 0u; mine = (j == x) ? c : mine; }
        if (sum == G) break;
        __builtin_amdgcn_s_sleep(1);
        if ((++sp & 255u) == 0u) { if (xb_ld(&bar[XB_TMO])) break; if (sp > XB_SPIN_CAP) { atomicAdd(&bar[XB_TMO], 1u); break; } }
    }
    nloc = mine > 0u ? mine : 1u; nx = cnt > 0u ? cnt : 1u;
}
__device__ __forceinline__ void xcd_barrier(const XcdBarrier& b) {
    asm volatile("s_waitcnt vmcnt(0)" ::: "memory");
    __syncthreads();
    if (threadIdx.x == 0) {
        unsigned* bar = b.bar;
        __builtin_amdgcn_s_waitcnt(0);
        unsigned nloc = b.st[0], nx = b.st[1];
        if (nloc == 0u) { xcd_barrier_complete(bar, b.x, nloc, nx); b.st[0] = nloc; b.st[1] = nx; }
        const unsigned old = xb_add(&bar[XB_XSUB(b.x)], 1u);
        const unsigned gen = old / nloc;
        if (old + 1u == (gen + 1u) * nloc) {
            __builtin_amdgcn_fence(__ATOMIC_RELEASE, "agent");
            asm volatile("s_waitcnt vmcnt(0)" ::: "memory");
            const unsigned og = xb_add(&bar[XB_TOP], 1u);
            const unsigned tg = og / nx;
            if (og + 1u == (tg + 1u) * nx) xb_add(&bar[XB_TOPGEN], 1u);
            else XB_SPIN(xb_ld(&bar[XB_TOPGEN]) == tg, bar);
            __builtin_amdgcn_fence(__ATOMIC_ACQUIRE, "agent");
            xb_add(&bar[XB_XGEN(b.x)], 1u);
            asm volatile("s_waitcnt vmcnt(0)" ::: "memory");
        } else {
            XB_SPIN(xb_ld(&bar[XB_XGEN(b.x)]) == gen, bar);
            __builtin_amdgcn_fence(__ATOMIC_ACQUIRE, "agent");
            asm volatile("s_waitcnt vmcnt(0)" ::: "memory");
        }
    }
    __syncthreads();
}

#ifndef DBG_ZERO_YA
#define DBG_ZERO_YA 1
#endif
#ifndef PH
#define PH 0xFFFF
#endif
__global__ void __launch_bounds__(512, 2) mega_fwd(Args a) {
    extern __shared__ __attribute__((aligned(16))) unsigned char lds[];
    cg::grid_group grid = cg::this_grid();
    LAS unsigned char* ldsl = (LAS unsigned char*)lds;
    unsigned char* ws = a.ws;
    const int G = gridDim.x, bid = blockIdx.x;
    bf16_t* XB = (bf16_t*)(ws + WS_XB); bf16_t* Pb = (bf16_t*)(ws + WS_P); bf16_t* MG = (bf16_t*)(ws + WS_MG); bf16_t* QKb = (bf16_t*)(ws + WS_QK);
    float* ss0 = (float*)(ws + WS_SS0); float* ss1 = (float*)(ws + WS_SS1); float* ss2 = (float*)(ws + WS_SS2);

    unsigned* barw = (unsigned*)(ws + WS_BAR);
    volatile LAS unsigned* bst = (volatile LAS unsigned*)(ldsl + LDS_BYTES - 16);
    if (threadIdx.x == 0) { bst[0] = 0u; bst[1] = 0u; }
    const XcdBarrier xbar = xcd_barrier_post(barw, bst);
    if (PH & 1) phase0(a, lds);
    if (a.ws == nullptr) grid.sync();
    xcd_barrier(xbar);
    if (PH & 2) {
        pg8::Gemm g{XB, (const bf16_t*)(ws + WS_W1), DM, DM, MROWS, 2 * FF, DM}; pg8::StaticOrder S; S.init(MROWS, 2 * FF, G, bid);
        pg8::EpiSwiGLU E{Pb, ss0}; pg8::gemm_phase(ldsl, g, S, E);
    }
    xcd_barrier(xbar);
    if (PH & 4) {
        pg8::Gemm g{Pb, (const bf16_t*)(ws + WS_W2), FF, FF, MROWS, DM, FF}; pg8::StaticOrder S; S.init(MROWS, DM, G, bid);
        pg8::EpiRes<false, false, true> E{a.in[I_X], nullptr, nullptr, XB, (bf16_t*)a.out, ss1, 0.5f}; pg8::gemm_phase(ldsl, g, S, E);
    }
    xcd_barrier(xbar);
    if (PH & 8) {
        pg8::Gemm g{XB, (const bf16_t*)(ws + WS_WIN), DM, DM, MROWS, LDP, DM}; pg8::StaticOrder S; S.init(MROWS, LDP, G, bid);
        pg8::EpiP E{Pb, (float*)(ws + WS_SM), ss1}; pg8::gemm_phase(ldsl, g, S, E);
    }
    xcd_barrier(xbar);
    if (PH & 16) phase_postp(a);
    xcd_barrier(xbar);
    if (PH & 32) {
        pg8::Gemm g{XB, (const bf16_t*)(ws + WS_WQK), 512, 512, MROWS, 512, 512}; pg8::StaticOrder S; S.init(MROWS, 512, G, bid);
        pg8::EpiBf16 E{QKb, 512}; pg8::gemm_phase(ldsl, g, S, E);
    }
    xcd_barrier(xbar);
    if (PH & 64) phase_mlstm_a(a, lds);
    xcd_barrier(xbar);
    if (PH & 128) phase_mlstm_b(a);
    xcd_barrier(xbar);
    if (PH & 256) phase_mlstm_c(a, lds);
    if (DBG_TWICE & 1) phase_dsa<true>(a, lds);
    if (PH & 512) phase_dsa<false>(a, lds);
    xcd_barrier(xbar);
    if (PH & 1024) {
        pg8::StaticOrder S; S.init(MROWS, DM, G, bid);
        { pg8::Gemm g{Pb + C_AQ, (const bf16_t*)(ws + WS_WA), LDP, 512, MROWS, DM, 512}; pg8::EpiMerge<0> E{Pb, MG, C_GA}; pg8::gemm_phase(ldsl, g, S, E); }
        { pg8::Gemm g{Pb + C_MO, (const bf16_t*)(ws + WS_WB), LDP, 512, MROWS, DM, 512}; pg8::EpiMerge<1> E{Pb, MG, C_GB}; pg8::gemm_phase(ldsl, g, S, E); }
    }
    xcd_barrier(xbar);
    if (PH & 2048) {
        pg8::Gemm g{MG, (const bf16_t*)(ws + WS_WO), DM, DM, MROWS, DM, DM}; pg8::StaticOrder S; S.init(MROWS, DM, G, bid);
        pg8::EpiRes<true, false, true> E{nullptr, (const bf16_t*)a.out, nullptr, XB, nullptr, ss2, 1.0f}; pg8::gemm_phase(ldsl, g, S, E);
    }
    xcd_barrier(xbar);
    if (PH & 4096) {
        pg8::Gemm g{XB, (const bf16_t*)(ws + WS_W3), DM, DM, MROWS, 2 * FF, DM}; pg8::StaticOrder S; S.init(MROWS, 2 * FF, G, bid);
        pg8::EpiSwiGLU E{Pb, ss2}; pg8::gemm_phase(ldsl, g, S, E);
    }
    xcd_barrier(xbar);
    if (PH & 8192) {
        pg8::Gemm g{Pb, (const bf16_t*)(ws + WS_W4), FF, FF, MROWS, DM, FF}; pg8::StaticOrder S; S.init(MROWS, DM, G, bid);
        pg8::EpiRes<true, true, false> E{nullptr, XB, a.out, nullptr, nullptr, nullptr, 0.5f}; pg8::gemm_phase(ldsl, g, S, E);
    }
}

extern "C" void kernel_launch(void* const* d_in, const int* in_sizes, int n_in, void* d_out, int out_size, void* d_ws, size_t ws_size, hipStream_t stream) {
    static int grid = 0;
    if (grid == 0) {
        if (n_in != 24 || ws_size < WS_END) { fprintf(stderr, "kernel_launch: unexpected n_in %d / ws %zu\n", n_in, ws_size); grid = -1; return; }
        int dev = 0, cus = 0, per_cu = 0;
        hipGetDevice(&dev);
        hipDeviceGetAttribute(&cus, hipDeviceAttributeMultiprocessorCount, dev);
        hipFuncSetAttribute((const void*)mega_fwd, hipFuncAttributeMaxDynamicSharedMemorySize, LDS_BYTES);
        hipOccupancyMaxActiveBlocksPerMultiprocessor(&per_cu, (const void*)mega_fwd, 512, LDS_BYTES);
        if (per_cu < 1) { fprintf(stderr, "kernel_launch: occupancy query says %d blocks/CU\n", per_cu); per_cu = 1; }
        (void)hipGetLastError();
        grid = cus * per_cu;
    }
    if (grid < 0) return;
    Args a{};
    for (int i = 0; i < 24; ++i) a.in[i] = (const float*)d_in[i];
    a.out = (float*)d_out; a.ws = (unsigned char*)d_ws;
    (void)hipMemsetAsync((char*)d_ws + WS_BAR, 0, XCD_BAR_WORDS * sizeof(unsigned), stream);
    void* args[] = {&a};
    hipError_t e = hipLaunchCooperativeKernel((const void*)mega_fwd, dim3(grid), dim3(512), args, LDS_BYTES, stream);
    if (e != hipSuccess) fprintf(stderr, "cooperative launch failed: %s (grid %d)\n", hipGetErrorString(e), grid);
}
```

```cpp
#include <hip/hip_runtime.h>
#include <hip/hip_cooperative_groups.h>
#include <cstdio>
#include <cstdint>
namespace cg = cooperative_groups;
#define DBG_ZERO_YA 0
#define DBG_TWICE 0
#define DBG_NOSEL 0

#define LAS __attribute__((address_space(3)))
typedef unsigned short bf16_t;
typedef short bf16x8 __attribute__((ext_vector_type(8)));
typedef float f32x4 __attribute__((ext_vector_type(4)));
typedef unsigned u32x4 __attribute__((ext_vector_type(4)));
typedef unsigned u32x2 __attribute__((ext_vector_type(2)));
typedef __bf16 bf2_t __attribute__((ext_vector_type(2)));
typedef short v4i16_t __attribute__((ext_vector_type(4)));

constexpr int MROWS = 65536, DM = 1024, FF = 2816, SEQ = 8192, NB = 8;
constexpr int LDP = 5120;
constexpr int C_AQ = 0, C_AK = 512, C_AV = 640, C_IQ = 768, C_IK = 1280, C_MX = 1344, C_MV = 1856, C_MO = 2368, C_GA = 2880, C_GB = 3904, C_SM = 4928;
constexpr float EPS = 1e-6f;
constexpr size_t MiB = 1u << 20;
constexpr size_t WS_SS0 = 0, WS_SS1 = 256 * 1024, WS_SS2 = 512 * 1024;
constexpr size_t WS_DN = 1 * MiB;
constexpr size_t WS_ML = 2 * MiB, WS_BL = 2 * MiB + 16384, WS_MS = 2 * MiB + 32768;
constexpr size_t WS_BAR = 2 * MiB + 65536;
constexpr size_t WS_SM = 3 * MiB;
constexpr size_t WS_W1 = 8 * MiB, WS_W2 = 19 * MiB, WS_W3 = 25 * MiB, WS_W4 = 36 * MiB, WS_WIN = 42 * MiB, WS_WA = 52 * MiB, WS_WB = 53 * MiB, WS_WO = 54 * MiB, WS_WQK = 56 * MiB;
constexpr size_t WS_XB = 64 * MiB;
constexpr size_t WS_P = 192 * MiB;
constexpr size_t WS_MG = 832 * MiB;
constexpr size_t WS_IKC = 832 * MiB;
constexpr size_t WS_KVC = 840 * MiB;
constexpr size_t WS_QK = 960 * MiB;
constexpr size_t WS_END = 1024 * MiB;
constexpr int LDS_BYTES = 156 * 1024;

__device__ __forceinline__ unsigned cvt_pk_bf16(float lo, float hi) { unsigned r; asm volatile("v_cvt_pk_bf16_f32 %0, %1, %2" : "=v"(r) : "v"(lo), "v"(hi)); return r; }
__device__ __forceinline__ float bflo(unsigned u) { return __uint_as_float(u << 16); }
__device__ __forceinline__ float bfhi(unsigned u) { return __uint_as_float(u & 0xffff0000u); }
__device__ __forceinline__ float bf1(bf16_t u) { return __uint_as_float(((unsigned)u) << 16); }
__device__ __forceinline__ bf16_t f2bf(float f) { return (bf16_t)(cvt_pk_bf16(f, 0.f) & 0xffffu); }
__device__ __forceinline__ bf16_t f2bf_sw(float f) { const unsigned u = __float_as_uint(f); return (bf16_t)((u + 0x7fffu + ((u >> 16) & 1u)) >> 16); }
__device__ __forceinline__ float wave_sum(float v) {
#pragma unroll
    for (int o = 1; o < 64; o <<= 1) v += __shfl_xor(v, o);
    return v;
}
__device__ __forceinline__ float wave_max(float v) {
#pragma unroll
    for (int o = 1; o < 64; o <<= 1) v = fmaxf(v, __shfl_xor(v, o));
    return v;
}
__device__ __forceinline__ float sigmoidf_(float x) { return __builtin_amdgcn_rcpf(1.f + __expf(-x)); }
__device__ __forceinline__ float dot2bf(unsigned a, unsigned b, float c) { const unsigned aa = a, bb = b; return __builtin_amdgcn_fdot2_f32_bf16(__builtin_bit_cast(bf2_t, aa), __builtin_bit_cast(bf2_t, bb), c, false); }
__device__ __forceinline__ float relu_(float x) { const int i = __float_as_int(x); return __int_as_float(i > 0 ? i : 0); }
__device__ __forceinline__ void lds_order() { asm volatile("" ::: "memory"); }
__device__ __forceinline__ void lds_fence() { asm volatile("s_waitcnt lgkmcnt(0)" ::: "memory"); }
__device__ __forceinline__ void unpack8(u32x4 v, float* f) {
    f[0] = bflo(v.x); f[1] = bfhi(v.x); f[2] = bflo(v.y); f[3] = bfhi(v.y); f[4] = bflo(v.z); f[5] = bfhi(v.z); f[6] = bflo(v.w); f[7] = bfhi(v.w);
}
__device__ __forceinline__ u32x4 pack8(const float* f) {
    u32x4 o; o.x = cvt_pk_bf16(f[0], f[1]); o.y = cvt_pk_bf16(f[2], f[3]); o.z = cvt_pk_bf16(f[4], f[5]); o.w = cvt_pk_bf16(f[6], f[7]); return o;
}

namespace pg8 {
constexpr int BM = 256, BK = 64, HALF = 128, HTB = HALF * BK * 2, NXCD = 8, WGM = 8;
__host__ __device__ __forceinline__ int lds_byte(int r, int c) { const int st = (r >> 4) * 2 + (c >> 5), rr = r & 15, cc = c & 31, ob = rr * 64 + cc * 2; return st * 1024 + (ob ^ (((ob >> 9) & 1) << 5)); }
__host__ __device__ __forceinline__ void stage_rc(int b, int& R, int& C) { const int st = b / 1024, sb = b % 1024, swz = sb ^ (((sb >> 9) & 1) << 5); R = (st >> 1) * 16 + swz / 64; C = (st & 1) * 32 + (swz % 64) / 2; }
__host__ __device__ __forceinline__ int perm32(int rho) { const int n = rho >> 4, i = rho & 15; return 8 * (i >> 2) + 4 * n + (i & 3); }
struct Unit { int pm, pn; };
struct Gemm { const bf16_t* A; const bf16_t* Bt; int lda, ldb, M, N, K; };
struct StaticOrder {
    int nM, nN, nwg, G, c;
    __device__ void init(int M, int N, int G_, int c_) { nM = M / BM; nN = N / BM; nwg = nM * nN; G = G_; c = c_; }
    __device__ bool next(int i, Unit& u) const {
        const long L = (long)i * G + c; if (L >= nwg) return false;
        int wgid = (int)L; { const int q = nwg / NXCD, r = nwg % NXCD, xcd = wgid % NXCD, off = wgid / NXCD; wgid = (xcd < r ? xcd * (q + 1) : r * (q + 1) + (xcd - r) * q) + off; }
        const int nig = WGM * nN, gid = wgid / nig, fm = gid * WGM, gsz = (nM - fm) < WGM ? (nM - fm) : WGM;
        u.pm = fm + ((wgid % nig) % gsz); u.pn = (wgid % nig) / gsz; return true;
    }
};

template <class Epi>
__device__ __forceinline__ void gemm_phase(LAS unsigned char* lds, const Gemm g, const StaticOrder& S, const Epi& E) {
    int tid_ = threadIdx.x; asm volatile("" : "+v"(tid_));
    const int tid = tid_, wid = __builtin_amdgcn_readfirstlane(tid >> 6), lane = tid & 63, wr = wid >> 2, wc = wid & 3, fr = lane & 15, fq = lane >> 4;
    const int K = g.K, nt = K / BK;
    unsigned voffA[2], voffB[2];
#pragma unroll
    for (int i = 0; i < 2; ++i) { int R, C; stage_rc(tid * 16 + i * 8192, R, C); const int Rb = (R & ~31) + perm32(R & 31);
        voffA[i] = (unsigned)(R * g.lda + C) * 2u; voffB[i] = (unsigned)(Rb * g.ldb + C) * 2u; }
    const size_t kstep = (size_t)(BK * 2);
    const size_t hsA = (size_t)HALF * g.lda * 2, hsB = (size_t)HALF * g.ldb * 2;
    const size_t tsA = 2 * hsA, tsB = 2 * hsB;
    const unsigned ldsw = (unsigned)wid * 1024u;
    const int aoff = lds_byte(wr * 64 + fr, fq * 8), boff = lds_byte(wc * 32 + fr, fq * 8);
#define PG8_SA(b, h) (((b) * 2 + (h)) * HTB)
#define PG8_SB(b, h) ((4 + (b) * 2 + (h)) * HTB)
#define PG8_STAGE(bufoff, gbase, voff) do { _Pragma("unroll") for (int _i = 0; _i < 2; ++_i) \
        __builtin_amdgcn_global_load_lds((const unsigned*)((const char*)(gbase) + (voff)[_i]), (LAS unsigned*)(lds + (bufoff) + ldsw + _i * 8192), 16, 0, 0); } while (0)
#define PG8_LDA(dst, b, h) do { _Pragma("unroll") for (int m = 0; m < 4; ++m) _Pragma("unroll") for (int k = 0; k < 2; ++k) dst[m][k] = *(const LAS bf16x8*)(lds + PG8_SA(b, h) + aoff + m * 2048 + k * 1024); } while (0)
#define PG8_LDB(dst, b, h) do { _Pragma("unroll") for (int n = 0; n < 2; ++n) _Pragma("unroll") for (int k = 0; k < 2; ++k) dst[n][k] = *(const LAS bf16x8*)(lds + PG8_SB(b, h) + boff + n * 2048 + k * 1024); } while (0)
#define PG8_MMA(ai, bj, At, Bt) do { __builtin_amdgcn_s_setprio(1); _Pragma("unroll") for (int m = 0; m < 4; ++m) _Pragma("unroll") for (int n = 0; n < 2; ++n) _Pragma("unroll") for (int k = 0; k < 2; ++k) \
        acc[ai][bj][m][n] = __builtin_amdgcn_mfma_f32_16x16x32_bf16(Bt[n][k], At[m][k], acc[ai][bj][m][n], 0, 0, 0); __builtin_amdgcn_s_setprio(0); } while (0)
#define PG8_WAIT_V(n) asm volatile("s_waitcnt vmcnt(" #n ")" ::: "memory")
#define PG8_WAIT_L(n) asm volatile("s_waitcnt lgkmcnt(" #n ")" ::: "memory")
#define PG8_BAR __builtin_amdgcn_s_barrier()
#define PG8_SCHED __builtin_amdgcn_sched_barrier(0)
    Unit cur, nxt; int ui = 0;
    if (!S.next(0, cur)) return;
    f32x4 acc[2][2][4][2];
#pragma unroll
    for (int a = 0; a < 2; ++a)
#pragma unroll
        for (int b = 0; b < 2; ++b)
#pragma unroll
            for (int m = 0; m < 4; ++m)
#pragma unroll
                for (int n = 0; n < 2; ++n) acc[a][b][m][n] = (f32x4){0.f, 0.f, 0.f, 0.f};
    bf16x8 At[4][2], B0[2][2], B1[2][2];
    const char* cA = (const char*)g.A + (size_t)cur.pm * tsA; const char* cB = (const char*)g.Bt + (size_t)cur.pn * tsB;
    PG8_STAGE(PG8_SB(0, 0), cB, voffB); PG8_STAGE(PG8_SB(0, 1), cB + hsB, voffB); PG8_STAGE(PG8_SA(0, 0), cA, voffA); PG8_STAGE(PG8_SA(0, 1), cA + hsA, voffA);
    if (wr == 1) PG8_BAR;
    PG8_WAIT_V(2); PG8_BAR;
    PG8_STAGE(PG8_SB(1, 0), cB + kstep, voffB); PG8_STAGE(PG8_SA(1, 0), cA + kstep, voffA); PG8_STAGE(PG8_SB(1, 1), cB + hsB + kstep, voffB);
    PG8_WAIT_V(6); PG8_BAR;
    for (;;) {
        const bool has_next = S.next(ui + 1, nxt);
        const char* nA = has_next ? (const char*)g.A + (size_t)nxt.pm * tsA : cA; const char* nB = has_next ? (const char*)g.Bt + (size_t)nxt.pn * tsB : cB;
        for (int t = 0; t < nt; t += 2) {
            const bool last = (t == nt - 2);
            const char* a1 = cA + (size_t)(t + 1) * kstep;
            const char* a2 = last ? nA : cA + (size_t)(t + 2) * kstep; const char* b2 = last ? nB : cB + (size_t)(t + 2) * kstep;
            const char* a3 = a2 + kstep; const char* b3 = b2 + kstep;
            PG8_LDB(B0, 0, 0); PG8_LDB(B1, 0, 1); PG8_SCHED; PG8_LDA(At, 0, 0); PG8_STAGE(PG8_SA(1, 1), a1 + hsA, voffA);
            PG8_WAIT_V(8); PG8_WAIT_L(0); PG8_BAR; PG8_MMA(0, 0, At, B0); PG8_MMA(0, 1, At, B1); PG8_BAR; PG8_SCHED;
            PG8_LDA(At, 0, 1); PG8_STAGE(PG8_SB(0, 0), b2, voffB); PG8_STAGE(PG8_SB(0, 1), b2 + hsB, voffB); PG8_STAGE(PG8_SA(0, 0), a2, voffA);
            PG8_WAIT_V(8); PG8_WAIT_L(0); PG8_BAR; PG8_MMA(1, 0, At, B0); PG8_MMA(1, 1, At, B1); PG8_BAR; PG8_SCHED;
            PG8_LDB(B0, 1, 0); PG8_LDB(B1, 1, 1); PG8_SCHED; PG8_LDA(At, 1, 0); PG8_STAGE(PG8_SA(0, 1), a2 + hsA, voffA);
            PG8_WAIT_V(8); PG8_WAIT_L(0); PG8_BAR; PG8_MMA(0, 0, At, B0); PG8_MMA(0, 1, At, B1); PG8_BAR; PG8_SCHED;
            PG8_LDA(At, 1, 1); PG8_STAGE(PG8_SB(1, 0), b3, voffB); PG8_STAGE(PG8_SB(1, 1), b3 + hsB, voffB); PG8_STAGE(PG8_SA(1, 0), a3, voffA);
            PG8_WAIT_V(8); PG8_WAIT_L(0); PG8_BAR; PG8_MMA(1, 0, At, B0); PG8_MMA(1, 1, At, B1); PG8_BAR; PG8_SCHED;
        }
        if (wr == 0) PG8_BAR;
        E(acc, cur, wr, wc, fr, fq);
        if (!has_next) break;
#pragma unroll
        for (int a = 0; a < 2; ++a)
#pragma unroll
            for (int b = 0; b < 2; ++b)
#pragma unroll
                for (int m = 0; m < 4; ++m)
#pragma unroll
                    for (int n = 0; n < 2; ++n) acc[a][b][m][n] = (f32x4){0.f, 0.f, 0.f, 0.f};
        cur = nxt; cA = nA; cB = nB; ++ui;
        if (wr == 1) PG8_BAR;
    }
    PG8_WAIT_V(0);
    PG8_BAR;
#undef PG8_SA
#undef PG8_SB
#undef PG8_STAGE
#undef PG8_LDA
#undef PG8_LDB
#undef PG8_MMA
#undef PG8_WAIT_V
#undef PG8_WAIT_L
#undef PG8_BAR
#undef PG8_SCHED
}

typedef f32x4 AccT[2][2][4][2];
struct EpiSwiGLU {
    bf16_t* O; const float* ss;
    __device__ __forceinline__ void operator()(const AccT& acc, const Unit& u, int wr, int wc, int fr, int fq) const {
        const int row0 = u.pm * BM + wr * 64 + fr, col = u.pn * 128 + wc * 32 + 8 * fq;
#pragma unroll
        for (int ai = 0; ai < 2; ++ai)
#pragma unroll
            for (int m = 0; m < 4; ++m) {
                const int row = row0 + ai * HALF + m * 16;
                const float rs = rsqrtf(ss[row] * (1.f / 1024.f) + EPS);
                float o[8];
#pragma unroll
                for (int n = 0; n < 2; ++n)
#pragma unroll
                    for (int j = 0; j < 4; ++j) { const float gt = acc[ai][0][m][n][j] * rs, up = acc[ai][1][m][n][j] * rs; o[n * 4 + j] = gt * up * sigmoidf_(gt); }
                *(u32x4*)(O + (size_t)row * FF + col) = pack8(o);
            }
    }
};
template <bool RES_BF16, bool WRITE_F32, bool WRITE_XB> struct EpiRes {
    const float* res; const bf16_t* resb; float* out; bf16_t* xb; bf16_t* xb2; float* ss; float alpha;
    __device__ __forceinline__ void operator()(const AccT& acc, const Unit& u, int wr, int wc, int fr, int fq) const {
        const int row0 = u.pm * BM + wr * 64 + fr, col0 = u.pn * BM + wc * 32 + 8 * fq;
#pragma unroll
        for (int ai = 0; ai < 2; ++ai)
#pragma unroll
            for (int m = 0; m < 4; ++m) {
                const int row = row0 + ai * HALF + m * 16; float sq = 0.f;
#pragma unroll
                for (int bj = 0; bj < 2; ++bj) {
                    const size_t off = (size_t)row * DM + col0 + bj * HALF;
                    f32x4 r0, r1;
                    if (RES_BF16) { float f[8]; unpack8(*(const u32x4*)(resb + off), f); r0 = (f32x4){f[0], f[1], f[2], f[3]}; r1 = (f32x4){f[4], f[5], f[6], f[7]}; }
                    else { r0 = *(const f32x4*)(res + off); r1 = *(const f32x4*)(res + off + 4); }
                    const f32x4 v0 = r0 + acc[ai][bj][m][0] * alpha, v1 = r1 + acc[ai][bj][m][1] * alpha;
                    if (WRITE_F32) { *(f32x4*)(out + off) = v0; *(f32x4*)(out + off + 4) = v1; }
                    if (WRITE_XB) {
                        u32x4 w; w.x = cvt_pk_bf16(v0[0], v0[1]); w.y = cvt_pk_bf16(v0[2], v0[3]); w.z = cvt_pk_bf16(v1[0], v1[1]); w.w = cvt_pk_bf16(v1[2], v1[3]);
                        *(u32x4*)(xb + off) = w; if (xb2) *(u32x4*)(xb2 + off) = w;
                        sq += v0[0] * v0[0] + v0[1] * v0[1] + v0[2] * v0[2] + v0[3] * v0[3] + v1[0] * v1[0] + v1[1] * v1[1] + v1[2] * v1[2] + v1[3] * v1[3];
                    }
                }
                if (WRITE_XB) { sq += __shfl_xor(sq, 16); sq += __shfl_xor(sq, 32); if (fq == 0) atomicAdd(ss + row, sq); }
            }
    }
};
struct EpiP {
    bf16_t* P; float* SM; const float* ss;
    __device__ __forceinline__ void operator()(const AccT& acc, const Unit& u, int wr, int wc, int fr, int fq) const {
        const int row0 = u.pm * BM + wr * 64 + fr, col0 = u.pn * BM + wc * 32 + 8 * fq;
#pragma unroll
        for (int ai = 0; ai < 2; ++ai)
#pragma unroll
            for (int m = 0; m < 4; ++m) {
                const int row = row0 + ai * HALF + m * 16;
                const float rs = rsqrtf(ss[row] * (1.f / 1024.f) + EPS);
#pragma unroll
                for (int bj = 0; bj < 2; ++bj) {
                    const int col = col0 + bj * HALF;
                    const f32x4 v0 = acc[ai][bj][m][0] * rs, v1 = acc[ai][bj][m][1] * rs;
                    u32x4 w; w.x = cvt_pk_bf16(v0[0], v0[1]); w.y = cvt_pk_bf16(v0[2], v0[3]); w.z = cvt_pk_bf16(v1[0], v1[1]); w.w = cvt_pk_bf16(v1[2], v1[3]);
                    *(u32x4*)(P + (size_t)row * LDP + col) = w;
                    if (col >= C_SM && col < C_SM + 16) { float* s = SM + (size_t)row * 16 + (col - C_SM); *(f32x4*)s = v0; *(f32x4*)(s + 4) = v1; }
                }
            }
    }
};
struct EpiBf16 {
    bf16_t* O; int ldc;
    __device__ __forceinline__ void operator()(const AccT& acc, const Unit& u, int wr, int wc, int fr, int fq) const {
        const int row0 = u.pm * BM + wr * 64 + fr, col0 = u.pn * BM + wc * 32 + 8 * fq;
#pragma unroll
        for (int ai = 0; ai < 2; ++ai)
#pragma unroll
            for (int m = 0; m < 4; ++m) {
                const int row = row0 + ai * HALF + m * 16;
#pragma unroll
                for (int bj = 0; bj < 2; ++bj) {
                    const f32x4 v0 = acc[ai][bj][m][0], v1 = acc[ai][bj][m][1];
                    u32x4 w; w.x = cvt_pk_bf16(v0[0], v0[1]); w.y = cvt_pk_bf16(v0[2], v0[3]); w.z = cvt_pk_bf16(v1[0], v1[1]); w.w = cvt_pk_bf16(v1[2], v1[3]);
                    *(u32x4*)(O + (size_t)row * ldc + col0 + bj * HALF) = w;
                }
            }
    }
};
template <int PASS> struct EpiMerge {
    const bf16_t* P; bf16_t* MG; int goff;
    __device__ __forceinline__ void operator()(const AccT& acc, const Unit& u, int wr, int wc, int fr, int fq) const {
        const int row0 = u.pm * BM + wr * 64 + fr, col0 = u.pn * BM + wc * 32 + 8 * fq;
#pragma unroll
        for (int ai = 0; ai < 2; ++ai)
#pragma unroll
            for (int m = 0; m < 4; ++m) {
                const int row = row0 + ai * HALF + m * 16;
#pragma unroll
                for (int bj = 0; bj < 2; ++bj) {
                    const int col = col0 + bj * HALF;
                    float gt[8], o[8]; unpack8(*(const u32x4*)(P + (size_t)row * LDP + goff + col), gt);
                    if (PASS == 1) unpack8(*(const u32x4*)(MG + (size_t)row * DM + col), o);
#pragma unroll
                    for (int j = 0; j < 8; ++j) { const float a = acc[ai][bj][m][j >> 2][j & 3] * sigmoidf_(gt[j]); o[j] = (PASS == 1) ? o[j] + a : a; }
                    *(u32x4*)(MG + (size_t)row * DM + col) = pack8(o);
                }
            }
    }
};
}

struct Args {
    const float* in[24];
    float* out;
    unsigned char* ws;
};
enum { I_X = 0, I_F1N, I_F1G, I_F1U, I_F1D, I_MIXN, I_WIN, I_QN, I_KN, I_IKN, I_CW, I_CB, I_WMQ, I_WMK, I_BI, I_BF, I_MHN, I_WPA, I_WPB, I_WOUT, I_F2N, I_F2G, I_F2U, I_F2D };

template <class F> __device__ __forceinline__ void prep_load(int n0, int k0, const F src, float (&v)[8]) {
    const int tid = threadIdx.x, nn = tid & 63, kk = tid >> 6;
#pragma unroll
    for (int i = 0; i < 8; ++i) v[i] = src(k0 + i * 8 + kk, n0 + nn);
}
__device__ __forceinline__ void prep_store(bf16_t* Bt, int K, int n0, int k0, const float (&v)[8], float* tile) {
    const int tid = threadIdx.x;
    { const int nn = tid & 63, kk = tid >> 6;
#pragma unroll
        for (int i = 0; i < 8; ++i) tile[(i * 8 + kk) * 65 + nn] = v[i]; }
    lds_fence(); __builtin_amdgcn_s_barrier();
    { const int nn = tid >> 3, kc = tid & 7; const float* s = tile + (kc * 8) * 65 + nn;
        u32x4 o; o.x = cvt_pk_bf16(s[0], s[65]); o.y = cvt_pk_bf16(s[130], s[195]); o.z = cvt_pk_bf16(s[260], s[325]); o.w = cvt_pk_bf16(s[390], s[455]);
        *(u32x4*)(Bt + (size_t)(n0 + nn) * K + k0 + kc * 8) = o; }
    lds_fence(); __builtin_amdgcn_s_barrier();
}
struct SrcUp { const float* wg; const float* wu; const float* g;
    __device__ __forceinline__ float operator()(int k, int n) const { const int col = (n >> 8) * 128 + (n & 127); const size_t bj = (size_t)((n >> 7) & 1); const float* w = (const float*)((uintptr_t)wg + ((uintptr_t)wu - (uintptr_t)wg) * bj); return w[(size_t)k * FF + col] * g[k]; } };
struct SrcPlain { const float* w; int ldw;
    __device__ __forceinline__ float operator()(int k, int n) const { return w[(size_t)k * ldw + n]; } };
struct SrcIn { const float* w; const float* g;
    __device__ __forceinline__ float operator()(int k, int n) const {
        int col;
        if (n < 1344) col = n; else if (n < 2368) col = n + 8; else if (n < 4928) col = n + 16;
        else if (n < 4936) col = n - 4928 + 1344; else if (n < 4940) col = n - 4936 + 2376; else if (n < 4944) col = n - 4940 + 2380; else col = -1;
        return col >= 0 ? w[(size_t)k * 4944 + col] * g[k] : 0.f; } };
struct SrcQK { const float* wq; const float* wk;
    __device__ __forceinline__ float operator()(int k, int n) const {
        const int isk = n >> 8, h = (n >> 6) & 3, j = n & 63, hk = k >> 7, c = k & 127;
        if (hk != h) return 0.f;
        const float* w = (const float*)((uintptr_t)wq + ((uintptr_t)wk - (uintptr_t)wq) * (size_t)isk); return w[(size_t)(h * 128 + c) * 64 + j] * (isk ? 1.f : 0.125f); } };

__device__ __forceinline__ void phase0(const Args& a, unsigned char* lds) {
    float* tile = (float*)lds;
    unsigned char* ws = a.ws;
    constexpr int T_UP = 88 * 16, T_DN = 16 * 44, T_IN = 80 * 16, T_PR = 16 * 8, T_WO = 16 * 16, T_QK = 8 * 8;
    constexpr int NITEMS = 2 * T_UP + 2 * T_DN + T_IN + 2 * T_PR + T_WO + T_QK;
#define P0_LOAD(IT, V, BOFF, KK, N0, K0) do { int r = (IT); \
        if (r < T_UP) { SrcUp s_{a.in[I_F1G], a.in[I_F1U], a.in[I_F1N]}; BOFF = WS_W1; KK = 1024; N0 = (r / 16) * 64; K0 = (r % 16) * 64; prep_load(N0, K0, s_, V); break; } r -= T_UP; \
        if (r < T_UP) { SrcUp s_{a.in[I_F2G], a.in[I_F2U], a.in[I_F2N]}; BOFF = WS_W3; KK = 1024; N0 = (r / 16) * 64; K0 = (r % 16) * 64; prep_load(N0, K0, s_, V); break; } r -= T_UP; \
        if (r < T_DN) { SrcPlain s_{a.in[I_F1D], 1024}; BOFF = WS_W2; KK = FF; N0 = (r / 44) * 64; K0 = (r % 44) * 64; prep_load(N0, K0, s_, V); break; } r -= T_DN; \
        if (r < T_DN) { SrcPlain s_{a.in[I_F2D], 1024}; BOFF = WS_W4; KK = FF; N0 = (r / 44) * 64; K0 = (r % 44) * 64; prep_load(N0, K0, s_, V); break; } r -= T_DN; \
        if (r < T_IN) { SrcIn s_{a.in[I_WIN], a.in[I_MIXN]}; BOFF = WS_WIN; KK = 1024; N0 = (r / 16) * 64; K0 = (r % 16) * 64; prep_load(N0, K0, s_, V); break; } r -= T_IN; \
        if (r < T_PR) { SrcPlain s_{a.in[I_WPA], 1024}; BOFF = WS_WA; KK = 512; N0 = (r / 8) * 64; K0 = (r % 8) * 64; prep_load(N0, K0, s_, V); break; } r -= T_PR; \
        if (r < T_PR) { SrcPlain s_{a.in[I_WPB], 1024}; BOFF = WS_WB; KK = 512; N0 = (r / 8) * 64; K0 = (r % 8) * 64; prep_load(N0, K0, s_, V); break; } r -= T_PR; \
        if (r < T_WO) { SrcPlain s_{a.in[I_WOUT], 1024}; BOFF = WS_WO; KK = 1024; N0 = (r / 16) * 64; K0 = (r % 16) * 64; prep_load(N0, K0, s_, V); break; } r -= T_WO; \
        { SrcQK s_{a.in[I_WMQ], a.in[I_WMK]}; BOFF = WS_WQK; KK = 512; N0 = (r / 8) * 64; K0 = (r % 8) * 64; prep_load(N0, K0, s_, V); } } while (0)
    {
        float v[8], vn[8]; size_t boff = 0, boffn = 0; int kk_ = 0, n0_ = 0, k0_ = 0, kkn = 0, n0n = 0, k0n = 0;
        int it = blockIdx.x;
        if (it < NITEMS) P0_LOAD(it, v, boff, kk_, n0_, k0_);
        for (; it < NITEMS; it += gridDim.x) {
            const int itn = it + (int)gridDim.x;
            if (itn < NITEMS) P0_LOAD(itn, vn, boffn, kkn, n0n, k0n);
            prep_store((bf16_t*)(ws + boff), kk_, n0_, k0_, v, tile);
#pragma unroll
            for (int i = 0; i < 8; ++i) v[i] = vn[i];
            boff = boffn; kk_ = kkn; n0_ = n0n; k0_ = k0n;
        }
    }
#undef P0_LOAD
    const int lane = threadIdx.x & 63, gw = blockIdx.x * 8 + (threadIdx.x >> 6), NGW = gridDim.x * 8;
    const float* x = a.in[I_X]; bf16_t* XB = (bf16_t*)(ws + WS_XB);
    float* ss0 = (float*)(ws + WS_SS0); float* ss1 = (float*)(ws + WS_SS1); float* ss2 = (float*)(ws + WS_SS2);
    for (int row = gw; row < MROWS; row += NGW) {
        const f32x4* xr = (const f32x4*)(x + (size_t)row * DM) + lane;
        f32x4 v[4]; float s = 0.f;
#pragma unroll
        for (int j = 0; j < 4; ++j) { v[j] = xr[64 * j]; s += v[j][0] * v[j][0] + v[j][1] * v[j][1] + v[j][2] * v[j][2] + v[j][3] * v[j][3]; }
        s = wave_sum(s);
        if (lane == 0) { ss0[row] = s; ss1[row] = 0.f; ss2[row] = 0.f; }
        unsigned long long* o8 = (unsigned long long*)(XB + (size_t)row * DM) + lane;
#pragma unroll
        for (int j = 0; j < 4; ++j) o8[64 * j] = (unsigned long long)cvt_pk_bf16(v[j][0], v[j][1]) | ((unsigned long long)cvt_pk_bf16(v[j][2], v[j][3]) << 32);
    }
}

__device__ __forceinline__ void phase_postp(const Args& a) {
    unsigned char* ws = a.ws;
    bf16_t* P = (bf16_t*)(ws + WS_P); bf16_t* XC = (bf16_t*)(ws + WS_XB); bf16_t* IKC = (bf16_t*)(ws + WS_IKC); bf16_t* KVC = (bf16_t*)(ws + WS_KVC);
    const int lane = threadIdx.x & 63, gw = blockIdx.x * 8 + (threadIdx.x >> 6), NGW = gridDim.x * 8;
    const int c0 = lane * 8;
    float cw[4][8], cb[8], gq[8], gk[8];
#pragma unroll
    for (int e = 0; e < 8; ++e) {
        cb[e] = a.in[I_CB][c0 + e];
#pragma unroll
        for (int j = 0; j < 4; ++j) cw[j][e] = a.in[I_CW][j * 512 + c0 + e];
        gq[e] = a.in[I_QN][(lane & 7) * 8 + e];
        gk[e] = (lane < 16) ? a.in[I_KN][(lane & 7) * 8 + e] : a.in[I_IKN][(lane & 7) * 8 + e];
    }
    const int koff = (lane < 16) ? (C_AK + lane * 8) : (C_IK + (lane & 7) * 8);
    const int voff = C_AV + ((lane - 32) & 15) * 8;
    u32x4 nmx[4], naq, nkk, nav;
#define PP_LOAD(ROW) do { const int t_ = (ROW) & (SEQ - 1); const bf16_t* pr_ = P + (size_t)(ROW) * LDP; \
        _Pragma("unroll") for (int j = 0; j < 4; ++j) { if (t_ - 3 + j >= 0) nmx[j] = *(const u32x4*)(P + (size_t)((ROW) - 3 + j) * LDP + C_MX + c0); else nmx[j] = (u32x4){0u, 0u, 0u, 0u}; } \
        naq = *(const u32x4*)(pr_ + C_AQ + c0); nkk = *(const u32x4*)(pr_ + koff); nav = *(const u32x4*)(pr_ + voff); } while (0)
    if (gw < MROWS) PP_LOAD(gw);
    for (int row = gw; row < MROWS; row += NGW) {
        bf16_t* pr = P + (size_t)row * LDP;
        u32x4 cmx[4];
#pragma unroll
        for (int j = 0; j < 4; ++j) cmx[j] = nmx[j];
        const u32x4 caq = naq, ckk = nkk, cav = nav;
        if (row + NGW < MROWS) PP_LOAD(row + NGW);
        float accv[8];
#pragma unroll
        for (int e = 0; e < 8; ++e) accv[e] = cb[e];
#pragma unroll
        for (int j = 0; j < 4; ++j) { float xf[8]; unpack8(cmx[j], xf);
#pragma unroll
            for (int e = 0; e < 8; ++e) accv[e] += xf[e] * cw[j][e]; }
#pragma unroll
        for (int e = 0; e < 8; ++e) accv[e] = accv[e] * sigmoidf_(accv[e]);
        *(u32x4*)(XC + (size_t)row * 512 + c0) = pack8(accv);
        { float f[8]; unpack8(caq, f); float s = 0.f;
#pragma unroll
            for (int e = 0; e < 8; ++e) s += f[e] * f[e];
            s += __shfl_xor(s, 1); s += __shfl_xor(s, 2); s += __shfl_xor(s, 4);
            const float rs = rsqrtf(s * (1.f / 64.f) + EPS);
#pragma unroll
            for (int e = 0; e < 8; ++e) f[e] = f[e] * rs * gq[e];
            *(u32x4*)(pr + C_AQ + c0) = pack8(f); }
        { float f[8]; unpack8(ckk, f); float s = 0.f;
#pragma unroll
            for (int e = 0; e < 8; ++e) s += f[e] * f[e];
            s += __shfl_xor(s, 1); s += __shfl_xor(s, 2); s += __shfl_xor(s, 4);
            const float rs = rsqrtf(s * (1.f / 64.f) + EPS);
#pragma unroll
            for (int e = 0; e < 8; ++e) f[e] = f[e] * rs * gk[e];
            if (lane < 16) *(u32x4*)(KVC + (size_t)row * 256 + lane * 8) = pack8(f);
            else if (lane < 24) *(u32x4*)(IKC + ((((size_t)(row >> 4)) * 8 + (lane - 16)) * 16 + (row & 15)) * 8) = pack8(f);
            else if (lane >= 32 && lane < 48) *(u32x4*)(KVC + (size_t)row * 256 + 128 + (lane - 32) * 8) = cav; }
    }
#undef PP_LOAD
}

__device__ __forceinline__ unsigned fkey(float s) { const unsigned u = __float_as_uint(s); return (u & 0x80000000u) ? ~u : (u | 0x80000000u); }


__device__ __forceinline__ unsigned wave_incl_scan_dpp(unsigned x) {
    x += (unsigned)__builtin_amdgcn_update_dpp(0, (int)x, 0x111, 0xf, 0xf, false);
    x += (unsigned)__builtin_amdgcn_update_dpp(0, (int)x, 0x112, 0xf, 0xf, false);
    x += (unsigned)__builtin_amdgcn_update_dpp(0, (int)x, 0x114, 0xf, 0xf, false);
    x += (unsigned)__builtin_amdgcn_update_dpp(0, (int)x, 0x118, 0xf, 0xf, false);
    x += (unsigned)__builtin_amdgcn_update_dpp(0, (int)x, 0x142, 0xa, 0xf, false);
    x += (unsigned)__builtin_amdgcn_update_dpp(0, (int)x, 0x143, 0xc, 0xf, false);
    return x;
}
__device__ __forceinline__ int find_bin(const unsigned* hist, int& need, int lane, int& binc) {
    const int base = 1023 - 16 * lane; unsigned s = 0;
#pragma unroll
    for (int i = 0; i < 16; ++i) { const unsigned w = hist[base - ((i + lane) & 15)]; s += (w & 0xffffu) + (w >> 16); }
    const unsigned p = wave_incl_scan_dpp(s);
    const unsigned long long bal = __ballot(p >= (unsigned)need);
    const int L = bal ? (__ffsll((long long)bal) - 1) : 63;
    const unsigned excl = __shfl(p - s, L);
    const int b0 = 1023 - 16 * L, t = lane & 31;
    const unsigned w2 = hist[b0 - (t >> 1)];
    const unsigned v2 = (lane < 32) ? ((t & 1) ? (w2 & 0xffffu) : (w2 >> 16)) : 0u;
    const unsigned p2 = wave_incl_scan_dpp(v2);
    const unsigned long long bal2 = __ballot((lane < 32) && ((unsigned)excl + p2 >= (unsigned)need));
    const int ts = bal2 ? (__ffsll((long long)bal2) - 1) : 31;
    const int vs = (int)__shfl(v2, ts), ps = (int)__shfl(p2, ts);
    int bin = 2 * (b0 - (ts >> 1)) + ((ts & 1) ? 0 : 1);
    int fneed = need - ((int)excl + ps - vs), bc = vs;
    if (fneed < 1) fneed = 1;
    need = fneed; binc = bc; return bin;
}


__device__ __forceinline__ int find_bin128(const unsigned* sh, int& need, int lane, int& binc) {
    const unsigned hi = sh[127 - 2 * lane], lo = sh[126 - 2 * lane]; const unsigned s = hi + lo;
    const unsigned p = wave_incl_scan_dpp(s);
    const unsigned long long bal = __ballot(p >= (unsigned)need);
    const int L = bal ? (__ffsll((long long)bal) - 1) : 63;
    const int excl = (int)__shfl(p - s, L); const int hiL = (int)__shfl(hi, L), loL = (int)__shfl(lo, L);
    int bin, fneed, bc;
    if (excl + hiL >= need) { bin = 127 - 2 * L; fneed = need - excl; bc = hiL; } else { bin = 126 - 2 * L; fneed = need - excl - hiL; bc = loL; }
    if (fneed < 1) fneed = 1;
    need = fneed; binc = bc; return bin;
}

template <bool DUMMY> __device__ __forceinline__ void phase_dsa(const Args& a, unsigned char* lds) {
    unsigned char* ws = a.ws;
    bf16_t* P = (bf16_t*)(ws + WS_P); const float* SM = (const float*)(ws + WS_SM);
    const bf16_t* IKC = (const bf16_t*)(ws + WS_IKC); const bf16_t* KVC = (const bf16_t*)(ws + WS_KVC);
    constexpr int SCS = 8200;
    float* SC = (float*)lds;
    unsigned* HIST = (unsigned*)(lds + 131200);
    int* LIST = (int*)(lds + 131200 + 16384);
    unsigned* QS = (unsigned*)(lds + 131200 + 16384 + 4096);
    int* CNT = (int*)(lds + 131200 + 16384 + 4096 + 4096);
    const float idx_scale = 0.125f * 0.35355339059327373f;
    f32x4 wqv[2]; unsigned qsv[2];
#define DSA_LOAD_ITEM(ITEM) do { const int b_ = (ITEM) & 7, t0_ = ((ITEM) >> 3) * 4; const size_t r_ = (size_t)b_ * SEQ + t0_; \
        int tl_ = threadIdx.x; asm volatile("" : "+v"(tl_)); const int ln_ = tl_ & 63, q4_ = ln_ >> 4; \
        wqv[0] = *(const f32x4*)(SM + (r_ + q4_) * 16); wqv[1] = *(const f32x4*)(SM + (r_ + q4_) * 16 + 4); \
        _Pragma("unroll") for (int i_ = 0; i_ < 2; ++i_) { const int e_ = tl_ + 512 * i_; qsv[i_] = *(const unsigned*)(P + (r_ + (e_ >> 8)) * LDP + C_AQ + (e_ & 255) * 2); } } while (0)
    if ((int)blockIdx.x < 16384) DSA_LOAD_ITEM(blockIdx.x);
    for (int item = blockIdx.x; item < 16384; item += gridDim.x) {
        int tid_ = threadIdx.x; asm volatile("" : "+v"(tid_));
        const int tid = tid_, wave = __builtin_amdgcn_readfirstlane(tid >> 6), lane = tid & 63, quad = lane >> 4, l15 = lane & 15;
        const int b = item & 7, tq = item >> 3, t0 = tq * 4, L = ((t0 >> 6) + 1) * 64;
        const size_t r0 = (size_t)b * SEQ + t0;
        const bool do_sel = (L > 256) && !DBG_NOSEL;
        { u32x4* hz = (u32x4*)HIST; hz[tid] = (u32x4){0u, 0u, 0u, 0u}; hz[tid + 512] = (u32x4){0u, 0u, 0u, 0u}; }
        if (tid < 8) CNT[4 + tid] = 0;
        QS[tid] = qsv[0]; QS[tid + 512] = qsv[1];
        float wq[8];
#pragma unroll
        for (int h = 0; h < 4; ++h) { wq[h] = wqv[0][h] * idx_scale; wq[4 + h] = wqv[1][h] * idx_scale; }
        bf16x8 af[2][2];
#pragma unroll
        for (int T = 0; T < 2; ++T)
#pragma unroll
            for (int ks = 0; ks < 2; ++ks) af[T][ks] = *(const bf16x8*)(P + (r0 + (l15 >> 2)) * LDP + C_IQ + (4 * T + (l15 & 3)) * 64 + ks * 32 + quad * 8);
        const int ngroups = L >> 6;
        const bf16_t* ikb = IKC + (size_t)b * SEQ * 64 + (quad * 16 + l15) * 8;
        bf16x8 B0[4][2], B1[4][2], B2[4][2];
#define IDX_LOAD(BUF, G) do { _Pragma("unroll") for (int tt = 0; tt < 4; ++tt) _Pragma("unroll") for (int ks = 0; ks < 2; ++ks) \
                BUF[tt][ks] = *(const bf16x8*)(ikb + (size_t)(((G) * 4 + tt) * 8 + ks * 4) * 128); } while (0)
        if (wave < ngroups) IDX_LOAD(B0, wave);
        if (wave + 8 < ngroups) IDX_LOAD(B1, wave + 8);
        if (wave + 16 < ngroups) IDX_LOAD(B2, wave + 16);
        lds_fence(); __builtin_amdgcn_s_barrier();
        for (int rep = 0; rep < ((DBG_TWICE & 2) ? 2 : 1); ++rep) {
            const bool hist_on = do_sel && (rep == (((DBG_TWICE & 2) ? 2 : 1) - 1));
#define IDX_COMPUTE(BUF, G) do { _Pragma("unroll") for (int tt = 0; tt < 4; ++tt) { \
                const int key = (G) * 64 + tt * 16 + l15; \
                f32x4 c0 = (f32x4){0.f, 0.f, 0.f, 0.f}, c1 = (f32x4){0.f, 0.f, 0.f, 0.f}; \
                c0 = __builtin_amdgcn_mfma_f32_16x16x32_bf16(af[0][0], BUF[tt][0], c0, 0, 0, 0); \
                c1 = __builtin_amdgcn_mfma_f32_16x16x32_bf16(af[1][0], BUF[tt][0], c1, 0, 0, 0); \
                c0 = __builtin_amdgcn_mfma_f32_16x16x32_bf16(af[0][1], BUF[tt][1], c0, 0, 0, 0); \
                c1 = __builtin_amdgcn_mfma_f32_16x16x32_bf16(af[1][1], BUF[tt][1], c1, 0, 0, 0); \
                float sc = 0.f; \
                _Pragma("unroll") for (int j = 0; j < 4; ++j) { sc += wq[j] * relu_(c0[j]); sc += wq[4 + j] * relu_(c1[j]); } \
                sc += 0.f; \
                SC[quad * SCS + key] = sc; \
                if (hist_on) { const unsigned bin = fkey(sc) >> 21; atomicAdd(&HIST[quad * 1024 + (bin >> 1)], (bin & 1u) ? 0x10000u : 1u); } } } while (0)
            int g = wave;
            for (; g < ngroups; g += 24) {
                IDX_COMPUTE(B0, g);
                if (g + 24 < ngroups) IDX_LOAD(B0, g + 24);
                if (g + 8 < ngroups) { IDX_COMPUTE(B1, g + 8); if (g + 32 < ngroups) IDX_LOAD(B1, g + 32); }
                if (g + 16 < ngroups) { IDX_COMPUTE(B2, g + 16); if (g + 40 < ngroups) IDX_LOAD(B2, g + 40); }
            }
#undef IDX_LOAD
#undef IDX_COMPUTE
        }
        lds_fence(); __builtin_amdgcn_s_barrier();
        if (item + (int)gridDim.x < 16384) DSA_LOAD_ITEM(item + (int)gridDim.x);
        {
            constexpr int CAP = 448;
            const unsigned long long ltmask = (1ull << lane) - 1ull;
            if (!do_sel) {
                const int q = wave >> 1, hf = wave & 1; int* list = LIST + q * 256;
                if (hf == 0) { for (int i = lane; i < 256; i += 64) list[i] = (i < L) ? i : 0; if (lane == 0) CNT[q] = L; }
            } else {
                {
                    const int q = wave >> 1, hf = wave & 1; int* list = LIST + q * 256; const float* sc = SC + q * SCS; unsigned* hist = HIST + q * 1024;
                    const int halfL = L >> 1, beg = hf * halfL, end = beg + halfL;
                    int need = 256, binc = 0;
                    const unsigned b1 = (unsigned)find_bin(hist, need, lane, binc);
                    const int c1 = binc, nsure = 256 - need; const bool store_c = c1 <= CAP;
                    if (hf == 0 && lane == 0) { CNT[12 + q] = (int)b1; CNT[16 + q] = need; CNT[8 + q] = c1; }
                    lds_fence(); __builtin_amdgcn_s_barrier();
                    int cs = 0, cc = 0;
                    for (int i0 = beg + lane * 4; i0 < end; i0 += 256) { const f32x4 v = *(const f32x4*)(sc + i0);
#pragma unroll
                        for (int e = 0; e < 4; ++e) { const unsigned k = fkey(v[e]); const unsigned kb = k >> 21;
                            const bool sure = kb > b1, cand = (kb == b1) && store_c;
                            const unsigned long long ms = __ballot(sure), mc = __ballot(cand);
                            if (ms) { const int p = cs + __popcll(ms & ltmask); const int pp = hf ? nsure - 1 - p : p; if (sure && pp >= 0 && pp < 256) list[pp] = i0 + e; cs += __popcll(ms); }
                            if (mc) { const int p = cc + __popcll(mc & ltmask); const int pp = hf ? c1 - 1 - p : p; if (cand && pp >= 0 && pp < CAP) { hist[2 * pp] = k; hist[2 * pp + 1] = (unsigned)(i0 + e); } cc += __popcll(mc); } } }
                    lds_fence(); __builtin_amdgcn_s_barrier();
                }
                if (wave < 4) {
                    const int q = wave; int* list = LIST + q * 256; unsigned* hist = HIST + q * 1024; unsigned* sh = hist + 896; const float* sc = SC + q * SCS;
                    const unsigned b1 = (unsigned)CNT[12 + q]; int need = CNT[16 + q]; const int c = CNT[8 + q]; const int nsure = 256 - need;
                    if (c <= CAP) {
                        unsigned ck[7]; int ci[7];
#pragma unroll
                        for (int t = 0; t < 7; ++t) { const int i = lane + 64 * t; const bool valid = i < c; ck[t] = valid ? hist[2 * i] : 0u; ci[t] = valid ? (int)hist[2 * i + 1] : -1; }
                        int binc = 0;
                        sh[2 * lane] = 0u; sh[2 * lane + 1] = 0u; lds_order();
#pragma unroll
                        for (int t = 0; t < 7; ++t) if (ci[t] >= 0) atomicAdd(&sh[(ck[t] >> 14) & 127u], 1u);
                        lds_order();
                        const unsigned bA = (unsigned)find_bin128(sh, need, lane, binc);
                        lds_order();
                        sh[2 * lane] = 0u; sh[2 * lane + 1] = 0u; lds_order();
#pragma unroll
                        for (int t = 0; t < 7; ++t) if (ci[t] >= 0 && ((ck[t] >> 14) & 127u) == bA) atomicAdd(&sh[(ck[t] >> 7) & 127u], 1u);
                        lds_order();
                        const unsigned bB = (unsigned)find_bin128(sh, need, lane, binc);
                        const unsigned preB = (bA << 7) | bB;
                        lds_order();
                        sh[2 * lane] = 0u; sh[2 * lane + 1] = 0u; lds_order();
#pragma unroll
                        for (int t = 0; t < 7; ++t) if (ci[t] >= 0 && ((ck[t] >> 7) & 0x3fffu) == preB) atomicAdd(&sh[ck[t] & 127u], 1u);
                        lds_order();
                        const unsigned bC = (unsigned)find_bin128(sh, need, lane, binc);
                        const unsigned T = (b1 << 21) | (preB << 7) | bC;
                        const int tie_total = binc, need_t = need;
                        int cnt = 0;
#pragma unroll
                        for (int t = 0; t < 7; ++t) {
                            const bool valid = ci[t] >= 0;
                            bool sel = valid && (ck[t] > T);
                            if (valid && ck[t] == T) {
                                if (tie_total == need_t) sel = true;
                                else { int rank = 0; for (int j = 0; j < c; ++j) rank += (hist[2 * j] == T && (int)hist[2 * j + 1] < ci[t]) ? 1 : 0; sel = rank < need_t; }
                            }
                            const unsigned long long m = __ballot(sel);
                            const int pos = nsure + cnt + __popcll(m & ltmask);
                            if (sel && pos < 256) list[pos] = ci[t];
                            cnt += __popcll(m);
                        }
                    } else {
                        int binc = 0;
                        lds_order();
#pragma unroll
                        for (int i = 0; i < 16; ++i) hist[lane * 16 + i] = 0u;
                        lds_order();
                        for (int i0 = 0; i0 < L; i0 += 64) { const unsigned k = fkey(sc[i0 + lane]); if ((k >> 21) == b1) { const unsigned bin = (k >> 10) & 2047u; atomicAdd(&hist[bin >> 1], (bin & 1u) ? 0x10000u : 1u); } }
                        lds_order();
                        const unsigned b2 = (unsigned)find_bin(hist, need, lane, binc);
                        const unsigned pre2 = (b1 << 11) | b2;
                        lds_order();
#pragma unroll
                        for (int i = 0; i < 16; ++i) hist[lane * 16 + i] = 0u;
                        lds_order();
                        for (int i0 = 0; i0 < L; i0 += 64) { const unsigned k = fkey(sc[i0 + lane]); if ((k >> 10) == pre2) { const unsigned bin = k & 1023u; atomicAdd(&hist[bin >> 1], (bin & 1u) ? 0x10000u : 1u); } }
                        lds_order();
                        const unsigned b3 = (unsigned)find_bin(hist, need, lane, binc);
                        const unsigned T = (pre2 << 10) | b3;
                        int count = 0, ties = 0;
                        for (int i0 = 0; i0 < L; i0 += 64) {
                            const unsigned k = fkey(sc[i0 + lane]);
                            const bool eq = (k == T);
                            const unsigned long long em = __ballot(eq);
                            const int erank = ties + __popcll(em & ltmask);
                            const bool sel = (k > T) || (eq && erank < need);
                            const unsigned long long smk = __ballot(sel);
                            const int pos = count + __popcll(smk & ltmask);
                            if (sel && pos < 256) list[pos] = i0 + lane;
                            count += __popcll(smk); ties += __popcll(em);
                        }
                        if (count > 256) count = 256;
                        for (int i = count + lane; i < 256; i += 64) list[i] = 0;
                    }
                    if (lane == 0) CNT[q] = 256;
                }
            }
        }
        lds_fence(); __builtin_amdgcn_s_barrier();
        for (int repc = 0; repc < ((DBG_TWICE & 4) ? 2 : 1); ++repc) {
            const bool dummy_c = (repc + 1) < ((DBG_TWICE & 4) ? 2 : 1);
            int lane_c = lane; asm volatile("" : "+v"(lane_c));
            const int qi = wave >> 1, g = wave & 1; const int count = CNT[qi];
            const int* list = LIST + qi * 256;
            float* PB = SC + wave * 1024;
            const unsigned* qd = QS + (qi * 8 + g * 4) * 32;
            const bf16_t* kvb = KVC + (size_t)b * SEQ * 256 + g * 64;
            const int ks = lane_c >> 3, dg = lane_c & 7, l15c = lane_c & 15, quadc = lane_c >> 4;
            const int nblk = count >> 6;
            bf16_t* KL = (bf16_t*)(lds + 32768 + wave * 9216);
            bf16x8 bq[2];
#pragma unroll
            for (int s2 = 0; s2 < 2; ++s2) {
                bf16x8 t = *(const bf16x8*)((const bf16_t*)QS + (qi * 8 + g * 4 + (l15c & 3)) * 64 + s2 * 32 + quadc * 8);
                if (l15c >= 4) t = (bf16x8){0, 0, 0, 0, 0, 0, 0, 0};
                bq[s2] = t;
            }
            const bf16_t* kb = kvb + dg * 8;
            float sreg[4][4][4];
            u32x4 kcur[8];
#pragma unroll
            for (int u = 0; u < 8; ++u) kcur[u] = *(const u32x4*)(kb + (size_t)list[u * 8 + ks] * 256);
#pragma unroll
            for (int blk = 0; blk < 4; ++blk) {
                if (blk < nblk) {
#pragma unroll
                    for (int u = 0; u < 8; ++u) *(u32x4*)(KL + (u * 8 + ks) * 72 + dg * 8) = kcur[u];
                    if (blk + 1 < nblk) {
#pragma unroll
                        for (int u = 0; u < 8; ++u) kcur[u] = *(const u32x4*)(kb + (size_t)list[(blk + 1) * 64 + u * 8 + ks] * 256);
                    }
                    lds_order();
#pragma unroll
                    for (int kt = 0; kt < 4; ++kt) {
                        f32x4 acc = (f32x4){0.f, 0.f, 0.f, 0.f};
#pragma unroll
                        for (int s2 = 0; s2 < 2; ++s2) acc = __builtin_amdgcn_mfma_f32_16x16x32_bf16(*(const bf16x8*)(KL + (kt * 16 + l15c) * 72 + s2 * 32 + quadc * 8), bq[s2], acc, 0, 0, 0);
#pragma unroll
                        for (int j = 0; j < 4; ++j) sreg[blk][kt][j] = acc[j] * 0.125f;
                    }
                    lds_order();
                } else {
#pragma unroll
                    for (int kt = 0; kt < 4; ++kt)
#pragma unroll
                        for (int j = 0; j < 4; ++j) sreg[blk][kt][j] = -INFINITY;
                }
            }
            const bf16_t* vb = kvb + 128 + dg * 8;
            u32x4 vreg[8];
#pragma unroll
            for (int u = 0; u < 8; ++u) vreg[u] = *(const u32x4*)(vb + (size_t)list[u * 8 + ks] * 256);
            float mx = -INFINITY;
#pragma unroll
            for (int blk = 0; blk < 4; ++blk)
#pragma unroll
                for (int kt = 0; kt < 4; ++kt)
#pragma unroll
                    for (int j = 0; j < 4; ++j) mx = fmaxf(mx, sreg[blk][kt][j]);
            mx = fmaxf(mx, __shfl_xor(mx, 16)); mx = fmaxf(mx, __shfl_xor(mx, 32));
            float sum = 0.f;
#pragma unroll
            for (int blk = 0; blk < 4; ++blk)
#pragma unroll
                for (int kt = 0; kt < 4; ++kt)
#pragma unroll
                    for (int j = 0; j < 4; ++j) { const float e = __expf(sreg[blk][kt][j] - mx); sreg[blk][kt][j] = e; sum += e; }
            sum += __shfl_xor(sum, 16); sum += __shfl_xor(sum, 32);
            const float invs = 1.f / sum;
            f32x4 oacc[4];
#pragma unroll
            for (int dt = 0; dt < 4; ++dt) oacc[dt] = (f32x4){0.f, 0.f, 0.f, 0.f};
            bf16_t* VT = KL;
#pragma unroll
            for (int blk = 0; blk < 4; ++blk) {
                if (blk < nblk) {
#pragma unroll
                    for (int u = 0; u < 8; ++u) {
                        const int rho = ((u >> 2) << 5) + ((((2 * u) & 3) + (ks >> 2)) << 3) + (((u >> 1) & 1) << 2) + (ks & 3);
                        *(u32x4*)(VT + rho * 72 + dg * 8) = vreg[u];
                    }
                    if (blk + 1 < nblk) {
#pragma unroll
                        for (int u = 0; u < 8; ++u) vreg[u] = *(const u32x4*)(vb + (size_t)list[(blk + 1) * 64 + u * 8 + ks] * 256);
                    }
                    lds_order();
#pragma unroll
                    for (int s2 = 0; s2 < 2; ++s2) {
                        u32x4 pw;
                        pw[0] = cvt_pk_bf16(sreg[blk][2 * s2][0], sreg[blk][2 * s2][1]); pw[1] = cvt_pk_bf16(sreg[blk][2 * s2][2], sreg[blk][2 * s2][3]);
                        pw[2] = cvt_pk_bf16(sreg[blk][2 * s2 + 1][0], sreg[blk][2 * s2 + 1][1]); pw[3] = cvt_pk_bf16(sreg[blk][2 * s2 + 1][2], sreg[blk][2 * s2 + 1][3]);
                        const bf16x8 pf = __builtin_bit_cast(bf16x8, pw);
#pragma unroll
                        for (int dt = 0; dt < 4; ++dt) {
                            const LAS unsigned char* vp = (const LAS unsigned char*)VT + ((32 * s2 + 8 * quadc + (l15c >> 2)) * 72) * 2 + dt * 32 + (l15c & 3) * 8;
                            const v4i16_t t0 = __builtin_amdgcn_ds_read_tr16_b64_v4i16((LAS v4i16_t*)vp);
                            const v4i16_t t1 = __builtin_amdgcn_ds_read_tr16_b64_v4i16((LAS v4i16_t*)(vp + 4 * 72 * 2));
                            const bf16x8 af2 = (bf16x8){t0[0], t0[1], t0[2], t0[3], t1[0], t1[1], t1[2], t1[3]};
                            oacc[dt] = __builtin_amdgcn_mfma_f32_16x16x32_bf16(af2, pf, oacc[dt], 0, 0, 0);
                        }
                    }
                    lds_order();
                }
            }
            if (l15c < 4) {
                bf16_t* yo = (DUMMY || dummy_c) ? ((bf16_t*)(ws + WS_MG + 48 * MiB) + (r0 + qi) * 512 + (g * 4 + l15c) * 64 + quadc * 4) : (P + (r0 + qi) * LDP + C_AQ + (g * 4 + l15c) * 64 + quadc * 4);
#pragma unroll
                for (int dt = 0; dt < 4; ++dt) {
                    const f32x4 v = oacc[dt] * invs;
                    u32x2 w; w[0] = cvt_pk_bf16(v[0], v[1]); w[1] = cvt_pk_bf16(v[2], v[3]);
                    *(u32x2*)(yo + dt * 16) = w;
                }
            }
        }
        lds_fence(); __builtin_amdgcn_s_barrier();
    }
#undef DSA_LOAD_ITEM
}

__device__ __forceinline__ float logsigmoidf_(float x) { return fminf(x, 0.f) - log1pf(__expf(-fabsf(x))); }
#define DPP_F(x, ident, ctrl, rmask) __int_as_float(__builtin_amdgcn_update_dpp(__float_as_int(ident), __float_as_int(x), ctrl, rmask, 0xf, false))
__device__ __forceinline__ float wave_incl_sum(float v, int lane) {
    (void)lane;
    v += DPP_F(v, 0.f, 0x111, 0xf); v += DPP_F(v, 0.f, 0x112, 0xf); v += DPP_F(v, 0.f, 0x114, 0xf); v += DPP_F(v, 0.f, 0x118, 0xf);
    v += DPP_F(v, 0.f, 0x142, 0xa); v += DPP_F(v, 0.f, 0x143, 0xc);
    return v;
}
__device__ __forceinline__ float wave_incl_max(float v, int lane) {
    (void)lane;
    const float ninf = -INFINITY;
    v = fmaxf(v, DPP_F(v, ninf, 0x111, 0xf)); v = fmaxf(v, DPP_F(v, ninf, 0x112, 0xf)); v = fmaxf(v, DPP_F(v, ninf, 0x114, 0xf)); v = fmaxf(v, DPP_F(v, ninf, 0x118, 0xf));
    v = fmaxf(v, DPP_F(v, ninf, 0x142, 0xa)); v = fmaxf(v, DPP_F(v, ninf, 0x143, 0xc));
    return v;
}
__device__ __forceinline__ f32x4 mma_lds(const bf16_t* A, int lda, const bf16_t* Bt, int ldb, int K, int lane) {
    f32x4 acc = (f32x4){0.f, 0.f, 0.f, 0.f};
    const bf16_t* ap = A + (lane & 15) * lda + (lane >> 4) * 8; const bf16_t* bp = Bt + (lane & 15) * ldb + (lane >> 4) * 8;
    for (int k = 0; k < K; k += 32) acc = __builtin_amdgcn_mfma_f32_16x16x32_bf16(*(const bf16x8*)(ap + k), *(const bf16x8*)(bp + k), acc, 0, 0, 0);
    return acc;
}

__device__ __forceinline__ void phase_mlstm_a(const Args& a, unsigned char* lds) {
    unsigned char* ws = a.ws;
    const bf16_t* P = (const bf16_t*)(ws + WS_P); const bf16_t* QK = (const bf16_t*)(ws + WS_QK); const float* SM = (const float*)(ws + WS_SM);
    bf16_t* ST = (bf16_t*)(ws + WS_XB); float* DN = (float*)(ws + WS_DN); float* ML = (float*)(ws + WS_ML); float* BL = (float*)(ws + WS_BL);
    bf16_t* VT = (bf16_t*)lds;
    bf16_t* KT = (bf16_t*)(lds + 18432);
    float* WS_ = (float*)(lds + 18432 + 9216);
    const int tid = threadIdx.x, wave = tid >> 6, lane = tid & 63;
    for (int item = blockIdx.x; item < 4096; item += gridDim.x) {
        const int c = item & 127, h = (item >> 7) & 3, b = item >> 9;
        const size_t r0 = (size_t)b * SEQ + c * 64;
        if (wave == 0) {
            const float ig = SM[(r0 + lane) * 16 + 8 + h] + a.in[I_BI][h];
            const float lf = logsigmoidf_(SM[(r0 + lane) * 16 + 12 + h] + a.in[I_BF][h]);
            const float bs = wave_incl_sum(lf, lane);
            const float bl = __shfl(bs, 63);
            const float wk = bl - bs + ig;
            const float ml = wave_max(wk);
            WS_[lane] = __expf(wk - ml);
            if (lane == 0) { ML[item] = ml; BL[item] = bl; }
        }
        for (int i = tid; i < 1024; i += 512) { const int s = i >> 4, d0 = (i & 15) * 8; float f[8]; unpack8(*(const u32x4*)(P + (r0 + s) * LDP + C_MV + h * 128 + d0), f);
#pragma unroll
            for (int e = 0; e < 8; ++e) VT[(d0 + e) * 72 + s] = f2bf(f[e]); }
        __syncthreads();
        { const int s = tid >> 3, d0 = (tid & 7) * 8; float f[8]; unpack8(*(const u32x4*)(QK + (r0 + s) * 512 + 256 + h * 64 + d0), f); const float w = WS_[s];
#pragma unroll
            for (int e = 0; e < 8; ++e) KT[(d0 + e) * 72 + s] = f2bf(f[e] * w); }
        __syncthreads();
        bf16_t* st = ST + (size_t)item * 8192;
#pragma unroll
        for (int nt = 0; nt < 4; ++nt) {
            const f32x4 acc = mma_lds(VT + wave * 16 * 72, 72, KT + nt * 16 * 72, 72, 64, lane);
#pragma unroll
            for (int j = 0; j < 4; ++j) st[(wave * 16 + (lane >> 4) * 4 + j) * 64 + nt * 16 + (lane & 15)] = f2bf_sw(acc[j]);
        }
        if (tid < 64) { float s = 0.f; for (int k = 0; k < 64; ++k) s += bf1(KT[tid * 72 + k]); DN[item * 64 + tid] = s; }
        __syncthreads();
    }
}
__device__ __forceinline__ void phase_mlstm_b(const Args& a) {
    unsigned char* ws = a.ws;
    unsigned* ST2 = (unsigned*)(ws + WS_XB);
    float* DN = (float*)(ws + WS_DN); const float* ML = (const float*)(ws + WS_ML); const float* BL = (const float*)(ws + WS_BL); float* MS = (float*)(ws + WS_MS);
    const int total = 32 * 4160;
    for (int w = blockIdx.x * 512 + threadIdx.x; w < total; w += gridDim.x * 512) {
        const int bh = w / 4160, e = w % 4160;
        if (e < 4096) {
            unsigned* p = ST2 + (size_t)bh * 128 * 4096 + e;
            float C0 = 0.f, C1 = 0.f, m = 0.f;
            for (int c0 = 0; c0 < 128; c0 += 8) {
                unsigned d[8]; float bl[8], ml[8];
#pragma unroll
                for (int u = 0; u < 8; ++u) { d[u] = p[(size_t)(c0 + u) * 4096]; bl[u] = BL[bh * 128 + c0 + u]; ml[u] = ML[bh * 128 + c0 + u]; }
#pragma unroll
                for (int u = 0; u < 8; ++u) {
                    p[(size_t)(c0 + u) * 4096] = cvt_pk_bf16(C0, C1);
                    if (e == 0) MS[bh * 128 + c0 + u] = m;
                    const float mn = fmaxf(bl[u] + m, ml[u]);
                    const float wc = __expf(bl[u] + m - mn), wd = __expf(ml[u] - mn);
                    C0 = wc * C0 + wd * bflo(d[u]); C1 = wc * C1 + wd * bfhi(d[u]);
                    m = mn;
                }
            }
        } else {
            float* p = DN + (size_t)bh * 128 * 64 + (e - 4096);
            float C = 0.f, m = 0.f;
            for (int c0 = 0; c0 < 128; c0 += 8) {
                float d[8], bl[8], ml[8];
#pragma unroll
                for (int u = 0; u < 8; ++u) { d[u] = p[(size_t)(c0 + u) * 64]; bl[u] = BL[bh * 128 + c0 + u]; ml[u] = ML[bh * 128 + c0 + u]; }
#pragma unroll
                for (int u = 0; u < 8; ++u) {
                    p[(size_t)(c0 + u) * 64] = C;
                    const float mn = fmaxf(bl[u] + m, ml[u]);
                    C = __expf(bl[u] + m - mn) * C + __expf(ml[u] - mn) * d[u];
                    m = mn;
                }
            }
        }
    }
}
__device__ __forceinline__ void phase_mlstm_c(const Args& a, unsigned char* lds) {
    unsigned char* ws = a.ws;
    bf16_t* P = (bf16_t*)(ws + WS_P); const bf16_t* QK = (const bf16_t*)(ws + WS_QK); const float* SM = (const float*)(ws + WS_SM);
    const bf16_t* ST = (const bf16_t*)(ws + WS_XB); const float* DN = (const float*)(ws + WS_DN); const float* MS = (const float*)(ws + WS_MS);
    bf16_t* QS_ = (bf16_t*)lds;
    bf16_t* KS = (bf16_t*)(lds + 9216);
    bf16_t* AP = (bf16_t*)(lds + 18432);
    bf16_t* BT = (bf16_t*)(lds + 18432 + 17408);
    float* OUT = (float*)(lds + 18432 + 17408 + 34816);
    float* GS = (float*)(lds + 18432 + 17408 + 34816 + 33792);
    float* bS = GS; float* aS = GS + 64; float* mtS = GS + 128; float* wiS = GS + 192; float* nS = GS + 256; float* denS = GS + 320;
    const int tid = threadIdx.x, wave = tid >> 6, lane = tid & 63;
    for (int item = blockIdx.x; item < 4096; item += gridDim.x) {
        const int c = item & 127, h = (item >> 7) & 3, b = item >> 9;
        const size_t r0 = (size_t)b * SEQ + c * 64;
        if (wave == 0) {
            const float ig = SM[(r0 + lane) * 16 + 8 + h] + a.in[I_BI][h];
            const float lf = logsigmoidf_(SM[(r0 + lane) * 16 + 12 + h] + a.in[I_BF][h]);
            const float bs = wave_incl_sum(lf, lane);
            const float av = ig - bs;
            const float pm = wave_incl_max(av, lane);
            const float m0 = MS[item];
            const float mt = bs + fmaxf(pm, m0);
            bS[lane] = bs; aS[lane] = av; mtS[lane] = mt; wiS[lane] = __expf(bs + m0 - mt);
            nS[lane] = DN[item * 64 + lane];
        }
        { const int s = tid >> 3, d0 = (tid & 7) * 8;
            *(u32x4*)(QS_ + s * 72 + d0) = *(const u32x4*)(QK + (r0 + s) * 512 + h * 64 + d0);
            *(u32x4*)(KS + s * 72 + d0) = *(const u32x4*)(QK + (r0 + s) * 512 + 256 + h * 64 + d0); }
        for (int i = tid; i < 1024; i += 512) { const int s = i >> 4, d0 = (i & 15) * 8; float f[8]; unpack8(*(const u32x4*)(P + (r0 + s) * LDP + C_MV + h * 128 + d0), f);
#pragma unroll
            for (int e = 0; e < 8; ++e) BT[(d0 + e) * 136 + s] = f2bf(f[e]); }
        { const bf16_t* st = ST + (size_t)item * 8192;
            for (int i = tid; i < 1024; i += 512) { const int dv = i >> 3, k0 = (i & 7) * 8; *(u32x4*)(BT + dv * 136 + 64 + k0) = *(const u32x4*)(st + dv * 64 + k0); } }
        __syncthreads();
#pragma unroll
        for (int u = 0; u < 2; ++u) {
            const int id = wave * 2 + u, tr = id >> 2, tc = id & 3;
            f32x4 acc = (f32x4){0.f, 0.f, 0.f, 0.f};
            if (tc <= tr) acc = mma_lds(QS_ + tr * 16 * 72, 72, KS + tc * 16 * 72, 72, 64, lane);
            const int s = tc * 16 + (lane & 15);
#pragma unroll
            for (int j = 0; j < 4; ++j) { const int t = tr * 16 + (lane >> 4) * 4 + j;
                const float w = (s <= t) ? acc[j] * __expf(bS[t] + aS[s] - mtS[t]) : 0.f;
                AP[t * 136 + s] = f2bf(w); }
        }
        { const int t = tid >> 3, d0 = (tid & 7) * 8; float f[8]; unpack8(*(const u32x4*)(QS_ + t * 72 + d0), f); const float w = wiS[t];
#pragma unroll
            for (int e = 0; e < 8; ++e) f[e] *= w;
            *(u32x4*)(AP + t * 136 + 64 + d0) = pack8(f); }
        __syncthreads();
#pragma unroll
        for (int tr = 0; tr < 4; ++tr) {
            const f32x4 acc = mma_lds(AP + tr * 16 * 136, 136, BT + wave * 16 * 136, 136, 128, lane);
#pragma unroll
            for (int j = 0; j < 4; ++j) OUT[(tr * 16 + (lane >> 4) * 4 + j) * 132 + wave * 16 + (lane & 15)] = acc[j];
        }
        { const int t = tid >> 3, part = tid & 7; float s = 0.f;
#pragma unroll
            for (int e = 0; e < 16; ++e) { const int k = part * 16 + e; const float v = bf1(AP[t * 136 + k]); s += (k < 64) ? v : v * nS[k - 64]; }
            s += __shfl_xor(s, 1); s += __shfl_xor(s, 2); s += __shfl_xor(s, 4);
            if (part == 0) denS[t] = s; }
        __syncthreads();
        { const int t = tid >> 3, part = tid & 7, dv0 = part * 16;
            const float den = fmaxf(fabsf(denS[t]), __expf(-mtS[t])); const float inv = 1.f / den;
            float hv[16]; float sq = 0.f;
#pragma unroll
            for (int e = 0; e < 16; ++e) { hv[e] = OUT[t * 132 + dv0 + e] * inv; sq += hv[e] * hv[e]; }
            sq += __shfl_xor(sq, 1); sq += __shfl_xor(sq, 2); sq += __shfl_xor(sq, 4);
            const float rs = rsqrtf(sq * (1.f / 128.f) + EPS);
            bf16_t* po = P + (r0 + t) * LDP + C_MO + h * 128 + dv0;
            float og[16]; unpack8(*(const u32x4*)po, og); unpack8(*(const u32x4*)(po + 8), og + 8);
#pragma unroll
            for (int e = 0; e < 16; ++e) hv[e] = hv[e] * rs * a.in[I_MHN][h * 128 + dv0 + e] * sigmoidf_(og[e]);
            *(u32x4*)po = pack8(hv); *(u32x4*)(po + 8) = pack8(hv + 8); }
        __syncthreads();
    }
}


#define XB_TMO      128
#define XB_XCNT(j)  (256  + 64 * (j))
#define XB_XSUB(j)  (1280 + 64 * (j))
#define XB_XGEN(j)  (2304 + 64 * (j))
#define XB_TOP      3328
#define XB_TOPGEN   3392
#define XCD_BAR_WORDS 3456
#define XB_SPIN_CAP (1u << 22)
__device__ __forceinline__ unsigned xb_ld(unsigned* p)              { return __hip_atomic_load(p, __ATOMIC_RELAXED, __HIP_MEMORY_SCOPE_AGENT); }
__device__ __forceinline__ unsigned xb_add(unsigned* p, unsigned v) { return __hip_atomic_fetch_add(p, v, __ATOMIC_RELAXED, __HIP_MEMORY_SCOPE_AGENT); }
__device__ __forceinline__ unsigned xb_xcc_id() { return (unsigned)__builtin_amdgcn_s_getreg((3 << 11) | 20) & 0xFu; }
#define XB_SPIN(cond, bar) do { unsigned _sp = 0; while (cond) { __builtin_amdgcn_s_sleep(1); \
    if ((++_sp & 255u) == 0u) { if (xb_ld(&(bar)[XB_TMO])) break; if (_sp > XB_SPIN_CAP) { atomicAdd(&(bar)[XB_TMO], 1u); break; } } } } while (0)
struct XcdBarrier { unsigned* bar; unsigned x; volatile LAS unsigned* st; };
__device__ __forceinline__ XcdBarrier xcd_barrier_post(unsigned* bar, volatile LAS unsigned* st) {
    XcdBarrier b; b.bar = bar; b.x = xb_xcc_id(); b.st = st;
    if (threadIdx.x == 0) (void)xb_add(&bar[XB_XCNT(b.x)], 1u);
    return b;
}
__device__ __forceinline__ void xcd_barrier_complete(unsigned* bar, unsigned x, unsigned& nloc, unsigned& nx) {
    const unsigned G = gridDim.x * gridDim.y * gridDim.z;
    unsigned sum, cnt, mine, sp = 0u;
    for (;;) {
        sum = 0u; cnt = 0u; mine = 0u;
#pragma unroll
        for (unsigned j = 0; j < 16; ++j) { const unsigned c = xb_ld(&bar[XB_XCNT(j)]); sum += c; cnt += (c > 0u) ? 1u : 0u; mine = (j == x) ? c : mine; }
        if (sum == G) break;
        __builtin_amdgcn_s_sleep(1);
        if ((++sp & 255u) == 0u) { if (xb_ld(&bar[XB_TMO])) break; if (sp > XB_SPIN_CAP) { atomicAdd(&bar[XB_TMO], 1u); break; } }
    }
    nloc = mine > 0u ? mine : 1u; nx = cnt > 0u ? cnt : 1u;
}
__device__ __forceinline__ void xcd_barrier(const XcdBarrier& b) {
    asm volatile("s_waitcnt vmcnt(0)" ::: "memory");
    __syncthreads();
    if (threadIdx.x == 0) {
        unsigned* bar = b.bar;
        __builtin_amdgcn_s_waitcnt(0);
        unsigned nloc = b.st[0], nx = b.st[1];
        if (nloc == 0u) { xcd_barrier_complete(bar, b.x, nloc, nx); b.st[0] = nloc; b.st[1] = nx; }
        const unsigned old = xb_add(&bar[XB_XSUB(b.x)], 1u);
        const unsigned gen = old / nloc;
        if (old + 1u == (gen + 1u) * nloc) {
            __builtin_amdgcn_fence(__ATOMIC_RELEASE, "agent");
            asm volatile("s_waitcnt vmcnt(0)" ::: "memory");
            const unsigned og = xb_add(&bar[XB_TOP], 1u);
            const unsigned tg = og / nx;
            if (og + 1u == (tg + 1u) * nx) xb_add(&bar[XB_TOPGEN], 1u);
            else XB_SPIN(xb_ld(&bar[XB_TOPGEN]) == tg, bar);
            __builtin_amdgcn_fence(__ATOMIC_ACQUIRE, "agent");
            xb_add(&bar[XB_XGEN(b.x)], 1u);
            asm volatile("s_waitcnt vmcnt(0)" ::: "memory");
        } else {
            XB_SPIN(xb_ld(&bar[XB_XGEN(b.x)]) == gen, bar);
            __builtin_amdgcn_fence(__ATOMIC_ACQUIRE, "agent");
            asm volatile("s_waitcnt vmcnt(0)" ::: "memory");
        }
    }
    __syncthreads();
}

#ifndef DBG_ZERO_YA
#define DBG_ZERO_YA 1
#endif
#ifndef PH
#define PH 0xFFFF
#endif
__global__ void __launch_bounds__(512, 2) mega_fwd(Args a) {
    extern __shared__ __attribute__((aligned(16))) unsigned char lds[];
    cg::grid_group grid = cg::this_grid();
    LAS unsigned char* ldsl = (LAS unsigned char*)lds;
    unsigned char* ws = a.ws;
    const int G = gridDim.x, bid = blockIdx.x;
    bf16_t* XB = (bf16_t*)(ws + WS_XB); bf16_t* Pb = (bf16_t*)(ws + WS_P); bf16_t* MG = (bf16_t*)(ws + WS_MG); bf16_t* QKb = (bf16_t*)(ws + WS_QK);
    float* ss0 = (float*)(ws + WS_SS0); float* ss1 = (float*)(ws + WS_SS1); float* ss2 = (float*)(ws + WS_SS2);

    unsigned* barw = (unsigned*)(ws + WS_BAR);
    volatile LAS unsigned* bst = (volatile LAS unsigned*)(ldsl + LDS_BYTES - 16);
    if (threadIdx.x == 0) { bst[0] = 0u; bst[1] = 0u; }
    const XcdBarrier xbar = xcd_barrier_post(barw, bst);
    if (PH & 1) phase0(a, lds);
    if (a.ws == nullptr) grid.sync();
    xcd_barrier(xbar);
    if (PH & 2) {
        pg8::Gemm g{XB, (const bf16_t*)(ws + WS_W1), DM, DM, MROWS, 2 * FF, DM}; pg8::StaticOrder S; S.init(MROWS, 2 * FF, G, bid);
        pg8::EpiSwiGLU E{Pb, ss0}; pg8::gemm_phase(ldsl, g, S, E);
    }
    xcd_barrier(xbar);
    if (PH & 4) {
        pg8::Gemm g{Pb, (const bf16_t*)(ws + WS_W2), FF, FF, MROWS, DM, FF}; pg8::StaticOrder S; S.init(MROWS, DM, G, bid);
        pg8::EpiRes<false, false, true> E{a.in[I_X], nullptr, nullptr, XB, (bf16_t*)a.out, ss1, 0.5f}; pg8::gemm_phase(ldsl, g, S, E);
    }
    xcd_barrier(xbar);
    if (PH & 8) {
        pg8::Gemm g{XB, (const bf16_t*)(ws + WS_WIN), DM, DM, MROWS, LDP, DM}; pg8::StaticOrder S; S.init(MROWS, LDP, G, bid);
        pg8::EpiP E{Pb, (float*)(ws + WS_SM), ss1}; pg8::gemm_phase(ldsl, g, S, E);
    }
    xcd_barrier(xbar);
    if (PH & 16) phase_postp(a);
    xcd_barrier(xbar);
    if (PH & 32) {
        pg8::Gemm g{XB, (const bf16_t*)(ws + WS_WQK), 512, 512, MROWS, 512, 512}; pg8::StaticOrder S; S.init(MROWS, 512, G, bid);
        pg8::EpiBf16 E{QKb, 512}; pg8::gemm_phase(ldsl, g, S, E);
    }
    xcd_barrier(xbar);
    if (PH & 64) phase_mlstm_a(a, lds);
    xcd_barrier(xbar);
    if (PH & 128) phase_mlstm_b(a);
    xcd_barrier(xbar);
    if (PH & 256) phase_mlstm_c(a, lds);
    if (DBG_TWICE & 1) phase_dsa<true>(a, lds);
    if (PH & 512) phase_dsa<false>(a, lds);
    xcd_barrier(xbar);
    if (PH & 1024) {
        pg8::StaticOrder S; S.init(MROWS, DM, G, bid);
        { pg8::Gemm g{Pb + C_AQ, (const bf16_t*)(ws + WS_WA), LDP, 512, MROWS, DM, 512}; pg8::EpiMerge<0> E{Pb, MG, C_GA}; pg8::gemm_phase(ldsl, g, S, E); }
        { pg8::Gemm g{Pb + C_MO, (const bf16_t*)(ws + WS_WB), LDP, 512, MROWS, DM, 512}; pg8::EpiMerge<1> E{Pb, MG, C_GB}; pg8::gemm_phase(ldsl, g, S, E); }
    }
    xcd_barrier(xbar);
    if (PH & 2048) {
        pg8::Gemm g{MG, (const bf16_t*)(ws + WS_WO), DM, DM, MROWS, DM, DM}; pg8::StaticOrder S; S.init(MROWS, DM, G, bid);
        pg8::EpiRes<true, false, true> E{nullptr, (const bf16_t*)a.out, nullptr, XB, nullptr, ss2, 1.0f}; pg8::gemm_phase(ldsl, g, S, E);
    }
    xcd_barrier(xbar);
    if (PH & 4096) {
        pg8::Gemm g{XB, (const bf16_t*)(ws + WS_W3), DM, DM, MROWS, 2 * FF, DM}; pg8::StaticOrder S; S.init(MROWS, 2 * FF, G, bid);
        pg8::EpiSwiGLU E{Pb, ss2}; pg8::gemm_phase(ldsl, g, S, E);
    }
    xcd_barrier(xbar);
    if (PH & 8192) {
        pg8::Gemm g{Pb, (const bf16_t*)(ws + WS_W4), FF, FF, MROWS, DM, FF}; pg8::StaticOrder S; S.init(MROWS, DM, G, bid);
        pg8::EpiRes<true, true, false> E{nullptr, XB, a.out, nullptr, nullptr, nullptr, 0.5f}; pg8::gemm_phase(ldsl, g, S, E);
    }
}

extern "C" void kernel_launch(void* const* d_in, const int* in_sizes, int n_in, void* d_out, int out_size, void* d_ws, size_t ws_size, hipStream_t stream) {
    static int grid = 0;
    if (grid == 0) {
        if (n_in != 24 || ws_size < WS_END) { fprintf(stderr, "kernel_launch: unexpected n_in %d / ws %zu\n", n_in, ws_size); grid = -1; return; }
        int dev = 0, cus = 0, per_cu = 0;
        hipGetDevice(&dev);
        hipDeviceGetAttribute(&cus, hipDeviceAttributeMultiprocessorCount, dev);
        hipFuncSetAttribute((const void*)mega_fwd, hipFuncAttributeMaxDynamicSharedMemorySize, LDS_BYTES);
        hipOccupancyMaxActiveBlocksPerMultiprocessor(&per_cu, (const void*)mega_fwd, 512, LDS_BYTES);
        if (per_cu < 1) { fprintf(stderr, "kernel_launch: occupancy query says %d blocks/CU\n", per_cu); per_cu = 1; }
        (void)hipGetLastError();
        grid = cus * per_cu;
    }
    if (grid < 0) return;
    Args a{};
    for (int i = 0; i < 24; ++i) a.in[i] = (const float*)d_in[i];
    a.out = (float*)d_out; a.ws = (unsigned char*)d_ws;
    (void)hipMemsetAsync((char*)d_ws + WS_BAR, 0, XCD_BAR_WORDS * sizeof(unsigned), stream);
    void* args[] = {&a};
    hipError_t e = hipLaunchCooperativeKernel((const void*)mega_fwd, dim3(grid), dim3(512), args, LDS_BYTES, stream);
    if (e != hipSuccess) fprintf(stderr, "cooperative launch failed: %s (grid %d)\n", hipGetErrorString(e), grid);
}
```
